# Optimizing an MI355X kernel written in HIP

```python
import math
import jax, jax.numpy as jnp
from jax import lax
import numpy as np

D_MODEL = 1024
BATCH = 8
SEQ = 2048
DEPTH = 2

N_EVEN = (DEPTH + 1) // 2
N_ODD = DEPTH // 2
D_MIX = 2 * D_MODEL
HEAD_DIM = 64
SSD_WIDTH = D_MIX // 2
SSD_HEADS = SSD_WIDTH // HEAD_DIM
SSD_GROUPS = 2
SSD_STATE = 128
SSD_CONV = 4
SSD_CHUNK = 128
SSD_CONV_CH = SSD_WIDTH + 2 * SSD_GROUPS * SSD_STATE
MOBA_WIDTH = D_MIX - SSD_WIDTH
MOBA_HEADS = MOBA_WIDTH // HEAD_DIM
MOBA_BLOCK = 256
MOBA_TOPK = 3
MOBA_Q_CHUNK = 32
FOX_WIDTH = 3 * D_MIX // 4
FOX_HEADS = FOX_WIDTH // HEAD_DIM
FOX_Q_BLOCK = 128
S5_WIDTH = D_MIX - FOX_WIDTH
S5_GROUP = 16
S5_GROUPS = S5_WIDTH // S5_GROUP
S5_STATE = 64
EVEN_PROJ = D_MIX + SSD_CONV_CH + SSD_HEADS + 3 * MOBA_WIDTH
ODD_PROJ = D_MIX + 3 * FOX_WIDTH + FOX_HEADS + S5_WIDTH
RMS_EPS = 1e-6

kernel_name = "hybrid_ssd_moba_fox_s5_trunk"


def rmsnorm(x, g):
    xf = x.astype(jnp.float32)
    xf = xf * lax.rsqrt(jnp.mean(xf * xf, axis=-1, keepdims=True) + RMS_EPS)
    return (xf * g.astype(jnp.float32)).astype(x.dtype)


def split_cols(t, widths):
    offs = np.cumsum(widths)[:-1].tolist()
    return jnp.split(t, offs, axis=-1)


def causal_dwconv(u, w, b):
    ch = u.shape[-1]
    out = lax.conv_general_dilated(u, w[:, None, :].astype(u.dtype), window_strides=(1,),
                                   padding=[(w.shape[0] - 1, 0)],
                                   dimension_numbers=('NWC', 'WIO', 'NWC'),
                                   feature_group_count=ch)
    return out + b.astype(u.dtype)


def segsum(a):
    T = a.shape[-1]
    ar = jnp.broadcast_to(a[..., None], a.shape + (T,))
    ar = jnp.where(jnp.tril(jnp.ones((T, T), bool), -1), ar, 0.0)
    cs = jnp.cumsum(ar, axis=-2)
    return jnp.where(jnp.tril(jnp.ones((T, T), bool)), cs, -jnp.inf)


def ssd_chunked(xs, dt, a, b_in, c_in):
    Bsz, L, H, P = xs.shape
    G, N = b_in.shape[2], b_in.shape[3]
    R = H // G
    nc = L // SSD_CHUNK
    x = (xs.astype(jnp.float32) * dt[..., None]).reshape(Bsz, nc, SSD_CHUNK, G, R, P)
    adt = (dt * a).reshape(Bsz, nc, SSD_CHUNK, G, R).transpose(0, 3, 4, 1, 2)
    Bc = b_in.astype(jnp.float32).reshape(Bsz, nc, SSD_CHUNK, G, N)
    Cc = c_in.astype(jnp.float32).reshape(Bsz, nc, SSD_CHUNK, G, N)
    a_cum = jnp.cumsum(adt, axis=-1)
    decay_in = jnp.exp(segsum(adt))
    cb = jnp.einsum('bclgn,bcsgn->bgcls', Cc, Bc)[:, :, None]
    y_diag = jnp.einsum('bgrcls,bcsgrp->bclgrp', cb * decay_in, x)
    decay_states = jnp.exp(a_cum[..., -1:] - a_cum)
    states = jnp.einsum('bclgn,bgrcl,bclgrp->bcgrpn', Bc, decay_states, x)
    a_last = jnp.pad(a_cum[..., -1], ((0, 0), (0, 0), (0, 0), (1, 0)))
    decay_chunk = jnp.exp(segsum(a_last))
    states0 = jnp.concatenate([jnp.zeros_like(states[:, :1]), states], axis=1)
    new_states = jnp.einsum('bgrzc,bcgrpn->bzgrpn', decay_chunk, states0)
    prev_states = new_states[:, :-1]
    y_off = jnp.einsum('bclgn,bcgrpn,bgrcl->bclgrp', Cc, prev_states, jnp.exp(a_cum))
    return (y_diag + y_off).reshape(Bsz, L, H, P)


def moba_attention(q, k, v):
    Bsz, L, H, Dh = q.shape
    nb = -(-L // MOBA_BLOCK)
    pad = nb * MOBA_BLOCK - L
    kp = jnp.pad(k, ((0, 0), (0, pad), (0, 0), (0, 0)))
    vp = jnp.pad(v, ((0, 0), (0, pad), (0, 0), (0, 0)))
    kb = kp.reshape(Bsz, nb, MOBA_BLOCK, H, Dh).transpose(0, 3, 1, 2, 4)
    vb = vp.reshape(Bsz, nb, MOBA_BLOCK, H, Dh).transpose(0, 3, 1, 2, 4)
    kbar = jnp.mean(kb.astype(jnp.float32), axis=3)
    qh = q.transpose(0, 2, 1, 3)
    gate = jnp.einsum('bhqd,bhnd->bhqn', qh.astype(jnp.float32), kbar)
    pos = jnp.arange(L, dtype=jnp.int32)
    qblk = pos // MOBA_BLOCK
    past = jnp.arange(nb, dtype=jnp.int32)[None, :] < qblk[:, None]
    gate = jnp.where(past, gate, -jnp.inf)
    n_top = min(MOBA_TOPK, nb)
    _, top_idx = lax.top_k(gate, n_top)
    own = jnp.broadcast_to(qblk[None, None, :, None], (Bsz, H, L, 1)).astype(top_idx.dtype)
    sel = jnp.concatenate([top_idx, own], axis=-1)
    nsel = n_top + 1
    sel_ok = jnp.concatenate([jnp.arange(n_top, dtype=jnp.int32)[None, :] < qblk[:, None],
                              jnp.ones((L, 1), bool)], axis=-1)
    nc = L // MOBA_Q_CHUNK
    scale = 1.0 / math.sqrt(Dh)
    gather = jax.vmap(jax.vmap(lambda blocks, ids: blocks[ids]))
    offs = jnp.arange(MOBA_BLOCK, dtype=jnp.int32)

    def chunk(args):
        qc, selc, okc, posc = args
        kg = gather(kb, selc)
        vg = gather(vb, selc)
        s = jnp.einsum('bhqd,bhqjpd->bhqjp', qc, kg).astype(jnp.float32) * scale
        kpos = selc[..., None] * MOBA_BLOCK + offs
        mask = okc[None, None, :, :, None] & (kpos <= posc[None, None, :, None, None])
        s = jnp.where(mask, s, -jnp.inf)
        p = jax.nn.softmax(s.reshape(Bsz, H, MOBA_Q_CHUNK, nsel * MOBA_BLOCK), axis=-1).reshape(s.shape)
        return jnp.einsum('bhqjp,bhqjpd->bhqd', p.astype(vg.dtype), vg)

    xs = (qh.reshape(Bsz, H, nc, MOBA_Q_CHUNK, Dh).transpose(2, 0, 1, 3, 4),
          sel.reshape(Bsz, H, nc, MOBA_Q_CHUNK, nsel).transpose(2, 0, 1, 3, 4),
          sel_ok.reshape(nc, MOBA_Q_CHUNK, nsel),
          pos.reshape(nc, MOBA_Q_CHUNK))
    out = lax.map(chunk, xs)
    return out.transpose(1, 0, 3, 2, 4).reshape(Bsz, L, H, Dh)


def forgetting_attention(q, k, v, log_f):
    Bsz, L, H, Dh = q.shape
    F = jnp.cumsum(log_f, axis=1).transpose(0, 2, 1)
    qh = q.transpose(0, 2, 1, 3)
    kh = k.transpose(0, 2, 1, 3)
    vh = v.transpose(0, 2, 1, 3)
    nq = L // FOX_Q_BLOCK
    kpos = jnp.arange(L, dtype=jnp.int32)
    scale = 1.0 / math.sqrt(Dh)

    def block(args):
        qc, Fc, posc = args
        s = jnp.einsum('bhqd,bhsd->bhqs', qc, kh).astype(jnp.float32) * scale
        s = s + Fc[..., None] - F[:, :, None, :]
        s = jnp.where(posc[:, None] >= kpos[None, :], s, -jnp.inf)
        p = jax.nn.softmax(s, axis=-1)
        return jnp.einsum('bhqs,bhsd->bhqd', p.astype(vh.dtype), vh)

    xs = (qh.reshape(Bsz, H, nq, FOX_Q_BLOCK, Dh).transpose(2, 0, 1, 3, 4),
          F.reshape(Bsz, H, nq, FOX_Q_BLOCK).transpose(2, 0, 1, 3),
          kpos.reshape(nq, FOX_Q_BLOCK))
    out = lax.map(block, xs)
    return out.transpose(1, 0, 3, 2, 4).reshape(Bsz, L, H, Dh)


def _complex_affine_combine(e1, e2):
    a1r, a1i, b1r, b1i = e1
    a2r, a2i, b2r, b2i = e2
    return (a2r * a1r - a2i * a1i,
            a2r * a1i + a2i * a1r,
            a2r * b1r - a2i * b1i + b2r,
            a2r * b1i + a2i * b1r + b2i)


def s5_ssm(u, lam_re, lam_im, log_dt, b_re, b_im, c_re, c_im, d_skip):
    Bsz, L, W = u.shape
    uf = u.astype(jnp.float32).reshape(Bsz, L, S5_GROUPS, S5_GROUP)
    dt = jnp.exp(log_dt.astype(jnp.float32))[:, None]
    lr = lam_re.astype(jnp.float32)
    li = lam_im.astype(jnp.float32)
    mag = jnp.exp(lr * dt)
    ar = mag * jnp.cos(li * dt)
    ai = mag * jnp.sin(li * dt)
    den = lr * lr + li * li
    qr = ((ar - 1.0) * lr + ai * li) / den
    qi = (ai * lr - (ar - 1.0) * li) / den
    br = b_re.astype(jnp.float32)
    bi = b_im.astype(jnp.float32)
    bbr = qr[..., None] * br - qi[..., None] * bi
    bbi = qr[..., None] * bi + qi[..., None] * br
    bu_r = jnp.einsum('blgc,gnc->blgn', uf, bbr)
    bu_i = jnp.einsum('blgc,gnc->blgn', uf, bbi)
    a_r = jnp.broadcast_to(ar[None, None], (1, L, S5_GROUPS, S5_STATE))
    a_i = jnp.broadcast_to(ai[None, None], (1, L, S5_GROUPS, S5_STATE))
    _, _, sr, si = lax.associative_scan(_complex_affine_combine, (a_r, a_i, bu_r, bu_i), axis=1)
    y = (jnp.einsum('blgn,gcn->blgc', sr, c_re.astype(jnp.float32))
         - jnp.einsum('blgn,gcn->blgc', si, c_im.astype(jnp.float32)))
    return y.reshape(Bsz, L, W) + d_skip.astype(jnp.float32) * uf.reshape(Bsz, L, W)


def even_mixer(h, in_w, conv_w, conv_b, dt_bias, a_log, d_skip, norm_g, out_w):
    Bsz, L, _ = h.shape
    proj = h @ in_w
    z_a, z_b, xbc, dt_raw, q, k, v = split_cols(
        proj, [SSD_WIDTH, MOBA_WIDTH, SSD_CONV_CH, SSD_HEADS, MOBA_WIDTH, MOBA_WIDTH, MOBA_WIDTH])
    xbc = jax.nn.silu(causal_dwconv(xbc, conv_w, conv_b))
    xs, b_in, c_in = split_cols(xbc, [SSD_WIDTH, SSD_GROUPS * SSD_STATE, SSD_GROUPS * SSD_STATE])
    xs = xs.reshape(Bsz, L, SSD_HEADS, HEAD_DIM)
    b_in = b_in.reshape(Bsz, L, SSD_GROUPS, SSD_STATE)
    c_in = c_in.reshape(Bsz, L, SSD_GROUPS, SSD_STATE)
    dt = jax.nn.softplus(dt_raw.astype(jnp.float32) + dt_bias.astype(jnp.float32))
    a = -jnp.exp(a_log.astype(jnp.float32))
    y_a = ssd_chunked(xs, dt, a, b_in, c_in) + d_skip.astype(jnp.float32)[:, None] * xs.astype(jnp.float32)
    y_a = y_a.reshape(Bsz, L, SSD_WIDTH) * jax.nn.silu(z_a.astype(jnp.float32))
    y_a = rmsnorm(y_a, norm_g).astype(h.dtype)
    y_b = moba_attention(q.reshape(Bsz, L, MOBA_HEADS, HEAD_DIM),
                         k.reshape(Bsz, L, MOBA_HEADS, HEAD_DIM),
                         v.reshape(Bsz, L, MOBA_HEADS, HEAD_DIM)).reshape(Bsz, L, MOBA_WIDTH)
    y_b = y_b.astype(h.dtype) * jax.nn.silu(z_b)
    return jnp.concatenate([y_a, y_b], axis=-1) @ out_w


def odd_mixer(h, in_w, fgate_b, lam_re, lam_im, log_dt, b_re, b_im, c_re, c_im, d_skip, glu_w, glu_b, out_w):
    Bsz, L, _ = h.shape
    proj = h @ in_w
    z_c, z_d, q, k, v, f_raw, u = split_cols(
        proj, [FOX_WIDTH, S5_WIDTH, FOX_WIDTH, FOX_WIDTH, FOX_WIDTH, FOX_HEADS, S5_WIDTH])
    log_f = jax.nn.log_sigmoid(f_raw.astype(jnp.float32) + fgate_b.astype(jnp.float32))
    y_c = forgetting_attention(q.reshape(Bsz, L, FOX_HEADS, HEAD_DIM),
                               k.reshape(Bsz, L, FOX_HEADS, HEAD_DIM),
                               v.reshape(Bsz, L, FOX_HEADS, HEAD_DIM), log_f).reshape(Bsz, L, FOX_WIDTH)
    y_c = y_c.astype(h.dtype) * jax.nn.silu(z_c)
    y_d = jax.nn.gelu(s5_ssm(u, lam_re, lam_im, log_dt, b_re, b_im, c_re, c_im, d_skip))
    y_d = y_d * jax.nn.sigmoid(y_d @ glu_w.astype(jnp.float32) + glu_b.astype(jnp.float32))
    y_d = y_d.astype(h.dtype) * jax.nn.silu(z_d)
    return jnp.concatenate([y_c, y_d], axis=-1) @ out_w


def setup_inputs(seed: int = 0) -> dict:
    key = jax.random.key(seed)
    ks = iter(jax.random.split(key, 40))
    f32 = jnp.float32

    def nrm(shape, s):
        return s * jax.random.normal(next(ks), shape, f32)

    def unif(shape, lo, hi):
        return jax.random.uniform(next(ks), shape, f32, lo, hi)

    x = nrm((BATCH, SEQ, D_MODEL), 1.0)
    c = nrm((BATCH, D_MODEL), 1.0)
    ada_w = nrm((DEPTH, D_MODEL, 3 * D_MODEL), 0.5 * D_MODEL ** -0.5)
    ada_b = nrm((DEPTH, 3 * D_MODEL), 0.02)
    pre_g = 1.0 + nrm((DEPTH, D_MODEL), 0.02)
    post_g = 1.0 + nrm((DEPTH, D_MODEL), 0.02)
    even_in_w = nrm((N_EVEN, D_MODEL, EVEN_PROJ), D_MODEL ** -0.5)
    even_conv_w = nrm((N_EVEN, SSD_CONV, SSD_CONV_CH), SSD_CONV ** -0.5)
    even_conv_b = nrm((N_EVEN, SSD_CONV_CH), 0.02)
    dt0 = jnp.exp(unif((N_EVEN, SSD_HEADS), math.log(1e-3), math.log(1e-1)))
    even_dt_bias = dt0 + jnp.log(-jnp.expm1(-dt0))
    even_a_log = jnp.log(unif((N_EVEN, SSD_HEADS), 1.0, 16.0))
    even_d_skip = 1.0 + nrm((N_EVEN, SSD_HEADS), 0.1)
    even_norm_g = 1.0 + nrm((N_EVEN, SSD_WIDTH), 0.02)
    even_out_w = nrm((N_EVEN, D_MIX, D_MODEL), D_MIX ** -0.5)
    odd_in_w = nrm((N_ODD, D_MODEL, ODD_PROJ), D_MODEL ** -0.5)
    odd_fgate_b = 1.0 + nrm((N_ODD, FOX_HEADS), 0.5)
    odd_lam_re = -0.5 + nrm((N_ODD, S5_GROUPS, S5_STATE), 0.01)
    odd_lam_im = jnp.pi * jnp.arange(S5_STATE, dtype=f32) + nrm((N_ODD, S5_GROUPS, S5_STATE), 0.01)
    odd_log_dt = unif((N_ODD, S5_GROUPS), math.log(1e-3), math.log(1e-1))
    odd_b_re = nrm((N_ODD, S5_GROUPS, S5_STATE, S5_GROUP), (2 * S5_GROUP) ** -0.5)
    odd_b_im = nrm((N_ODD, S5_GROUPS, S5_STATE, S5_GROUP), (2 * S5_GROUP) ** -0.5)
    odd_c_re = nrm((N_ODD, S5_GROUPS, S5_GROUP, S5_STATE), (2 * S5_STATE) ** -0.5)
    odd_c_im = nrm((N_ODD, S5_GROUPS, S5_GROUP, S5_STATE), (2 * S5_STATE) ** -0.5)
    odd_d_skip = nrm((N_ODD, S5_WIDTH), 1.0)
    odd_glu_w = nrm((N_ODD, S5_WIDTH, S5_WIDTH), S5_WIDTH ** -0.5)
    odd_glu_b = nrm((N_ODD, S5_WIDTH), 0.02)
    odd_out_w = nrm((N_ODD, D_MIX, D_MODEL), D_MIX ** -0.5)
    return {"x": x, "c": c, "ada_w": ada_w, "ada_b": ada_b, "pre_g": pre_g, "post_g": post_g,
            "even_in_w": even_in_w, "even_conv_w": even_conv_w, "even_conv_b": even_conv_b,
            "even_dt_bias": even_dt_bias, "even_a_log": even_a_log, "even_d_skip": even_d_skip,
            "even_norm_g": even_norm_g, "even_out_w": even_out_w,
            "odd_in_w": odd_in_w, "odd_fgate_b": odd_fgate_b, "odd_lam_re": odd_lam_re,
            "odd_lam_im": odd_lam_im, "odd_log_dt": odd_log_dt, "odd_b_re": odd_b_re,
            "odd_b_im": odd_b_im, "odd_c_re": odd_c_re, "odd_c_im": odd_c_im,
            "odd_d_skip": odd_d_skip, "odd_glu_w": odd_glu_w, "odd_glu_b": odd_glu_b,
            "odd_out_w": odd_out_w}


def reference(x, c, ada_w, ada_b, pre_g, post_g,
              even_in_w, even_conv_w, even_conv_b, even_dt_bias, even_a_log, even_d_skip,
              even_norm_g, even_out_w,
              odd_in_w, odd_fgate_b, odd_lam_re, odd_lam_im, odd_log_dt, odd_b_re, odd_b_im,
              odd_c_re, odd_c_im, odd_d_skip, odd_glu_w, odd_glu_b, odd_out_w):
    cond = jax.nn.silu(c)
    for layer in range(DEPTH):
        mod = cond @ ada_w[layer] + ada_b[layer]
        shift, scale, gate = jnp.split(mod, 3, axis=-1)
        h = rmsnorm(x, pre_g[layer]) * (1.0 + scale[:, None, :]) + shift[:, None, :]
        i = layer // 2
        if layer % 2 == 0:
            y = even_mixer(h, even_in_w[i], even_conv_w[i], even_conv_b[i], even_dt_bias[i],
                           even_a_log[i], even_d_skip[i], even_norm_g[i], even_out_w[i])
        else:
            y = odd_mixer(h, odd_in_w[i], odd_fgate_b[i], odd_lam_re[i], odd_lam_im[i], odd_log_dt[i],
                          odd_b_re[i], odd_b_im[i], odd_c_re[i], odd_c_im[i], odd_d_skip[i],
                          odd_glu_w[i], odd_glu_b[i], odd_out_w[i])
        x = x + gate[:, None, :] * rmsnorm(y, post_g[layer])
    return x
```

```cpp
#include <hip/hip_runtime.h>
#include <hip/hip_cooperative_groups.h>
#include <cstdio>
#include <cstdint>
namespace cg = cooperative_groups;
__device__ __forceinline__ int opaque_tid() { int t = threadIdx.x; asm volatile("" : "+v"(t)); return t; }
namespace pg8 {
#define PG8_LAS __attribute__((address_space(3)))
typedef unsigned short bf16_t;
typedef short bf16x8 __attribute__((ext_vector_type(8)));
typedef float f32x4 __attribute__((ext_vector_type(4)));
typedef unsigned u32x4 __attribute__((ext_vector_type(4)));
constexpr int BM = 256, BK = 64, HALF = 128, HTB = HALF * BK * 2  , STAGE_BYTES = 8 * HTB, NXCD = 8, WGM = 8;

__host__ __device__ __forceinline__ int lds_byte(int r, int c) { const int st = (r >> 4) * 2 + (c >> 5), rr = r & 15, cc = c & 31, ob = rr * 64 + cc * 2; return st * 1024 + (ob ^ (((ob >> 9) & 1) << 5)); }
__host__ __device__ __forceinline__ void stage_rc(int b, int& R, int& C) { const int st = b / 1024, sb = b % 1024, swz = sb ^ (((sb >> 9) & 1) << 5); R = (st >> 1) * 16 + swz / 64; C = (st & 1) * 32 + (swz % 64) / 2; }
__host__ __device__ __forceinline__ int perm32(int rho) { const int n = rho >> 4, i = rho & 15; return 8 * (i >> 2) + 4 * n + (i & 3); }

struct Unit { int pm, pn; };
struct Gemm { const bf16_t* A; const bf16_t* Bt; int M, N, K, lda, ldb, ksplit; };

struct StaticOrder {
    int nM, nN, nwg, G, c;
    __host__ __device__ __forceinline__ void init(int M, int N, int G_, int c_) { nM = M / BM; nN = N / BM; nwg = nM * nN; G = G_; c = c_; }
    __host__ __device__ __forceinline__ bool next(int i, Unit& u) const {
        const long L = (long)i * G + c; if (L >= nwg) return false;
        int wgid = (int)L; { const int q = nwg / NXCD, r = nwg % NXCD, xcd = wgid % NXCD, off = wgid / NXCD; wgid = (xcd < r ? xcd * (q + 1) : r * (q + 1) + (xcd - r) * q) + off; }
        const int nig = WGM * nN, gid = wgid / nig, fm = gid * WGM, gsz = (nM - fm) < WGM ? (nM - fm) : WGM;
        u.pm = fm + ((wgid % nig) % gsz); u.pn = (wgid % nig) / gsz; return true;
    }
    __device__ __forceinline__ void a_ready(const Unit&) const {}
    __device__ __forceinline__ void done(const Unit&) const {}
};

__device__ __forceinline__ unsigned cvt_pk_bf16(float lo, float hi) { unsigned r; asm volatile("v_cvt_pk_bf16_f32 %0, %1, %2" : "=v"(r) : "v"(lo), "v"(hi)); return r; }
__device__ __forceinline__ float bflo(unsigned w) { return __uint_as_float(w << 16); }
__device__ __forceinline__ float bfhi(unsigned w) { return __uint_as_float(w & 0xffff0000u); }
__device__ __forceinline__ float softplus_f(float x) { return x > 20.f ? x : log1pf(__expf(x)); }
__device__ __forceinline__ float sigmoid_f(float x) { return 1.f / (1.f + __expf(-x)); }
constexpr int MROWS_ = 16384;
template <int MODE> struct EpiX {
    static constexpr bool PERM = true, AFTER_DRAIN = false; static constexpr int MIDT = (MODE == 5) ? 16 : -1;
    bf16_t* O; int ldc; const float* bias; float* F32O; const bf16_t* Y; const bf16_t* Zp; float qscale;
    __device__ __forceinline__ void mid(f32x4 (&acc)[2][2][4][2], int wr, int fr, PG8_LAS unsigned char* lds) const {
        const PG8_LAS float* rs = (const PG8_LAS float*)(lds + 131072);
#pragma unroll
        for (int ai = 0; ai < 2; ++ai)
#pragma unroll
            for (int m = 0; m < 4; ++m) { const float r = rs[ai * HALF + wr * 64 + m * 16 + fr];
#pragma unroll
                for (int bj = 0; bj < 2; ++bj)
#pragma unroll
                    for (int n = 0; n < 2; ++n) acc[ai][bj][m][n] = acc[ai][bj][m][n] * r; }
    }
    __device__ __forceinline__ void operator()(const f32x4 (&acc)[2][2][4][2], const Unit& u, int wr, int wc, int fr, int fq) const {
        const int row0 = u.pm * BM + wr * 64 + fr; const int col0 = u.pn * BM + wc * 32 + 8 * fq;
        float sc = 1.f;
        if (MODE == 0) { if (u.pn >= 4 && u.pn < 8) sc = qscale; }
        if (MODE == 1) { if (u.pn < 6) sc = qscale; }
        const bool special = (MODE == 0 && u.pn == 26);
#pragma unroll
        for (int ai = 0; ai < 2; ++ai)
#pragma unroll
            for (int m = 0; m < 4; ++m) { const int row = row0 + ai * HALF + m * 16;
#pragma unroll
                for (int bj = 0; bj < 2; ++bj) { f32x4 v0 = acc[ai][bj][m][0], v1 = acc[ai][bj][m][1]; const int col = col0 + bj * HALF;
                    if (MODE == 0 || MODE == 1) {
                        if (!special) { v0 = v0 * sc; v1 = v1 * sc; u32x4 w; w.x = cvt_pk_bf16(v0[0], v0[1]); w.y = cvt_pk_bf16(v0[2], v0[3]); w.z = cvt_pk_bf16(v1[0], v1[1]); w.w = cvt_pk_bf16(v1[2], v1[3]);
                            *(u32x4*)(O + (size_t)row * ldc + col) = w; }
                        else { const int lc = col - u.pn * BM; const int NV = (MODE == 0) ? 16 : 24;
                            if (lc < NV) { f32x4 o0, o1;
#pragma unroll
                                for (int i = 0; i < 4; ++i) { const float a0 = v0[i] + bias[lc + i], a1 = v1[i] + bias[lc + 4 + i];
                                    if (MODE == 0) { o0[i] = softplus_f(a0); o1[i] = softplus_f(a1); } else { o0[i] = -softplus_f(-a0); o1[i] = -softplus_f(-a1); } }
                                *(f32x4*)(F32O + (size_t)row * NV + lc) = o0; *(f32x4*)(F32O + (size_t)row * NV + lc + 4) = o1; } }
                    } else if (MODE == 4) {
                        const int lc = col - u.pn * BM;
                        if (lc < 24) { float* dst = (u.pn == 0 ? F32O : (float*)((unsigned char*)Y + (size_t)(u.pn - 1) * (MROWS_ * 24 * 4))) + (size_t)row * 24 + lc; *(f32x4*)dst = v0; *(f32x4*)(dst + 4) = v1; }
                    } else if (MODE == 2 || MODE == 5) {
                        u32x4 w; w.x = cvt_pk_bf16(v0[0], v0[1]); w.y = cvt_pk_bf16(v0[2], v0[3]); w.z = cvt_pk_bf16(v1[0], v1[1]); w.w = cvt_pk_bf16(v1[2], v1[3]);
                        *(u32x4*)(O + (size_t)row * ldc + col) = w;
                    } else {
                        const u32x4 yv = *(const u32x4*)(Y + (size_t)row * 2048 + col); const u32x4 zv = *(const u32x4*)(Zp + (size_t)row * ldc + col);
                        const f32x4 b0 = *(const f32x4*)(bias + col), b1 = *(const f32x4*)(bias + col + 4);
                        float r[8];
#pragma unroll
                        for (int e = 0; e < 4; ++e) { const float y0 = bflo(yv[e]), y1 = bfhi(yv[e]), z0 = bflo(zv[e]), z1 = bfhi(zv[e]);
                            const float a0 = (e < 2 ? v0[2 * e] : v1[2 * e - 4]) + (e < 2 ? b0[2 * e] : b1[2 * e - 4]);
                            const float a1 = (e < 2 ? v0[2 * e + 1] : v1[2 * e - 3]) + (e < 2 ? b0[2 * e + 1] : b1[2 * e - 3]);
                            r[2 * e] = y0 * sigmoid_f(a0) * z0 * sigmoid_f(z0); r[2 * e + 1] = y1 * sigmoid_f(a1) * z1 * sigmoid_f(z1); }
                        u32x4 w; w.x = cvt_pk_bf16(r[0], r[1]); w.y = cvt_pk_bf16(r[2], r[3]); w.z = cvt_pk_bf16(r[4], r[5]); w.w = cvt_pk_bf16(r[6], r[7]);
                        *(u32x4*)(O + (size_t)row * ldc + col) = w;
                    } } }
    }
};
template <class Epi, class Sched, bool ALIGN_EPI = false, bool SP2 = false>
__device__ __forceinline__ void gemm_phase(PG8_LAS unsigned char* lds, const Gemm g, const Sched& S, const Epi& E) {
    const int tid = opaque_tid(), wid = __builtin_amdgcn_readfirstlane(tid >> 6), lane = tid & 63, wr = wid >> 2, wc = wid & 3, fr = lane & 15, fq = lane >> 4;
    const int K = g.K, nt = K / BK;
    unsigned voffA[2], voffB[2];
#pragma unroll
    for (int i = 0; i < 2; ++i) { int R, C; stage_rc(tid * 16 + i * 8192, R, C); const int Rb = Epi::PERM ? ((R & ~31) + perm32(R & 31)) : R;
        voffA[i] = (unsigned)(R * g.lda + C) * 2u; voffB[i] = (unsigned)(Rb * g.ldb + C) * 2u; }
    const size_t kstep = (size_t)(BK * 2);
    const size_t hstepA = (size_t)HALF * g.lda * 2, hstepB = (size_t)HALF * g.ldb * 2;
    const size_t tstepA = 2 * hstepA, tstepB = g.ksplit ? (size_t)K * 2 : 2 * hstepB, kslA = g.ksplit ? (size_t)K * 2 : 0;
    const unsigned ldsw = (unsigned)wid * 1024u;
    const int aoff = lds_byte(wr * 64 + fr, fq * 8), boff = lds_byte(wc * 32 + fr, fq * 8);
#define PG8_SA(b, h) (((b) * 2 + (h)) * HTB)
#define PG8_SB(b, h) ((4 + (b) * 2 + (h)) * HTB)
#define PG8_STAGE(bufoff, gbase, voff) do { _Pragma("unroll") for (int _i = 0; _i < 2; ++_i) \
        __builtin_amdgcn_global_load_lds((const unsigned*)((const char*)(gbase) + (voff)[_i]), (PG8_LAS unsigned*)(lds + (bufoff) + ldsw + _i * 8192), 16, 0, 0); } while (0)
#define PG8_LDA(dst, b, h) do { _Pragma("unroll") for (int m = 0; m < 4; ++m) _Pragma("unroll") for (int k = 0; k < 2; ++k) dst[m][k] = *(const PG8_LAS bf16x8*)(lds + PG8_SA(b, h) + aoff + m * 2048 + k * 1024); } while (0)
#define PG8_LDB(dst, b, h) do { _Pragma("unroll") for (int n = 0; n < 2; ++n) _Pragma("unroll") for (int k = 0; k < 2; ++k) dst[n][k] = *(const PG8_LAS bf16x8*)(lds + PG8_SB(b, h) + boff + n * 2048 + k * 1024); } while (0)
#define PG8_MMA(ai, bj, At, Bt) do { __builtin_amdgcn_s_setprio(1); _Pragma("unroll") for (int m = 0; m < 4; ++m) _Pragma("unroll") for (int n = 0; n < 2; ++n) _Pragma("unroll") for (int k = 0; k < 2; ++k) \
        acc[ai][bj][m][n] = __builtin_amdgcn_mfma_f32_16x16x32_bf16(Bt[n][k], At[m][k], acc[ai][bj][m][n], 0, 0, 0); __builtin_amdgcn_s_setprio(0); } while (0)
#define PG8_WAIT_V(n) asm volatile("s_waitcnt vmcnt(" #n ")" ::: "memory")
#define PG8_WAIT_L(n) asm volatile("s_waitcnt lgkmcnt(" #n ")" ::: "memory")
#define PG8_BAR __builtin_amdgcn_s_barrier()
#define PG8_SCHED __builtin_amdgcn_sched_barrier(0)
    Unit cur, nxt; int ui = 0;
    if (!S.next(0, cur)) return;
    f32x4 acc[2][2][4][2];
#pragma unroll
    for (int a = 0; a < 2; ++a)
#pragma unroll
        for (int b = 0; b < 2; ++b)
#pragma unroll
            for (int m = 0; m < 4; ++m)
#pragma unroll
                for (int n = 0; n < 2; ++n) acc[a][b][m][n] = (f32x4){0.f, 0.f, 0.f, 0.f};
    bf16x8 At[4][2], B0[2][2], B1[2][2];
    const char* cA = (const char*)g.A + (size_t)cur.pm * tstepA + (size_t)cur.pn * kslA; const char* cB = (const char*)g.Bt + (size_t)cur.pn * tstepB;
    S.a_ready(cur);
    if constexpr (SP2) {
        PG8_STAGE(PG8_SB(0, 0), cB, voffB); PG8_STAGE(PG8_SB(0, 1), cB + hstepB, voffB); PG8_STAGE(PG8_SA(0, 0), cA, voffA); PG8_STAGE(PG8_SA(0, 1), cA + hstepA, voffA);
        if (wr == 1) PG8_BAR;
        PG8_WAIT_V(2); PG8_BAR;
        PG8_STAGE(PG8_SB(1, 0), cB + kstep, voffB); PG8_STAGE(PG8_SA(1, 0), cA + kstep, voffA); PG8_STAGE(PG8_SB(1, 1), cB + hstepB + kstep, voffB);
        PG8_WAIT_V(6); PG8_BAR;
    } else {
        PG8_STAGE(PG8_SB(0, 0), cB, voffB); PG8_STAGE(PG8_SA(0, 0), cA, voffA); PG8_STAGE(PG8_SB(0, 1), cB + hstepB, voffB); PG8_STAGE(PG8_SA(0, 1), cA + hstepA, voffA);
        if (wr == 1) PG8_BAR;
        PG8_WAIT_V(4); PG8_BAR;
        PG8_STAGE(PG8_SB(1, 0), cB + kstep, voffB); PG8_STAGE(PG8_SA(1, 0), cA + kstep, voffA); PG8_STAGE(PG8_SB(1, 1), cB + hstepB + kstep, voffB);
        PG8_WAIT_V(6); PG8_BAR;
    }
    for (;;) {
        const bool has_next = S.next(ui + 1, nxt);
        const char* nA = has_next ? (const char*)g.A + (size_t)nxt.pm * tstepA + (size_t)nxt.pn * kslA : cA; const char* nB = has_next ? (const char*)g.Bt + (size_t)nxt.pn * tstepB : cB;
        for (int t = 0; t < nt; t += 2) {
            if constexpr (Epi::MIDT >= 0) { if (t == Epi::MIDT) E.mid(acc, wr, fr, lds); }
            const bool last = (t == nt - 2);
            const char* a1 = cA + (size_t)(t + 1) * kstep;
            const char* a2 = last ? nA : cA + (size_t)(t + 2) * kstep; const char* b2 = last ? nB : cB + (size_t)(t + 2) * kstep;
            const char* a3 = a2 + kstep; const char* b3 = b2 + kstep;
            if (last && has_next) S.a_ready(nxt);
            if constexpr (SP2) {
            PG8_LDB(B0, 0, 0); PG8_LDB(B1, 0, 1); PG8_SCHED; PG8_LDA(At, 0, 0); PG8_STAGE(PG8_SA(1, 1), a1 + hstepA, voffA);
            PG8_WAIT_V(8); PG8_WAIT_L(0); PG8_BAR; PG8_MMA(0, 0, At, B0); PG8_MMA(0, 1, At, B1); PG8_BAR; PG8_SCHED;
            PG8_LDA(At, 0, 1); PG8_STAGE(PG8_SB(0, 0), b2, voffB); PG8_STAGE(PG8_SB(0, 1), b2 + hstepB, voffB); PG8_STAGE(PG8_SA(0, 0), a2, voffA);
            PG8_WAIT_V(8); PG8_WAIT_L(0); PG8_BAR; PG8_MMA(1, 0, At, B0); PG8_MMA(1, 1, At, B1); PG8_BAR; PG8_SCHED;
            PG8_LDB(B0, 1, 0); PG8_LDB(B1, 1, 1); PG8_SCHED; PG8_LDA(At, 1, 0); PG8_STAGE(PG8_SA(0, 1), a2 + hstepA, voffA);
            PG8_WAIT_V(8); PG8_WAIT_L(0); PG8_BAR; PG8_MMA(0, 0, At, B0); PG8_MMA(0, 1, At, B1); PG8_BAR; PG8_SCHED;
            PG8_LDA(At, 1, 1); PG8_STAGE(PG8_SB(1, 0), b3, voffB); PG8_STAGE(PG8_SB(1, 1), b3 + hstepB, voffB); PG8_STAGE(PG8_SA(1, 0), a3, voffA);
            PG8_WAIT_V(8); PG8_WAIT_L(0); PG8_BAR; PG8_MMA(1, 0, At, B0); PG8_MMA(1, 1, At, B1); PG8_BAR; PG8_SCHED;
            } else {
            PG8_LDB(B0, 0, 0); PG8_SCHED; PG8_LDA(At, 0, 0); PG8_STAGE(PG8_SA(1, 1), a1 + hstepA, voffA);
            PG8_WAIT_L(8); PG8_BAR; PG8_WAIT_L(0); PG8_MMA(0, 0, At, B0); PG8_BAR; PG8_SCHED;
            PG8_LDB(B1, 0, 1); PG8_STAGE(PG8_SB(0, 0), b2, voffB);
            PG8_BAR; PG8_WAIT_L(0); PG8_MMA(0, 1, At, B1); PG8_BAR;
            PG8_LDA(At, 0, 1); PG8_STAGE(PG8_SA(0, 0), a2, voffA);
            PG8_BAR; PG8_WAIT_L(0); PG8_MMA(1, 0, At, B0); PG8_BAR; PG8_SCHED;
            PG8_STAGE(PG8_SB(0, 1), b2 + hstepB, voffB);
            PG8_WAIT_V(6); PG8_BAR; PG8_MMA(1, 1, At, B1); PG8_BAR;
            PG8_LDB(B0, 1, 0); PG8_SCHED; PG8_LDA(At, 1, 0); PG8_STAGE(PG8_SA(0, 1), a2 + hstepA, voffA);
            PG8_WAIT_L(8); PG8_BAR; PG8_WAIT_L(0); PG8_MMA(0, 0, At, B0); PG8_BAR; PG8_SCHED;
            PG8_LDB(B1, 1, 1); PG8_STAGE(PG8_SB(1, 0), b3, voffB);
            PG8_BAR; PG8_WAIT_L(0); PG8_MMA(0, 1, At, B1); PG8_BAR;
            PG8_LDA(At, 1, 1); PG8_STAGE(PG8_SA(1, 0), a3, voffA);
            PG8_BAR; PG8_WAIT_L(0); PG8_MMA(1, 0, At, B0); PG8_BAR; PG8_SCHED;
            PG8_STAGE(PG8_SB(1, 1), b3 + hstepB, voffB);
            PG8_WAIT_V(6); PG8_BAR; PG8_MMA(1, 1, At, B1); PG8_BAR;
            }
        }
        if constexpr (ALIGN_EPI) { if (wr == 0) PG8_BAR; }
        if constexpr (!Epi::AFTER_DRAIN) { E(acc, cur, wr, wc, fr, fq); S.done(cur); }
        if (!has_next) break;
#pragma unroll
        for (int a = 0; a < 2; ++a)
#pragma unroll
            for (int b = 0; b < 2; ++b)
#pragma unroll
                for (int m = 0; m < 4; ++m)
#pragma unroll
                    for (int n = 0; n < 2; ++n) acc[a][b][m][n] = (f32x4){0.f, 0.f, 0.f, 0.f};
        cur = nxt; cA = nA; cB = nB; ++ui;
        if constexpr (ALIGN_EPI) { if (wr == 1) PG8_BAR; }
    }
    PG8_WAIT_V(0);
    if constexpr (!ALIGN_EPI) { if (wr == 0) PG8_BAR; }
    PG8_BAR;
    if constexpr (Epi::AFTER_DRAIN) { E.fused(acc, cur, wr, wc, fr, fq, lds, wid, lane); S.done(cur); }
#undef PG8_SA
#undef PG8_SB
#undef PG8_STAGE
#undef PG8_LDA
#undef PG8_LDB
#undef PG8_MMA
#undef PG8_WAIT_V
#undef PG8_WAIT_L
#undef PG8_BAR
#undef PG8_SCHED
}
}

#include <hip/hip_bf16.h>
#include <cmath>
namespace attn_body {
using bf16=__hip_bfloat16;
using bf16x8=__attribute__((ext_vector_type(8)))short;
using s16x4=__attribute__((ext_vector_type(4)))short;
using f32x16=__attribute__((ext_vector_type(16)))float;
using u32x4=__attribute__((ext_vector_type(4)))unsigned;
constexpr int SEQ=2048,D=64;
constexpr int NW=8,QBLK=32,QB=QBLK*NW,KVBLK=64,NQB=SEQ/QB;
constexpr int ATTN_UNIT_ROWS=QB;
__device__ __forceinline__ int crow(int r,int hi){return (r&3)+8*(r>>2)+4*hi;}
#define SBAR() __builtin_amdgcn_sched_barrier(0)
__device__ __forceinline__ void cmask(f32x16&p0,f32x16&p1,int jb,int qrel,int hi){
  const float NEG=-INFINITY; int kb=64*jb+4*hi;
  #pragma unroll
  for(int r=0;r<16;++r){int kv=kb+(r&3)+8*(r>>2); if(kv>qrel)p0[r]=NEG; if(kv+32>qrel)p1[r]=NEG;}
}

constexpr int NSLOT=3, SLOTB=8192;
constexpr int LDS_K=0, LDS_V=NSLOT*SLOTB, LDS_WS=2*NSLOT*SLOTB, LDS_OST=LDS_WS+NW*64*4, LDS_BYTES=LDS_OST+NW*4096;
constexpr int XOFF=86016; constexpr float SENT=-30000.f; using f32x4=__attribute__((ext_vector_type(4)))float;
constexpr float C2=0.125f*1.4426950408889634f;
__device__ __forceinline__ void glds16(const void*gsrc,unsigned lds_dst){unsigned keep;
  asm volatile("s_mov_b32 %0, m0\n\ts_mov_b32 m0, %2\n\ts_nop 0\n\tglobal_load_lds_dwordx4 %1, off\n\ts_mov_b32 m0, %0":"=&s"(keep):"v"(gsrc),"s"(lds_dst):"memory");}
__device__ __forceinline__ float max3f(float a,float b,float c){float r;asm("v_max3_f32 %0, %1, %2, %3":"=v"(r):"v"(a),"v"(b),"v"(c));return r;}
__device__ __forceinline__ float max2f(float a,float b){float r;asm("v_max_f32_e32 %0, %1, %2":"=v"(r):"v"(a),"v"(b));return r;}
__device__ __forceinline__ float fadd_s(float a,float b){float r;asm("v_add_f32_e32 %0, %1, %2":"=v"(r):"v"(a),"v"(b));return r;}
__device__ __forceinline__ float fsub_s(float a,float b){float r;asm("v_sub_f32_e32 %0, %1, %2":"=v"(r):"v"(a),"v"(b));return r;}
typedef float f32x2_t __attribute__((ext_vector_type(2))); typedef __bf16 bf16x2_t __attribute__((ext_vector_type(2)));
__device__ __forceinline__ unsigned cvtpk_s(float lo,float hi){f32x2_t v={lo,hi};bf16x2_t b=__builtin_convertvector(v,bf16x2_t);return __builtin_bit_cast(unsigned,b);}
#define WAIT_BAR(N) asm volatile("s_waitcnt vmcnt(" #N ") lgkmcnt(0)\n\ts_barrier":::"memory")

__device__ __forceinline__ void qkt(f32x16&p0,f32x16&p1,const char*Kslot,const bf16x8*qr,const f32x16&negm,int r32,int hi){
  const char*kb=Kslot+hi*1024+r32*16;
  #pragma unroll
  for(int d0=0;d0<4;++d0){
    const bf16x8 b0=*reinterpret_cast<const bf16x8*>(kb+d0*2048);
    const bf16x8 b1=*reinterpret_cast<const bf16x8*>(kb+d0*2048+512);
    if(d0==0){p0=__builtin_amdgcn_mfma_f32_32x32x16_bf16(b0,qr[0],negm,0,0,0);p1=__builtin_amdgcn_mfma_f32_32x32x16_bf16(b1,qr[0],negm,0,0,0);}
    else{p0=__builtin_amdgcn_mfma_f32_32x32x16_bf16(b0,qr[d0],p0,0,0,0);p1=__builtin_amdgcn_mfma_f32_32x32x16_bf16(b1,qr[d0],p1,0,0,0);}}
}
typedef __attribute__((address_space(3))) const char* lds_cptr;
typedef short v4i16_t __attribute__((ext_vector_type(4)));
__device__ __forceinline__ void kload8(bf16x8*kf,lds_cptr kp){
  kf[0]=*(const __attribute__((address_space(3))) bf16x8*)(kp);      kf[1]=*(const __attribute__((address_space(3))) bf16x8*)(kp+512);
  kf[2]=*(const __attribute__((address_space(3))) bf16x8*)(kp+2048); kf[3]=*(const __attribute__((address_space(3))) bf16x8*)(kp+2560);
  kf[4]=*(const __attribute__((address_space(3))) bf16x8*)(kp+4096); kf[5]=*(const __attribute__((address_space(3))) bf16x8*)(kp+4608);
  kf[6]=*(const __attribute__((address_space(3))) bf16x8*)(kp+6144); kf[7]=*(const __attribute__((address_space(3))) bf16x8*)(kp+6656);
}
__device__ __forceinline__ void kload2(bf16x8*kf,lds_cptr kp,int j){ kf[2*j]=*(const __attribute__((address_space(3))) bf16x8*)(kp+j*2048); kf[2*j+1]=*(const __attribute__((address_space(3))) bf16x8*)(kp+j*2048+512); }
__device__ __forceinline__ s16x4 vtr(lds_cptr p){ return __builtin_bit_cast(s16x4,__builtin_amdgcn_ds_read_tr16_b64_v4i16((__attribute__((address_space(3))) v4i16_t*)p)); }
__device__ __forceinline__ float rowmax(const f32x16&p0,const f32x16&p1){
  float a=max3f(p0[0],p0[1],p1[0]),b=max3f(p0[2],p0[3],p1[1]);a=max3f(a,p1[2],p1[3]);
  #pragma unroll
  for(int r=4;r<16;r+=4){a=max3f(a,p0[r],p0[r+1]);b=max3f(b,p0[r+2],p0[r+3]);a=max3f(a,p1[r],p1[r+1]);b=max3f(b,p1[r+2],p1[r+3]);}
  const float m=max2f(a,b);
  auto rr=__builtin_amdgcn_permlane32_swap(__float_as_uint(m),__float_as_uint(m),false,false);
  return max2f(__uint_as_float(rr[0]),__uint_as_float(rr[1]));
}
__device__ __forceinline__ void pv(f32x16*o,int vb,bf16x8 pa0,bf16x8 pa1,bf16x8 pa2,bf16x8 pa3){
  #pragma unroll
  for(int d0=0;d0<2;++d0){s16x4 lo[4],hi[4];
    #pragma unroll
    for(int ks=0;ks<4;++ks){
      asm volatile("ds_read_b64_tr_b16 %0,%1 offset:%c2":"=&v"(lo[ks]):"v"(vb),"i"(d0*4096+ks*1024):"memory");
      asm volatile("ds_read_b64_tr_b16 %0,%1 offset:%c2":"=&v"(hi[ks]):"v"(vb),"i"(d0*4096+ks*1024+512):"memory");}
    asm volatile("s_waitcnt lgkmcnt(0)":::"memory");SBAR();
    #define PK(k) (bf16x8){lo[k][0],lo[k][1],lo[k][2],lo[k][3],hi[k][0],hi[k][1],hi[k][2],hi[k][3]}
    o[d0]=__builtin_amdgcn_mfma_f32_32x32x16_bf16(pa0,PK(0),o[d0],0,0,0);
    o[d0]=__builtin_amdgcn_mfma_f32_32x32x16_bf16(pa1,PK(1),o[d0],0,0,0);
    o[d0]=__builtin_amdgcn_mfma_f32_32x32x16_bf16(pa2,PK(2),o[d0],0,0,0);
    o[d0]=__builtin_amdgcn_mfma_f32_32x32x16_bf16(pa3,PK(3),o[d0],0,0,0);
    #undef PK
  }
}

#ifndef ATTN_STORE16
#define ATTN_STORE16(p,v) (*(u32x4*)(p)=(v))
#endif
template<int THRL,int MODE,int DM,bool DRY=false> __device__ __forceinline__ void attn_unit(int b,int h,int qb,const bf16*Q,const bf16*__restrict__ K,const bf16*__restrict__ V,bf16*O,const bf16*__restrict__ Z,const float*__restrict__ XP,const int*__restrict__ TS,volatile unsigned*lw,unsigned nxt,char*shm){
  const int tid=opaque_tid(),lane=tid&63,r32=lane&31,hi=lane>>5; const int wid=__builtin_amdgcn_readfirstlane(tid>>6);
  const long rowbase=(long)b*SEQ; const int q0=qb*QB;
  const bf16*Qw=Q+(rowbase+q0+wid*QBLK)*DM+h*D;
  bf16x8 qr[4];
  #pragma unroll
  for(int d0=0;d0<4;++d0)qr[d0]=*reinterpret_cast<const bf16x8*>(&Qw[(long)r32*DM+d0*16+hi*8]);
  const bf16*Kh=K+rowbase*DM+h*D,*Vh=V+rowbase*DM+h*D;
  const unsigned lds0=(unsigned)(uintptr_t)shm;
  float*wsf=(float*)(shm+LDS_WS)+wid*64;
  const bf16*ksrc_=Kh+(long)lane*DM+wid*8; int tskip=0; const bf16*ksrc=ksrc_;
  const bf16*vsrc_=Vh+(long)(16*(wid&3)+(lane>>2))*DM+(wid>>2)*32+(lane&3)*8; const bf16*vsrc=vsrc_;
  const unsigned kdst=lds0+LDS_K+wid*1024, vdst=lds0+LDS_V+wid*1024;
  #define DMA_K(t,slot) glds16(ksrc+(long)(t)*KVBLK*DM,(unsigned)__builtin_amdgcn_readfirstlane(kdst+(slot)))
  #define DMA_V(t,slot) glds16(vsrc+(long)(t)*KVBLK*DM,(unsigned)__builtin_amdgcn_readfirstlane(vdst+(slot)))
  const int vb0=(int)(lds0+LDS_V)+((lane>>4)&1)*32+(lane&3)*8+(4*hi+((lane&15)>>2))*64;
  const char*Kbase=shm+LDS_K; bf16x8 kf[8];
  const lds_cptr shm3=(lds_cptr)shm; const lds_cptr kp0=shm3+LDS_K+hi*1024+r32*16; const lds_cptr vp0=shm3+LDS_V+((lane>>4)&1)*32+(lane&3)*8+(4*hi+((lane&15)>>2))*64;
  int NT=(q0+QB)/KVBLK;
  const int qrel=wid*QBLK+r32;
  unsigned sel=0u;
  if constexpr(MODE==1){
    tskip=__builtin_amdgcn_readfirstlane(TS[qb]);
    ksrc=ksrc_+(long)tskip*KVBLK*DM; vsrc=vsrc_+(long)tskip*KVBLK*DM; NT-=tskip;
  }
  const lds_cptr fsl=(lds_cptr)shm+XOFF+16*hi+tskip*256;
  #define XMASK(P0,P1,t) do{ if constexpr(MODE==0){ if((t)<NT-4){ const bool keep_=(sel>>((t)>>2))&1u; \
        _Pragma("unroll") for(int r=0;r<16;++r){P0[r]=keep_?P0[r]:SENT;P1[r]=keep_?P1[r]:SENT;} } } \
      else { const lds_cptr fp_=fsl+(t)*256; const float mh_=mhat; \
        _Pragma("unroll") for(int g_=0;g_<4;++g_){ const f32x4 fa_=*(const __attribute__((address_space(3))) f32x4*)(fp_+g_*32)+mh_; const f32x4 fb_=*(const __attribute__((address_space(3))) f32x4*)(fp_+128+g_*32)+mh_; \
          _Pragma("unroll") for(int i_=0;i_<4;++i_){P0[4*g_+i_]-=fa_[i_];P1[4*g_+i_]-=fb_[i_];} } } }while(0)
  DMA_K(0,0);DMA_V(0,0);DMA_K(1,SLOTB);
  float mhat=0.f,l_reg=0.f;f32x16 o[2];o[0]=f32x16{};o[1]=f32x16{};f32x16 negm=f32x16{}; if constexpr(MODE==0){asm volatile("":"+v"(negm));}
  #define CMASK(P0,P1,t) do{int jb_=(t)-(NT-4); if(jb_>=0)cmask(P0,P1,jb_,qrel,hi);}while(0)
  const f32x16 czero_=f32x16{};
  #define NEGM (MODE==1?czero_:negm)
  bool resc=false;
  #define START(P0,P1) do{ const float rm=rowmax(P0,P1); resc=false; \
    { const float dl=rm; mhat=fadd_s(mhat,dl); \
      _Pragma("unroll") for(int r=0;r<16;++r){P0[r]=fsub_s(P0[r],dl);P1[r]=fsub_s(P1[r],dl);} \
      if constexpr(MODE==0){ _Pragma("unroll") for(int r=0;r<16;++r)negm[r]=-mhat; asm volatile("":"+v"(negm)); } } \
    _Pragma("unroll") for(int r=0;r<16;++r)P0[r]=__builtin_amdgcn_exp2f(P0[r]); }while(0)
  #define RESC() do{ if(resc){ asm volatile("s_waitcnt lgkmcnt(0)":::"memory"); \
      _Pragma("unroll") for(int d_=0;d_<2;++d_) _Pragma("unroll") for(int r=0;r<16;++r)o[d_][r]*=wsf[crow(r,hi)]; } }while(0)
  f32x16 pA0,pA1,pB0,pB1;
  int sl_prev=0,sl_cur=0,sl_next=SLOTB;
  #define ROT() do{sl_prev=sl_cur;sl_cur=sl_next;sl_next=(sl_next==(NSLOT-1)*SLOTB)?0:sl_next+SLOTB;}while(0)
  DMA_K(2,2*SLOTB);
  if constexpr(MODE==1){ float*fs=(float*)(shm+XOFF); for(int i=tid+64*tskip;i<q0+QB;i+=NW*64)fs[i]=XP[i]; }
  if constexpr(MODE==0){
    float*kbs=(float*)(shm+XOFF); unsigned*sm=(unsigned*)(shm+XOFF+2048);
    kbs[tid]=XP[tid];
    asm volatile("s_waitcnt vmcnt(0) lgkmcnt(0)\n\ts_barrier":::"memory");
    if(tid<QB){ unsigned m=(1u<<qb)-1u;
      if(qb>3){ const bf16*qp=Q+(rowbase+q0+tid)*DM+h*D; float g[8];
        _Pragma("unroll") for(int n=0;n<8;++n)g[n]=0.f;
        _Pragma("unroll") for(int c=0;c<8;++c){ const bf16x8 qv=*reinterpret_cast<const bf16x8*>(qp+c*8);
          _Pragma("unroll") for(int j=0;j<8;++j){ const float qf=__uint_as_float(((unsigned)(unsigned short)qv[j])<<16);
            _Pragma("unroll") for(int n=0;n<8;++n)g[n]+=qf*kbs[n*64+c*8+j]; } }
        m=0u;
        _Pragma("unroll") for(int it=0;it<3;++it){ float best=-INFINITY; int bi=0;
          _Pragma("unroll") for(int n=0;n<8;++n){ const bool ok=(n<qb)&&!((m>>n)&1u)&&(g[n]>best); best=ok?g[n]:best; bi=ok?n:bi; }
          m|=1u<<bi; } }
      sm[tid]=m; }
    asm volatile("s_waitcnt vmcnt(0) lgkmcnt(0)\n\ts_barrier":::"memory");
    sel=sm[qrel];
  }
  WAIT_BAR(3);
  qkt(pA0,pA1,Kbase,qr,NEGM,r32,hi);asm volatile("s_nop 15\n\ts_nop 7":"+v"(pA0),"+v"(pA1));XMASK(pA0,pA1,0);CMASK(pA0,pA1,0);
  START(pA0,pA1);
  _Pragma("unroll") for(int r=0;r<16;++r)pA1[r]=__builtin_amdgcn_exp2f(pA1[r]);
  WAIT_BAR(0);
  DMA_K(3,0);DMA_V(1,SLOTB);
  ROT();
  kload8(kf,kp0+sl_cur);
  WAIT_BAR(2);
  s16x4 vlo[8],vhi[8]; u32x4 pw0,pw1,pw2,pw3;
  #define PKW(P,B) cvtpk_s(P[B],P[B+1])
  #define PAF(k) __builtin_bit_cast(bf16x8,pw##k)
  #define VFR(i) (bf16x8){vlo[i][0],vlo[i][1],vlo[i][2],vlo[i][3],vhi[i][0],vhi[i][1],vhi[i][2],vhi[i][3]}
  #define PIN(x) asm volatile("":"+v"(x))
  #define MX3(a,b,c) __builtin_fmaxf(__builtin_fmaxf((a),(b)),(c))
  #define GAPA(MF,A0,A1,A2,A3,W0,W1,PW) do{ MF; sacc+=A0; sacc+=A1; sacc+=A2; sacc+=A3; PIN(sacc); W0; W1; PIN(PW); SBAR(); }while(0)
  #define EX(v) __builtin_amdgcn_exp2f(v)
  #define GAPB(MF,X,B) do{ MF; X[B]=EX(X[B]); X[B+1]=EX(X[B+1]); X[B+2]=EX(X[B+2]); X[B+3]=EX(X[B+3]); PIN(X); SBAR(); }while(0)
  #define VRD(i) do{ vlo[i]=vtr(vp_+(((i)>>2)*4096+((i)&3)*1024)); vhi[i]=vtr(vp_+(((i)>>2)*4096+((i)&3)*1024+512)); }while(0)
  #define KRD(G,j) do{ if(G){ kload2(kf,kp0+sl_next,j); SBAR(); } }while(0)
  #define STEP(C0,C1,P0,P1,t,GK,GV,GL) do{ SBAR(); \
    const lds_cptr vp_=vp0+sl_prev; \
    VRD(0); SBAR(); float sacc=(P0[0]+P0[1]); \
    GAPA(C0=__builtin_amdgcn_mfma_f32_32x32x16_bf16(kf[0],qr[0],NEGM,0,0,0), P0[2],P0[3],P0[4],P0[5],     pw0[0]=PKW(P0,0), pw0[1]=PKW(P0,2), pw0); \
    VRD(4); SBAR(); GAPA(C1=__builtin_amdgcn_mfma_f32_32x32x16_bf16(kf[1],qr[0],NEGM,0,0,0), P0[6],P0[7],P0[8],P0[9],     pw0[2]=PKW(P0,4), pw0[3]=PKW(P0,6), pw0); \
    VRD(1); SBAR(); GAPA(C0=__builtin_amdgcn_mfma_f32_32x32x16_bf16(kf[2],qr[1],C0,0,0,0),   P0[10],P0[11],P0[12],P0[13], pw1[0]=PKW(P0,8), pw1[1]=PKW(P0,10), pw1); \
    VRD(5); SBAR(); GAPA(C1=__builtin_amdgcn_mfma_f32_32x32x16_bf16(kf[3],qr[1],C1,0,0,0),   P0[14],P0[15],P1[0],P1[1],   pw1[2]=PKW(P0,12),pw1[3]=PKW(P0,14), pw1); \
    VRD(2); SBAR(); GAPA(C0=__builtin_amdgcn_mfma_f32_32x32x16_bf16(kf[4],qr[2],C0,0,0,0),   P1[2],P1[3],P1[4],P1[5],     pw2[0]=PKW(P1,0), pw2[1]=PKW(P1,2), pw2); \
    VRD(6); SBAR(); GAPA(C1=__builtin_amdgcn_mfma_f32_32x32x16_bf16(kf[5],qr[2],C1,0,0,0),   P1[6],P1[7],P1[8],P1[9],     pw2[2]=PKW(P1,4), pw2[3]=PKW(P1,6), pw2); \
    VRD(3); SBAR(); GAPA(C0=__builtin_amdgcn_mfma_f32_32x32x16_bf16(kf[6],qr[3],C0,0,0,0),   P1[10],P1[11],P1[12],P1[13], pw3[0]=PKW(P1,8), pw3[1]=PKW(P1,10), pw3); \
    VRD(7); SBAR(); GAPA(C1=__builtin_amdgcn_mfma_f32_32x32x16_bf16(kf[7],qr[3],C1,0,0,0),   P1[14],P1[15],0.f,0.f,       pw3[2]=PKW(P1,12),pw3[3]=PKW(P1,14), pw3); \
    l_reg+=sacc; \
    if(GK){DMA_K((t)+3,sl_cur);} if(GV){DMA_V((t)+1,sl_next);} \
    XMASK(C0,C1,t); CMASK(C0,C1,t); \
    { float a=MX3(C0[0],C0[1],C1[0]),b=MX3(C0[2],C0[3],C1[1]); a=MX3(a,C1[2],C1[3]); \
      _Pragma("unroll") for(int r=4;r<16;r+=4){a=MX3(a,C0[r],C0[r+1]);b=MX3(b,C0[r+2],C0[r+3]);a=MX3(a,C1[r],C1[r+1]);b=MX3(b,C1[r+2],C1[r+3]);} \
      float rm=__builtin_fmaxf(a,b); { auto rr=__builtin_amdgcn_permlane32_swap(__float_as_uint(rm),__float_as_uint(rm),false,false); rm=__builtin_fmaxf(__uint_as_float(rr[0]),__uint_as_float(rr[1])); } \
      resc=false; \
      if(__builtin_expect(__any(rm>(float)THRL),0)){ const float dl=__builtin_fmaxf(rm,0.f); mhat+=dl; \
        _Pragma("unroll") for(int r=0;r<16;++r){C0[r]-=dl;C1[r]-=dl;} \
        if constexpr(MODE==0){ _Pragma("unroll") for(int r=0;r<16;++r)negm[r]=-mhat; asm volatile("":"+v"(negm)); } \
        const float f=__builtin_amdgcn_exp2f(-dl); l_reg*=f; if(hi==0)wsf[r32]=f; resc=true; } } \
    SBAR(); \
    GAPB(o[0]=__builtin_amdgcn_mfma_f32_32x32x16_bf16(PAF(0),VFR(0),o[0],0,0,0), C0,0); \
    GAPB(o[1]=__builtin_amdgcn_mfma_f32_32x32x16_bf16(PAF(0),VFR(4),o[1],0,0,0), C0,4); \
    KRD(GL,0); GAPB(o[0]=__builtin_amdgcn_mfma_f32_32x32x16_bf16(PAF(1),VFR(1),o[0],0,0,0), C0,8); \
    KRD(GL,1); GAPB(o[1]=__builtin_amdgcn_mfma_f32_32x32x16_bf16(PAF(1),VFR(5),o[1],0,0,0), C0,12); \
    KRD(GL,2); GAPB(o[0]=__builtin_amdgcn_mfma_f32_32x32x16_bf16(PAF(2),VFR(2),o[0],0,0,0), C1,0); \
    KRD(GL,3); GAPB(o[1]=__builtin_amdgcn_mfma_f32_32x32x16_bf16(PAF(2),VFR(6),o[1],0,0,0), C1,4); \
    GAPB(o[0]=__builtin_amdgcn_mfma_f32_32x32x16_bf16(PAF(3),VFR(3),o[0],0,0,0), C1,8); \
    GAPB(o[1]=__builtin_amdgcn_mfma_f32_32x32x16_bf16(PAF(3),VFR(7),o[1],0,0,0), C1,12); \
    }while(0)
  int t=1;
  #undef CMASK
  #define CMASK(P0,P1,t) do{}while(0)
  for(;t+5<NT;t+=2){
    STEP(pB0,pB1,pA0,pA1,t,true,true,true);     WAIT_BAR(2); RESC(); ROT();
    STEP(pA0,pA1,pB0,pB1,t+1,true,true,true);   WAIT_BAR(2); RESC(); ROT();
  }
  #undef CMASK
  #define CMASK(P0,P1,t) do{int jb_=(t)-(NT-4); if(jb_>=0)cmask(P0,P1,jb_,qrel,hi);}while(0)
  #define ENDW(tt) do{ if((tt)+3<NT){WAIT_BAR(2);} else if((tt)+2<NT){WAIT_BAR(1);} else {WAIT_BAR(0);} }while(0)
  for(;t+1<NT;t+=2){
    STEP(pB0,pB1,pA0,pA1,t,(t+3<NT),(t+1<NT),(t+1<NT));       ENDW(t);   RESC(); ROT();
    STEP(pA0,pA1,pB0,pB1,t+1,(t+4<NT),(t+2<NT),(t+2<NT));     ENDW(t+1); RESC(); ROT();
  }
  STEP(pB0,pB1,pA0,pA1,NT-1,false,false,false); RESC();
  const bf16*Zw=Z+(rowbase+q0+wid*QBLK)*DM+h*D; u32x4 zpre[4];
  #pragma unroll
  for(int i=0;i<4;++i)zpre[i]=*(const u32x4*)(Zw+(long)(i*8+(lane>>3))*DM+(lane&7)*8);
  { float sacc=pB0[0]+pB0[1]; _Pragma("unroll") for(int r=2;r<16;++r)sacc+=pB0[r]; _Pragma("unroll") for(int r=0;r<16;++r)sacc+=pB1[r]; l_reg+=sacc;
    pw0=(u32x4){PKW(pB0,0),PKW(pB0,2),PKW(pB0,4),PKW(pB0,6)};pw1=(u32x4){PKW(pB0,8),PKW(pB0,10),PKW(pB0,12),PKW(pB0,14)};pw2=(u32x4){PKW(pB1,0),PKW(pB1,2),PKW(pB1,4),PKW(pB1,6)};pw3=(u32x4){PKW(pB1,8),PKW(pB1,10),PKW(pB1,12),PKW(pB1,14)};
    SBAR(); pv(o,vb0+sl_cur,PAF(0),PAF(1),PAF(2),PAF(3)); }
  #undef PKW
  #undef PAF
  #undef VFR
  #undef PIN
  #undef MX3
  #undef GAPA
  #undef GAPB
  #undef EX
  #undef VRD
  #undef KRD
  #undef STEP
  #undef ENDW
  if(lw!=nullptr&&tid==0)lw[0]=nxt;
  {auto rr=__builtin_amdgcn_permlane32_swap(__float_as_uint(l_reg),__float_as_uint(l_reg),false,false);l_reg=__uint_as_float(rr[0])+__uint_as_float(rr[1]);}
  if(hi==0)wsf[32+r32]=l_reg;asm volatile("s_waitcnt lgkmcnt(0)":::"memory");
  float rli[16];
  #pragma unroll
  for(int r=0;r<16;++r)rli[r]=__builtin_amdgcn_rcpf(wsf[32+crow(r,hi)]);
  bf16*Ow=O+(rowbase+q0+wid*QBLK)*DM+h*D;
  { bf16*stg=(bf16*)(shm+LDS_OST)+wid*2048;
    #pragma unroll
    for(int r=0;r<16;++r){const int orow=crow(r,hi);
      #pragma unroll
      for(int d0=0;d0<2;++d0)stg[orow*64+d0*32+r32]=__float2bfloat16(o[d0][r]*rli[r]);}
    asm volatile("s_waitcnt lgkmcnt(0)":::"memory");
    #pragma unroll
    for(int i=0;i<4;++i){const int row=i*8+(lane>>3),ch=lane&7; const u32x4 v=*(const u32x4*)(stg+row*64+ch*8); const u32x4 zv=zpre[i]; u32x4 ov;
      #pragma unroll
      for(int e=0;e<4;++e){ const float o0=__uint_as_float(v[e]<<16),o1=__uint_as_float(v[e]&0xffff0000u),z0=__uint_as_float(zv[e]<<16),z1=__uint_as_float(zv[e]&0xffff0000u);
        ov[e]=cvtpk_s(o0*z0/(1.f+__expf(-z0)),o1*z1/(1.f+__expf(-z1))); }
      if(!DRY||ov[0]==0x7fc12345u)ATTN_STORE16(Ow+(long)row*DM+ch*8,ov);} }
  asm volatile("s_waitcnt lgkmcnt(0)\n\ts_barrier":::"memory");
  #undef DMA_K
  #undef DMA_V
  #undef CMASK
  #undef XMASK
  #undef NEGM
  #undef START
  #undef RESC
  #undef ROT
}
constexpr int ATTN_LDS_BYTES=LDS_BYTES;
#undef SBAR
#undef WAIT_BAR
}
constexpr int NWAVES = 8, NTHR = 512;
constexpr int NB = 8, SEQL = 2048, DMOD = 1024, MROWS = NB * SEQL;
constexpr int LD0 = 6656, NP0 = 6912, LD1 = 7168, NP1 = 7424;
constexpr int C0_ZA = 0, C0_Q = 1024, C0_ZB = 2048, C0_XBC = 3072, C0_K = 4608, C0_V = 5632;
constexpr int C1_Q = 0, C1_U = 1536, C1_K = 2048, C1_V = 3584, C1_ZC = 5120, C1_ZD = 6656;
constexpr float RMS_EPS = 1e-6f, LOG2E = 1.4426950408889634f;
constexpr size_t MiB = 1u << 20;
constexpr int KS = 8;
constexpr size_t WS_MODP = 0;
constexpr size_t WS_SSQ = 2 * MiB;
constexpr size_t WS_KBAR = 2 * MiB + 65536;
constexpr size_t WS_DT = 3 * MiB;
constexpr size_t WS_LF = 4 * MiB;
constexpr size_t WS_F2 = 6 * MiB;
constexpr size_t WS_S5P = 7 * MiB + 512 * 1024;
constexpr int S5P_STRIDE = 8704;
constexpr size_t WS_WT1 = 8 * MiB;
constexpr size_t WS_WO1 = WS_WT1 + (size_t)NP1 * 1024 * 2;
constexpr size_t WS_WG = WS_WO1 + 4 * MiB;
constexpr size_t WS_BIG = 27 * MiB;
constexpr size_t WS_WT0 = WS_BIG + (size_t)MROWS * LD0 * 2;
constexpr size_t WS_WO0 = WS_WT0 + (size_t)NP0 * 1024 * 2;
constexpr size_t WS_LFP = 251 * MiB;
constexpr size_t WS_END = WS_WO0 + 4 * MiB;
static_assert(WS_WG + 512 * 1024 <= WS_BIG && WS_END <= 256 * MiB && WS_BIG + (size_t)MROWS * LD1 * 2 <= 256 * MiB, "ws map");
constexpr int LDS_BYTES = 147456;
constexpr size_t WS_CNT = 1835008 + 3584 * 4, WS_UB = 1835008 + 32768, WS_TS = 1835008 + 32768 + 1024;
constexpr size_t WS_BAR = 1835008;
constexpr int BARST_OFF = 132608;

typedef unsigned short bf16;
typedef unsigned v4u __attribute__((ext_vector_type(4)));
typedef unsigned v2u __attribute__((ext_vector_type(2)));
typedef float f32x4 __attribute__((ext_vector_type(4)));
typedef short bf16x8 __attribute__((ext_vector_type(8)));
typedef float f32x16 __attribute__((ext_vector_type(16)));
typedef float f32x2_c __attribute__((ext_vector_type(2))); typedef __bf16 bf16x2_c __attribute__((ext_vector_type(2)));
__device__ __forceinline__ unsigned pk2(float lo, float hi) { f32x2_c v = {lo, hi}; return __builtin_bit_cast(unsigned, __builtin_convertvector(v, bf16x2_c)); }
__device__ __forceinline__ unsigned f2bf(float f) { return pk2(f, f) & 0xffffu; }
__device__ __forceinline__ float bf2f(unsigned short h) { return __uint_as_float(((unsigned)h) << 16); }
template <int CTRL> __device__ __forceinline__ float dppf(float old, float src) { return __builtin_bit_cast(float, __builtin_amdgcn_update_dpp(__builtin_bit_cast(int, old), __builtin_bit_cast(int, src), CTRL, 0xF, 0xF, false)); }
__device__ __forceinline__ float row_sum16(float v) { v += dppf<0xB1>(v, v); v += dppf<0x4E>(v, v); v += dppf<0x141>(v, v); v += dppf<0x140>(v, v); return v; }
__device__ __forceinline__ float rdlane(float v, int l) { return __builtin_bit_cast(float, __builtin_amdgcn_readlane(__builtin_bit_cast(int, v), l)); }
__device__ __forceinline__ float wave_sum(float v) { v = row_sum16(v); return (rdlane(v, 0) + rdlane(v, 16)) + (rdlane(v, 32) + rdlane(v, 48)); }
__device__ __forceinline__ float wave_scan(float x, int lane) {
    x += dppf<0x111>(0.f, x); x += dppf<0x112>(0.f, x); x += dppf<0x114>(0.f, x); x += dppf<0x118>(0.f, x);
    const float t0 = rdlane(x, 15), t1 = rdlane(x, 31), t2 = rdlane(x, 47); const int rw = lane >> 4;
    return x + (rw == 0 ? 0.f : (rw == 1 ? t0 : (rw == 2 ? t0 + t1 : (t0 + t1) + t2)));
}
__device__ __forceinline__ float silu_f(float x) { return x / (1.f + __expf(-x)); }
__device__ __forceinline__ float softplus_g(float x) { return x > 20.f ? x : log1pf(__expf(x)); }

struct Args {
    const float* in[27]; float* out; unsigned char* ws;
};
enum { I_X = 0, I_C, I_ADAW, I_ADAB, I_PREG, I_POSTG, I_EINW, I_ECONVW, I_ECONVB, I_EDTB, I_EALOG, I_EDSKIP, I_ENORMG, I_EOUTW,
       I_OINW, I_OFGB, I_OLRE, I_OLIM, I_OLDT, I_OBRE, I_OBIM, I_OCRE, I_OCIM, I_ODSKIP, I_OGLUW, I_OGLUB, I_OOUTW };

__device__ __forceinline__ int src_col0(int n) {
    if (n < 1024) return n;
    if (n < 2048) return 3600 + (n - 1024);
    if (n < 3072) return 1024 + (n - 2048);
    if (n < 4608) return 2048 + (n - 3072);
    if (n < 5632) return 4624 + (n - 4608);
    if (n < 6656) return 5648 + (n - 5632);
    if (n < 6672) return 3584 + (n - 6656);
    return -1;
}
__device__ __forceinline__ int src_col1(int n) {
    if (n < 1536) return 2048 + n;
    if (n < 2048) return 6680 + (n - 1536);
    if (n < 3584) return 3584 + (n - 2048);
    if (n < 5120) return 5120 + (n - 3584);
    if (n < 6656) return n - 5120;
    if (n < 7168) return 1536 + (n - 6656);
    if (n < 7192) return 6656 + (n - 7168);
    return -1;
}
template <int MAP> __device__ __forceinline__ void transpose_item(const float* __restrict__ W, int K, int NSRC, int NDST, bf16* WT, float* scr, int item, int lane, const float* __restrict__ kscale = nullptr) {
    const int nblk = NDST / 32, kb = item / nblk, nb = item % nblk, k0 = 64 * kb, n0 = 32 * nb;
    const int nn = n0 + (lane & 31); const int sc = MAP == 0 ? src_col0(nn) : (MAP == 1 ? src_col1(nn) : nn);
    float tv[32];
#pragma unroll
    for (int i = 0; i < 32; ++i) { const int kk = 2 * i + (lane >> 5); tv[i] = sc >= 0 ? W[(size_t)(k0 + kk) * NSRC + sc] : 0.f; if (kscale && k0 + kk < 1024) tv[i] *= kscale[k0 + kk]; }
#pragma unroll
    for (int i = 0; i < 32; ++i) { const int kk = 2 * i + (lane >> 5); scr[kk * 33 + (lane & 31)] = tv[i]; }
    asm volatile("s_waitcnt lgkmcnt(0)" ::: "memory");
    const int c = lane & 7;
#pragma unroll
    for (int j = 0; j < 4; ++j) { const int n = (lane >> 3) + 8 * j; const float* s = scr + (8 * c) * 33 + n;
        v4u o; o.x = pk2(s[0 * 33], s[1 * 33]); o.y = pk2(s[2 * 33], s[3 * 33]); o.z = pk2(s[4 * 33], s[5 * 33]); o.w = pk2(s[6 * 33], s[7 * 33]);
        *(v4u*)(WT + (size_t)(n0 + n) * K + k0 + 8 * c) = o; }
    asm volatile("s_waitcnt lgkmcnt(0)" ::: "memory");
}

__device__ __forceinline__ float mod_val(const float* modp, const float* adab, int l, int b, int j) {
    float s = adab[l * 3072 + j];
#pragma unroll
    for (int kc = 0; kc < KS; ++kc) s += modp[((size_t)(kc * 2 + l) * 8 + b) * 3072 + j];
    return s;
}

__device__ __forceinline__ void p0_prologue(const Args& A, char* lds, int vcu, int G) {
    const int tid = opaque_tid(), lane = tid & 63, wave = tid >> 6;
    unsigned char* ws = A.ws;
    float* scr = (float*)(lds + wave * 16384);
    const int gw = vcu * NWAVES + wave, NGW = G * NWAVES;
    constexpr int I0 = 16 * (NP0 / 32), I1 = 16 * (NP1 / 32), IO = 32 * 32, IG = 8 * 16;
    constexpr int NITEMS = I0 + I1 + 2 * IO + IG;
    for (int it = gw; it < NITEMS; it += NGW) {
        int r = it;
        if (r < I0) { transpose_item<0>(A.in[I_EINW], 1024, 6672, NP0, (bf16*)(ws + WS_WT0), scr, r, lane); continue; } r -= I0;
        if (r < I1) { transpose_item<1>(A.in[I_OINW], 1024, 7192, NP1, (bf16*)(ws + WS_WT1), scr, r, lane); continue; } r -= I1;
        if (r < IO) { transpose_item<2>(A.in[I_EOUTW], 2048, 1024, 1024, (bf16*)(ws + WS_WO0), scr, r, lane, G == 256 ? A.in[I_ENORMG] : nullptr); continue; } r -= IO;
        if (r < IO) { transpose_item<2>(A.in[I_OOUTW], 2048, 1024, 1024, (bf16*)(ws + WS_WO1), scr, r, lane); continue; } r -= IO;
        transpose_item<2>(A.in[I_OGLUW], 512, 512, 512, (bf16*)(ws + WS_WG), scr, r, lane);
    }
    __syncthreads();
    float* sc = (float*)lds;
    float* modp = (float*)(ws + WS_MODP);
    for (int item = blockIdx.x; item < 2 * KS * 6; item += G) {
        const int l = item / (KS * 6), r = item % (KS * 6), kc = r / 6, cb = r % 6;
        __syncthreads();
        for (int i = tid; i < 1024; i += NTHR) { const int b = i >> 7, k = i & 127; const float cv = A.in[I_C][b * 1024 + kc * 128 + k]; sc[i] = silu_f(cv); }
        __syncthreads();
        const int col = cb * 512 + tid; float acc[8];
#pragma unroll
        for (int b = 0; b < 8; ++b) acc[b] = 0.f;
        const float* wp = A.in[I_ADAW] + ((size_t)l * 1024 + kc * 128) * 3072 + col;
#pragma unroll 16
        for (int k = 0; k < 128; ++k) { const float w = wp[(size_t)k * 3072];
#pragma unroll
            for (int b = 0; b < 8; ++b) acc[b] += sc[b * 128 + k] * w; }
#pragma unroll
        for (int b = 0; b < 8; ++b) modp[((size_t)(kc * 2 + l) * 8 + b) * 3072 + col] = acc[b];
    }
    const int gt = blockIdx.x * NTHR + tid;
    if (gt < 2048) {
        const int g = gt >> 6, n = gt & 63;
        const float dt = __expf(A.in[I_OLDT][g]);
        const float lr = A.in[I_OLRE][g * 64 + n], li = A.in[I_OLIM][g * 64 + n];
        const float mag = expf(lr * dt); float sn, cs; sincosf(li * dt, &sn, &cs);
        const float ar = mag * cs, ai = mag * sn, den = lr * lr + li * li;
        const float qr = ((ar - 1.f) * lr + ai * li) / den, qi = (ai * lr - (ar - 1.f) * li) / den;
        unsigned char* pg = ws + WS_S5P + (size_t)g * S5P_STRIDE;
        bf16* BbT = (bf16*)pg; bf16* Cm = (bf16*)(pg + 4096); float* ari = (float*)(pg + 8192);
        ari[n] = ar; ari[64 + n] = ai;
        for (int c = 0; c < 16; ++c) { const float br = A.in[I_OBRE][(g * 64 + n) * 16 + c], bi = A.in[I_OBIM][(g * 64 + n) * 16 + c];
            BbT[n * 16 + c] = (bf16)f2bf(qr * br - qi * bi); BbT[(64 + n) * 16 + c] = (bf16)f2bf(qr * bi + qi * br);
            Cm[c * 128 + n] = (bf16)f2bf(A.in[I_OCRE][(g * 16 + c) * 64 + n]); Cm[c * 128 + 64 + n] = (bf16)f2bf(-A.in[I_OCIM][(g * 16 + c) * 64 + n]); }
    }
    float* ssq = (float*)(ws + WS_SSQ);
    for (int i = gt; i < MROWS; i += G * NTHR) ssq[i] = 0.f;
}

__device__ __forceinline__ void p1a_rows(const Args& A, char* lds, int G) {
    const int tid = opaque_tid(), lane = tid & 63, wave = tid >> 6;
    const float* modp = (const float*)(A.ws + WS_MODP); float* mv = (float*)lds;
    for (int rb = blockIdx.x; rb < MROWS / 64; rb += G) {
        const int b = rb >> 5;
        __syncthreads();
#pragma unroll 1
        for (int col = tid; col < 1024; col += NTHR) { mv[col] = A.in[I_PREG][col] * (1.f + mod_val(modp, A.in[I_ADAB], 0, b, 1024 + col)); mv[1024 + col] = mod_val(modp, A.in[I_ADAB], 0, b, col); }
        __syncthreads();
        f32x4 mul[4], add[4];
#pragma unroll
        for (int j = 0; j < 4; ++j) { mul[j] = *(const f32x4*)(mv + 4 * lane + 256 * j); add[j] = *(const f32x4*)(mv + 1024 + 4 * lane + 256 * j); }
        f32x4 nx[4];
        { const f32x4* xr = (const f32x4*)(A.in[I_X] + (size_t)(rb * 64 + wave * 8) * DMOD) + lane;
#pragma unroll
          for (int j = 0; j < 4; ++j) nx[j] = xr[64 * j]; }
#pragma unroll 1
        for (int r = 0; r < 8; ++r) { const int m = rb * 64 + wave * 8 + r;
            f32x4 v[4]; float s = 0.f;
#pragma unroll
            for (int j = 0; j < 4; ++j) { v[j] = nx[j]; s += (v[j].x * v[j].x + v[j].y * v[j].y) + (v[j].z * v[j].z + v[j].w * v[j].w); }
            if (r < 7) { const f32x4* xr = (const f32x4*)(A.in[I_X] + (size_t)(m + 1) * DMOD) + lane;
#pragma unroll
                for (int j = 0; j < 4; ++j) nx[j] = xr[64 * j]; }
            const float rstd = rsqrtf(wave_sum(s) * (1.f / DMOD) + RMS_EPS);
            unsigned long long* o8 = (unsigned long long*)((unsigned char*)A.out + (size_t)m * 4096) + lane;
#pragma unroll
            for (int j = 0; j < 4; ++j) { const f32x4 h = v[j] * rstd * mul[j] + add[j]; o8[64 * j] = (unsigned long long)pk2(h.x, h.y) | ((unsigned long long)pk2(h.z, h.w) << 32); } }
    }
}
__device__ __forceinline__ void p3b_rows(const Args& A, char* lds, int G) {
    const int tid = opaque_tid(), lane = tid & 63, wave = tid >> 6;
    const float* modp = (const float*)(A.ws + WS_MODP); float* mv = (float*)lds;
    for (int rb = blockIdx.x; rb < MROWS / 64; rb += G) {
        const int b = rb >> 5;
        __syncthreads();
#pragma unroll 1
        for (int col = tid; col < 1024; col += NTHR) { mv[col] = A.in[I_POSTG][col] * mod_val(modp, A.in[I_ADAB], 0, b, 2048 + col);
            mv[1024 + col] = A.in[I_PREG][1024 + col] * (1.f + mod_val(modp, A.in[I_ADAB], 1, b, 1024 + col)); mv[2048 + col] = mod_val(modp, A.in[I_ADAB], 1, b, col); }
        __syncthreads();
        f32x4 g0[4], mul[4], add[4];
#pragma unroll
        for (int j = 0; j < 4; ++j) { g0[j] = *(const f32x4*)(mv + 4 * lane + 256 * j); mul[j] = *(const f32x4*)(mv + 1024 + 4 * lane + 256 * j); add[j] = *(const f32x4*)(mv + 2048 + 4 * lane + 256 * j); }
        f32x4 nx[4]; v2u ny[4];
        { const int m = rb * 64 + wave * 8; const f32x4* xr = (const f32x4*)(A.in[I_X] + (size_t)m * DMOD) + lane; const v2u* yr = (const v2u*)((unsigned char*)A.out + (size_t)m * 4096) + lane;
#pragma unroll
          for (int j = 0; j < 4; ++j) { nx[j] = xr[64 * j]; ny[j] = yr[64 * j]; } }
#pragma unroll 1
        for (int r = 0; r < 8; ++r) { const int m = rb * 64 + wave * 8 + r;
            unsigned char* slot = (unsigned char*)A.out + (size_t)m * 4096;
            f32x4 v[4], y[4]; float sy = 0.f; v2u wy[4];
#pragma unroll
            for (int j = 0; j < 4; ++j) { v[j] = nx[j]; wy[j] = ny[j]; }
            if (r < 7) { const f32x4* xr = (const f32x4*)(A.in[I_X] + (size_t)(m + 1) * DMOD) + lane; const v2u* yr = (const v2u*)(slot + 4096) + lane;
#pragma unroll
                for (int j = 0; j < 4; ++j) { nx[j] = xr[64 * j]; ny[j] = yr[64 * j]; } }
#pragma unroll
            for (int j = 0; j < 4; ++j) { const v2u w = wy[j]; y[j] = (f32x4){__uint_as_float(w.x << 16), __uint_as_float(w.x & 0xffff0000u), __uint_as_float(w.y << 16), __uint_as_float(w.y & 0xffff0000u)};
                sy += (y[j].x * y[j].x + y[j].y * y[j].y) + (y[j].z * y[j].z + y[j].w * y[j].w); }
            const float ry = rsqrtf(wave_sum(sy) * (1.f / DMOD) + RMS_EPS); float s = 0.f;
#pragma unroll
            for (int j = 0; j < 4; ++j) { v[j] = v[j] + g0[j] * (y[j] * ry); s += (v[j].x * v[j].x + v[j].y * v[j].y) + (v[j].z * v[j].z + v[j].w * v[j].w); }
            const float rstd = rsqrtf(wave_sum(s) * (1.f / DMOD) + RMS_EPS);
            unsigned long long* o8 = (unsigned long long*)(slot + 2048) + lane;
#pragma unroll
            for (int j = 0; j < 4; ++j) { const f32x4 h = v[j] * rstd * mul[j] + add[j]; o8[64 * j] = (unsigned long long)pk2(h.x, h.y) | ((unsigned long long)pk2(h.z, h.w) << 32); } }
    }
}
__device__ __forceinline__ void p6b_rows(const Args& A, char* lds, int G) {
    const int tid = opaque_tid(), lane = tid & 63, wave = tid >> 6;
    const float* modp = (const float*)(A.ws + WS_MODP); float* mv = (float*)lds;
    for (int rb = blockIdx.x; rb < MROWS / 64; rb += G) {
        const int b = rb >> 5;
        __syncthreads();
#pragma unroll 1
        for (int col = tid; col < 1024; col += NTHR) { mv[col] = A.in[I_POSTG][col] * mod_val(modp, A.in[I_ADAB], 0, b, 2048 + col); mv[1024 + col] = A.in[I_POSTG][1024 + col] * mod_val(modp, A.in[I_ADAB], 1, b, 2048 + col); }
        __syncthreads();
        f32x4 g0[4], g1[4];
#pragma unroll
        for (int j = 0; j < 4; ++j) { g0[j] = *(const f32x4*)(mv + 4 * lane + 256 * j); g1[j] = *(const f32x4*)(mv + 1024 + 4 * lane + 256 * j); }
        f32x4 nx[4]; v2u n0[4], n1[4];
        { const int m = rb * 64 + wave * 8; const f32x4* xr = (const f32x4*)(A.in[I_X] + (size_t)m * DMOD) + lane; const v2u* y1r = (const v2u*)((unsigned char*)A.out + (size_t)m * 4096) + lane;
#pragma unroll
          for (int j = 0; j < 4; ++j) { nx[j] = xr[64 * j]; n0[j] = y1r[64 * j]; n1[j] = y1r[256 + 64 * j]; } }
#pragma unroll 1
        for (int r = 0; r < 8; ++r) { const int m = rb * 64 + wave * 8 + r;
            unsigned char* slot = (unsigned char*)A.out + (size_t)m * 4096;
            f32x4 v[4], y0[4], y1[4]; float s0 = 0.f, s1 = 0.f; v2u w0[4], w1[4];
#pragma unroll
            for (int j = 0; j < 4; ++j) { v[j] = nx[j]; w0[j] = n0[j]; w1[j] = n1[j]; }
            if (r < 7) { const f32x4* xr = (const f32x4*)(A.in[I_X] + (size_t)(m + 1) * DMOD) + lane; const v2u* y1r = (const v2u*)(slot + 4096) + lane;
#pragma unroll
                for (int j = 0; j < 4; ++j) { nx[j] = xr[64 * j]; n0[j] = y1r[64 * j]; n1[j] = y1r[256 + 64 * j]; } }
#pragma unroll
            for (int j = 0; j < 4; ++j) { const v2u w = w0[j], u = w1[j];
                y0[j] = (f32x4){__uint_as_float(w.x << 16), __uint_as_float(w.x & 0xffff0000u), __uint_as_float(w.y << 16), __uint_as_float(w.y & 0xffff0000u)};
                y1[j] = (f32x4){__uint_as_float(u.x << 16), __uint_as_float(u.x & 0xffff0000u), __uint_as_float(u.y << 16), __uint_as_float(u.y & 0xffff0000u)};
                s0 += (y0[j].x * y0[j].x + y0[j].y * y0[j].y) + (y0[j].z * y0[j].z + y0[j].w * y0[j].w);
                s1 += (y1[j].x * y1[j].x + y1[j].y * y1[j].y) + (y1[j].z * y1[j].z + y1[j].w * y1[j].w); }
            const float r0 = rsqrtf(wave_sum(s0) * (1.f / DMOD) + RMS_EPS), r1 = rsqrtf(wave_sum(s1) * (1.f / DMOD) + RMS_EPS);
            f32x4* orow = (f32x4*)slot + lane;
#pragma unroll
            for (int j = 0; j < 4; ++j) { const f32x4 x1 = v[j] + g0[j] * (y0[j] * r0); v[j] = x1 + g1[j] * (y1[j] * r1); }
            asm volatile("" ::: "memory");
#pragma unroll
            for (int j = 0; j < 4; ++j) orow[64 * j] = v[j]; }
    }
}
#define BAR_ALL() asm volatile("s_waitcnt vmcnt(0) lgkmcnt(0)\n\ts_barrier" ::: "memory")
#define BAR_LDS() asm volatile("s_waitcnt lgkmcnt(0)\n\ts_barrier" ::: "memory")
typedef float f32x4m __attribute__((ext_vector_type(4)));
__device__ __forceinline__ void p2a_kbar(const Args& A, char* lds, int G) {
    const int tid = opaque_tid(); const bf16* P0 = (const bf16*)(A.ws + WS_BIG); float* kbar = (float*)(A.ws + WS_KBAR); float* red = (float*)lds;
    for (int item = blockIdx.x; item < NB * 16 * 8; item += G) {
        const int b = item >> 7, h = (item >> 3) & 15, n = item & 7; const int c8 = tid & 7, rg = tid >> 3;
        float acc[8];
#pragma unroll
        for (int e = 0; e < 8; ++e) acc[e] = 0.f;
#pragma unroll
        for (int i = 0; i < 4; ++i) { const bf16x8 kv = *(const bf16x8*)(P0 + (size_t)(b * SEQL + n * 256 + rg + 64 * i) * LD0 + C0_K + h * 64 + c8 * 8);
#pragma unroll
            for (int e = 0; e < 8; ++e) acc[e] += bf2f((unsigned short)kv[e]); }
        __syncthreads();
#pragma unroll
        for (int e = 0; e < 8; ++e) red[rg * 65 + c8 * 8 + e] = acc[e];
        __syncthreads();
        if (tid < 64) { float s = 0.f; for (int r = 0; r < 64; ++r) s += red[r * 65 + tid]; kbar[(size_t)item * 64 + tid] = s * (1.f / 256.f); }
    }
    __syncthreads();
}
__device__ __forceinline__ void p2a_conv(const Args& A, int G) {
    const int tid = opaque_tid(); const bf16* P0 = (const bf16*)(A.ws + WS_BIG); bf16* XC = (bf16*)A.out;
    if (tid >= 384) return;
    const int chg = tid % 192, half = tid / 192, ch = chg * 8;
    float w[4][8], bs[8];
#pragma unroll
    for (int k = 0; k < 4; ++k) { const f32x4 a = *(const f32x4*)(A.in[I_ECONVW] + k * 1536 + ch), b2 = *(const f32x4*)(A.in[I_ECONVW] + k * 1536 + ch + 4);
#pragma unroll
        for (int e = 0; e < 4; ++e) { w[k][e] = a[e]; w[k][4 + e] = b2[e]; } }
    { const f32x4 a = *(const f32x4*)(A.in[I_ECONVB] + ch), b2 = *(const f32x4*)(A.in[I_ECONVB] + ch + 4);
#pragma unroll
      for (int e = 0; e < 4; ++e) { bs[e] = a[e]; bs[4 + e] = b2[e]; } }
    for (int rb = blockIdx.x; rb < MROWS / 64; rb += G) {
        const int m0 = rb * 64 + half * 32; const int tb = m0 & (SEQL - 1);
        bf16x8 r0 = {}, r1 = {}, r2 = {};
        if (tb > 0) { r0 = *(const bf16x8*)(P0 + (size_t)(m0 - 3) * LD0 + C0_XBC + ch); r1 = *(const bf16x8*)(P0 + (size_t)(m0 - 2) * LD0 + C0_XBC + ch); r2 = *(const bf16x8*)(P0 + (size_t)(m0 - 1) * LD0 + C0_XBC + ch); }
#pragma unroll 4
        for (int i = 0; i < 32; ++i) { const bf16x8 r3 = *(const bf16x8*)(P0 + (size_t)(m0 + i) * LD0 + C0_XBC + ch); float o[8];
#pragma unroll
            for (int e = 0; e < 8; ++e) { const float a = bs[e] + w[0][e] * bf2f((unsigned short)r0[e]) + w[1][e] * bf2f((unsigned short)r1[e]) + w[2][e] * bf2f((unsigned short)r2[e]) + w[3][e] * bf2f((unsigned short)r3[e]); o[e] = silu_f(a); }
            v4u pw; pw.x = pk2(o[0], o[1]); pw.y = pk2(o[2], o[3]); pw.z = pk2(o[4], o[5]); pw.w = pk2(o[6], o[7]);
            *(v4u*)(XC + (size_t)(m0 + i) * 2048 + ch) = pw; r0 = r1; r1 = r2; r2 = r3; }
    }
}
constexpr int S_CS = 0, S_BS = 17408, S_BST = 34816, S_XT = 53248, S_XWT = 57856, S_XS = 62464, S_GG = 67584, S_SBF = 76800, S_DTA = 85504;
constexpr int F_CS = 0, F_BS = 17408, F_BST = 34816, F_XT = 53248, F_XWT = 62464, F_XS = 71680, F_GG = 80896, F_SBF = 90112, F_DTA = 107520;
template <bool DRY> __device__ __forceinline__ void ssd_unit(const Args& A, char* lds, int b, int h) {
    const int tid = opaque_tid(), lane = tid & 63, wave = __builtin_amdgcn_readfirstlane(tid >> 6); const int fr = lane & 15, fq = lane >> 4;
    bf16* P0 = (bf16*)(A.ws + WS_BIG); const bf16* XC = (const bf16*)A.out; const float* DT = (const float*)(A.ws + WS_DT);
    const int g = h >> 3; const int xcol = h * 64, bcol = 1024 + g * 128, ccol = 1280 + g * 128;
    bf16* CS = (bf16*)(lds + F_CS); bf16* BS = (bf16*)(lds + F_BS); bf16* BST = (bf16*)(lds + F_BST); bf16* XT = (bf16*)(lds + F_XT); bf16* XWT = (bf16*)(lds + F_XWT);
    bf16* XS = (bf16*)(lds + F_XS); bf16* GG = (bf16*)(lds + F_GG); bf16* SBF = (bf16*)(lds + F_SBF); float* DTA0 = (float*)(lds + F_DTA);
    for (int i = tid; i < 64 * 136; i += NTHR) SBF[i] = 0;
    const float Ah = -__expf(A.in[I_EALOG][h]), Dh = A.in[I_EDSKIP][h];
    const int lt = wave >> 1, pt0 = 2 * (wave & 1), st0 = 2 * (wave & 1), nt0 = (wave >> 1) * 2;
    f32x4m sta[2][2];
#pragma unroll
    for (int pi = 0; pi < 2; ++pi)
#pragma unroll
        for (int ni = 0; ni < 2; ++ni) sta[pi][ni] = (f32x4m){0.f, 0.f, 0.f, 0.f};
    const size_t rb0 = (size_t)b * SEQL;
    const bf16* pB = XC + (rb0 + (tid >> 4)) * 2048 + bcol + (tid & 15) * 8; const bf16* pC = XC + (rb0 + (tid >> 4)) * 2048 + ccol + (tid & 15) * 8; const bf16* pX = XC + (rb0 + (tid >> 3)) * 2048 + xcol + (tid & 7) * 8;
    const bf16* pZ = P0 + (rb0 + lt * 16 + 4 * fq) * LD0 + C0_ZA + h * 64 + pt0 * 16 + fr;
    bf16x8 pre[5]; float dtn = 0.f;
    pre[0] = *(const bf16x8*)pB; pre[1] = *(const bf16x8*)(pB + 32 * 2048); pre[2] = *(const bf16x8*)pC; pre[3] = *(const bf16x8*)(pC + 32 * 2048); pre[4] = *(const bf16x8*)pX;
    unsigned short zn[2][4], gts[2][4]; float sqs[2][4];
#pragma unroll
    for (int pi = 0; pi < 2; ++pi)
#pragma unroll
        for (int r = 0; r < 4; ++r) { zn[pi][r] = pZ[(size_t)r * LD0 + 16 * pi]; gts[pi][r] = 0; sqs[pi][r] = 0.f; }
    if (wave == 0) { dtn = DT[(rb0 + lane) * 16 + h]; const float s = wave_scan(Ah * dtn, lane); const float tot = rdlane(s, 63);
        DTA0[lane] = dtn; DTA0[64 + lane] = s; DTA0[128 + lane] = __expf(s); DTA0[192 + lane] = __expf(tot - s); dtn = DT[(rb0 + 64 + lane) * 16 + h]; }
    BAR_LDS();
    for (int c = 0; c < SEQL / 64; ++c) {
        const size_t m0 = rb0 + c * 64; float* DTA = DTA0 + (c & 1) * 256;
        { const int t = tid >> 4, c8 = tid & 15;
          *(bf16x8*)(BS + t * 136 + c8 * 8) = pre[0]; *(bf16x8*)(BS + (t + 32) * 136 + c8 * 8) = pre[1]; *(bf16x8*)(CS + t * 136 + c8 * 8) = pre[2]; *(bf16x8*)(CS + (t + 32) * 136 + c8 * 8) = pre[3];
          const int sw0 = ((((t >> 3) ^ (c8 & 7)) << 3) + (t & 7)), sw1 = (((((t + 32) >> 3) ^ (c8 & 7)) << 3) + (t & 7));
#pragma unroll
          for (int e = 0; e < 8; ++e) { BST[(c8 * 8 + e) * 72 + sw0] = (bf16)pre[0][e]; BST[(c8 * 8 + e) * 72 + sw1] = (bf16)pre[1][e]; }
          const int tx = tid >> 3, cx = tid & 7; *(bf16x8*)(XS + tx * 72 + cx * 8) = pre[4]; const float dtv = DTA[tx], wv = DTA[192 + tx]; const int sx = ((((tx >> 3) ^ cx) << 3) + (tx & 7));
#pragma unroll
          for (int e = 0; e < 8; ++e) { const float xd = bf2f((unsigned short)pre[4][e]) * dtv; XT[(cx * 8 + e) * 72 + sx] = (bf16)f2bf(xd); XWT[(cx * 8 + e) * 72 + sx] = (bf16)f2bf(xd * wv); } }
        if (c > 0) {
#pragma unroll
            for (int pi = 0; pi < 2; ++pi)
#pragma unroll
                for (int r = 0; r < 4; ++r) { const int l = lt * 16 + 4 * fq + r;
                    if (!DRY || sqs[pi][r] == 1.2345e30f) { ((bf16*)pZ)[((size_t)(c - 1) * 64 + r) * LD0 + 16 * pi] = gts[pi][r];
                        if (fr == 0) ((float*)((unsigned char*)A.out + (m0 - 64 + l) * 4096 + 3072))[h * 4 + pt0 + pi] = sqs[pi][r]; } } }
        if (c + 1 < SEQL / 64) { const size_t o = (size_t)(c + 1) * 64 * 2048;
            pre[0] = *(const bf16x8*)(pB + o); pre[1] = *(const bf16x8*)(pB + o + 32 * 2048); pre[2] = *(const bf16x8*)(pC + o); pre[3] = *(const bf16x8*)(pC + o + 32 * 2048); pre[4] = *(const bf16x8*)(pX + o); }
        unsigned short zv[2][4];
#pragma unroll
        for (int pi = 0; pi < 2; ++pi)
#pragma unroll
            for (int r = 0; r < 4; ++r) zv[pi][r] = zn[pi][r];
        if (c + 1 < SEQL / 64) {
#pragma unroll
            for (int pi = 0; pi < 2; ++pi)
#pragma unroll
                for (int r = 0; r < 4; ++r) zn[pi][r] = pZ[((size_t)(c + 1) * 64 + r) * LD0 + 16 * pi]; }
        BAR_LDS();
        f32x4m cb[2], ya[2]; cb[0] = (f32x4m){0.f, 0.f, 0.f, 0.f}; cb[1] = cb[0]; ya[0] = cb[0]; ya[1] = cb[0];
#pragma unroll
        for (int ks = 0; ks < 4; ++ks) { const bf16x8 af = *(const bf16x8*)(CS + (lt * 16 + fr) * 136 + ks * 32 + 8 * fq);
#pragma unroll
            for (int si = 0; si < 2; ++si) { const bf16x8 bfv = *(const bf16x8*)(BS + ((st0 + si) * 16 + fr) * 136 + ks * 32 + 8 * fq); cb[si] = __builtin_amdgcn_mfma_f32_16x16x32_bf16(af, bfv, cb[si], 0, 0, 0); }
#pragma unroll
            for (int pi = 0; pi < 2; ++pi) { const bf16x8 sf = *(const bf16x8*)(SBF + ((pt0 + pi) * 16 + fr) * 136 + ks * 32 + 8 * fq); ya[pi] = __builtin_amdgcn_mfma_f32_16x16x32_bf16(af, sf, ya[pi], 0, 0, 0); } }
#pragma unroll
        for (int r = 0; r < 4; ++r) { const int l = lt * 16 + 4 * fq + r; const float al = DTA[64 + l];
#pragma unroll
            for (int si = 0; si < 2; ++si) { const int s = (st0 + si) * 16 + fr; const float v = (s <= l) ? cb[si][r] * __expf(al - DTA[64 + s]) : 0.f; GG[l * 72 + s] = (bf16)f2bf(v); }
            const float ea = DTA[128 + l]; ya[0][r] *= ea; ya[1][r] *= ea; }
        const float decay = __expf(DTA[64 + 63]);
        BAR_LDS();
#pragma unroll
        for (int ks = 0; ks < 2; ++ks) { const bf16x8 gf = *(const bf16x8*)(GG + (lt * 16 + fr) * 72 + ks * 32 + 8 * fq);
#pragma unroll
            for (int pi = 0; pi < 2; ++pi) { const int p = (pt0 + pi) * 16 + fr; const bf16x8 xf = *(const bf16x8*)(XT + p * 72 + (((ks * 4 + fq) ^ ((p >> 3) & 7)) << 3)); ya[pi] = __builtin_amdgcn_mfma_f32_16x16x32_bf16(gf, xf, ya[pi], 0, 0, 0); } }
#pragma unroll
        for (int pi = 0; pi < 2; ++pi)
#pragma unroll
            for (int ni = 0; ni < 2; ++ni) sta[pi][ni] = sta[pi][ni] * decay;
#pragma unroll
        for (int ks = 0; ks < 2; ++ks) { bf16x8 bt[2];
#pragma unroll
            for (int ni = 0; ni < 2; ++ni) { const int n = (nt0 + ni) * 16 + fr; bt[ni] = *(const bf16x8*)(BST + n * 72 + (((ks * 4 + fq) ^ ((n >> 3) & 7)) << 3)); }
#pragma unroll
            for (int pi = 0; pi < 2; ++pi) { const int p = (pt0 + pi) * 16 + fr; const bf16x8 xw = *(const bf16x8*)(XWT + p * 72 + (((ks * 4 + fq) ^ ((p >> 3) & 7)) << 3));
#pragma unroll
                for (int ni = 0; ni < 2; ++ni) sta[pi][ni] = __builtin_amdgcn_mfma_f32_16x16x32_bf16(xw, bt[ni], sta[pi][ni], 0, 0, 0); } }
#pragma unroll
        for (int pi = 0; pi < 2; ++pi)
#pragma unroll
            for (int ni = 0; ni < 2; ++ni)
#pragma unroll
                for (int r = 0; r < 4; ++r) SBF[((pt0 + pi) * 16 + 4 * fq + r) * 136 + (nt0 + ni) * 16 + fr] = (bf16)f2bf(sta[pi][ni][r]);
#pragma unroll
        for (int pi = 0; pi < 2; ++pi)
#pragma unroll
            for (int r = 0; r < 4; ++r) { const int l = lt * 16 + 4 * fq + r, p = (pt0 + pi) * 16 + fr;
                const float y = ya[pi][r] + Dh * bf2f(XS[l * 72 + p]);
                const float z = bf2f(zv[pi][r]); const float gt = y * silu_f(z);
                gts[pi][r] = (unsigned short)f2bf(gt); sqs[pi][r] = row_sum16(gt * gt); }
        if (wave == 0 && c + 1 < SEQL / 64) { float* DN = DTA0 + ((c + 1) & 1) * 256; const float s = wave_scan(Ah * dtn, lane); const float tot = rdlane(s, 63);
            DN[lane] = dtn; DN[64 + lane] = s; DN[128 + lane] = __expf(s); DN[192 + lane] = __expf(tot - s);
            if (c + 2 < SEQL / 64) dtn = DT[(m0 + 128 + lane) * 16 + h]; }
        BAR_LDS();
    }
#pragma unroll
    for (int pi = 0; pi < 2; ++pi)
#pragma unroll
        for (int r = 0; r < 4; ++r) { const int l = lt * 16 + 4 * fq + r;
            if (!DRY || sqs[pi][r] == 1.2345e30f) { ((bf16*)pZ)[((size_t)(SEQL / 64 - 1) * 64 + r) * LD0 + 16 * pi] = gts[pi][r];
                if (fr == 0) ((float*)((unsigned char*)A.out + (rb0 + SEQL - 64 + l) * 4096 + 3072))[h * 4 + pt0 + pi] = sqs[pi][r]; } }
}
__device__ __forceinline__ void p2c_fixup(const Args& A, int vcu, int G) {
    const int tid = opaque_tid(), lane = tid & 63, wave = tid >> 6; bf16* P0 = (bf16*)(A.ws + WS_BIG); const float* ssq = (const float*)(A.ws + WS_SSQ);
    f32x4 gn[4];
#pragma unroll
    for (int j = 0; j < 4; ++j) gn[j] = *((const f32x4*)A.in[I_ENORMG] + lane + 64 * j);
    for (int m = vcu * NWAVES + wave; m < MROWS; m += G * NWAVES) { const float r = rsqrtf(wave_sum(((const float*)((const unsigned char*)A.out + (size_t)m * 4096 + 3072))[lane]) * (1.f / 1024.f) + RMS_EPS);
        v2u* p = (v2u*)(P0 + (size_t)m * LD0 + C0_ZA) + lane;
#pragma unroll
        for (int j = 0; j < 4; ++j) { const v2u w = p[64 * j]; v2u o; o.x = pk2(__uint_as_float(w.x << 16) * r * gn[j].x, __uint_as_float(w.x & 0xffff0000u) * r * gn[j].y);
            o.y = pk2(__uint_as_float(w.y << 16) * r * gn[j].z, __uint_as_float(w.y & 0xffff0000u) * r * gn[j].w); p[64 * j] = o; } }
}
__device__ __forceinline__ void p5a_fcum(const Args& A, char* lds, int G) {
    const int tid = opaque_tid(), lane = tid & 63, wave = tid >> 6; const float* LF = (const float*)(A.ws + WS_LF); float* F2 = (float*)(A.ws + WS_F2); float* wtot = (float*)(lds + 120 * 1024);
    for (int item = blockIdx.x; item < NB * 24; item += G) { const int b = item / 24, h = item % 24; const float fb = A.in[I_OFGB][h];
        float v[4]; float run = 0.f;
#pragma unroll
        for (int i = 0; i < 4; ++i) { const size_t ix = ((size_t)b * SEQL + 4 * tid + i) * 24 + h; const float* L1p = (const float*)(A.ws + WS_LFP);
            const float fr_ = (LF[ix] + L1p[ix]) + (L1p[ix + (size_t)MROWS * 24] + L1p[ix + (size_t)2 * MROWS * 24]) + fb; run += -softplus_g(-fr_); v[i] = run; }
        float s = run;
#pragma unroll
        for (int o = 1; o < 64; o <<= 1) { const float x = __shfl_up(s, o); if (lane >= o) s += x; }
        __syncthreads();
        if (lane == 63) wtot[wave] = s;
        __syncthreads();
        float off = s - run; for (int w = 0; w < wave; ++w) off += wtot[w];
#pragma unroll
        for (int i = 0; i < 4; ++i) { const float f2v = (off + v[i]) * LOG2E; const int t = 4 * tid + i; F2[(size_t)item * SEQL + t] = f2v;
            if ((t & 127) == 127) wtot[64 + (t >> 7)] = f2v; if ((t & 255) == 0) wtot[96 + (t >> 8)] = f2v; }
        { const bf16* P1 = (const bf16*)(A.ws + WS_BIG); float qm = 0.f, km = 0.f;
#pragma unroll 8
          for (int i = 0; i < 32; ++i) { const size_t m = (size_t)b * SEQL + (tid >> 3) + 64 * i; const int c8 = tid & 7; float qs = 0.f, ks2 = 0.f;
              const bf16x8 qv = *(const bf16x8*)(P1 + m * LD1 + C1_Q + h * 64 + c8 * 8), kv = *(const bf16x8*)(P1 + m * LD1 + C1_K + h * 64 + c8 * 8);
#pragma unroll
              for (int e = 0; e < 8; ++e) { const float qf = bf2f((unsigned short)qv[e]), kf = bf2f((unsigned short)kv[e]); qs += qf * qf; ks2 += kf * kf; }
              qs += dppf<0xB1>(qs, qs); qs += dppf<0x4E>(qs, qs); qs += dppf<0x141>(qs, qs); ks2 += dppf<0xB1>(ks2, ks2); ks2 += dppf<0x4E>(ks2, ks2); ks2 += dppf<0x141>(ks2, ks2);
              qm = fmaxf(qm, qs); km = fmaxf(km, ks2); }
#pragma unroll
          for (int o = 1; o < 64; o <<= 1) { qm = fmaxf(qm, __shfl_xor(qm, o)); km = fmaxf(km, __shfl_xor(km, o)); }
          __syncthreads();
          if (lane == 0) { wtot[16 + wave] = qm; wtot[32 + wave] = km; }
          __syncthreads();
          if (tid < 8) { float a = 0.f, c = 0.f; for (int w = 0; w < 8; ++w) { a = fmaxf(a, wtot[16 + w]); c = fmaxf(c, wtot[32 + w]); } const float u2 = 2.f * sqrtf(a) * sqrtf(c) * 1.01f;
              const int qb = tid; const float fi0 = wtot[96 + qb]; int ts = 0; while (ts + 2 <= 4 * qb && u2 - (wtot[64 + (ts >> 1)] - fi0) <= -40.f) ts += 2;
              ((int*)(A.ws + WS_TS))[item * 8 + qb] = ts; } }
    }
    __syncthreads();
}
constexpr int S5_BU = 0  , S5_SS = 67584  , S5_US = 102400  ;
__device__ __forceinline__ float gelu_tanh(float x) { const float u = 0.7978845608028654f * (x + 0.044715f * x * x * x); const float e = __expf(2.f * u); const float t = 1.f - 2.f / (e + 1.f); return 0.5f * x * (1.f + t); }
__device__ __forceinline__ void s5_unit(const Args& A, char* lds, int b, int g) {
    const int tid = opaque_tid(), lane = tid & 63, wave = __builtin_amdgcn_readfirstlane(tid >> 6); const int fr = lane & 15, fq = lane >> 4, r32 = lane & 31, hi = lane >> 5;
    const bf16* P1 = (const bf16*)(A.ws + WS_BIG); bf16* YD = (bf16*)A.out;
    const unsigned char* pg = A.ws + WS_S5P + (size_t)g * S5P_STRIDE; const bf16* BbT = (const bf16*)pg; const bf16* Cm = (const bf16*)(pg + 4096); const float* ari = (const float*)(pg + 8192);
    const int ttile = wave >> 2, ntile = wave & 3;
    const bf16x8 bfrag = *(const bf16x8*)(BbT + (ntile * 32 + r32) * 16 + 8 * hi);
    bf16x8 cfrag[4];
#pragma unroll
    for (int ks = 0; ks < 4; ++ks) cfrag[ks] = *(const bf16x8*)(Cm + fr * 128 + ks * 32 + 8 * fq);
    const float ar = ari[lane], ai = ari[64 + lane]; float sr = 0.f, si = 0.f;
    const float dskip = A.in[I_ODSKIP][g * 16 + fr];
    const size_t rb0 = (size_t)b * SEQL; const bf16* pU = P1 + (rb0 + ttile * 32 + r32) * LD1 + C1_U + g * 16 + 8 * hi;
    bf16x8 un = *(const bf16x8*)pU;
    BAR_LDS();
    for (int i = 0; i < SEQL / 64 + 2; ++i) {
        if (i < SEQL / 64) { float* BU = (float*)(lds + S5_BU) + (i & 1) * (64 * 132); f32x16 acc = {};
            acc = __builtin_amdgcn_mfma_f32_32x32x16_bf16(un, bfrag, acc, 0, 0, 0);
            if (ntile == 0) *(bf16x8*)((bf16*)(lds + S5_US) + ((i & 3) * 64 + ttile * 32 + r32) * 16 + 8 * hi) = un;
            if (i + 1 < SEQL / 64) un = *(const bf16x8*)(pU + (size_t)(i + 1) * 64 * LD1);
#pragma unroll
            for (int r = 0; r < 16; ++r) { const int t = ttile * 32 + (r & 3) + 8 * (r >> 2) + 4 * hi; BU[t * 132 + ntile * 32 + r32] = acc[r]; } }
        if (wave == 0 && i >= 1 && i <= SEQL / 64) { const float* BU = (const float*)(lds + S5_BU) + ((i - 1) & 1) * (64 * 132); bf16* SS = (bf16*)(lds + S5_SS) + ((i - 1) & 1) * (64 * 136);
#pragma unroll
            for (int hb = 0; hb < 2; ++hb) { float brv[32], biv[32];
#pragma unroll
                for (int t = 0; t < 32; ++t) { brv[t] = BU[(hb * 32 + t) * 132 + lane]; biv[t] = BU[(hb * 32 + t) * 132 + 64 + lane]; }
#pragma unroll
                for (int t = 0; t < 32; ++t) { const float nr = ar * sr - ai * si + brv[t], ni = ar * si + ai * sr + biv[t]; sr = nr; si = ni;
                    const unsigned pk = pk2(sr, si); SS[(hb * 32 + t) * 136 + lane] = (bf16)(pk & 0xffffu); SS[(hb * 32 + t) * 136 + 64 + lane] = (bf16)(pk >> 16); } } }
        if (wave >= 4 && i >= 2) { const bf16* SS = (const bf16*)(lds + S5_SS) + ((i - 2) & 1) * (64 * 136); const int mt = wave - 4; const size_t m0 = rb0 + (size_t)(i - 2) * 64;
            unsigned short uv[4];
#pragma unroll
            for (int r = 0; r < 4; ++r) uv[r] = ((const bf16*)(lds + S5_US))[(((i - 2) & 3) * 64 + mt * 16 + 4 * fq + r) * 16 + fr];
            f32x4m acc = (f32x4m){0.f, 0.f, 0.f, 0.f};
#pragma unroll
            for (int ks = 0; ks < 4; ++ks) { const bf16x8 af = *(const bf16x8*)(SS + (mt * 16 + fr) * 136 + ks * 32 + 8 * fq); acc = __builtin_amdgcn_mfma_f32_16x16x32_bf16(af, cfrag[ks], acc, 0, 0, 0); }
#pragma unroll
            for (int r = 0; r < 4; ++r) { const size_t m = m0 + mt * 16 + 4 * fq + r; YD[m * 2048 + 1024 + g * 16 + fr] = (bf16)f2bf(gelu_tanh(acc[r] + dskip * bf2f(uv[r]))); } }
        BAR_LDS();
    }
}
template <bool DRY> __device__ __forceinline__ void moba_phase(const Args& A, char* lds, int vcu, int G) {
    const bf16* P0 = (const bf16*)(A.ws + WS_BIG); const float* kbar = (const float*)(A.ws + WS_KBAR);
    unsigned* cnt = (unsigned*)(A.ws + WS_CNT) + (DRY ? 192 : 128); volatile unsigned* lw = (volatile unsigned*)(lds + BARST_OFF + 16);
    const int tid = opaque_tid();
    if (tid == 0) lw[0] = atomicAdd(cnt, 1u);
    BAR_ALL();
    int u = __builtin_amdgcn_readfirstlane((int)lw[0]);
    while (u < NB * 16 * 8) {
        unsigned nxt = 0u; if (tid == 0) nxt = atomicAdd(cnt, 1u);
        const int qb = 7 - u / 128, bh = u % 128, b = bh >> 4, h = bh & 15;
        attn_body::attn_unit<8, 0, LD0, DRY>(b, h, qb, (const attn_body::bf16*)(P0 + C0_Q), (const attn_body::bf16*)(P0 + C0_K), (const attn_body::bf16*)(P0 + C0_V), (attn_body::bf16*)(P0 + C0_Q),
                                            (const attn_body::bf16*)(P0 + C0_ZB), kbar + (size_t)bh * 512, nullptr, lw, nxt, lds);
        BAR_LDS();
        u = __builtin_amdgcn_readfirstlane((int)lw[0]);
    }
}
template <bool DRY> __device__ __forceinline__ void fox_phase(const Args& A, char* lds, int vcu, int G) {
    const bf16* P1 = (const bf16*)(A.ws + WS_BIG); const float* F2 = (const float*)(A.ws + WS_F2); const int* TSv = (const int*)(A.ws + WS_TS);
    unsigned* cnt = (unsigned*)(A.ws + WS_CNT) + (DRY ? 64 : 0); volatile unsigned* lw = (volatile unsigned*)(lds + BARST_OFF + 16);
    const int tid = opaque_tid();
    if (tid == 0) lw[0] = atomicAdd(cnt, 1u);
    BAR_ALL();
    int u = __builtin_amdgcn_readfirstlane((int)lw[0]);
    while (u < NB * 24 * 8) {
        unsigned nxt = 0u; if (tid == 0) nxt = atomicAdd(cnt, 1u);
        const int qb = 7 - u / 192, bh = u % 192, b = bh / 24, h = bh % 24;
        attn_body::attn_unit<8, 1, LD1, DRY>(b, h, qb, (const attn_body::bf16*)(P1 + C1_Q), (const attn_body::bf16*)(P1 + C1_K), (const attn_body::bf16*)(P1 + C1_V), (attn_body::bf16*)(P1 + C1_Q),
                                            (const attn_body::bf16*)(P1 + C1_ZC), F2 + (size_t)bh * SEQL, TSv + bh * 8, lw, nxt, lds);
        BAR_LDS();
        u = __builtin_amdgcn_readfirstlane((int)lw[0]);
    }
}
#define LAS __attribute__((address_space(3)))
#define XB_TMO      128
#define XB_XCNT(j)  (256  + 64 * (j))
#define XB_XSUB(j)  (1280 + 64 * (j))
#define XB_XGEN(j)  (2304 + 64 * (j))
#define XB_TOP      3328
#define XB_TOPGEN   3392
#define XCD_BAR_WORDS 3456
#define XB_SPIN_CAP (1u << 18)

__device__ __forceinline__ unsigned xb_ld(unsigned* p)              { return __hip_atomic_load(p, __ATOMIC_RELAXED, __HIP_MEMORY_SCOPE_AGENT); }
__device__ __forceinline__ unsigned xb_add(unsigned* p, unsigned v) { return __hip_atomic_fetch_add(p, v, __ATOMIC_RELAXED, __HIP_MEMORY_SCOPE_AGENT); }
__device__ __forceinline__ unsigned xb_xcc_id() { return (unsigned)__builtin_amdgcn_s_getreg((3 << 11) | 20) & 0xFu; }
#define XB_SPIN(cond, bar) do { unsigned _sp = 0; while (cond) { __builtin_amdgcn_s_sleep(1); \
    if ((++_sp & 255u) == 0u) { if (xb_ld(&(bar)[XB_TMO])) break; if (_sp > XB_SPIN_CAP) { atomicAdd(&(bar)[XB_TMO], 1u); break; } } } } while (0)

struct XcdBarrier {
    unsigned* bar; unsigned x;
    volatile LAS unsigned* st;
};

__device__ __forceinline__ XcdBarrier xcd_barrier_post(unsigned* bar, volatile LAS unsigned* st) {
    XcdBarrier b; b.bar = bar; b.x = xb_xcc_id(); b.st = st;
    if (threadIdx.x == 0) (void)xb_add(&bar[XB_XCNT(b.x)], 1u);
    return b;
}
__device__ __forceinline__ void xcd_barrier_complete(unsigned* bar, unsigned x, unsigned& nloc, unsigned& nx) {
    const unsigned G = gridDim.x * gridDim.y * gridDim.z;
    unsigned sum, cnt, mine, sp = 0u;
    for (;;) {
        sum = 0u; cnt = 0u; mine = 0u;
#pragma unroll
        for (unsigned j = 0; j < 16; ++j) { const unsigned c = xb_ld(&bar[XB_XCNT(j)]); sum += c; cnt += (c > 0u) ? 1u : 0u; mine = (j == x) ? c : mine; }
        if (sum == G) break;
        __builtin_amdgcn_s_sleep(1);
        if ((++sp & 255u) == 0u) { if (xb_ld(&bar[XB_TMO])) break; if (sp > XB_SPIN_CAP) { atomicAdd(&bar[XB_TMO], 1u); break; } }
    }
    nloc = mine > 0u ? mine : 1u; nx = cnt > 0u ? cnt : 1u;
}

__device__ __forceinline__ void xcd_barrier(const XcdBarrier& b) {
    asm volatile("s_waitcnt vmcnt(0)" ::: "memory");
    __syncthreads();
    if (threadIdx.x == 0) {
        unsigned* bar = b.bar;
        __builtin_amdgcn_s_waitcnt(0);
        unsigned nloc = b.st[0], nx = b.st[1];
        if (nloc == 0u) { xcd_barrier_complete(bar, b.x, nloc, nx); b.st[0] = nloc; b.st[1] = nx; }
        const unsigned old = xb_add(&bar[XB_XSUB(b.x)], 1u);
        const unsigned gen = old / nloc;
        if (old + 1u == (gen + 1u) * nloc) {
            __builtin_amdgcn_fence(__ATOMIC_RELEASE, "agent");
            asm volatile("s_waitcnt vmcnt(0)" ::: "memory");
            const unsigned og = xb_add(&bar[XB_TOP], 1u);
            const unsigned tg = og / nx;
            if (og + 1u == (tg + 1u) * nx) xb_add(&bar[XB_TOPGEN], 1u);
            else XB_SPIN(xb_ld(&bar[XB_TOPGEN]) == tg, bar);
            __builtin_amdgcn_fence(__ATOMIC_ACQUIRE, "agent");
            xb_add(&bar[XB_XGEN(b.x)], 1u);
            asm volatile("s_waitcnt vmcnt(0)" ::: "memory");
        } else {
            XB_SPIN(xb_ld(&bar[XB_XGEN(b.x)]) == gen, bar);
            __builtin_amdgcn_fence(__ATOMIC_ACQUIRE, "agent");
            asm volatile("s_waitcnt vmcnt(0)" ::: "memory");
        }
    }
    __syncthreads();
}

constexpr int ARGS_OFF = 132096;
__device__ __forceinline__ Args get_args(const unsigned char* lds) {
    Args a; const unsigned long long* p = (const unsigned long long*)(lds + ARGS_OFF);
#pragma unroll
    for (int i = 0; i < 29; ++i) { const unsigned long long v = p[i]; const unsigned lo = __builtin_amdgcn_readfirstlane((unsigned)v), hi = __builtin_amdgcn_readfirstlane((unsigned)(v >> 32));
        const unsigned long long w = ((unsigned long long)hi << 32) | lo; if (i < 27) a.in[i] = (const float*)w; else if (i == 27) a.out = (float*)w; else a.ws = (unsigned char*)w; }
    return a;
}
#define PHASE_BEGIN { const Args args = get_args(lds); unsigned char* ws = args.ws; bf16* XN = (bf16*)args.out; bf16* PB = (bf16*)(ws + WS_BIG); (void)ws; (void)XN; (void)PB;
#ifdef DUP_SYNC
#define PHASE_END } xcd_barrier(xbar); xcd_barrier(xbar);
#else
#define PHASE_END } xcd_barrier(xbar);
#endif
#define PHASE_END_NOSYNC }
__global__ void __launch_bounds__(NTHR, 2) trunk_fwd(Args kargs_unused) {
    extern __shared__ __attribute__((aligned(16))) unsigned char lds[];
    cg::grid_group grid = cg::this_grid();
    const int G = gridDim.x, bx = blockIdx.x; const int vcu = (G % 8 == 0) ? (bx % 8) * (G / 8) + bx / 8 : bx;
    char* ldsc = (char*)lds; PG8_LAS unsigned char* ldsg = (PG8_LAS unsigned char*)lds;
    { const int t = opaque_tid(); if (t < 29) { const unsigned long long* ka = (const unsigned long long*)__builtin_amdgcn_kernarg_segment_ptr(); ((unsigned long long*)(lds + ARGS_OFF))[t] = ka[t]; }
      if (t < 2) ((unsigned*)(lds + BARST_OFF))[t] = 0u; }
    __syncthreads();
    XcdBarrier xbar;
    {
    const Args args = get_args(lds);
    unsigned* rdy = (unsigned*)(args.ws + WS_BAR) + 4160;
    if (bx == 0) { unsigned* bw = (unsigned*)(args.ws + WS_BAR); for (int i = opaque_tid(); i < 4096; i += NTHR) bw[i] = 0u;
        asm volatile("s_waitcnt vmcnt(0)" ::: "memory"); __syncthreads();
        if (opaque_tid() == 0) { __builtin_amdgcn_fence(__ATOMIC_RELEASE, "agent"); asm volatile("s_waitcnt vmcnt(0)" ::: "memory"); __hip_atomic_store(rdy, 0x600DF00Du, __ATOMIC_RELAXED, __HIP_MEMORY_SCOPE_AGENT); } }
    if (G > 0x40000000) grid.sync();
    p0_prologue(args, ldsc, vcu, G);
    if (opaque_tid() == 0) { unsigned sp = 0; while (__hip_atomic_load(rdy, __ATOMIC_RELAXED, __HIP_MEMORY_SCOPE_AGENT) != 0x600DF00Du && ++sp < (1u << 22)) __builtin_amdgcn_s_sleep(2);
        __builtin_amdgcn_fence(__ATOMIC_ACQUIRE, "agent"); asm volatile("s_waitcnt vmcnt(0)" ::: "memory"); }
    __syncthreads();
    xbar = xcd_barrier_post((unsigned*)(args.ws + WS_BAR), (volatile LAS unsigned*)(lds + BARST_OFF));
    xcd_barrier(xbar);
    if (bx == 0 && opaque_tid() == 0) __hip_atomic_store(rdy, 0u, __ATOMIC_RELAXED, __HIP_MEMORY_SCOPE_AGENT);
    }
    PHASE_BEGIN
    p1a_rows(args, ldsc, G);
#ifdef DUP_MISC
    p1a_rows(args, ldsc, G);
#endif
    PHASE_END
    PHASE_BEGIN
    { pg8::Gemm g{XN, (const bf16*)(ws + WS_WT0), MROWS, NP0, 1024, 2048, 1024, 0}; pg8::StaticOrder S; S.init(MROWS, NP0, G, bx);
      pg8::EpiX<0> E{PB, LD0, args.in[I_EDTB], (float*)(ws + WS_DT), nullptr, nullptr, attn_body::C2};
      pg8::gemm_phase<pg8::EpiX<0>, pg8::StaticOrder, true, true>(ldsg, g, S, E); }
#ifdef DUP_GEMM
    { pg8::Gemm g{XN, (const bf16*)(ws + WS_WT0), MROWS, NP0, 1024, 2048, 1024, 0}; pg8::StaticOrder S; S.init(MROWS, NP0, G, bx);
      pg8::EpiX<0> E{PB, LD0, args.in[I_EDTB], (float*)(ws + WS_DT), nullptr, nullptr, attn_body::C2};
      pg8::gemm_phase<pg8::EpiX<0>, pg8::StaticOrder, true, true>(ldsg, g, S, E); }
#endif
    PHASE_END
    PHASE_BEGIN
    p2a_kbar(args, ldsc, G);
    p2a_conv(args, G);
#ifdef DUP_MISC
    p2a_kbar(args, ldsc, G);
    p2a_conv(args, G);
#endif
    PHASE_END
    PHASE_BEGIN
#ifdef DUP_SSD
    for (int v = vcu; v < 128; v += G) ssd_unit<true>(args, ldsc, v >> 4, v & 15);
#endif
    for (int v = vcu; v < 128; v += G) ssd_unit<false>(args, ldsc, v >> 4, v & 15);
    PHASE_END_NOSYNC
    PHASE_BEGIN
#ifdef DUP_MOBA
    moba_phase<true>(args, ldsc, vcu, G);
#endif
    moba_phase<false>(args, ldsc, vcu, G);
    PHASE_END
    if (G != 256) {
    PHASE_BEGIN
    p2c_fixup(args, vcu, G);
    PHASE_END
    }
    PHASE_BEGIN
    { pg8::Gemm g{PB, (const bf16*)(ws + WS_WO0), MROWS, 1024, 2048, LD0, 2048, 0}; pg8::StaticOrder S; S.init(MROWS, 1024, G, bx);
      { pg8::Unit u0; u0.pm = 0; u0.pn = 0; const bool have = S.next(0, u0); const int pm0 = u0.pm; float* rs = (float*)(lds + 131072); const int t = opaque_tid();
        if (t < 256) { float r = 1.f;
            if (G == 256 && have) { const f32x4* pp = (const f32x4*)((const unsigned char*)args.out + (size_t)(pm0 * 256 + t) * 4096 + 3072); float sm = 0.f;
#pragma unroll
                for (int i = 0; i < 16; ++i) { const f32x4 v = pp[i]; sm += (v.x + v.y) + (v.z + v.w); }
                r = rsqrtf(sm * (1.f / 1024.f) + RMS_EPS); }
            rs[t] = r; }
        __syncthreads(); }
      pg8::EpiX<5> E{XN, 2048, nullptr, nullptr, nullptr, nullptr, 1.f};
      pg8::gemm_phase<pg8::EpiX<5>, pg8::StaticOrder, true, true>(ldsg, g, S, E); }
    PHASE_END
    PHASE_BEGIN
    p3b_rows(args, ldsc, G);
#ifdef DUP_MISC
    p3b_rows(args, ldsc, G);
#endif
    PHASE_END
    PHASE_BEGIN
    { pg8::Gemm g{XN + 1024, (const bf16*)(ws + WS_WT1), MROWS, LD1, 1024, 2048, 1024, 0}; pg8::StaticOrder S; S.init(MROWS, LD1, G, bx);
      pg8::EpiX<1> E{PB, LD1, nullptr, nullptr, nullptr, nullptr, attn_body::C2};
      pg8::gemm_phase<pg8::EpiX<1>, pg8::StaticOrder, true, true>(ldsg, g, S, E); }
    { pg8::Gemm g{XN + 1024, (const bf16*)(ws + WS_WT1) + (size_t)LD1 * 1024, MROWS, 1024, 256, 2048, 1024, 1}; pg8::StaticOrder S; S.init(MROWS, 1024, G, bx);
      pg8::EpiX<4> E{nullptr, 0, nullptr, (float*)(ws + WS_LF), (const bf16*)(ws + WS_LFP), nullptr, 1.f};
      pg8::gemm_phase<pg8::EpiX<4>, pg8::StaticOrder, true, true>(ldsg, g, S, E); }
#ifdef DUP_GEMM
    { pg8::Gemm g{XN + 1024, (const bf16*)(ws + WS_WT1), MROWS, LD1, 1024, 2048, 1024, 0}; pg8::StaticOrder S; S.init(MROWS, LD1, G, bx);
      pg8::EpiX<1> E{PB, LD1, nullptr, nullptr, nullptr, nullptr, attn_body::C2};
      pg8::gemm_phase<pg8::EpiX<1>, pg8::StaticOrder, true, true>(ldsg, g, S, E); }
#endif
    PHASE_END
    PHASE_BEGIN
    p5a_fcum(args, ldsc, G);
#ifdef DUP_S5
    p5a_fcum(args, ldsc, G);
#endif
    for (int v = vcu; v < 256; v += G) s5_unit(args, ldsc, v >> 5, v & 31);
#ifdef DUP_S5
    for (int v = vcu; v < 256; v += G) s5_unit(args, ldsc, v >> 5, v & 31);
#endif
    PHASE_END
    PHASE_BEGIN
#ifdef DUP_FOX
    fox_phase<true>(args, ldsc, vcu, G);
#endif
    if (vcu < 128) { pg8::Gemm g{XN + 1024, (const bf16*)(ws + WS_WG), MROWS, 512, 512, 2048, 512, 0}; pg8::StaticOrder S; S.init(MROWS, 512, 128, vcu);
      pg8::EpiX<3> E{PB + C1_U, LD1, args.in[I_OGLUB], nullptr, XN + 1024, PB + C1_ZD, 1.f};
      pg8::gemm_phase<pg8::EpiX<3>, pg8::StaticOrder, true, true>(ldsg, g, S, E); }
    fox_phase<false>(args, ldsc, vcu, G);
    PHASE_END
    PHASE_BEGIN
    { pg8::Gemm g{PB, (const bf16*)(ws + WS_WO1), MROWS, 1024, 2048, LD1, 2048, 0}; pg8::StaticOrder S; S.init(MROWS, 1024, G, bx);
      pg8::EpiX<2> E{XN + 1024, 2048, nullptr, nullptr, nullptr, nullptr, 1.f};
      pg8::gemm_phase<pg8::EpiX<2>, pg8::StaticOrder, true, true>(ldsg, g, S, E); }
#ifdef DUP_GEMM
    { pg8::Gemm g{PB, (const bf16*)(ws + WS_WO1), MROWS, 1024, 2048, LD1, 2048, 0}; pg8::StaticOrder S; S.init(MROWS, 1024, G, bx);
      pg8::EpiX<2> E{XN + 1024, 2048, nullptr, nullptr, nullptr, nullptr, 1.f};
      pg8::gemm_phase<pg8::EpiX<2>, pg8::StaticOrder, true, true>(ldsg, g, S, E); }
#endif
    PHASE_END
    PHASE_BEGIN
    p6b_rows(args, ldsc, G);
    PHASE_END_NOSYNC
}

extern "C" void kernel_launch(void* const* d_in, const int* in_sizes, int n_in, void* d_out, int out_size, void* d_ws, size_t ws_size, hipStream_t stream) {
    static int grid = 0;
    if (grid == 0) {
        if (n_in != 27 || out_size != MROWS * DMOD || ws_size < (size_t)256 * MiB) { fprintf(stderr, "kernel_launch: unexpected shapes n_in %d out %d ws %zu\n", n_in, out_size, ws_size); grid = -1; return; }
        int dev = 0, cus = 0, per_cu = 0;
        (void)hipGetDevice(&dev); (void)hipDeviceGetAttribute(&cus, hipDeviceAttributeMultiprocessorCount, dev);
        if (hipFuncSetAttribute((const void*)trunk_fwd, hipFuncAttributeMaxDynamicSharedMemorySize, LDS_BYTES) != hipSuccess) { fprintf(stderr, "kernel_launch: hipFuncSetAttribute failed\n"); }
        if (hipOccupancyMaxActiveBlocksPerMultiprocessor(&per_cu, (const void*)trunk_fwd, NTHR, LDS_BYTES) != hipSuccess || per_cu < 1) { fprintf(stderr, "kernel_launch: occupancy query says %d\n", per_cu); per_cu = 1; }
        (void)hipGetLastError();
        grid = cus * per_cu; if (grid > 256) grid = 256; if (grid < 1) grid = 256;
    }
    if (grid < 0) return;
    Args a{};
    for (int i = 0; i < 27; ++i) a.in[i] = (const float*)d_in[i];
    a.out = (float*)d_out; a.ws = (unsigned char*)d_ws;
    void* kargs[] = {&a};
    hipError_t e = hipLaunchCooperativeKernel((const void*)trunk_fwd, dim3(grid), dim3(NTHR), kargs, LDS_BYTES, stream);
    if (e != hipSuccess) fprintf(stderr, "cooperative launch failed: %s (grid %d)\n", hipGetErrorString(e), grid);
}
```

```cpp
#include <hip/hip_runtime.h>
#include <hip/hip_cooperative_groups.h>
#include <cstdio>
#include <cstdint>
namespace cg = cooperative_groups;
__device__ __forceinline__ int opaque_tid() { int t = threadIdx.x; asm volatile("" : "+v"(t)); return t; }
namespace pg8 {
#define PG8_LAS __attribute__((address_space(3)))
typedef unsigned short bf16_t;
typedef short bf16x8 __attribute__((ext_vector_type(8)));
typedef float f32x4 __attribute__((ext_vector_type(4)));
typedef unsigned u32x4 __attribute__((ext_vector_type(4)));
constexpr int BM = 256, BK = 64, HALF = 128, HTB = HALF * BK * 2  , STAGE_BYTES = 8 * HTB, NXCD = 8, WGM = 8;

__host__ __device__ __forceinline__ int lds_byte(int r, int c) { const int st = (r >> 4) * 2 + (c >> 5), rr = r & 15, cc = c & 31, ob = rr * 64 + cc * 2; return st * 1024 + (ob ^ (((ob >> 9) & 1) << 5)); }
__host__ __device__ __forceinline__ void stage_rc(int b, int& R, int& C) { const int st = b / 1024, sb = b % 1024, swz = sb ^ (((sb >> 9) & 1) << 5); R = (st >> 1) * 16 + swz / 64; C = (st & 1) * 32 + (swz % 64) / 2; }
__host__ __device__ __forceinline__ int perm32(int rho) { const int n = rho >> 4, i = rho & 15; return 8 * (i >> 2) + 4 * n + (i & 3); }

struct Unit { int pm, pn; };
struct Gemm { const bf16_t* A; const bf16_t* Bt; int M, N, K, lda, ldb, ksplit; };

struct StaticOrder {
    int nM, nN, nwg, G, c;
    __host__ __device__ __forceinline__ void init(int M, int N, int G_, int c_) { nM = M / BM; nN = N / BM; nwg = nM * nN; G = G_; c = c_; }
    __host__ __device__ __forceinline__ bool next(int i, Unit& u) const {
        const long L = (long)i * G + c; if (L >= nwg) return false;
        int wgid = (int)L; { const int q = nwg / NXCD, r = nwg % NXCD, xcd = wgid % NXCD, off = wgid / NXCD; wgid = (xcd < r ? xcd * (q + 1) : r * (q + 1) + (xcd - r) * q) + off; }
        const int nig = WGM * nN, gid = wgid / nig, fm = gid * WGM, gsz = (nM - fm) < WGM ? (nM - fm) : WGM;
        u.pm = fm + ((wgid % nig) % gsz); u.pn = (wgid % nig) / gsz; return true;
    }
    __device__ __forceinline__ void a_ready(const Unit&) const {}
    __device__ __forceinline__ void done(const Unit&) const {}
};

__device__ __forceinline__ unsigned cvt_pk_bf16(float lo, float hi) { unsigned r; asm volatile("v_cvt_pk_bf16_f32 %0, %1, %2" : "=v"(r) : "v"(lo), "v"(hi)); return r; }
__device__ __forceinline__ float bflo(unsigned w) { return __uint_as_float(w << 16); }
__device__ __forceinline__ float bfhi(unsigned w) { return __uint_as_float(w & 0xffff0000u); }
__device__ __forceinline__ float softplus_f(float x) { return x > 20.f ? x : log1pf(__expf(x)); }
__device__ __forceinline__ float sigmoid_f(float x) { return 1.f / (1.f + __expf(-x)); }
constexpr int MROWS_ = 16384;
template <int MODE> struct EpiX {
    static constexpr bool PERM = true, AFTER_DRAIN = false; static constexpr int MIDT = (MODE == 5) ? 16 : -1;
    bf16_t* O; int ldc; const float* bias; float* F32O; const bf16_t* Y; const bf16_t* Zp; float qscale;
    __device__ __forceinline__ void mid(f32x4 (&acc)[2][2][4][2], int wr, int fr, PG8_LAS unsigned char* lds) const {
        const PG8_LAS float* rs = (const PG8_LAS float*)(lds + 131072);
#pragma unroll
        for (int ai = 0; ai < 2; ++ai)
#pragma unroll
            for (int m = 0; m < 4; ++m) { const float r = rs[ai * HALF + wr * 64 + m * 16 + fr];
#pragma unroll
                for (int bj = 0; bj < 2; ++bj)
#pragma unroll
                    for (int n = 0; n < 2; ++n) acc[ai][bj][m][n] = acc[ai][bj][m][n] * r; }
    }
    __device__ __forceinline__ void operator()(const f32x4 (&acc)[2][2][4][2], const Unit& u, int wr, int wc, int fr, int fq) const {
        const int row0 = u.pm * BM + wr * 64 + fr; const int col0 = u.pn * BM + wc * 32 + 8 * fq;
        float sc = 1.f;
        if (MODE == 0) { if (u.pn >= 4 && u.pn < 8) sc = qscale; }
        if (MODE == 1) { if (u.pn < 6) sc = qscale; }
        const bool special = (MODE == 0 && u.pn == 26);
#pragma unroll
        for (int ai = 0; ai < 2; ++ai)
#pragma unroll
            for (int m = 0; m < 4; ++m) { const int row = row0 + ai * HALF + m * 16;
#pragma unroll
                for (int bj = 0; bj < 2; ++bj) { f32x4 v0 = acc[ai][bj][m][0], v1 = acc[ai][bj][m][1]; const int col = col0 + bj * HALF;
                    if (MODE == 0 || MODE == 1) {
                        if (!special) { v0 = v0 * sc; v1 = v1 * sc; u32x4 w; w.x = cvt_pk_bf16(v0[0], v0[1]); w.y = cvt_pk_bf16(v0[2], v0[3]); w.z = cvt_pk_bf16(v1[0], v1[1]); w.w = cvt_pk_bf16(v1[2], v1[3]);
                            *(u32x4*)(O + (size_t)row * ldc + col) = w; }
                        else { const int lc = col - u.pn * BM; const int NV = (MODE == 0) ? 16 : 24;
                            if (lc < NV) { f32x4 o0, o1;
#pragma unroll
                                for (int i = 0; i < 4; ++i) { const float a0 = v0[i] + bias[lc + i], a1 = v1[i] + bias[lc + 4 + i];
                                    if (MODE == 0) { o0[i] = softplus_f(a0); o1[i] = softplus_f(a1); } else { o0[i] = -softplus_f(-a0); o1[i] = -softplus_f(-a1); } }
                                *(f32x4*)(F32O + (size_t)row * NV + lc) = o0; *(f32x4*)(F32O + (size_t)row * NV + lc + 4) = o1; } }
                    } else if (MODE == 4) {
                        const int lc = col - u.pn * BM;
                        if (lc < 24) { float* dst = (u.pn == 0 ? F32O : (float*)((unsigned char*)Y + (size_t)(u.pn - 1) * (MROWS_ * 24 * 4))) + (size_t)row * 24 + lc; *(f32x4*)dst = v0; *(f32x4*)(dst + 4) = v1; }
                    } else if (MODE == 2 || MODE == 5) {
                        u32x4 w; w.x = cvt_pk_bf16(v0[0], v0[1]); w.y = cvt_pk_bf16(v0[2], v0[3]); w.z = cvt_pk_bf16(v1[0], v1[1]); w.w = cvt_pk_bf16(v1[2], v1[3]);
                        *(u32x4*)(O + (size_t)row * ldc + col) = w;
                    } else {
                        const u32x4 yv = *(const u32x4*)(Y + (size_t)row * 2048 + col); const u32x4 zv = *(const u32x4*)(Zp + (size_t)row * ldc + col);
                        const f32x4 b0 = *(const f32x4*)(bias + col), b1 = *(const f32x4*)(bias + col + 4);
                        float r[8];
#pragma unroll
                        for (int e = 0; e < 4; ++e) { const float y0 = bflo(yv[e]), y1 = bfhi(yv[e]), z0 = bflo(zv[e]), z1 = bfhi(zv[e]);
                            const float a0 = (e < 2 ? v0[2 * e] : v1[2 * e - 4]) + (e < 2 ? b0[2 * e] : b1[2 * e - 4]);
                            const float a1 = (e < 2 ? v0[2 * e + 1] : v1[2 * e - 3]) + (e < 2 ? b0[2 * e + 1] : b1[2 * e - 3]);
                            r[2 * e] = y0 * sigmoid_f(a0) * z0 * sigmoid_f(z0); r[2 * e + 1] = y1 * sigmoid_f(a1) * z1 * sigmoid_f(z1); }
                        u32x4 w; w.x = cvt_pk_bf16(r[0], r[1]); w.y = cvt_pk_bf16(r[2], r[3]); w.z = cvt_pk_bf16(r[4], r[5]); w.w = cvt_pk_bf16(r[6], r[7]);
                        *(u32x4*)(O + (size_t)row * ldc + col) = w;
                    } } }
    }
};
template <class Epi, class Sched, bool ALIGN_EPI = false, bool SP2 = false>
__device__ __forceinline__ void gemm_phase(PG8_LAS unsigned char* lds, const Gemm g, const Sched& S, const Epi& E) {
    const int tid = opaque_tid(), wid = __builtin_amdgcn_readfirstlane(tid >> 6), lane = tid & 63, wr = wid >> 2, wc = wid & 3, fr = lane & 15, fq = lane >> 4;
    const int K = g.K, nt = K / BK;
    unsigned voffA[2], voffB[2];
#pragma unroll
    for (int i = 0; i < 2; ++i) { int R, C; stage_rc(tid * 16 + i * 8192, R, C); const int Rb = Epi::PERM ? ((R & ~31) + perm32(R & 31)) : R;
        voffA[i] = (unsigned)(R * g.lda + C) * 2u; voffB[i] = (unsigned)(Rb * g.ldb + C) * 2u; }
    const size_t kstep = (size_t)(BK * 2);
    const size_t hstepA = (size_t)HALF * g.lda * 2, hstepB = (size_t)HALF * g.ldb * 2;
    const size_t tstepA = 2 * hstepA, tstepB = g.ksplit ? (size_t)K * 2 : 2 * hstepB, kslA = g.ksplit ? (size_t)K * 2 : 0;
    const unsigned ldsw = (unsigned)wid * 1024u;
    const int aoff = lds_byte(wr * 64 + fr, fq * 8), boff = lds_byte(wc * 32 + fr, fq * 8);
#define PG8_SA(b, h) (((b) * 2 + (h)) * HTB)
#define PG8_SB(b, h) ((4 + (b) * 2 + (h)) * HTB)
#define PG8_STAGE(bufoff, gbase, voff) do { _Pragma("unroll") for (int _i = 0; _i < 2; ++_i) \
        __builtin_amdgcn_global_load_lds((const unsigned*)((const char*)(gbase) + (voff)[_i]), (PG8_LAS unsigned*)(lds + (bufoff) + ldsw + _i * 8192), 16, 0, 0); } while (0)
#define PG8_LDA(dst, b, h) do { _Pragma("unroll") for (int m = 0; m < 4; ++m) _Pragma("unroll") for (int k = 0; k < 2; ++k) dst[m][k] = *(const PG8_LAS bf16x8*)(lds + PG8_SA(b, h) + aoff + m * 2048 + k * 1024); } while (0)
#define PG8_LDB(dst, b, h) do { _Pragma("unroll") for (int n = 0; n < 2; ++n) _Pragma("unroll") for (int k = 0; k < 2; ++k) dst[n][k] = *(const PG8_LAS bf16x8*)(lds + PG8_SB(b, h) + boff + n * 2048 + k * 1024); } while (0)
#define PG8_MMA(ai, bj, At, Bt) do { __builtin_amdgcn_s_setprio(1); _Pragma("unroll") for (int m = 0; m < 4; ++m) _Pragma("unroll") for (int n = 0; n < 2; ++n) _Pragma("unroll") for (int k = 0; k < 2; ++k) \
        acc[ai][bj][m][n] = __builtin_amdgcn_mfma_f32_16x16x32_bf16(Bt[n][k], At[m][k], acc[ai][bj][m][n], 0, 0, 0); __builtin_amdgcn_s_setprio(0); } while (0)
#define PG8_WAIT_V(n) asm volatile("s_waitcnt vmcnt(" #n ")" ::: "memory")
#define PG8_WAIT_L(n) asm volatile("s_waitcnt lgkmcnt(" #n ")" ::: "memory")
#define PG8_BAR __builtin_amdgcn_s_barrier()
#define PG8_SCHED __builtin_amdgcn_sched_barrier(0)
    Unit cur, nxt; int ui = 0;
    if (!S.next(0, cur)) return;
    f32x4 acc[2][2][4][2];
#pragma unroll
    for (int a = 0; a < 2; ++a)
#pragma unroll
        for (int b = 0; b < 2; ++b)
#pragma unroll
            for (int m = 0; m < 4; ++m)
#pragma unroll
                for (int n = 0; n < 2; ++n) acc[a][b][m][n] = (f32x4){0.f, 0.f, 0.f, 0.f};
    bf16x8 At[4][2], B0[2][2], B1[2][2];
    const char* cA = (const char*)g.A + (size_t)cur.pm * tstepA + (size_t)cur.pn * kslA; const char* cB = (const char*)g.Bt + (size_t)cur.pn * tstepB;
    S.a_ready(cur);
    if constexpr (SP2) {
        PG8_STAGE(PG8_SB(0, 0), cB, voffB); PG8_STAGE(PG8_SB(0, 1), cB + hstepB, voffB); PG8_STAGE(PG8_SA(0, 0), cA, voffA); PG8_STAGE(PG8_SA(0, 1), cA + hstepA, voffA);
        if (wr == 1) PG8_BAR;
        PG8_WAIT_V(2); PG8_BAR;
        PG8_STAGE(PG8_SB(1, 0), cB + kstep, voffB); PG8_STAGE(PG8_SA(1, 0), cA + kstep, voffA); PG8_STAGE(PG8_SB(1, 1), cB + hstepB + kstep, voffB);
        PG8_WAIT_V(6); PG8_BAR;
    } else {
        PG8_STAGE(PG8_SB(0, 0), cB, voffB); PG8_STAGE(PG8_SA(0, 0), cA, voffA); PG8_STAGE(PG8_SB(0, 1), cB + hstepB, voffB); PG8_STAGE(PG8_SA(0, 1), cA + hstepA, voffA);
        if (wr == 1) PG8_BAR;
        PG8_WAIT_V(4); PG8_BAR;
        PG8_STAGE(PG8_SB(1, 0), cB + kstep, voffB); PG8_STAGE(PG8_SA(1, 0), cA + kstep, voffA); PG8_STAGE(PG8_SB(1, 1), cB + hstepB + kstep, voffB);
        PG8_WAIT_V(6); PG8_BAR;
    }
    for (;;) {
        const bool has_next = S.next(ui + 1, nxt);
        const char* nA = has_next ? (const char*)g.A + (size_t)nxt.pm * tstepA + (size_t)nxt.pn * kslA : cA; const char* nB = has_next ? (const char*)g.Bt + (size_t)nxt.pn * tstepB : cB;
        for (int t = 0; t < nt; t += 2) {
            if constexpr (Epi::MIDT >= 0) { if (t == Epi::MIDT) E.mid(acc, wr, fr, lds); }
            const bool last = (t == nt - 2);
            const char* a1 = cA + (size_t)(t + 1) * kstep;
            const char* a2 = last ? nA : cA + (size_t)(t + 2) * kstep; const char* b2 = last ? nB : cB + (size_t)(t + 2) * kstep;
            const char* a3 = a2 + kstep; const char* b3 = b2 + kstep;
            if (last && has_next) S.a_ready(nxt);
            if constexpr (SP2) {
            PG8_LDB(B0, 0, 0); PG8_LDB(B1, 0, 1); PG8_SCHED; PG8_LDA(At, 0, 0); PG8_STAGE(PG8_SA(1, 1), a1 + hstepA, voffA);
            PG8_WAIT_V(8); PG8_WAIT_L(0); PG8_BAR; PG8_MMA(0, 0, At, B0); PG8_MMA(0, 1, At, B1); PG8_BAR; PG8_SCHED;
            PG8_LDA(At, 0, 1); PG8_STAGE(PG8_SB(0, 0), b2, voffB); PG8_STAGE(PG8_SB(0, 1), b2 + hstepB, voffB); PG8_STAGE(PG8_SA(0, 0), a2, voffA);
            PG8_WAIT_V(8); PG8_WAIT_L(0); PG8_BAR; PG8_MMA(1, 0, At, B0); PG8_MMA(1, 1, At, B1); PG8_BAR; PG8_SCHED;
            PG8_LDB(B0, 1, 0); PG8_LDB(B1, 1, 1); PG8_SCHED; PG8_LDA(At, 1, 0); PG8_STAGE(PG8_SA(0, 1), a2 + hstepA, voffA);
            PG8_WAIT_V(8); PG8_WAIT_L(0); PG8_BAR; PG8_MMA(0, 0, At, B0); PG8_MMA(0, 1, At, B1); PG8_BAR; PG8_SCHED;
            PG8_LDA(At, 1, 1); PG8_STAGE(PG8_SB(1, 0), b3, voffB); PG8_STAGE(PG8_SB(1, 1), b3 + hstepB, voffB); PG8_STAGE(PG8_SA(1, 0), a3, voffA);
            PG8_WAIT_V(8); PG8_WAIT_L(0); PG8_BAR; PG8_MMA(1, 0, At, B0); PG8_MMA(1, 1, At, B1); PG8_BAR; PG8_SCHED;
            } else {
            PG8_LDB(B0, 0, 0); PG8_SCHED; PG8_LDA(At, 0, 0); PG8_STAGE(PG8_SA(1, 1), a1 + hstepA, voffA);
            PG8_WAIT_L(8); PG8_BAR; PG8_WAIT_L(0); PG8_MMA(0, 0, At, B0); PG8_BAR; PG8_SCHED;
            PG8_LDB(B1, 0, 1); PG8_STAGE(PG8_SB(0, 0), b2, voffB);
            PG8_BAR; PG8_WAIT_L(0); PG8_MMA(0, 1, At, B1); PG8_BAR;
            PG8_LDA(At, 0, 1); PG8_STAGE(PG8_SA(0, 0), a2, voffA);
            PG8_BAR; PG8_WAIT_L(0); PG8_MMA(1, 0, At, B0); PG8_BAR; PG8_SCHED;
            PG8_STAGE(PG8_SB(0, 1), b2 + hstepB, voffB);
            PG8_WAIT_V(6); PG8_BAR; PG8_MMA(1, 1, At, B1); PG8_BAR;
            PG8_LDB(B0, 1, 0); PG8_SCHED; PG8_LDA(At, 1, 0); PG8_STAGE(PG8_SA(0, 1), a2 + hstepA, voffA);
            PG8_WAIT_L(8); PG8_BAR; PG8_WAIT_L(0); PG8_MMA(0, 0, At, B0); PG8_BAR; PG8_SCHED;
            PG8_LDB(B1, 1, 1); PG8_STAGE(PG8_SB(1, 0), b3, voffB);
            PG8_BAR; PG8_WAIT_L(0); PG8_MMA(0, 1, At, B1); PG8_BAR;
            PG8_LDA(At, 1, 1); PG8_STAGE(PG8_SA(1, 0), a3, voffA);
            PG8_BAR; PG8_WAIT_L(0); PG8_MMA(1, 0, At, B0); PG8_BAR; PG8_SCHED;
            PG8_STAGE(PG8_SB(1, 1), b3 + hstepB, voffB);
            PG8_WAIT_V(6); PG8_BAR; PG8_MMA(1, 1, At, B1); PG8_BAR;
            }
        }
        if constexpr (ALIGN_EPI) { if (wr == 0) PG8_BAR; }
        if constexpr (!Epi::AFTER_DRAIN) { E(acc, cur, wr, wc, fr, fq); S.done(cur); }
        if (!has_next) break;
#pragma unroll
        for (int a = 0; a < 2; ++a)
#pragma unroll
            for (int b = 0; b < 2; ++b)
#pragma unroll
                for (int m = 0; m < 4; ++m)
#pragma unroll
                    for (int n = 0; n < 2; ++n) acc[a][b][m][n] = (f32x4){0.f, 0.f, 0.f, 0.f};
        cur = nxt; cA = nA; cB = nB; ++ui;
        if constexpr (ALIGN_EPI) { if (wr == 1) PG8_BAR; }
    }
    PG8_WAIT_V(0);
    if constexpr (!ALIGN_EPI) { if (wr == 0) PG8_BAR; }
    PG8_BAR;
    if constexpr (Epi::AFTER_DRAIN) { E.fused(acc, cur, wr, wc, fr, fq, lds, wid, lane); S.done(cur); }
#undef PG8_SA
#undef PG8_SB
#undef PG8_STAGE
#undef PG8_LDA
#undef PG8_LDB
#undef PG8_MMA
#undef PG8_WAIT_V
#undef PG8_WAIT_L
#undef PG8_BAR
#undef PG8_SCHED
}
}

#include <hip/hip_bf16.h>
#include <cmath>
namespace attn_body {
using bf16=__hip_bfloat16;
using bf16x8=__attribute__((ext_vector_type(8)))short;
using s16x4=__attribute__((ext_vector_type(4)))short;
using f32x16=__attribute__((ext_vector_type(16)))float;
using u32x4=__attribute__((ext_vector_type(4)))unsigned;
constexpr int SEQ=2048,D=64;
constexpr int NW=8,QBLK=32,QB=QBLK*NW,KVBLK=64,NQB=SEQ/QB;
constexpr int ATTN_UNIT_ROWS=QB;
__device__ __forceinline__ int crow(int r,int hi){return (r&3)+8*(r>>2)+4*hi;}
#define SBAR() __builtin_amdgcn_sched_barrier(0)
__device__ __forceinline__ void cmask(f32x16&p0,f32x16&p1,int jb,int qrel,int hi){
  const float NEG=-INFINITY; int kb=64*jb+4*hi;
  #pragma unroll
  for(int r=0;r<16;++r){int kv=kb+(r&3)+8*(r>>2); if(kv>qrel)p0[r]=NEG; if(kv+32>qrel)p1[r]=NEG;}
}

constexpr int NSLOT=3, SLOTB=8192;
constexpr int LDS_K=0, LDS_V=NSLOT*SLOTB, LDS_WS=2*NSLOT*SLOTB, LDS_OST=LDS_WS+NW*64*4, LDS_BYTES=LDS_OST+NW*4096;
constexpr int XOFF=86016; constexpr float SENT=-30000.f; using f32x4=__attribute__((ext_vector_type(4)))float;
constexpr float C2=0.125f*1.4426950408889634f;
__device__ __forceinline__ void glds16(const void*gsrc,unsigned lds_dst){unsigned keep;
  asm volatile("s_mov_b32 %0, m0\n\ts_mov_b32 m0, %2\n\ts_nop 0\n\tglobal_load_lds_dwordx4 %1, off\n\ts_mov_b32 m0, %0":"=&s"(keep):"v"(gsrc),"s"(lds_dst):"memory");}
__device__ __forceinline__ float max3f(float a,float b,float c){float r;asm("v_max3_f32 %0, %1, %2, %3":"=v"(r):"v"(a),"v"(b),"v"(c));return r;}
__device__ __forceinline__ float max2f(float a,float b){float r;asm("v_max_f32_e32 %0, %1, %2":"=v"(r):"v"(a),"v"(b));return r;}
__device__ __forceinline__ float fadd_s(float a,float b){float r;asm("v_add_f32_e32 %0, %1, %2":"=v"(r):"v"(a),"v"(b));return r;}
__device__ __forceinline__ float fsub_s(float a,float b){float r;asm("v_sub_f32_e32 %0, %1, %2":"=v"(r):"v"(a),"v"(b));return r;}
typedef float f32x2_t __attribute__((ext_vector_type(2))); typedef __bf16 bf16x2_t __attribute__((ext_vector_type(2)));
__device__ __forceinline__ unsigned cvtpk_s(float lo,float hi){f32x2_t v={lo,hi};bf16x2_t b=__builtin_convertvector(v,bf16x2_t);return __builtin_bit_cast(unsigned,b);}
#define WAIT_BAR(N) asm volatile("s_waitcnt vmcnt(" #N ") lgkmcnt(0)\n\ts_barrier":::"memory")

__device__ __forceinline__ void qkt(f32x16&p0,f32x16&p1,const char*Kslot,const bf16x8*qr,const f32x16&negm,int r32,int hi){
  const char*kb=Kslot+hi*1024+r32*16;
  #pragma unroll
  for(int d0=0;d0<4;++d0){
    const bf16x8 b0=*reinterpret_cast<const bf16x8*>(kb+d0*2048);
    const bf16x8 b1=*reinterpret_cast<const bf16x8*>(kb+d0*2048+512);
    if(d0==0){p0=__builtin_amdgcn_mfma_f32_32x32x16_bf16(b0,qr[0],negm,0,0,0);p1=__builtin_amdgcn_mfma_f32_32x32x16_bf16(b1,qr[0],negm,0,0,0);}
    else{p0=__builtin_amdgcn_mfma_f32_32x32x16_bf16(b0,qr[d0],p0,0,0,0);p1=__builtin_amdgcn_mfma_f32_32x32x16_bf16(b1,qr[d0],p1,0,0,0);}}
}
typedef __attribute__((address_space(3))) const char* lds_cptr;
typedef short v4i16_t __attribute__((ext_vector_type(4)));
__device__ __forceinline__ void kload8(bf16x8*kf,lds_cptr kp){
  kf[0]=*(const __attribute__((address_space(3))) bf16x8*)(kp);      kf[1]=*(const __attribute__((address_space(3))) bf16x8*)(kp+512);
  kf[2]=*(const __attribute__((address_space(3))) bf16x8*)(kp+2048); kf[3]=*(const __attribute__((address_space(3))) bf16x8*)(kp+2560);
  kf[4]=*(const __attribute__((address_space(3))) bf16x8*)(kp+4096); kf[5]=*(const __attribute__((address_space(3))) bf16x8*)(kp+4608);
  kf[6]=*(const __attribute__((address_space(3))) bf16x8*)(kp+6144); kf[7]=*(const __attribute__((address_space(3))) bf16x8*)(kp+6656);
}
__device__ __forceinline__ void kload2(bf16x8*kf,lds_cptr kp,int j){ kf[2*j]=*(const __attribute__((address_space(3))) bf16x8*)(kp+j*2048); kf[2*j+1]=*(const __attribute__((address_space(3))) bf16x8*)(kp+j*2048+512); }
__device__ __forceinline__ s16x4 vtr(lds_cptr p){ return __builtin_bit_cast(s16x4,__builtin_amdgcn_ds_read_tr16_b64_v4i16((__attribute__((address_space(3))) v4i16_t*)p)); }
__device__ __forceinline__ float rowmax(const f32x16&p0,const f32x16&p1){
  float a=max3f(p0[0],p0[1],p1[0]),b=max3f(p0[2],p0[3],p1[1]);a=max3f(a,p1[2],p1[3]);
  #pragma unroll
  for(int r=4;r<16;r+=4){a=max3f(a,p0[r],p0[r+1]);b=max3f(b,p0[r+2],p0[r+3]);a=max3f(a,p1[r],p1[r+1]);b=max3f(b,p1[r+2],p1[r+3]);}
  const float m=max2f(a,b);
  auto rr=__builtin_amdgcn_permlane32_swap(__float_as_uint(m),__float_as_uint(m),false,false);
  return max2f(__uint_as_float(rr[0]),__uint_as_float(rr[1]));
}
__device__ __forceinline__ void pv(f32x16*o,int vb,bf16x8 pa0,bf16x8 pa1,bf16x8 pa2,bf16x8 pa3){
  #pragma unroll
  for(int d0=0;d0<2;++d0){s16x4 lo[4],hi[4];
    #pragma unroll
    for(int ks=0;ks<4;++ks){
      asm volatile("ds_read_b64_tr_b16 %0,%1 offset:%c2":"=&v"(lo[ks]):"v"(vb),"i"(d0*4096+ks*1024):"memory");
      asm volatile("ds_read_b64_tr_b16 %0,%1 offset:%c2":"=&v"(hi[ks]):"v"(vb),"i"(d0*4096+ks*1024+512):"memory");}
    asm volatile("s_waitcnt lgkmcnt(0)":::"memory");SBAR();
    #define PK(k) (bf16x8){lo[k][0],lo[k][1],lo[k][2],lo[k][3],hi[k][0],hi[k][1],hi[k][2],hi[k][3]}
    o[d0]=__builtin_amdgcn_mfma_f32_32x32x16_bf16(pa0,PK(0),o[d0],0,0,0);
    o[d0]=__builtin_amdgcn_mfma_f32_32x32x16_bf16(pa1,PK(1),o[d0],0,0,0);
    o[d0]=__builtin_amdgcn_mfma_f32_32x32x16_bf16(pa2,PK(2),o[d0],0,0,0);
    o[d0]=__builtin_amdgcn_mfma_f32_32x32x16_bf16(pa3,PK(3),o[d0],0,0,0);
    #undef PK
  }
}

#ifndef ATTN_STORE16
#define ATTN_STORE16(p,v) (*(u32x4*)(p)=(v))
#endif
template<int THRL,int MODE,int DM,bool DRY=false> __device__ __forceinline__ void attn_unit(int b,int h,int qb,const bf16*Q,const bf16*__restrict__ K,const bf16*__restrict__ V,bf16*O,const bf16*__restrict__ Z,const float*__restrict__ XP,const int*__restrict__ TS,volatile unsigned*lw,unsigned nxt,char*shm){
  const int tid=opaque_tid(),lane=tid&63,r32=lane&31,hi=lane>>5; const int wid=__builtin_amdgcn_readfirstlane(tid>>6);
  const long rowbase=(long)b*SEQ; const int q0=qb*QB;
  const bf16*Qw=Q+(rowbase+q0+wid*QBLK)*DM+h*D;
  bf16x8 qr[4];
  #pragma unroll
  for(int d0=0;d0<4;++d0)qr[d0]=*reinterpret_cast<const bf16x8*>(&Qw[(long)r32*DM+d0*16+hi*8]);
  const bf16*Kh=K+rowbase*DM+h*D,*Vh=V+rowbase*DM+h*D;
  const unsigned lds0=(unsigned)(uintptr_t)shm;
  float*wsf=(float*)(shm+LDS_WS)+wid*64;
  const bf16*ksrc_=Kh+(long)lane*DM+wid*8; int tskip=0; const bf16*ksrc=ksrc_;
  const bf16*vsrc_=Vh+(long)(16*(wid&3)+(lane>>2))*DM+(wid>>2)*32+(lane&3)*8; const bf16*vsrc=vsrc_;
  const unsigned kdst=lds0+LDS_K+wid*1024, vdst=lds0+LDS_V+wid*1024;
  #define DMA_K(t,slot) glds16(ksrc+(long)(t)*KVBLK*DM,(unsigned)__builtin_amdgcn_readfirstlane(kdst+(slot)))
  #define DMA_V(t,slot) glds16(vsrc+(long)(t)*KVBLK*DM,(unsigned)__builtin_amdgcn_readfirstlane(vdst+(slot)))
  const int vb0=(int)(lds0+LDS_V)+((lane>>4)&1)*32+(lane&3)*8+(4*hi+((lane&15)>>2))*64;
  const char*Kbase=shm+LDS_K; bf16x8 kf[8];
  const lds_cptr shm3=(lds_cptr)shm; const lds_cptr kp0=shm3+LDS_K+hi*1024+r32*16; const lds_cptr vp0=shm3+LDS_V+((lane>>4)&1)*32+(lane&3)*8+(4*hi+((lane&15)>>2))*64;
  int NT=(q0+QB)/KVBLK;
  const int qrel=wid*QBLK+r32;
  unsigned sel=0u;
  if constexpr(MODE==1){
    tskip=__builtin_amdgcn_readfirstlane(TS[qb]);
    ksrc=ksrc_+(long)tskip*KVBLK*DM; vsrc=vsrc_+(long)tskip*KVBLK*DM; NT-=tskip;
  }
  const lds_cptr fsl=(lds_cptr)shm+XOFF+16*hi+tskip*256;
  #define XMASK(P0,P1,t) do{ if constexpr(MODE==0){ if((t)<NT-4){ const bool keep_=(sel>>((t)>>2))&1u; \
        _Pragma("unroll") for(int r=0;r<16;++r){P0[r]=keep_?P0[r]:SENT;P1[r]=keep_?P1[r]:SENT;} } } \
      else { const lds_cptr fp_=fsl+(t)*256; const float mh_=mhat; \
        _Pragma("unroll") for(int g_=0;g_<4;++g_){ const f32x4 fa_=*(const __attribute__((address_space(3))) f32x4*)(fp_+g_*32)+mh_; const f32x4 fb_=*(const __attribute__((address_space(3))) f32x4*)(fp_+128+g_*32)+mh_; \
          _Pragma("unroll") for(int i_=0;i_<4;++i_){P0[4*g_+i_]-=fa_[i_];P1[4*g_+i_]-=fb_[i_];} } } }while(0)
  DMA_K(0,0);DMA_V(0,0);DMA_K(1,SLOTB);
  float mhat=0.f,l_reg=0.f;f32x16 o[2];o[0]=f32x16{};o[1]=f32x16{};f32x16 negm=f32x16{}; if constexpr(MODE==0){asm volatile("":"+v"(negm));}
  #define CMASK(P0,P1,t) do{int jb_=(t)-(NT-4); if(jb_>=0)cmask(P0,P1,jb_,qrel,hi);}while(0)
  const f32x16 czero_=f32x16{};
  #define NEGM (MODE==1?czero_:negm)
  bool resc=false;
  #define START(P0,P1) do{ const float rm=rowmax(P0,P1); resc=false; \
    { const float dl=rm; mhat=fadd_s(mhat,dl); \
      _Pragma("unroll") for(int r=0;r<16;++r){P0[r]=fsub_s(P0[r],dl);P1[r]=fsub_s(P1[r],dl);} \
      if constexpr(MODE==0){ _Pragma("unroll") for(int r=0;r<16;++r)negm[r]=-mhat; asm volatile("":"+v"(negm)); } } \
    _Pragma("unroll") for(int r=0;r<16;++r)P0[r]=__builtin_amdgcn_exp2f(P0[r]); }while(0)
  #define RESC() do{ if(resc){ asm volatile("s_waitcnt lgkmcnt(0)":::"memory"); \
      _Pragma("unroll") for(int d_=0;d_<2;++d_) _Pragma("unroll") for(int r=0;r<16;++r)o[d_][r]*=wsf[crow(r,hi)]; } }while(0)
  f32x16 pA0,pA1,pB0,pB1;
  int sl_prev=0,sl_cur=0,sl_next=SLOTB;
  #define ROT() do{sl_prev=sl_cur;sl_cur=sl_next;sl_next=(sl_next==(NSLOT-1)*SLOTB)?0:sl_next+SLOTB;}while(0)
  DMA_K(2,2*SLOTB);
  if constexpr(MODE==1){ float*fs=(float*)(shm+XOFF); for(int i=tid+64*tskip;i<q0+QB;i+=NW*64)fs[i]=XP[i]; }
  if constexpr(MODE==0){
    float*kbs=(float*)(shm+XOFF); unsigned*sm=(unsigned*)(shm+XOFF+2048);
    kbs[tid]=XP[tid];
    asm volatile("s_waitcnt vmcnt(0) lgkmcnt(0)\n\ts_barrier":::"memory");
    if(tid<QB){ unsigned m=(1u<<qb)-1u;
      if(qb>3){ const bf16*qp=Q+(rowbase+q0+tid)*DM+h*D; float g[8];
        _Pragma("unroll") for(int n=0;n<8;++n)g[n]=0.f;
        _Pragma("unroll") for(int c=0;c<8;++c){ const bf16x8 qv=*reinterpret_cast<const bf16x8*>(qp+c*8);
          _Pragma("unroll") for(int j=0;j<8;++j){ const float qf=__uint_as_float(((unsigned)(unsigned short)qv[j])<<16);
            _Pragma("unroll") for(int n=0;n<8;++n)g[n]+=qf*kbs[n*64+c*8+j]; } }
        m=0u;
        _Pragma("unroll") for(int it=0;it<3;++it){ float best=-INFINITY; int bi=0;
          _Pragma("unroll") for(int n=0;n<8;++n){ const bool ok=(n<qb)&&!((m>>n)&1u)&&(g[n]>best); best=ok?g[n]:best; bi=ok?n:bi; }
          m|=1u<<bi; } }
      sm[tid]=m; }
    asm volatile("s_waitcnt vmcnt(0) lgkmcnt(0)\n\ts_barrier":::"memory");
    sel=sm[qrel];
  }
  WAIT_BAR(3);
  qkt(pA0,pA1,Kbase,qr,NEGM,r32,hi);asm volatile("s_nop 15\n\ts_nop 7":"+v"(pA0),"+v"(pA1));XMASK(pA0,pA1,0);CMASK(pA0,pA1,0);
  START(pA0,pA1);
  _Pragma("unroll") for(int r=0;r<16;++r)pA1[r]=__builtin_amdgcn_exp2f(pA1[r]);
  WAIT_BAR(0);
  DMA_K(3,0);DMA_V(1,SLOTB);
  ROT();
  kload8(kf,kp0+sl_cur);
  WAIT_BAR(2);
  s16x4 vlo[8],vhi[8]; u32x4 pw0,pw1,pw2,pw3;
  #define PKW(P,B) cvtpk_s(P[B],P[B+1])
  #define PAF(k) __builtin_bit_cast(bf16x8,pw##k)
  #define VFR(i) (bf16x8){vlo[i][0],vlo[i][1],vlo[i][2],vlo[i][3],vhi[i][0],vhi[i][1],vhi[i][2],vhi[i][3]}
  #define PIN(x) asm volatile("":"+v"(x))
  #define MX3(a,b,c) __builtin_fmaxf(__builtin_fmaxf((a),(b)),(c))
  #define GAPA(MF,A0,A1,A2,A3,W0,W1,PW) do{ MF; sacc+=A0; sacc+=A1; sacc+=A2; sacc+=A3; PIN(sacc); W0; W1; PIN(PW); SBAR(); }while(0)
  #define EX(v) __builtin_amdgcn_exp2f(v)
  #define GAPB(MF,X,B) do{ MF; X[B]=EX(X[B]); X[B+1]=EX(X[B+1]); X[B+2]=EX(X[B+2]); X[B+3]=EX(X[B+3]); PIN(X); SBAR(); }while(0)
  #define VRD(i) do{ vlo[i]=vtr(vp_+(((i)>>2)*4096+((i)&3)*1024)); vhi[i]=vtr(vp_+(((i)>>2)*4096+((i)&3)*1024+512)); }while(0)
  #define KRD(G,j) do{ if(G){ kload2(kf,kp0+sl_next,j); SBAR(); } }while(0)
  #define STEP(C0,C1,P0,P1,t,GK,GV,GL) do{ SBAR(); \
    const lds_cptr vp_=vp0+sl_prev; \
    VRD(0); SBAR(); float sacc=(P0[0]+P0[1]); \
    GAPA(C0=__builtin_amdgcn_mfma_f32_32x32x16_bf16(kf[0],qr[0],NEGM,0,0,0), P0[2],P0[3],P0[4],P0[5],     pw0[0]=PKW(P0,0), pw0[1]=PKW(P0,2), pw0); \
    VRD(4); SBAR(); GAPA(C1=__builtin_amdgcn_mfma_f32_32x32x16_bf16(kf[1],qr[0],NEGM,0,0,0), P0[6],P0[7],P0[8],P0[9],     pw0[2]=PKW(P0,4), pw0[3]=PKW(P0,6), pw0); \
    VRD(1); SBAR(); GAPA(C0=__builtin_amdgcn_mfma_f32_32x32x16_bf16(kf[2],qr[1],C0,0,0,0),   P0[10],P0[11],P0[12],P0[13], pw1[0]=PKW(P0,8), pw1[1]=PKW(P0,10), pw1); \
    VRD(5); SBAR(); GAPA(C1=__builtin_amdgcn_mfma_f32_32x32x16_bf16(kf[3],qr[1],C1,0,0,0),   P0[14],P0[15],P1[0],P1[1],   pw1[2]=PKW(P0,12),pw1[3]=PKW(P0,14), pw1); \
    VRD(2); SBAR(); GAPA(C0=__builtin_amdgcn_mfma_f32_32x32x16_bf16(kf[4],qr[2],C0,0,0,0),   P1[2],P1[3],P1[4],P1[5],     pw2[0]=PKW(P1,0), pw2[1]=PKW(P1,2), pw2); \
    VRD(6); SBAR(); GAPA(C1=__builtin_amdgcn_mfma_f32_32x32x16_bf16(kf[5],qr[2],C1,0,0,0),   P1[6],P1[7],P1[8],P1[9],     pw2[2]=PKW(P1,4), pw2[3]=PKW(P1,6), pw2); \
    VRD(3); SBAR(); GAPA(C0=__builtin_amdgcn_mfma_f32_32x32x16_bf16(kf[6],qr[3],C0,0,0,0),   P1[10],P1[11],P1[12],P1[13], pw3[0]=PKW(P1,8), pw3[1]=PKW(P1,10), pw3); \
    VRD(7); SBAR(); GAPA(C1=__builtin_amdgcn_mfma_f32_32x32x16_bf16(kf[7],qr[3],C1,0,0,0),   P1[14],P1[15],0.f,0.f,       pw3[2]=PKW(P1,12),pw3[3]=PKW(P1,14), pw3); \
    l_reg+=sacc; \
    if(GK){DMA_K((t)+3,sl_cur);} if(GV){DMA_V((t)+1,sl_next);} \
    XMASK(C0,C1,t); CMASK(C0,C1,t); \
    { float a=MX3(C0[0],C0[1],C1[0]),b=MX3(C0[2],C0[3],C1[1]); a=MX3(a,C1[2],C1[3]); \
      _Pragma("unroll") for(int r=4;r<16;r+=4){a=MX3(a,C0[r],C0[r+1]);b=MX3(b,C0[r+2],C0[r+3]);a=MX3(a,C1[r],C1[r+1]);b=MX3(b,C1[r+2],C1[r+3]);} \
      float rm=__builtin_fmaxf(a,b); { auto rr=__builtin_amdgcn_permlane32_swap(__float_as_uint(rm),__float_as_uint(rm),false,false); rm=__builtin_fmaxf(__uint_as_float(rr[0]),__uint_as_float(rr[1])); } \
      resc=false; \
      if(__builtin_expect(__any(rm>(float)THRL),0)){ const float dl=__builtin_fmaxf(rm,0.f); mhat+=dl; \
        _Pragma("unroll") for(int r=0;r<16;++r){C0[r]-=dl;C1[r]-=dl;} \
        if constexpr(MODE==0){ _Pragma("unroll") for(int r=0;r<16;++r)negm[r]=-mhat; asm volatile("":"+v"(negm)); } \
        const float f=__builtin_amdgcn_exp2f(-dl); l_reg*=f; if(hi==0)wsf[r32]=f; resc=true; } } \
    SBAR(); \
    GAPB(o[0]=__builtin_amdgcn_mfma_f32_32x32x16_bf16(PAF(0),VFR(0),o[0],0,0,0), C0,0); \
    GAPB(o[1]=__builtin_amdgcn_mfma_f32_32x32x16_bf16(PAF(0),VFR(4),o[1],0,0,0), C0,4); \
    KRD(GL,0); GAPB(o[0]=__builtin_amdgcn_mfma_f32_32x32x16_bf16(PAF(1),VFR(1),o[0],0,0,0), C0,8); \
    KRD(GL,1); GAPB(o[1]=__builtin_amdgcn_mfma_f32_32x32x16_bf16(PAF(1),VFR(5),o[1],0,0,0), C0,12); \
    KRD(GL,2); GAPB(o[0]=__builtin_amdgcn_mfma_f32_32x32x16_bf16(PAF(2),VFR(2),o[0],0,0,0), C1,0); \
    KRD(GL,3); GAPB(o[1]=__builtin_amdgcn_mfma_f32_32x32x16_bf16(PAF(2),VFR(6),o[1],0,0,0), C1,4); \
    GAPB(o[0]=__builtin_amdgcn_mfma_f32_32x32x16_bf16(PAF(3),VFR(3),o[0],0,0,0), C1,8); \
    GAPB(o[1]=__builtin_amdgcn_mfma_f32_32x32x16_bf16(PAF(3),VFR(7),o[1],0,0,0), C1,12); \
    }while(0)
  int t=1;
  #undef CMASK
  #define CMASK(P0,P1,t) do{}while(0)
  for(;t+5<NT;t+=2){
    STEP(pB0,pB1,pA0,pA1,t,true,true,true);     WAIT_BAR(2); RESC(); ROT();
    STEP(pA0,pA1,pB0,pB1,t+1,true,true,true);   WAIT_BAR(2); RESC(); ROT();
  }
  #undef CMASK
  #define CMASK(P0,P1,t) do{int jb_=(t)-(NT-4); if(jb_>=0)cmask(P0,P1,jb_,qrel,hi);}while(0)
  #define ENDW(tt) do{ if((tt)+3<NT){WAIT_BAR(2);} else if((tt)+2<NT){WAIT_BAR(1);} else {WAIT_BAR(0);} }while(0)
  for(;t+1<NT;t+=2){
    STEP(pB0,pB1,pA0,pA1,t,(t+3<NT),(t+1<NT),(t+1<NT));       ENDW(t);   RESC(); ROT();
    STEP(pA0,pA1,pB0,pB1,t+1,(t+4<NT),(t+2<NT),(t+2<NT));     ENDW(t+1); RESC(); ROT();
  }
  STEP(pB0,pB1,pA0,pA1,NT-1,false,false,false); RESC();
  const bf16*Zw=Z+(rowbase+q0+wid*QBLK)*DM+h*D; u32x4 zpre[4];
  #pragma unroll
  for(int i=0;i<4;++i)zpre[i]=*(const u32x4*)(Zw+(long)(i*8+(lane>>3))*DM+(lane&7)*8);
  { float sacc=pB0[0]+pB0[1]; _Pragma("unroll") for(int r=2;r<16;++r)sacc+=pB0[r]; _Pragma("unroll") for(int r=0;r<16;++r)sacc+=pB1[r]; l_reg+=sacc;
    pw0=(u32x4){PKW(pB0,0),PKW(pB0,2),PKW(pB0,4),PKW(pB0,6)};pw1=(u32x4){PKW(pB0,8),PKW(pB0,10),PKW(pB0,12),PKW(pB0,14)};pw2=(u32x4){PKW(pB1,0),PKW(pB1,2),PKW(pB1,4),PKW(pB1,6)};pw3=(u32x4){PKW(pB1,8),PKW(pB1,10),PKW(pB1,12),PKW(pB1,14)};
    SBAR(); pv(o,vb0+sl_cur,PAF(0),PAF(1),PAF(2),PAF(3)); }
  #undef PKW
  #undef PAF
  #undef VFR
  #undef PIN
  #undef MX3
  #undef GAPA
  #undef GAPB
  #undef EX
  #undef VRD
  #undef KRD
  #undef STEP
  #undef ENDW
  if(lw!=nullptr&&tid==0)lw[0]=nxt;
  {auto rr=__builtin_amdgcn_permlane32_swap(__float_as_uint(l_reg),__float_as_uint(l_reg),false,false);l_reg=__uint_as_float(rr[0])+__uint_as_float(rr[1]);}
  if(hi==0)wsf[32+r32]=l_reg;asm volatile("s_waitcnt lgkmcnt(0)":::"memory");
  float rli[16];
  #pragma unroll
  for(int r=0;r<16;++r)rli[r]=__builtin_amdgcn_rcpf(wsf[32+crow(r,hi)]);
  bf16*Ow=O+(rowbase+q0+wid*QBLK)*DM+h*D;
  { bf16*stg=(bf16*)(shm+LDS_OST)+wid*2048;
    #pragma unroll
    for(int r=0;r<16;++r){const int orow=crow(r,hi);
      #pragma unroll
      for(int d0=0;d0<2;++d0)stg[orow*64+d0*32+r32]=__float2bfloat16(o[d0][r]*rli[r]);}
    asm volatile("s_waitcnt lgkmcnt(0)":::"memory");
    #pragma unroll
    for(int i=0;i<4;++i){const int row=i*8+(lane>>3),ch=lane&7; const u32x4 v=*(const u32x4*)(stg+row*64+ch*8); const u32x4 zv=zpre[i]; u32x4 ov;
      #pragma unroll
      for(int e=0;e<4;++e){ const float o0=__uint_as_float(v[e]<<16),o1=__uint_as_float(v[e]&0xffff0000u),z0=__uint_as_float(zv[e]<<16),z1=__uint_as_float(zv[e]&0xffff0000u);
        ov[e]=cvtpk_s(o0*z0/(1.f+__expf(-z0)),o1*z1/(1.f+__expf(-z1))); }
      if(!DRY||ov[0]==0x7fc12345u)ATTN_STORE16(Ow+(long)row*DM+ch*8,ov);} }
  asm volatile("s_waitcnt lgkmcnt(0)\n\ts_barrier":::"memory");
  #undef DMA_K
  #undef DMA_V
  #undef CMASK
  #undef XMASK
  #undef NEGM
  #undef START
  #undef RESC
  #undef ROT
}
constexpr int ATTN_LDS_BYTES=LDS_BYTES;
#undef SBAR
#undef WAIT_BAR
}
constexpr int NWAVES = 8, NTHR = 512;
constexpr int NB = 8, SEQL = 2048, DMOD = 1024, MROWS = NB * SEQL;
constexpr int LD0 = 6656, NP0 = 6912, LD1 = 7168, NP1 = 7424;
constexpr int C0_ZA = 0, C0_Q = 1024, C0_ZB = 2048, C0_XBC = 3072, C0_K = 4608, C0_V = 5632;
constexpr int C1_Q = 0, C1_U = 1536, C1_K = 2048, C1_V = 3584, C1_ZC = 5120, C1_ZD = 6656;
constexpr float RMS_EPS = 1e-6f, LOG2E = 1.4426950408889634f;
constexpr size_t MiB = 1u << 20;
constexpr int KS = 8;
constexpr size_t WS_MODP = 0;
constexpr size_t WS_SSQ = 2 * MiB;
constexpr size_t WS_KBAR = 2 * MiB + 65536;
constexpr size_t WS_DT = 3 * MiB;
constexpr size_t WS_LF = 4 * MiB;
constexpr size_t WS_F2 = 6 * MiB;
constexpr size_t WS_S5P = 7 * MiB + 512 * 1024;
constexpr int S5P_STRIDE = 8704;
constexpr size_t WS_WT1 = 8 * MiB;
constexpr size_t WS_WO1 = WS_WT1 + (size_t)NP1 * 1024 * 2;
constexpr size_t WS_WG = WS_WO1 + 4 * MiB;
constexpr size_t WS_BIG = 27 * MiB;
constexpr size_t WS_WT0 = WS_BIG + (size_t)MROWS * LD0 * 2;
constexpr size_t WS_WO0 = WS_WT0 + (size_t)NP0 * 1024 * 2;
constexpr size_t WS_LFP = 251 * MiB;
constexpr size_t WS_END = WS_WO0 + 4 * MiB;
static_assert(WS_WG + 512 * 1024 <= WS_BIG && WS_END <= 256 * MiB && WS_BIG + (size_t)MROWS * LD1 * 2 <= 256 * MiB, "ws map");
constexpr int LDS_BYTES = 147456;
constexpr size_t WS_CNT = 1835008 + 3584 * 4, WS_UB = 1835008 + 32768, WS_TS = 1835008 + 32768 + 1024;
constexpr size_t WS_BAR = 1835008;
constexpr int BARST_OFF = 132608;

typedef unsigned short bf16;
typedef unsigned v4u __attribute__((ext_vector_type(4)));
typedef unsigned v2u __attribute__((ext_vector_type(2)));
typedef float f32x4 __attribute__((ext_vector_type(4)));
typedef short bf16x8 __attribute__((ext_vector_type(8)));
typedef float f32x16 __attribute__((ext_vector_type(16)));
typedef float f32x2_c __attribute__((ext_vector_type(2))); typedef __bf16 bf16x2_c __attribute__((ext_vector_type(2)));
__device__ __forceinline__ unsigned pk2(float lo, float hi) { f32x2_c v = {lo, hi}; return __builtin_bit_cast(unsigned, __builtin_convertvector(v, bf16x2_c)); }
__device__ __forceinline__ unsigned f2bf(float f) { return pk2(f, f) & 0xffffu; }
__device__ __forceinline__ float bf2f(unsigned short h) { return __uint_as_float(((unsigned)h) << 16); }
template <int CTRL> __device__ __forceinline__ float dppf(float old, float src) { return __builtin_bit_cast(float, __builtin_amdgcn_update_dpp(__builtin_bit_cast(int, old), __builtin_bit_cast(int, src), CTRL, 0xF, 0xF, false)); }
__device__ __forceinline__ float row_sum16(float v) { v += dppf<0xB1>(v, v); v += dppf<0x4E>(v, v); v += dppf<0x141>(v, v); v += dppf<0x140>(v, v); return v; }
__device__ __forceinline__ float rdlane(float v, int l) { return __builtin_bit_cast(float, __builtin_amdgcn_readlane(__builtin_bit_cast(int, v), l)); }
__device__ __forceinline__ float wave_sum(float v) { v = row_sum16(v); return (rdlane(v, 0) + rdlane(v, 16)) + (rdlane(v, 32) + rdlane(v, 48)); }
__device__ __forceinline__ float wave_scan(float x, int lane) {
    x += dppf<0x111>(0.f, x); x += dppf<0x112>(0.f, x); x += dppf<0x114>(0.f, x); x += dppf<0x118>(0.f, x);
    const float t0 = rdlane(x, 15), t1 = rdlane(x, 31), t2 = rdlane(x, 47); const int rw = lane >> 4;
    return x + (rw == 0 ? 0.f : (rw == 1 ? t0 : (rw == 2 ? t0 + t1 : (t0 + t1) + t2)));
}
__device__ __forceinline__ float silu_f(float x) { return x / (1.f + __expf(-x)); }
__device__ __forceinline__ float softplus_g(float x) { return x > 20.f ? x : log1pf(__expf(x)); }

struct Args {
    const float* in[27]; float* out; unsigned char* ws;
};
enum { I_X = 0, I_C, I_ADAW, I_ADAB, I_PREG, I_POSTG, I_EINW, I_ECONVW, I_ECONVB, I_EDTB, I_EALOG, I_EDSKIP, I_ENORMG, I_EOUTW,
       I_OINW, I_OFGB, I_OLRE, I_OLIM, I_OLDT, I_OBRE, I_OBIM, I_OCRE, I_OCIM, I_ODSKIP, I_OGLUW, I_OGLUB, I_OOUTW };

__device__ __forceinline__ int src_col0(int n) {
    if (n < 1024) return n;
    if (n < 2048) return 3600 + (n - 1024);
    if (n < 3072) return 1024 + (n - 2048);
    if (n < 4608) return 2048 + (n - 3072);
    if (n < 5632) return 4624 + (n - 4608);
    if (n < 6656) return 5648 + (n - 5632);
    if (n < 6672) return 3584 + (n - 6656);
    return -1;
}
__device__ __forceinline__ int src_col1(int n) {
    if (n < 1536) return 2048 + n;
    if (n < 2048) return 6680 + (n - 1536);
    if (n < 3584) return 3584 + (n - 2048);
    if (n < 5120) return 5120 + (n - 3584);
    if (n < 6656) return n - 5120;
    if (n < 7168) return 1536 + (n - 6656);
    if (n < 7192) return 6656 + (n - 7168);
    return -1;
}
template <int MAP> __device__ __forceinline__ void transpose_item(const float* __restrict__ W, int K, int NSRC, int NDST, bf16* WT, float* scr, int item, int lane, const float* __restrict__ kscale = nullptr) {
    const int nblk = NDST / 32, kb = item / nblk, nb = item % nblk, k0 = 64 * kb, n0 = 32 * nb;
    const int nn = n0 + (lane & 31); const int sc = MAP == 0 ? src_col0(nn) : (MAP == 1 ? src_col1(nn) : nn);
    float tv[32];
#pragma unroll
    for (int i = 0; i < 32; ++i) { const int kk = 2 * i + (lane >> 5); tv[i] = sc >= 0 ? W[(size_t)(k0 + kk) * NSRC + sc] : 0.f; if (kscale && k0 + kk < 1024) tv[i] *= kscale[k0 + kk]; }
#pragma unroll
    for (int i = 0; i < 32; ++i) { const int kk = 2 * i + (lane >> 5); scr[kk * 33 + (lane & 31)] = tv[i]; }
    asm volatile("s_waitcnt lgkmcnt(0)" ::: "memory");
    const int c = lane & 7;
#pragma unroll
    for (int j = 0; j < 4; ++j) { const int n = (lane >> 3) + 8 * j; const float* s = scr + (8 * c) * 33 + n;
        v4u o; o.x = pk2(s[0 * 33], s[1 * 33]); o.y = pk2(s[2 * 33], s[3 * 33]); o.z = pk2(s[4 * 33], s[5 * 33]); o.w = pk2(s[6 * 33], s[7 * 33]);
        *(v4u*)(WT + (size_t)(n0 + n) * K + k0 + 8 * c) = o; }
    asm volatile("s_waitcnt lgkmcnt(0)" ::: "memory");
}

__device__ __forceinline__ float mod_val(const float* modp, const float* adab, int l, int b, int j) {
    float s = adab[l * 3072 + j];
#pragma unroll
    for (int kc = 0; kc < KS; ++kc) s += modp[((size_t)(kc * 2 + l) * 8 + b) * 3072 + j];
    return s;
}

__device__ __forceinline__ void p0_prologue(const Args& A, char* lds, int vcu, int G) {
    const int tid = opaque_tid(), lane = tid & 63, wave = tid >> 6;
    unsigned char* ws = A.ws;
    float* scr = (float*)(lds + wave * 16384);
    const int gw = vcu * NWAVES + wave, NGW = G * NWAVES;
    constexpr int I0 = 16 * (NP0 / 32), I1 = 16 * (NP1 / 32), IO = 32 * 32, IG = 8 * 16;
    constexpr int NITEMS = I0 + I1 + 2 * IO + IG;
    for (int it = gw; it < NITEMS; it += NGW) {
        int r = it;
        if (r < I0) { transpose_item<0>(A.in[I_EINW], 1024, 6672, NP0, (bf16*)(ws + WS_WT0), scr, r, lane); continue; } r -= I0;
        if (r < I1) { transpose_item<1>(A.in[I_OINW], 1024, 7192, NP1, (bf16*)(ws + WS_WT1), scr, r, lane); continue; } r -= I1;
        if (r < IO) { transpose_item<2>(A.in[I_EOUTW], 2048, 1024, 1024, (bf16*)(ws + WS_WO0), scr, r, lane, G == 256 ? A.in[I_ENORMG] : nullptr); continue; } r -= IO;
        if (r < IO) { transpose_item<2>(A.in[I_OOUTW], 2048, 1024, 1024, (bf16*)(ws + WS_WO1), scr, r, lane); continue; } r -= IO;
        transpose_item<2>(A.in[I_OGLUW], 512, 512, 512, (bf16*)(ws + WS_WG), scr, r, lane);
    }
    __syncthreads();
    float* sc = (float*)lds;
    float* modp = (float*)(ws + WS_MODP);
    for (int item = blockIdx.x; item < 2 * KS * 6; item += G) {
        const int l = item / (KS * 6), r = item % (KS * 6), kc = r / 6, cb = r % 6;
        __syncthreads();
        for (int i = tid; i < 1024; i += NTHR) { const int b = i >> 7, k = i & 127; const float cv = A.in[I_C][b * 1024 + kc * 128 + k]; sc[i] = silu_f(cv); }
        __syncthreads();
        const int col = cb * 512 + tid; float acc[8];
#pragma unroll
        for (int b = 0; b < 8; ++b) acc[b] = 0.f;
        const float* wp = A.in[I_ADAW] + ((size_t)l * 1024 + kc * 128) * 3072 + col;
#pragma unroll 16
        for (int k = 0; k < 128; ++k) { const float w = wp[(size_t)k * 3072];
#pragma unroll
            for (int b = 0; b < 8; ++b) acc[b] += sc[b * 128 + k] * w; }
#pragma unroll
        for (int b = 0; b < 8; ++b) modp[((size_t)(kc * 2 + l) * 8 + b) * 3072 + col] = acc[b];
    }
    const int gt = blockIdx.x * NTHR + tid;
    if (gt < 2048) {
        const int g = gt >> 6, n = gt & 63;
        const float dt = __expf(A.in[I_OLDT][g]);
        const float lr = A.in[I_OLRE][g * 64 + n], li = A.in[I_OLIM][g * 64 + n];
        const float mag = expf(lr * dt); float sn, cs; sincosf(li * dt, &sn, &cs);
        const float ar = mag * cs, ai = mag * sn, den = lr * lr + li * li;
        const float qr = ((ar - 1.f) * lr + ai * li) / den, qi = (ai * lr - (ar - 1.f) * li) / den;
        unsigned char* pg = ws + WS_S5P + (size_t)g * S5P_STRIDE;
        bf16* BbT = (bf16*)pg; bf16* Cm = (bf16*)(pg + 4096); float* ari = (float*)(pg + 8192);
        ari[n] = ar; ari[64 + n] = ai;
        for (int c = 0; c < 16; ++c) { const float br = A.in[I_OBRE][(g * 64 + n) * 16 + c], bi = A.in[I_OBIM][(g * 64 + n) * 16 + c];
            BbT[(2 * n) * 16 + c] = (bf16)f2bf(qr * br - qi * bi); BbT[(2 * n + 1) * 16 + c] = (bf16)f2bf(qr * bi + qi * br);
            Cm[c * 128 + 2 * n] = (bf16)f2bf(A.in[I_OCRE][(g * 16 + c) * 64 + n]); Cm[c * 128 + 2 * n + 1] = (bf16)f2bf(-A.in[I_OCIM][(g * 16 + c) * 64 + n]); }
    }
    float* ssq = (float*)(ws + WS_SSQ);
    for (int i = gt; i < MROWS; i += G * NTHR) ssq[i] = 0.f;
}

__device__ __forceinline__ void p1a_rows(const Args& A, char* lds, int G) {
    const int tid = opaque_tid(), lane = tid & 63, wave = tid >> 6;
    const float* modp = (const float*)(A.ws + WS_MODP); float* mv = (float*)lds;
    for (int rb = blockIdx.x; rb < MROWS / 64; rb += G) {
        const int b = rb >> 5;
        __syncthreads();
#pragma unroll 1
        for (int col = tid; col < 1024; col += NTHR) { mv[col] = A.in[I_PREG][col] * (1.f + mod_val(modp, A.in[I_ADAB], 0, b, 1024 + col)); mv[1024 + col] = mod_val(modp, A.in[I_ADAB], 0, b, col); }
        __syncthreads();
        f32x4 mul[4], add[4];
#pragma unroll
        for (int j = 0; j < 4; ++j) { mul[j] = *(const f32x4*)(mv + 4 * lane + 256 * j); add[j] = *(const f32x4*)(mv + 1024 + 4 * lane + 256 * j); }
        f32x4 nx[4];
        { const f32x4* xr = (const f32x4*)(A.in[I_X] + (size_t)(rb * 64 + wave * 8) * DMOD) + lane;
#pragma unroll
          for (int j = 0; j < 4; ++j) nx[j] = xr[64 * j]; }
#pragma unroll 1
        for (int r = 0; r < 8; ++r) { const int m = rb * 64 + wave * 8 + r;
            f32x4 v[4]; float s = 0.f;
#pragma unroll
            for (int j = 0; j < 4; ++j) { v[j] = nx[j]; s += (v[j].x * v[j].x + v[j].y * v[j].y) + (v[j].z * v[j].z + v[j].w * v[j].w); }
            if (r < 7) { const f32x4* xr = (const f32x4*)(A.in[I_X] + (size_t)(m + 1) * DMOD) + lane;
#pragma unroll
                for (int j = 0; j < 4; ++j) nx[j] = xr[64 * j]; }
            const float rstd = rsqrtf(wave_sum(s) * (1.f / DMOD) + RMS_EPS);
            unsigned long long* o8 = (unsigned long long*)((unsigned char*)A.out + (size_t)m * 4096) + lane;
#pragma unroll
            for (int j = 0; j < 4; ++j) { const f32x4 h = v[j] * rstd * mul[j] + add[j]; o8[64 * j] = (unsigned long long)pk2(h.x, h.y) | ((unsigned long long)pk2(h.z, h.w) << 32); } }
    }
}
__device__ __forceinline__ void p3b_rows(const Args& A, char* lds, int G) {
    const int tid = opaque_tid(), lane = tid & 63, wave = tid >> 6;
    const float* modp = (const float*)(A.ws + WS_MODP); float* mv = (float*)lds;
    for (int rb = blockIdx.x; rb < MROWS / 64; rb += G) {
        const int b = rb >> 5;
        __syncthreads();
#pragma unroll 1
        for (int col = tid; col < 1024; col += NTHR) { mv[col] = A.in[I_POSTG][col] * mod_val(modp, A.in[I_ADAB], 0, b, 2048 + col);
            mv[1024 + col] = A.in[I_PREG][1024 + col] * (1.f + mod_val(modp, A.in[I_ADAB], 1, b, 1024 + col)); mv[2048 + col] = mod_val(modp, A.in[I_ADAB], 1, b, col); }
        __syncthreads();
        f32x4 g0[4], mul[4], add[4];
#pragma unroll
        for (int j = 0; j < 4; ++j) { g0[j] = *(const f32x4*)(mv + 4 * lane + 256 * j); mul[j] = *(const f32x4*)(mv + 1024 + 4 * lane + 256 * j); add[j] = *(const f32x4*)(mv + 2048 + 4 * lane + 256 * j); }
        f32x4 nx[4]; v2u ny[4];
        { const int m = rb * 64 + wave * 8; const f32x4* xr = (const f32x4*)(A.in[I_X] + (size_t)m * DMOD) + lane; const v2u* yr = (const v2u*)((unsigned char*)A.out + (size_t)m * 4096) + lane;
#pragma unroll
          for (int j = 0; j < 4; ++j) { nx[j] = xr[64 * j]; ny[j] = yr[64 * j]; } }
#pragma unroll 1
        for (int r = 0; r < 8; ++r) { const int m = rb * 64 + wave * 8 + r;
            unsigned char* slot = (unsigned char*)A.out + (size_t)m * 4096;
            f32x4 v[4], y[4]; float sy = 0.f; v2u wy[4];
#pragma unroll
            for (int j = 0; j < 4; ++j) { v[j] = nx[j]; wy[j] = ny[j]; }
            if (r < 7) { const f32x4* xr = (const f32x4*)(A.in[I_X] + (size_t)(m + 1) * DMOD) + lane; const v2u* yr = (const v2u*)(slot + 4096) + lane;
#pragma unroll
                for (int j = 0; j < 4; ++j) { nx[j] = xr[64 * j]; ny[j] = yr[64 * j]; } }
#pragma unroll
            for (int j = 0; j < 4; ++j) { const v2u w = wy[j]; y[j] = (f32x4){__uint_as_float(w.x << 16), __uint_as_float(w.x & 0xffff0000u), __uint_as_float(w.y << 16), __uint_as_float(w.y & 0xffff0000u)};
                sy += (y[j].x * y[j].x + y[j].y * y[j].y) + (y[j].z * y[j].z + y[j].w * y[j].w); }
            const float ry = rsqrtf(wave_sum(sy) * (1.f / DMOD) + RMS_EPS); float s = 0.f;
#pragma unroll
            for (int j = 0; j < 4; ++j) { v[j] = v[j] + g0[j] * (y[j] * ry); s += (v[j].x * v[j].x + v[j].y * v[j].y) + (v[j].z * v[j].z + v[j].w * v[j].w); }
            const float rstd = rsqrtf(wave_sum(s) * (1.f / DMOD) + RMS_EPS);
            unsigned long long* o8 = (unsigned long long*)(slot + 2048) + lane;
#pragma unroll
            for (int j = 0; j < 4; ++j) { const f32x4 h = v[j] * rstd * mul[j] + add[j]; o8[64 * j] = (unsigned long long)pk2(h.x, h.y) | ((unsigned long long)pk2(h.z, h.w) << 32); } }
    }
}
__device__ __forceinline__ void p6b_rows(const Args& A, char* lds, int G) {
    const int tid = opaque_tid(), lane = tid & 63, wave = tid >> 6;
    const float* modp = (const float*)(A.ws + WS_MODP); float* mv = (float*)lds;
    for (int rb = blockIdx.x; rb < MROWS / 64; rb += G) {
        const int b = rb >> 5;
        __syncthreads();
#pragma unroll 1
        for (int col = tid; col < 1024; col += NTHR) { mv[col] = A.in[I_POSTG][col] * mod_val(modp, A.in[I_ADAB], 0, b, 2048 + col); mv[1024 + col] = A.in[I_POSTG][1024 + col] * mod_val(modp, A.in[I_ADAB], 1, b, 2048 + col); }
        __syncthreads();
        f32x4 g0[4], g1[4];
#pragma unroll
        for (int j = 0; j < 4; ++j) { g0[j] = *(const f32x4*)(mv + 4 * lane + 256 * j); g1[j] = *(const f32x4*)(mv + 1024 + 4 * lane + 256 * j); }
        f32x4 nx[4]; v2u n0[4], n1[4];
        { const int m = rb * 64 + wave * 8; const f32x4* xr = (const f32x4*)(A.in[I_X] + (size_t)m * DMOD) + lane; const v2u* y1r = (const v2u*)((unsigned char*)A.out + (size_t)m * 4096) + lane;
#pragma unroll
          for (int j = 0; j < 4; ++j) { nx[j] = xr[64 * j]; n0[j] = y1r[64 * j]; n1[j] = y1r[256 + 64 * j]; } }
#pragma unroll 1
        for (int r = 0; r < 8; ++r) { const int m = rb * 64 + wave * 8 + r;
            unsigned char* slot = (unsigned char*)A.out + (size_t)m * 4096;
            f32x4 v[4], y0[4], y1[4]; float s0 = 0.f, s1 = 0.f; v2u w0[4], w1[4];
#pragma unroll
            for (int j = 0; j < 4; ++j) { v[j] = nx[j]; w0[j] = n0[j]; w1[j] = n1[j]; }
            if (r < 7) { const f32x4* xr = (const f32x4*)(A.in[I_X] + (size_t)(m + 1) * DMOD) + lane; const v2u* y1r = (const v2u*)(slot + 4096) + lane;
#pragma unroll
                for (int j = 0; j < 4; ++j) { nx[j] = xr[64 * j]; n0[j] = y1r[64 * j]; n1[j] = y1r[256 + 64 * j]; } }
#pragma unroll
            for (int j = 0; j < 4; ++j) { const v2u w = w0[j], u = w1[j];
                y0[j] = (f32x4){__uint_as_float(w.x << 16), __uint_as_float(w.x & 0xffff0000u), __uint_as_float(w.y << 16), __uint_as_float(w.y & 0xffff0000u)};
                y1[j] = (f32x4){__uint_as_float(u.x << 16), __uint_as_float(u.x & 0xffff0000u), __uint_as_float(u.y << 16), __uint_as_float(u.y & 0xffff0000u)};
                s0 += (y0[j].x * y0[j].x + y0[j].y * y0[j].y) + (y0[j].z * y0[j].z + y0[j].w * y0[j].w);
                s1 += (y1[j].x * y1[j].x + y1[j].y * y1[j].y) + (y1[j].z * y1[j].z + y1[j].w * y1[j].w); }
            const float r0 = rsqrtf(wave_sum(s0) * (1.f / DMOD) + RMS_EPS), r1 = rsqrtf(wave_sum(s1) * (1.f / DMOD) + RMS_EPS);
            f32x4* orow = (f32x4*)slot + lane;
#pragma unroll
            for (int j = 0; j < 4; ++j) { const f32x4 x1 = v[j] + g0[j] * (y0[j] * r0); v[j] = x1 + g1[j] * (y1[j] * r1); }
            asm volatile("" ::: "memory");
#pragma unroll
            for (int j = 0; j < 4; ++j) orow[64 * j] = v[j]; }
    }
}
#define BAR_ALL() asm volatile("s_waitcnt vmcnt(0) lgkmcnt(0)\n\ts_barrier" ::: "memory")
#define BAR_LDS() asm volatile("s_waitcnt lgkmcnt(0)\n\ts_barrier" ::: "memory")
typedef float f32x4m __attribute__((ext_vector_type(4)));
__device__ __forceinline__ void p2a_kbar(const Args& A, char* lds, int G) {
    const int tid = opaque_tid(); const bf16* P0 = (const bf16*)(A.ws + WS_BIG); float* kbar = (float*)(A.ws + WS_KBAR); float* red = (float*)lds;
    for (int item = blockIdx.x; item < NB * 16 * 8; item += G) {
        const int b = item >> 7, h = (item >> 3) & 15, n = item & 7; const int c8 = tid & 7, rg = tid >> 3;
        float acc[8];
#pragma unroll
        for (int e = 0; e < 8; ++e) acc[e] = 0.f;
#pragma unroll
        for (int i = 0; i < 4; ++i) { const bf16x8 kv = *(const bf16x8*)(P0 + (size_t)(b * SEQL + n * 256 + rg + 64 * i) * LD0 + C0_K + h * 64 + c8 * 8);
#pragma unroll
            for (int e = 0; e < 8; ++e) acc[e] += bf2f((unsigned short)kv[e]); }
        __syncthreads();
#pragma unroll
        for (int e = 0; e < 8; ++e) red[rg * 65 + c8 * 8 + e] = acc[e];
        __syncthreads();
        if (tid < 64) { float s = 0.f; for (int r = 0; r < 64; ++r) s += red[r * 65 + tid]; kbar[(size_t)item * 64 + tid] = s * (1.f / 256.f); }
    }
    __syncthreads();
}
__device__ __forceinline__ void p2a_conv(const Args& A, int G) {
    const int tid = opaque_tid(); const bf16* P0 = (const bf16*)(A.ws + WS_BIG); bf16* XC = (bf16*)A.out;
    if (tid >= 384) return;
    const int chg = tid % 192, half = tid / 192, ch = chg * 8;
    float w[4][8], bs[8];
#pragma unroll
    for (int k = 0; k < 4; ++k) { const f32x4 a = *(const f32x4*)(A.in[I_ECONVW] + k * 1536 + ch), b2 = *(const f32x4*)(A.in[I_ECONVW] + k * 1536 + ch + 4);
#pragma unroll
        for (int e = 0; e < 4; ++e) { w[k][e] = a[e]; w[k][4 + e] = b2[e]; } }
    { const f32x4 a = *(const f32x4*)(A.in[I_ECONVB] + ch), b2 = *(const f32x4*)(A.in[I_ECONVB] + ch + 4);
#pragma unroll
      for (int e = 0; e < 4; ++e) { bs[e] = a[e]; bs[4 + e] = b2[e]; } }
    for (int rb = blockIdx.x; rb < MROWS / 64; rb += G) {
        const int m0 = rb * 64 + half * 32; const int tb = m0 & (SEQL - 1);
        bf16x8 r0 = {}, r1 = {}, r2 = {};
        if (tb > 0) { r0 = *(const bf16x8*)(P0 + (size_t)(m0 - 3) * LD0 + C0_XBC + ch); r1 = *(const bf16x8*)(P0 + (size_t)(m0 - 2) * LD0 + C0_XBC + ch); r2 = *(const bf16x8*)(P0 + (size_t)(m0 - 1) * LD0 + C0_XBC + ch); }
#pragma unroll 4
        for (int i = 0; i < 32; ++i) { const bf16x8 r3 = *(const bf16x8*)(P0 + (size_t)(m0 + i) * LD0 + C0_XBC + ch); float o[8];
#pragma unroll
            for (int e = 0; e < 8; ++e) { const float a = bs[e] + w[0][e] * bf2f((unsigned short)r0[e]) + w[1][e] * bf2f((unsigned short)r1[e]) + w[2][e] * bf2f((unsigned short)r2[e]) + w[3][e] * bf2f((unsigned short)r3[e]); o[e] = silu_f(a); }
            v4u pw; pw.x = pk2(o[0], o[1]); pw.y = pk2(o[2], o[3]); pw.z = pk2(o[4], o[5]); pw.w = pk2(o[6], o[7]);
            *(v4u*)(XC + (size_t)(m0 + i) * 2048 + ch) = pw; r0 = r1; r1 = r2; r2 = r3; }
    }
}
constexpr int S_CS = 0, S_BS = 17408, S_BST = 34816, S_XT = 53248, S_XWT = 57856, S_XS = 62464, S_GG = 67584, S_SBF = 76800, S_DTA = 85504;
constexpr int F_CS = 0, F_BS = 17408, F_BST = 34816, F_XT = 53248, F_XWT = 62464, F_XS = 71680, F_GG = 80896, F_SBF = 90112, F_DTA = 107520;
template <bool DRY> __device__ __forceinline__ void ssd_unit(const Args& A, char* lds, int b, int h) {
    const int tid = opaque_tid(), lane = tid & 63, wave = __builtin_amdgcn_readfirstlane(tid >> 6); const int fr = lane & 15, fq = lane >> 4;
    bf16* P0 = (bf16*)(A.ws + WS_BIG); const bf16* XC = (const bf16*)A.out; const float* DT = (const float*)(A.ws + WS_DT);
    const int g = h >> 3; const int xcol = h * 64, bcol = 1024 + g * 128, ccol = 1280 + g * 128;
    bf16* CS = (bf16*)(lds + F_CS); bf16* BS = (bf16*)(lds + F_BS); bf16* BST = (bf16*)(lds + F_BST); bf16* XT = (bf16*)(lds + F_XT); bf16* XWT = (bf16*)(lds + F_XWT);
    bf16* XS = (bf16*)(lds + F_XS); bf16* GG = (bf16*)(lds + F_GG); bf16* SBF = (bf16*)(lds + F_SBF); float* DTA0 = (float*)(lds + F_DTA);
    for (int i = tid; i < 64 * 136; i += NTHR) SBF[i] = 0;
    const float Ah = -__expf(A.in[I_EALOG][h]), Dh = A.in[I_EDSKIP][h];
    const int lt = wave >> 1, pt0 = 2 * (wave & 1), st0 = 2 * (wave & 1), nt0 = (wave >> 1) * 2;
    f32x4m sta[2][2];
#pragma unroll
    for (int pi = 0; pi < 2; ++pi)
#pragma unroll
        for (int ni = 0; ni < 2; ++ni) sta[pi][ni] = (f32x4m){0.f, 0.f, 0.f, 0.f};
    const size_t rb0 = (size_t)b * SEQL;
    const bf16* pB = XC + (rb0 + (tid >> 4)) * 2048 + bcol + (tid & 15) * 8; const bf16* pC = XC + (rb0 + (tid >> 4)) * 2048 + ccol + (tid & 15) * 8; const bf16* pX = XC + (rb0 + (tid >> 3)) * 2048 + xcol + (tid & 7) * 8;
    const bf16* pZ = P0 + (rb0 + lt * 16 + 4 * fq) * LD0 + C0_ZA + h * 64 + pt0 * 16 + fr;
    bf16x8 pre[5]; float dtn = 0.f;
    pre[0] = *(const bf16x8*)pB; pre[1] = *(const bf16x8*)(pB + 32 * 2048); pre[2] = *(const bf16x8*)pC; pre[3] = *(const bf16x8*)(pC + 32 * 2048); pre[4] = *(const bf16x8*)pX;
    unsigned short zn[2][4], gts[2][4]; float sqs[2][4];
#pragma unroll
    for (int pi = 0; pi < 2; ++pi)
#pragma unroll
        for (int r = 0; r < 4; ++r) { zn[pi][r] = pZ[(size_t)r * LD0 + 16 * pi]; gts[pi][r] = 0; sqs[pi][r] = 0.f; }
    if (wave == 0) { dtn = DT[(rb0 + lane) * 16 + h]; const float s = wave_scan(Ah * dtn, lane); const float tot = rdlane(s, 63);
        DTA0[lane] = dtn; DTA0[64 + lane] = s; DTA0[128 + lane] = __expf(s); DTA0[192 + lane] = __expf(tot - s); dtn = DT[(rb0 + 64 + lane) * 16 + h]; }
    BAR_LDS();
    for (int c = 0; c < SEQL / 64; ++c) {
        const size_t m0 = rb0 + c * 64; float* DTA = DTA0 + (c & 1) * 256;
        { const int t = tid >> 4, c8 = tid & 15;
          *(bf16x8*)(BS + t * 136 + c8 * 8) = pre[0]; *(bf16x8*)(BS + (t + 32) * 136 + c8 * 8) = pre[1]; *(bf16x8*)(CS + t * 136 + c8 * 8) = pre[2]; *(bf16x8*)(CS + (t + 32) * 136 + c8 * 8) = pre[3];
          const int sw0 = ((((t >> 3) ^ (c8 & 7)) << 3) + (t & 7)), sw1 = (((((t + 32) >> 3) ^ (c8 & 7)) << 3) + (t & 7));
#pragma unroll
          for (int e = 0; e < 8; ++e) { BST[(c8 * 8 + e) * 72 + sw0] = (bf16)pre[0][e]; BST[(c8 * 8 + e) * 72 + sw1] = (bf16)pre[1][e]; }
          const int tx = tid >> 3, cx = tid & 7; *(bf16x8*)(XS + tx * 72 + cx * 8) = pre[4]; const float dtv = DTA[tx], wv = DTA[192 + tx]; const int sx = ((((tx >> 3) ^ cx) << 3) + (tx & 7));
#pragma unroll
          for (int e = 0; e < 8; ++e) { const float xd = bf2f((unsigned short)pre[4][e]) * dtv; XT[(cx * 8 + e) * 72 + sx] = (bf16)f2bf(xd); XWT[(cx * 8 + e) * 72 + sx] = (bf16)f2bf(xd * wv); } }
        if (c > 0) {
#pragma unroll
            for (int pi = 0; pi < 2; ++pi)
#pragma unroll
                for (int r = 0; r < 4; ++r) { const int l = lt * 16 + 4 * fq + r;
                    if (!DRY || sqs[pi][r] == 1.2345e30f) { ((bf16*)pZ)[((size_t)(c - 1) * 64 + r) * LD0 + 16 * pi] = gts[pi][r];
                        if (fr == 0) ((float*)((unsigned char*)A.out + (m0 - 64 + l) * 4096 + 3072))[h * 4 + pt0 + pi] = sqs[pi][r]; } } }
        if (c + 1 < SEQL / 64) { const size_t o = (size_t)(c + 1) * 64 * 2048;
            pre[0] = *(const bf16x8*)(pB + o); pre[1] = *(const bf16x8*)(pB + o + 32 * 2048); pre[2] = *(const bf16x8*)(pC + o); pre[3] = *(const bf16x8*)(pC + o + 32 * 2048); pre[4] = *(const bf16x8*)(pX + o); }
        unsigned short zv[2][4];
#pragma unroll
        for (int pi = 0; pi < 2; ++pi)
#pragma unroll
            for (int r = 0; r < 4; ++r) zv[pi][r] = zn[pi][r];
        if (c + 1 < SEQL / 64) {
#pragma unroll
            for (int pi = 0; pi < 2; ++pi)
#pragma unroll
                for (int r = 0; r < 4; ++r) zn[pi][r] = pZ[((size_t)(c + 1) * 64 + r) * LD0 + 16 * pi]; }
        BAR_LDS();
        f32x4m cb[2], ya[2]; cb[0] = (f32x4m){0.f, 0.f, 0.f, 0.f}; cb[1] = cb[0]; ya[0] = cb[0]; ya[1] = cb[0];
#pragma unroll
        for (int ks = 0; ks < 4; ++ks) { const bf16x8 af = *(const bf16x8*)(CS + (lt * 16 + fr) * 136 + ks * 32 + 8 * fq);
#pragma unroll
            for (int si = 0; si < 2; ++si) { const bf16x8 bfv = *(const bf16x8*)(BS + ((st0 + si) * 16 + fr) * 136 + ks * 32 + 8 * fq); cb[si] = __builtin_amdgcn_mfma_f32_16x16x32_bf16(af, bfv, cb[si], 0, 0, 0); }
#pragma unroll
            for (int pi = 0; pi < 2; ++pi) { const bf16x8 sf = *(const bf16x8*)(SBF + ((pt0 + pi) * 16 + fr) * 136 + ks * 32 + 8 * fq); ya[pi] = __builtin_amdgcn_mfma_f32_16x16x32_bf16(af, sf, ya[pi], 0, 0, 0); } }
#pragma unroll
        for (int r = 0; r < 4; ++r) { const int l = lt * 16 + 4 * fq + r; const float al = DTA[64 + l];
#pragma unroll
            for (int si = 0; si < 2; ++si) { const int s = (st0 + si) * 16 + fr; const float v = (s <= l) ? cb[si][r] * __expf(al - DTA[64 + s]) : 0.f; GG[l * 72 + s] = (bf16)f2bf(v); }
            const float ea = DTA[128 + l]; ya[0][r] *= ea; ya[1][r] *= ea; }
        const float decay = __expf(DTA[64 + 63]);
        BAR_LDS();
#pragma unroll
        for (int ks = 0; ks < 2; ++ks) { const bf16x8 gf = *(const bf16x8*)(GG + (lt * 16 + fr) * 72 + ks * 32 + 8 * fq);
#pragma unroll
            for (int pi = 0; pi < 2; ++pi) { const int p = (pt0 + pi) * 16 + fr; const bf16x8 xf = *(const bf16x8*)(XT + p * 72 + (((ks * 4 + fq) ^ ((p >> 3) & 7)) << 3)); ya[pi] = __builtin_amdgcn_mfma_f32_16x16x32_bf16(gf, xf, ya[pi], 0, 0, 0); } }
#pragma unroll
        for (int pi = 0; pi < 2; ++pi)
#pragma unroll
            for (int ni = 0; ni < 2; ++ni) sta[pi][ni] = sta[pi][ni] * decay;
#pragma unroll
        for (int ks = 0; ks < 2; ++ks) { bf16x8 bt[2];
#pragma unroll
            for (int ni = 0; ni < 2; ++ni) { const int n = (nt0 + ni) * 16 + fr; bt[ni] = *(const bf16x8*)(BST + n * 72 + (((ks * 4 + fq) ^ ((n >> 3) & 7)) << 3)); }
#pragma unroll
            for (int pi = 0; pi < 2; ++pi) { const int p = (pt0 + pi) * 16 + fr; const bf16x8 xw = *(const bf16x8*)(XWT + p * 72 + (((ks * 4 + fq) ^ ((p >> 3) & 7)) << 3));
#pragma unroll
                for (int ni = 0; ni < 2; ++ni) sta[pi][ni] = __builtin_amdgcn_mfma_f32_16x16x32_bf16(xw, bt[ni], sta[pi][ni], 0, 0, 0); } }
#pragma unroll
        for (int pi = 0; pi < 2; ++pi)
#pragma unroll
            for (int ni = 0; ni < 2; ++ni)
#pragma unroll
                for (int r = 0; r < 4; ++r) SBF[((pt0 + pi) * 16 + 4 * fq + r) * 136 + (nt0 + ni) * 16 + fr] = (bf16)f2bf(sta[pi][ni][r]);
#pragma unroll
        for (int pi = 0; pi < 2; ++pi)
#pragma unroll
            for (int r = 0; r < 4; ++r) { const int l = lt * 16 + 4 * fq + r, p = (pt0 + pi) * 16 + fr;
                const float y = ya[pi][r] + Dh * bf2f(XS[l * 72 + p]);
                const float z = bf2f(zv[pi][r]); const float gt = y * silu_f(z);
                gts[pi][r] = (unsigned short)f2bf(gt); sqs[pi][r] = row_sum16(gt * gt); }
        if (wave == 0 && c + 1 < SEQL / 64) { float* DN = DTA0 + ((c + 1) & 1) * 256; const float s = wave_scan(Ah * dtn, lane); const float tot = rdlane(s, 63);
            DN[lane] = dtn; DN[64 + lane] = s; DN[128 + lane] = __expf(s); DN[192 + lane] = __expf(tot - s);
            if (c + 2 < SEQL / 64) dtn = DT[(m0 + 128 + lane) * 16 + h]; }
        BAR_LDS();
    }
#pragma unroll
    for (int pi = 0; pi < 2; ++pi)
#pragma unroll
        for (int r = 0; r < 4; ++r) { const int l = lt * 16 + 4 * fq + r;
            if (!DRY || sqs[pi][r] == 1.2345e30f) { ((bf16*)pZ)[((size_t)(SEQL / 64 - 1) * 64 + r) * LD0 + 16 * pi] = gts[pi][r];
                if (fr == 0) ((float*)((unsigned char*)A.out + (rb0 + SEQL - 64 + l) * 4096 + 3072))[h * 4 + pt0 + pi] = sqs[pi][r]; } }
}
__device__ __forceinline__ void p2c_fixup(const Args& A, int vcu, int G) {
    const int tid = opaque_tid(), lane = tid & 63, wave = tid >> 6; bf16* P0 = (bf16*)(A.ws + WS_BIG); const float* ssq = (const float*)(A.ws + WS_SSQ);
    f32x4 gn[4];
#pragma unroll
    for (int j = 0; j < 4; ++j) gn[j] = *((const f32x4*)A.in[I_ENORMG] + lane + 64 * j);
    for (int m = vcu * NWAVES + wave; m < MROWS; m += G * NWAVES) { const float r = rsqrtf(wave_sum(((const float*)((const unsigned char*)A.out + (size_t)m * 4096 + 3072))[lane]) * (1.f / 1024.f) + RMS_EPS);
        v2u* p = (v2u*)(P0 + (size_t)m * LD0 + C0_ZA) + lane;
#pragma unroll
        for (int j = 0; j < 4; ++j) { const v2u w = p[64 * j]; v2u o; o.x = pk2(__uint_as_float(w.x << 16) * r * gn[j].x, __uint_as_float(w.x & 0xffff0000u) * r * gn[j].y);
            o.y = pk2(__uint_as_float(w.y << 16) * r * gn[j].z, __uint_as_float(w.y & 0xffff0000u) * r * gn[j].w); p[64 * j] = o; } }
}
__device__ __forceinline__ void p5a_fcum(const Args& A, char* lds, int G) {
    const int tid = opaque_tid(), lane = tid & 63, wave = tid >> 6; const float* LF = (const float*)(A.ws + WS_LF); float* F2 = (float*)(A.ws + WS_F2); float* wtot = (float*)(lds + 120 * 1024);
    for (int item = blockIdx.x; item < NB * 24; item += G) { const int b = item / 24, h = item % 24; const float fb = A.in[I_OFGB][h];
        float v[4]; float run = 0.f;
#pragma unroll
        for (int i = 0; i < 4; ++i) { const size_t ix = ((size_t)b * SEQL + 4 * tid + i) * 24 + h; const float* L1p = (const float*)(A.ws + WS_LFP);
            const float fr_ = (LF[ix] + L1p[ix]) + (L1p[ix + (size_t)MROWS * 24] + L1p[ix + (size_t)2 * MROWS * 24]) + fb; run += -softplus_g(-fr_); v[i] = run; }
        float s = run;
#pragma unroll
        for (int o = 1; o < 64; o <<= 1) { const float x = __shfl_up(s, o); if (lane >= o) s += x; }
        __syncthreads();
        if (lane == 63) wtot[wave] = s;
        __syncthreads();
        float off = s - run; for (int w = 0; w < wave; ++w) off += wtot[w];
#pragma unroll
        for (int i = 0; i < 4; ++i) { const float f2v = (off + v[i]) * LOG2E; const int t = 4 * tid + i; F2[(size_t)item * SEQL + t] = f2v;
            if ((t & 127) == 127) wtot[64 + (t >> 7)] = f2v; if ((t & 255) == 0) wtot[96 + (t >> 8)] = f2v; }
        { const bf16* P1 = (const bf16*)(A.ws + WS_BIG); float qm = 0.f, km = 0.f;
#pragma unroll 8
          for (int i = 0; i < 32; ++i) { const size_t m = (size_t)b * SEQL + (tid >> 3) + 64 * i; const int c8 = tid & 7; float qs = 0.f, ks2 = 0.f;
              const bf16x8 qv = *(const bf16x8*)(P1 + m * LD1 + C1_Q + h * 64 + c8 * 8), kv = *(const bf16x8*)(P1 + m * LD1 + C1_K + h * 64 + c8 * 8);
#pragma unroll
              for (int e = 0; e < 8; ++e) { const float qf = bf2f((unsigned short)qv[e]), kf = bf2f((unsigned short)kv[e]); qs += qf * qf; ks2 += kf * kf; }
              qs += dppf<0xB1>(qs, qs); qs += dppf<0x4E>(qs, qs); qs += dppf<0x141>(qs, qs); ks2 += dppf<0xB1>(ks2, ks2); ks2 += dppf<0x4E>(ks2, ks2); ks2 += dppf<0x141>(ks2, ks2);
              qm = fmaxf(qm, qs); km = fmaxf(km, ks2); }
#pragma unroll
          for (int o = 1; o < 64; o <<= 1) { qm = fmaxf(qm, __shfl_xor(qm, o)); km = fmaxf(km, __shfl_xor(km, o)); }
          __syncthreads();
          if (lane == 0) { wtot[16 + wave] = qm; wtot[32 + wave] = km; }
          __syncthreads();
          if (tid < 8) { float a = 0.f, c = 0.f; for (int w = 0; w < 8; ++w) { a = fmaxf(a, wtot[16 + w]); c = fmaxf(c, wtot[32 + w]); } const float u2 = 2.f * sqrtf(a) * sqrtf(c) * 1.01f;
              const int qb = tid; const float fi0 = wtot[96 + qb]; int ts = 0; while (ts + 2 <= 4 * qb && u2 - (wtot[64 + (ts >> 1)] - fi0) <= -40.f) ts += 2;
              ((int*)(A.ws + WS_TS))[item * 8 + qb] = ts; } }
    }
    __syncthreads();
}
constexpr int S5_BU = 0  , S5_SS = 67584  , S5_US = 102400  ;
__device__ __forceinline__ float gelu_tanh(float x) { const float u = 0.7978845608028654f * (x + 0.044715f * x * x * x); const float e = __expf(2.f * u); const float t = 1.f - 2.f / (e + 1.f); return 0.5f * x * (1.f + t); }
__device__ __forceinline__ void s5_unit(const Args& A, char* lds, int b, int g) {
    const int tid = opaque_tid(), lane = tid & 63, wave = __builtin_amdgcn_readfirstlane(tid >> 6); const int fr = lane & 15, fq = lane >> 4, r32 = lane & 31, hi = lane >> 5;
    const bf16* P1 = (const bf16*)(A.ws + WS_BIG); bf16* YD = (bf16*)A.out;
    const unsigned char* pg = A.ws + WS_S5P + (size_t)g * S5P_STRIDE; const bf16* BbT = (const bf16*)pg; const bf16* Cm = (const bf16*)(pg + 4096); const float* ari = (const float*)(pg + 8192);
    const int ttile = wave >> 2, ntile = wave & 3;
    const bf16x8 bfrag = *(const bf16x8*)(BbT + (ntile * 32 + r32) * 16 + 8 * hi);
    bf16x8 cfrag[4];
#pragma unroll
    for (int ks = 0; ks < 4; ++ks) cfrag[ks] = *(const bf16x8*)(Cm + fr * 128 + ks * 32 + 8 * fq);
    const float ar = ari[lane], ai = ari[64 + lane]; float sr = 0.f, si = 0.f;
    const float dskip = A.in[I_ODSKIP][g * 16 + fr];
    const size_t rb0 = (size_t)b * SEQL; const bf16* pU = P1 + (rb0 + ttile * 32 + r32) * LD1 + C1_U + g * 16 + 8 * hi;
    bf16x8 un = *(const bf16x8*)pU;
    BAR_LDS();
    for (int i = 0; i < SEQL / 64 + 2; ++i) {
        if (i < SEQL / 64) { float* BU = (float*)(lds + S5_BU) + (i & 1) * (64 * 132); f32x16 acc = {};
            acc = __builtin_amdgcn_mfma_f32_32x32x16_bf16(un, bfrag, acc, 0, 0, 0);
            if (ntile == 0) *(bf16x8*)((bf16*)(lds + S5_US) + ((i & 3) * 64 + ttile * 32 + r32) * 16 + 8 * hi) = un;
            if (i + 1 < SEQL / 64) un = *(const bf16x8*)(pU + (size_t)(i + 1) * 64 * LD1);
#pragma unroll
            for (int r = 0; r < 16; ++r) { const int t = ttile * 32 + (r & 3) + 8 * (r >> 2) + 4 * hi; BU[t * 132 + ntile * 32 + r32] = acc[r]; } }
        if (wave == 0 && i >= 1 && i <= SEQL / 64) { const float* BU = (const float*)(lds + S5_BU) + ((i - 1) & 1) * (64 * 132); bf16* SS = (bf16*)(lds + S5_SS) + ((i - 1) & 1) * (64 * 136);
#pragma unroll
            for (int hb = 0; hb < 2; ++hb) { f32x2_c bv[32];
#pragma unroll
                for (int t = 0; t < 32; ++t) bv[t] = *(const f32x2_c*)(BU + (hb * 32 + t) * 132 + 2 * lane);
                const f32x2_c a1 = {ar, ar}, a2 = {-ai, ai}; f32x2_c s2 = {sr, si};
#pragma unroll
                for (int t = 0; t < 32; ++t) { const f32x2_c sw = {s2.y, s2.x}; s2 = a1 * s2 + (a2 * sw + bv[t]);
                    *(unsigned*)(SS + (hb * 32 + t) * 136 + 2 * lane) = pk2(s2.x, s2.y); }
                sr = s2.x; si = s2.y; } }
        if (wave >= 4 && i >= 2) { const bf16* SS = (const bf16*)(lds + S5_SS) + ((i - 2) & 1) * (64 * 136); const int mt = wave - 4; const size_t m0 = rb0 + (size_t)(i - 2) * 64;
            unsigned short uv[4];
#pragma unroll
            for (int r = 0; r < 4; ++r) uv[r] = ((const bf16*)(lds + S5_US))[(((i - 2) & 3) * 64 + mt * 16 + 4 * fq + r) * 16 + fr];
            f32x4m acc = (f32x4m){0.f, 0.f, 0.f, 0.f};
#pragma unroll
            for (int ks = 0; ks < 4; ++ks) { const bf16x8 af = *(const bf16x8*)(SS + (mt * 16 + fr) * 136 + ks * 32 + 8 * fq); acc = __builtin_amdgcn_mfma_f32_16x16x32_bf16(af, cfrag[ks], acc, 0, 0, 0); }
#pragma unroll
            for (int r = 0; r < 4; ++r) { const size_t m = m0 + mt * 16 + 4 * fq + r; YD[m * 2048 + 1024 + g * 16 + fr] = (bf16)f2bf(gelu_tanh(acc[r] + dskip * bf2f(uv[r]))); } }
        BAR_LDS();
    }
}
template <bool DRY> __device__ __forceinline__ void moba_phase(const Args& A, char* lds, int vcu, int G) {
    const bf16* P0 = (const bf16*)(A.ws + WS_BIG); const float* kbar = (const float*)(A.ws + WS_KBAR);
    unsigned* cnt = (unsigned*)(A.ws + WS_CNT) + (DRY ? 192 : 128); volatile unsigned* lw = (volatile unsigned*)(lds + BARST_OFF + 16);
    const int tid = opaque_tid();
    if (tid == 0) lw[0] = atomicAdd(cnt, 1u);
    BAR_ALL();
    int u = __builtin_amdgcn_readfirstlane((int)lw[0]);
    while (u < NB * 16 * 8) {
        unsigned nxt = 0u; if (tid == 0) nxt = atomicAdd(cnt, 1u);
        const int qb = 7 - u / 128, bh = u % 128, b = bh >> 4, h = bh & 15;
        attn_body::attn_unit<8, 0, LD0, DRY>(b, h, qb, (const attn_body::bf16*)(P0 + C0_Q), (const attn_body::bf16*)(P0 + C0_K), (const attn_body::bf16*)(P0 + C0_V), (attn_body::bf16*)(P0 + C0_Q),
                                            (const attn_body::bf16*)(P0 + C0_ZB), kbar + (size_t)bh * 512, nullptr, lw, nxt, lds);
        BAR_LDS();
        u = __builtin_amdgcn_readfirstlane((int)lw[0]);
    }
}
template <bool DRY> __device__ __forceinline__ void fox_phase(const Args& A, char* lds, int vcu, int G) {
    const bf16* P1 = (const bf16*)(A.ws + WS_BIG); const float* F2 = (const float*)(A.ws + WS_F2); const int* TSv = (const int*)(A.ws + WS_TS);
    unsigned* cnt = (unsigned*)(A.ws + WS_CNT) + (DRY ? 64 : 0); volatile unsigned* lw = (volatile unsigned*)(lds + BARST_OFF + 16);
    const int tid = opaque_tid();
    if (tid == 0) lw[0] = atomicAdd(cnt, 1u);
    BAR_ALL();
    int u = __builtin_amdgcn_readfirstlane((int)lw[0]);
    while (u < NB * 24 * 8) {
        unsigned nxt = 0u; if (tid == 0) nxt = atomicAdd(cnt, 1u);
        const int qb = 7 - u / 192, bh = u % 192, b = bh / 24, h = bh % 24;
        attn_body::attn_unit<8, 1, LD1, DRY>(b, h, qb, (const attn_body::bf16*)(P1 + C1_Q), (const attn_body::bf16*)(P1 + C1_K), (const attn_body::bf16*)(P1 + C1_V), (attn_body::bf16*)(P1 + C1_Q),
                                            (const attn_body::bf16*)(P1 + C1_ZC), F2 + (size_t)bh * SEQL, TSv + bh * 8, lw, nxt, lds);
        BAR_LDS();
        u = __builtin_amdgcn_readfirstlane((int)lw[0]);
    }
}
#define LAS __attribute__((address_space(3)))
#define XB_TMO      128
#define XB_XCNT(j)  (256  + 64 * (j))
#define XB_XSUB(j)  (1280 + 64 * (j))
#define XB_XGEN(j)  (2304 + 64 * (j))
#define XB_TOP      3328
#define XB_TOPGEN   3392
#define XCD_BAR_WORDS 3456
#define XB_SPIN_CAP (1u << 18)

__device__ __forceinline__ unsigned xb_ld(unsigned* p)              { return __hip_atomic_load(p, __ATOMIC_RELAXED, __HIP_MEMORY_SCOPE_AGENT); }
__device__ __forceinline__ unsigned xb_add(unsigned* p, unsigned v) { return __hip_atomic_fetch_add(p, v, __ATOMIC_RELAXED, __HIP_MEMORY_SCOPE_AGENT); }
__device__ __forceinline__ unsigned xb_xcc_id() { return (unsigned)__builtin_amdgcn_s_getreg((3 << 11) | 20) & 0xFu; }
#define XB_SPIN(cond, bar) do { unsigned _sp = 0; while (cond) { __builtin_amdgcn_s_sleep(1); \
    if ((++_sp & 255u) == 0u) { if (xb_ld(&(bar)[XB_TMO])) break; if (_sp > XB_SPIN_CAP) { atomicAdd(&(bar)[XB_TMO], 1u); break; } } } } while (0)

struct XcdBarrier {
    unsigned* bar; unsigned x;
    volatile LAS unsigned* st;
};

__device__ __forceinline__ XcdBarrier xcd_barrier_post(unsigned* bar, volatile LAS unsigned* st) {
    XcdBarrier b; b.bar = bar; b.x = xb_xcc_id(); b.st = st;
    if (threadIdx.x == 0) (void)xb_add(&bar[XB_XCNT(b.x)], 1u);
    return b;
}
__device__ __forceinline__ void xcd_barrier_complete(unsigned* bar, unsigned x, unsigned& nloc, unsigned& nx) {
    const unsigned G = gridDim.x * gridDim.y * gridDim.z;
    unsigned sum, cnt, mine, sp = 0u;
    for (;;) {
        sum = 0u; cnt = 0u; mine = 0u;
#pragma unroll
        for (unsigned j = 0; j < 16; ++j) { const unsigned c = xb_ld(&bar[XB_XCNT(j)]); sum += c; cnt += (c > 0u) ? 1u : 0u; mine = (j == x) ? c : mine; }
        if (sum == G) break;
        __builtin_amdgcn_s_sleep(1);
        if ((++sp & 255u) == 0u) { if (xb_ld(&bar[XB_TMO])) break; if (sp > XB_SPIN_CAP) { atomicAdd(&bar[XB_TMO], 1u); break; } }
    }
    nloc = mine > 0u ? mine : 1u; nx = cnt > 0u ? cnt : 1u;
}

__device__ __forceinline__ void xcd_barrier(const XcdBarrier& b) {
    asm volatile("s_waitcnt vmcnt(0)" ::: "memory");
    __syncthreads();
    if (threadIdx.x == 0) {
        unsigned* bar = b.bar;
        __builtin_amdgcn_s_waitcnt(0);
        unsigned nloc = b.st[0], nx = b.st[1];
        if (nloc == 0u) { xcd_barrier_complete(bar, b.x, nloc, nx); b.st[0] = nloc; b.st[1] = nx; }
        const unsigned old = xb_add(&bar[XB_XSUB(b.x)], 1u);
        const unsigned gen = old / nloc;
        if (old + 1u == (gen + 1u) * nloc) {
            __builtin_amdgcn_fence(__ATOMIC_RELEASE, "agent");
            asm volatile("s_waitcnt vmcnt(0)" ::: "memory");
            const unsigned og = xb_add(&bar[XB_TOP], 1u);
            const unsigned tg = og / nx;
            if (og + 1u == (tg + 1u) * nx) xb_add(&bar[XB_TOPGEN], 1u);
            else XB_SPIN(xb_ld(&bar[XB_TOPGEN]) == tg, bar);
            __builtin_amdgcn_fence(__ATOMIC_ACQUIRE, "agent");
            xb_add(&bar[XB_XGEN(b.x)], 1u);
            asm volatile("s_waitcnt vmcnt(0)" ::: "memory");
        } else {
            XB_SPIN(xb_ld(&bar[XB_XGEN(b.x)]) == gen, bar);
            __builtin_amdgcn_fence(__ATOMIC_ACQUIRE, "agent");
            asm volatile("s_waitcnt vmcnt(0)" ::: "memory");
        }
    }
    __syncthreads();
}

constexpr int ARGS_OFF = 132096;
__device__ __forceinline__ Args get_args(const unsigned char* lds) {
    Args a; const unsigned long long* p = (const unsigned long long*)(lds + ARGS_OFF);
#pragma unroll
    for (int i = 0; i < 29; ++i) { const unsigned long long v = p[i]; const unsigned lo = __builtin_amdgcn_readfirstlane((unsigned)v), hi = __builtin_amdgcn_readfirstlane((unsigned)(v >> 32));
        const unsigned long long w = ((unsigned long long)hi << 32) | lo; if (i < 27) a.in[i] = (const float*)w; else if (i == 27) a.out = (float*)w; else a.ws = (unsigned char*)w; }
    return a;
}
#define PHASE_BEGIN { const Args args = get_args(lds); unsigned char* ws = args.ws; bf16* XN = (bf16*)args.out; bf16* PB = (bf16*)(ws + WS_BIG); (void)ws; (void)XN; (void)PB;
#ifdef DUP_SYNC
#define PHASE_END } xcd_barrier(xbar); xcd_barrier(xbar);
#else
#define PHASE_END } xcd_barrier(xbar);
#endif
#define PHASE_END_NOSYNC }
__global__ void __launch_bounds__(NTHR, 2) trunk_fwd(Args kargs_unused) {
    extern __shared__ __attribute__((aligned(16))) unsigned char lds[];
    cg::grid_group grid = cg::this_grid();
    const int G = gridDim.x, bx = blockIdx.x; const int vcu = (G % 8 == 0) ? (bx % 8) * (G / 8) + bx / 8 : bx;
    char* ldsc = (char*)lds; PG8_LAS unsigned char* ldsg = (PG8_LAS unsigned char*)lds;
    { const int t = opaque_tid(); if (t < 29) { const unsigned long long* ka = (const unsigned long long*)__builtin_amdgcn_kernarg_segment_ptr(); ((unsigned long long*)(lds + ARGS_OFF))[t] = ka[t]; }
      if (t < 2) ((unsigned*)(lds + BARST_OFF))[t] = 0u; }
    __syncthreads();
    XcdBarrier xbar;
    {
    const Args args = get_args(lds);
    unsigned* rdy = (unsigned*)(args.ws + WS_BAR) + 4160;
    if (bx == 0) { unsigned* bw = (unsigned*)(args.ws + WS_BAR); for (int i = opaque_tid(); i < 4096; i += NTHR) bw[i] = 0u;
        asm volatile("s_waitcnt vmcnt(0)" ::: "memory"); __syncthreads();
        if (opaque_tid() == 0) { __builtin_amdgcn_fence(__ATOMIC_RELEASE, "agent"); asm volatile("s_waitcnt vmcnt(0)" ::: "memory"); __hip_atomic_store(rdy, 0x600DF00Du, __ATOMIC_RELAXED, __HIP_MEMORY_SCOPE_AGENT); } }
    if (G > 0x40000000) grid.sync();
    p0_prologue(args, ldsc, vcu, G);
    if (opaque_tid() == 0) { unsigned sp = 0; while (__hip_atomic_load(rdy, __ATOMIC_RELAXED, __HIP_MEMORY_SCOPE_AGENT) != 0x600DF00Du && ++sp < (1u << 22)) __builtin_amdgcn_s_sleep(2);
        __builtin_amdgcn_fence(__ATOMIC_ACQUIRE, "agent"); asm volatile("s_waitcnt vmcnt(0)" ::: "memory"); }
    __syncthreads();
    xbar = xcd_barrier_post((unsigned*)(args.ws + WS_BAR), (volatile LAS unsigned*)(lds + BARST_OFF));
    xcd_barrier(xbar);
    if (bx == 0 && opaque_tid() == 0) __hip_atomic_store(rdy, 0u, __ATOMIC_RELAXED, __HIP_MEMORY_SCOPE_AGENT);
    }
    PHASE_BEGIN
    p1a_rows(args, ldsc, G);
#ifdef DUP_MISC
    p1a_rows(args, ldsc, G);
#endif
    PHASE_END
    PHASE_BEGIN
    { pg8::Gemm g{XN, (const bf16*)(ws + WS_WT0), MROWS, NP0, 1024, 2048, 1024, 0}; pg8::StaticOrder S; S.init(MROWS, NP0, G, bx);
      pg8::EpiX<0> E{PB, LD0, args.in[I_EDTB], (float*)(ws + WS_DT), nullptr, nullptr, attn_body::C2};
      pg8::gemm_phase<pg8::EpiX<0>, pg8::StaticOrder, true, true>(ldsg, g, S, E); }
#ifdef DUP_GEMM
    { pg8::Gemm g{XN, (const bf16*)(ws + WS_WT0), MROWS, NP0, 1024, 2048, 1024, 0}; pg8::StaticOrder S; S.init(MROWS, NP0, G, bx);
      pg8::EpiX<0> E{PB, LD0, args.in[I_EDTB], (float*)(ws + WS_DT), nullptr, nullptr, attn_body::C2};
      pg8::gemm_phase<pg8::EpiX<0>, pg8::StaticOrder, true, true>(ldsg, g, S, E); }
#endif
    PHASE_END
    PHASE_BEGIN
    p2a_kbar(args, ldsc, G);
    p2a_conv(args, G);
#ifdef DUP_MISC
    p2a_kbar(args, ldsc, G);
    p2a_conv(args, G);
#endif
    PHASE_END
    PHASE_BEGIN
#ifdef DUP_SSD
    for (int v = vcu; v < 128; v += G) ssd_unit<true>(args, ldsc, v >> 4, v & 15);
#endif
    for (int v = vcu; v < 128; v += G) ssd_unit<false>(args, ldsc, v >> 4, v & 15);
    PHASE_END_NOSYNC
    PHASE_BEGIN
#ifdef DUP_MOBA
    moba_phase<true>(args, ldsc, vcu, G);
#endif
    moba_phase<false>(args, ldsc, vcu, G);
    PHASE_END
    if (G != 256) {
    PHASE_BEGIN
    p2c_fixup(args, vcu, G);
    PHASE_END
    }
    PHASE_BEGIN
    { pg8::Gemm g{PB, (const bf16*)(ws + WS_WO0), MROWS, 1024, 2048, LD0, 2048, 0}; pg8::StaticOrder S; S.init(MROWS, 1024, G, bx);
      { pg8::Unit u0; u0.pm = 0; u0.pn = 0; const bool have = S.next(0, u0); const int pm0 = u0.pm; float* rs = (float*)(lds + 131072); const int t = opaque_tid();
        if (t < 256) { float r = 1.f;
            if (G == 256 && have) { const f32x4* pp = (const f32x4*)((const unsigned char*)args.out + (size_t)(pm0 * 256 + t) * 4096 + 3072); float sm = 0.f;
#pragma unroll
                for (int i = 0; i < 16; ++i) { const f32x4 v = pp[i]; sm += (v.x + v.y) + (v.z + v.w); }
                r = rsqrtf(sm * (1.f / 1024.f) + RMS_EPS); }
            rs[t] = r; }
        __syncthreads(); }
      pg8::EpiX<5> E{XN, 2048, nullptr, nullptr, nullptr, nullptr, 1.f};
      pg8::gemm_phase<pg8::EpiX<5>, pg8::StaticOrder, true, true>(ldsg, g, S, E); }
    PHASE_END
    PHASE_BEGIN
    p3b_rows(args, ldsc, G);
#ifdef DUP_MISC
    p3b_rows(args, ldsc, G);
#endif
    PHASE_END
    PHASE_BEGIN
    { pg8::Gemm g{XN + 1024, (const bf16*)(ws + WS_WT1), MROWS, LD1, 1024, 2048, 1024, 0}; pg8::StaticOrder S; S.init(MROWS, LD1, G, bx);
      pg8::EpiX<1> E{PB, LD1, nullptr, nullptr, nullptr, nullptr, attn_body::C2};
      pg8::gemm_phase<pg8::EpiX<1>, pg8::StaticOrder, true, true>(ldsg, g, S, E); }
    { pg8::Gemm g{XN + 1024, (const bf16*)(ws + WS_WT1) + (size_t)LD1 * 1024, MROWS, 1024, 256, 2048, 1024, 1}; pg8::StaticOrder S; S.init(MROWS, 1024, G, bx);
      pg8::EpiX<4> E{nullptr, 0, nullptr, (float*)(ws + WS_LF), (const bf16*)(ws + WS_LFP), nullptr, 1.f};
      pg8::gemm_phase<pg8::EpiX<4>, pg8::StaticOrder, true, true>(ldsg, g, S, E); }
#ifdef DUP_GEMM
    { pg8::Gemm g{XN + 1024, (const bf16*)(ws + WS_WT1), MROWS, LD1, 1024, 2048, 1024, 0}; pg8::StaticOrder S; S.init(MROWS, LD1, G, bx);
      pg8::EpiX<1> E{PB, LD1, nullptr, nullptr, nullptr, nullptr, attn_body::C2};
      pg8::gemm_phase<pg8::EpiX<1>, pg8::StaticOrder, true, true>(ldsg, g, S, E); }
#endif
    PHASE_END
    PHASE_BEGIN
    p5a_fcum(args, ldsc, G);
#ifdef DUP_S5
    p5a_fcum(args, ldsc, G);
#endif
    for (int v = vcu; v < 256; v += G) s5_unit(args, ldsc, v >> 5, v & 31);
#ifdef DUP_S5
    for (int v = vcu; v < 256; v += G) s5_unit(args, ldsc, v >> 5, v & 31);
#endif
    PHASE_END
    PHASE_BEGIN
#ifdef DUP_FOX
    fox_phase<true>(args, ldsc, vcu, G);
#endif
    if (vcu < 128) { pg8::Gemm g{XN + 1024, (const bf16*)(ws + WS_WG), MROWS, 512, 512, 2048, 512, 0}; pg8::StaticOrder S; S.init(MROWS, 512, 128, vcu);
      pg8::EpiX<3> E{PB + C1_U, LD1, args.in[I_OGLUB], nullptr, XN + 1024, PB + C1_ZD, 1.f};
      pg8::gemm_phase<pg8::EpiX<3>, pg8::StaticOrder, true, true>(ldsg, g, S, E); }
    fox_phase<false>(args, ldsc, vcu, G);
    PHASE_END
    PHASE_BEGIN
    { pg8::Gemm g{PB, (const bf16*)(ws + WS_WO1), MROWS, 1024, 2048, LD1, 2048, 0}; pg8::StaticOrder S; S.init(MROWS, 1024, G, bx);
      pg8::EpiX<2> E{XN + 1024, 2048, nullptr, nullptr, nullptr, nullptr, 1.f};
      pg8::gemm_phase<pg8::EpiX<2>, pg8::StaticOrder, true, true>(ldsg, g, S, E); }
#ifdef DUP_GEMM
    { pg8::Gemm g{PB, (const bf16*)(ws + WS_WO1), MROWS, 1024, 2048, LD1, 2048, 0}; pg8::StaticOrder S; S.init(MROWS, 1024, G, bx);
      pg8::EpiX<2> E{XN + 1024, 2048, nullptr, nullptr, nullptr, nullptr, 1.f};
      pg8::gemm_phase<pg8::EpiX<2>, pg8::StaticOrder, true, true>(ldsg, g, S, E); }
#endif
    PHASE_END
    PHASE_BEGIN
    p6b_rows(args, ldsc, G);
    PHASE_END_NOSYNC
}

extern "C" void kernel_launch(void* const* d_in, const int* in_sizes, int n_in, void* d_out, int out_size, void* d_ws, size_t ws_size, hipStream_t stream) {
    static int grid = 0;
    if (grid == 0) {
        if (n_in != 27 || out_size != MROWS * DMOD || ws_size < (size_t)256 * MiB) { fprintf(stderr, "kernel_launch: unexpected shapes n_in %d out %d ws %zu\n", n_in, out_size, ws_size); grid = -1; return; }
        int dev = 0, cus = 0, per_cu = 0;
        (void)hipGetDevice(&dev); (void)hipDeviceGetAttribute(&cus, hipDeviceAttributeMultiprocessorCount, dev);
        if (hipFuncSetAttribute((const void*)trunk_fwd, hipFuncAttributeMaxDynamicSharedMemorySize, LDS_BYTES) != hipSuccess) { fprintf(stderr, "kernel_launch: hipFuncSetAttribute failed\n"); }
        if (hipOccupancyMaxActiveBlocksPerMultiprocessor(&per_cu, (const void*)trunk_fwd, NTHR, LDS_BYTES) != hipSuccess || per_cu < 1) { fprintf(stderr, "kernel_launch: occupancy query says %d\n", per_cu); per_cu = 1; }
        (void)hipGetLastError();
        grid = cus * per_cu; if (grid > 256) grid = 256; if (grid < 1) grid = 256;
    }
    if (grid < 0) return;
    Args a{};
    for (int i = 0; i < 27; ++i) a.in[i] = (const float*)d_in[i];
    a.out = (float*)d_out; a.ws = (unsigned char*)d_ws;
    void* kargs[] = {&a};
    hipError_t e = hipLaunchCooperativeKernel((const void*)trunk_fwd, dim3(grid), dim3(NTHR), kargs, LDS_BYTES, stream);
    if (e != hipSuccess) fprintf(stderr, "cooperative launch failed: %s (grid %d)\n", hipGetErrorString(e), grid);
}
```

```cpp
#include <hip/hip_runtime.h>
#include <hip/hip_cooperative_groups.h>
#include <cstdio>
#include <cstdint>
namespace cg = cooperative_groups;
__device__ __forceinline__ int opaque_tid() { int t = threadIdx.x; asm volatile("" : "+v"(t)); return t; }
namespace pg8 {
#define PG8_LAS __attribute__((address_space(3)))
typedef unsigned short bf16_t;
typedef short bf16x8 __attribute__((ext_vector_type(8)));
typedef float f32x4 __attribute__((ext_vector_type(4)));
typedef unsigned u32x4 __attribute__((ext_vector_type(4)));
constexpr int BM = 256, BK = 64, HALF = 128, HTB = HALF * BK * 2  , STAGE_BYTES = 8 * HTB, NXCD = 8, WGM = 8;

__host__ __device__ __forceinline__ int lds_byte(int r, int c) { const int st = (r >> 4) * 2 + (c >> 5), rr = r & 15, cc = c & 31, ob = rr * 64 + cc * 2; return st * 1024 + (ob ^ (((ob >> 9) & 1) << 5)); }
__host__ __device__ __forceinline__ void stage_rc(int b, int& R, int& C) { const int st = b / 1024, sb = b % 1024, swz = sb ^ (((sb >> 9) & 1) << 5); R = (st >> 1) * 16 + swz / 64; C = (st & 1) * 32 + (swz % 64) / 2; }
__host__ __device__ __forceinline__ int perm32(int rho) { const int n = rho >> 4, i = rho & 15; return 8 * (i >> 2) + 4 * n + (i & 3); }

struct Unit { int pm, pn; };
struct Gemm { const bf16_t* A; const bf16_t* Bt; int M, N, K, lda, ldb, ksplit; };

struct StaticOrder {
    int nM, nN, nwg, G, c;
    __host__ __device__ __forceinline__ void init(int M, int N, int G_, int c_) { nM = M / BM; nN = N / BM; nwg = nM * nN; G = G_; c = c_; }
    __host__ __device__ __forceinline__ bool next(int i, Unit& u) const {
        const long L = (long)i * G + c; if (L >= nwg) return false;
        int wgid = (int)L; { const int q = nwg / NXCD, r = nwg % NXCD, xcd = wgid % NXCD, off = wgid / NXCD; wgid = (xcd < r ? xcd * (q + 1) : r * (q + 1) + (xcd - r) * q) + off; }
        const int nig = WGM * nN, gid = wgid / nig, fm = gid * WGM, gsz = (nM - fm) < WGM ? (nM - fm) : WGM;
        u.pm = fm + ((wgid % nig) % gsz); u.pn = (wgid % nig) / gsz; return true;
    }
    __device__ __forceinline__ void a_ready(const Unit&) const {}
    __device__ __forceinline__ void done(const Unit&) const {}
};

__device__ __forceinline__ unsigned cvt_pk_bf16(float lo, float hi) { unsigned r; asm volatile("v_cvt_pk_bf16_f32 %0, %1, %2" : "=v"(r) : "v"(lo), "v"(hi)); return r; }
__device__ __forceinline__ float bflo(unsigned w) { return __uint_as_float(w << 16); }
__device__ __forceinline__ float bfhi(unsigned w) { return __uint_as_float(w & 0xffff0000u); }
__device__ __forceinline__ float softplus_f(float x) { return x > 20.f ? x : log1pf(__expf(x)); }
__device__ __forceinline__ float sigmoid_f(float x) { return 1.f / (1.f + __expf(-x)); }
constexpr int MROWS_ = 16384;
template <int MODE> struct EpiX {
    static constexpr bool PERM = true, AFTER_DRAIN = false; static constexpr int MIDT = (MODE == 5) ? 16 : -1;
    bf16_t* O; int ldc; const float* bias; float* F32O; const bf16_t* Y; const bf16_t* Zp; float qscale;
    __device__ __forceinline__ void mid(f32x4 (&acc)[2][2][4][2], int wr, int fr, PG8_LAS unsigned char* lds) const {
        const PG8_LAS float* rs = (const PG8_LAS float*)(lds + 131072);
#pragma unroll
        for (int ai = 0; ai < 2; ++ai)
#pragma unroll
            for (int m = 0; m < 4; ++m) { const float r = rs[ai * HALF + wr * 64 + m * 16 + fr];
#pragma unroll
                for (int bj = 0; bj < 2; ++bj)
#pragma unroll
                    for (int n = 0; n < 2; ++n) acc[ai][bj][m][n] = acc[ai][bj][m][n] * r; }
    }
    __device__ __forceinline__ void operator()(const f32x4 (&acc)[2][2][4][2], const Unit& u, int wr, int wc, int fr, int fq) const {
        const int row0 = u.pm * BM + wr * 64 + fr; const int col0 = u.pn * BM + wc * 32 + 8 * fq;
        float sc = 1.f;
        if (MODE == 0) { if (u.pn >= 4 && u.pn < 8) sc = qscale; }
        if (MODE == 1) { if (u.pn < 6) sc = qscale; }
        const bool special = (MODE == 0 && u.pn == 26);
#pragma unroll
        for (int ai = 0; ai < 2; ++ai)
#pragma unroll
            for (int m = 0; m < 4; ++m) { const int row = row0 + ai * HALF + m * 16;
#pragma unroll
                for (int bj = 0; bj < 2; ++bj) { f32x4 v0 = acc[ai][bj][m][0], v1 = acc[ai][bj][m][1]; const int col = col0 + bj * HALF;
                    if (MODE == 0 || MODE == 1) {
                        if (!special) { v0 = v0 * sc; v1 = v1 * sc; u32x4 w; w.x = cvt_pk_bf16(v0[0], v0[1]); w.y = cvt_pk_bf16(v0[2], v0[3]); w.z = cvt_pk_bf16(v1[0], v1[1]); w.w = cvt_pk_bf16(v1[2], v1[3]);
                            *(u32x4*)(O + (size_t)row * ldc + col) = w; }
                        else { const int lc = col - u.pn * BM; const int NV = (MODE == 0) ? 16 : 24;
                            if (lc < NV) { f32x4 o0, o1;
#pragma unroll
                                for (int i = 0; i < 4; ++i) { const float a0 = v0[i] + bias[lc + i], a1 = v1[i] + bias[lc + 4 + i];
                                    if (MODE == 0) { o0[i] = softplus_f(a0); o1[i] = softplus_f(a1); } else { o0[i] = -softplus_f(-a0); o1[i] = -softplus_f(-a1); } }
                                *(f32x4*)(F32O + (size_t)row * NV + lc) = o0; *(f32x4*)(F32O + (size_t)row * NV + lc + 4) = o1; } }
                    } else if (MODE == 4) {
                        const int lc = col - u.pn * BM;
                        if (lc < 24) { float* dst = (u.pn == 0 ? F32O : (float*)((unsigned char*)Y + (size_t)(u.pn - 1) * (MROWS_ * 24 * 4))) + (size_t)row * 24 + lc; *(f32x4*)dst = v0; *(f32x4*)(dst + 4) = v1; }
                    } else if (MODE == 2 || MODE == 5) {
                        u32x4 w; w.x = cvt_pk_bf16(v0[0], v0[1]); w.y = cvt_pk_bf16(v0[2], v0[3]); w.z = cvt_pk_bf16(v1[0], v1[1]); w.w = cvt_pk_bf16(v1[2], v1[3]);
                        *(u32x4*)(O + (size_t)row * ldc + col) = w;
                    } else {
                        const u32x4 yv = *(const u32x4*)(Y + (size_t)row * 2048 + col); const u32x4 zv = *(const u32x4*)(Zp + (size_t)row * ldc + col);
                        const f32x4 b0 = *(const f32x4*)(bias + col), b1 = *(const f32x4*)(bias + col + 4);
                        float r[8];
#pragma unroll
                        for (int e = 0; e < 4; ++e) { const float y0 = bflo(yv[e]), y1 = bfhi(yv[e]), z0 = bflo(zv[e]), z1 = bfhi(zv[e]);
                            const float a0 = (e < 2 ? v0[2 * e] : v1[2 * e - 4]) + (e < 2 ? b0[2 * e] : b1[2 * e - 4]);
                            const float a1 = (e < 2 ? v0[2 * e + 1] : v1[2 * e - 3]) + (e < 2 ? b0[2 * e + 1] : b1[2 * e - 3]);
                            r[2 * e] = y0 * sigmoid_f(a0) * z0 * sigmoid_f(z0); r[2 * e + 1] = y1 * sigmoid_f(a1) * z1 * sigmoid_f(z1); }
                        u32x4 w; w.x = cvt_pk_bf16(r[0], r[1]); w.y = cvt_pk_bf16(r[2], r[3]); w.z = cvt_pk_bf16(r[4], r[5]); w.w = cvt_pk_bf16(r[6], r[7]);
                        *(u32x4*)(O + (size_t)row * ldc + col) = w;
                    } } }
    }
};
template <class Epi, class Sched, bool ALIGN_EPI = false, bool SP2 = false>
__device__ __forceinline__ void gemm_phase(PG8_LAS unsigned char* lds, const Gemm g, const Sched& S, const Epi& E) {
    const int tid = opaque_tid(), wid = __builtin_amdgcn_readfirstlane(tid >> 6), lane = tid & 63, wr = wid >> 2, wc = wid & 3, fr = lane & 15, fq = lane >> 4;
    const int K = g.K, nt = K / BK;
    unsigned voffA[2], voffB[2];
#pragma unroll
    for (int i = 0; i < 2; ++i) { int R, C; stage_rc(tid * 16 + i * 8192, R, C); const int Rb = Epi::PERM ? ((R & ~31) + perm32(R & 31)) : R;
        voffA[i] = (unsigned)(R * g.lda + C) * 2u; voffB[i] = (unsigned)(Rb * g.ldb + C) * 2u; }
    const size_t kstep = (size_t)(BK * 2);
    const size_t hstepA = (size_t)HALF * g.lda * 2, hstepB = (size_t)HALF * g.ldb * 2;
    const size_t tstepA = 2 * hstepA, tstepB = g.ksplit ? (size_t)K * 2 : 2 * hstepB, kslA = g.ksplit ? (size_t)K * 2 : 0;
    const unsigned ldsw = (unsigned)wid * 1024u;
    const int aoff = lds_byte(wr * 64 + fr, fq * 8), boff = lds_byte(wc * 32 + fr, fq * 8);
#define PG8_SA(b, h) (((b) * 2 + (h)) * HTB)
#define PG8_SB(b, h) ((4 + (b) * 2 + (h)) * HTB)
#define PG8_STAGE(bufoff, gbase, voff) do { _Pragma("unroll") for (int _i = 0; _i < 2; ++_i) \
        __builtin_amdgcn_global_load_lds((const unsigned*)((const char*)(gbase) + (voff)[_i]), (PG8_LAS unsigned*)(lds + (bufoff) + ldsw + _i * 8192), 16, 0, 0); } while (0)
#define PG8_LDA(dst, b, h) do { _Pragma("unroll") for (int m = 0; m < 4; ++m) _Pragma("unroll") for (int k = 0; k < 2; ++k) dst[m][k] = *(const PG8_LAS bf16x8*)(lds + PG8_SA(b, h) + aoff + m * 2048 + k * 1024); } while (0)
#define PG8_LDB(dst, b, h) do { _Pragma("unroll") for (int n = 0; n < 2; ++n) _Pragma("unroll") for (int k = 0; k < 2; ++k) dst[n][k] = *(const PG8_LAS bf16x8*)(lds + PG8_SB(b, h) + boff + n * 2048 + k * 1024); } while (0)
#define PG8_MMA(ai, bj, At, Bt) do { __builtin_amdgcn_s_setprio(1); _Pragma("unroll") for (int m = 0; m < 4; ++m) _Pragma("unroll") for (int n = 0; n < 2; ++n) _Pragma("unroll") for (int k = 0; k < 2; ++k) \
        acc[ai][bj][m][n] = __builtin_amdgcn_mfma_f32_16x16x32_bf16(Bt[n][k], At[m][k], acc[ai][bj][m][n], 0, 0, 0); __builtin_amdgcn_s_setprio(0); } while (0)
#define PG8_WAIT_V(n) asm volatile("s_waitcnt vmcnt(" #n ")" ::: "memory")
#define PG8_WAIT_L(n) asm volatile("s_waitcnt lgkmcnt(" #n ")" ::: "memory")
#define PG8_BAR __builtin_amdgcn_s_barrier()
#define PG8_SCHED __builtin_amdgcn_sched_barrier(0)
    Unit cur, nxt; int ui = 0;
    if (!S.next(0, cur)) return;
    f32x4 acc[2][2][4][2];
#pragma unroll
    for (int a = 0; a < 2; ++a)
#pragma unroll
        for (int b = 0; b < 2; ++b)
#pragma unroll
            for (int m = 0; m < 4; ++m)
#pragma unroll
                for (int n = 0; n < 2; ++n) acc[a][b][m][n] = (f32x4){0.f, 0.f, 0.f, 0.f};
    bf16x8 At[4][2], B0[2][2], B1[2][2];
    const char* cA = (const char*)g.A + (size_t)cur.pm * tstepA + (size_t)cur.pn * kslA; const char* cB = (const char*)g.Bt + (size_t)cur.pn * tstepB;
    S.a_ready(cur);
    if constexpr (SP2) {
        PG8_STAGE(PG8_SB(0, 0), cB, voffB); PG8_STAGE(PG8_SB(0, 1), cB + hstepB, voffB); PG8_STAGE(PG8_SA(0, 0), cA, voffA); PG8_STAGE(PG8_SA(0, 1), cA + hstepA, voffA);
        if (wr == 1) PG8_BAR;
        PG8_WAIT_V(2); PG8_BAR;
        PG8_STAGE(PG8_SB(1, 0), cB + kstep, voffB); PG8_STAGE(PG8_SA(1, 0), cA + kstep, voffA); PG8_STAGE(PG8_SB(1, 1), cB + hstepB + kstep, voffB);
        PG8_WAIT_V(6); PG8_BAR;
    } else {
        PG8_STAGE(PG8_SB(0, 0), cB, voffB); PG8_STAGE(PG8_SA(0, 0), cA, voffA); PG8_STAGE(PG8_SB(0, 1), cB + hstepB, voffB); PG8_STAGE(PG8_SA(0, 1), cA + hstepA, voffA);
        if (wr == 1) PG8_BAR;
        PG8_WAIT_V(4); PG8_BAR;
        PG8_STAGE(PG8_SB(1, 0), cB + kstep, voffB); PG8_STAGE(PG8_SA(1, 0), cA + kstep, voffA); PG8_STAGE(PG8_SB(1, 1), cB + hstepB + kstep, voffB);
        PG8_WAIT_V(6); PG8_BAR;
    }
    for (;;) {
        const bool has_next = S.next(ui + 1, nxt);
        const char* nA = has_next ? (const char*)g.A + (size_t)nxt.pm * tstepA + (size_t)nxt.pn * kslA : cA; const char* nB = has_next ? (const char*)g.Bt + (size_t)nxt.pn * tstepB : cB;
        for (int t = 0; t < nt; t += 2) {
            if constexpr (Epi::MIDT >= 0) { if (t == Epi::MIDT) E.mid(acc, wr, fr, lds); }
            const bool last = (t == nt - 2);
            const char* a1 = cA + (size_t)(t + 1) * kstep;
            const char* a2 = last ? nA : cA + (size_t)(t + 2) * kstep; const char* b2 = last ? nB : cB + (size_t)(t + 2) * kstep;
            const char* a3 = a2 + kstep; const char* b3 = b2 + kstep;
            if (last && has_next) S.a_ready(nxt);
            if constexpr (SP2) {
            PG8_LDB(B0, 0, 0); PG8_LDB(B1, 0, 1); PG8_SCHED; PG8_LDA(At, 0, 0); PG8_STAGE(PG8_SA(1, 1), a1 + hstepA, voffA);
            PG8_WAIT_V(8); PG8_WAIT_L(0); PG8_BAR; PG8_MMA(0, 0, At, B0); PG8_MMA(0, 1, At, B1); PG8_BAR; PG8_SCHED;
            PG8_LDA(At, 0, 1); PG8_STAGE(PG8_SB(0, 0), b2, voffB); PG8_STAGE(PG8_SB(0, 1), b2 + hstepB, voffB); PG8_STAGE(PG8_SA(0, 0), a2, voffA);
            PG8_WAIT_V(8); PG8_WAIT_L(0); PG8_BAR; PG8_MMA(1, 0, At, B0); PG8_MMA(1, 1, At, B1); PG8_BAR; PG8_SCHED;
            PG8_LDB(B0, 1, 0); PG8_LDB(B1, 1, 1); PG8_SCHED; PG8_LDA(At, 1, 0); PG8_STAGE(PG8_SA(0, 1), a2 + hstepA, voffA);
            PG8_WAIT_V(8); PG8_WAIT_L(0); PG8_BAR; PG8_MMA(0, 0, At, B0); PG8_MMA(0, 1, At, B1); PG8_BAR; PG8_SCHED;
            PG8_LDA(At, 1, 1); PG8_STAGE(PG8_SB(1, 0), b3, voffB); PG8_STAGE(PG8_SB(1, 1), b3 + hstepB, voffB); PG8_STAGE(PG8_SA(1, 0), a3, voffA);
            PG8_WAIT_V(8); PG8_WAIT_L(0); PG8_BAR; PG8_MMA(1, 0, At, B0); PG8_MMA(1, 1, At, B1); PG8_BAR; PG8_SCHED;
            } else {
            PG8_LDB(B0, 0, 0); PG8_SCHED; PG8_LDA(At, 0, 0); PG8_STAGE(PG8_SA(1, 1), a1 + hstepA, voffA);
            PG8_WAIT_L(8); PG8_BAR; PG8_WAIT_L(0); PG8_MMA(0, 0, At, B0); PG8_BAR; PG8_SCHED;
            PG8_LDB(B1, 0, 1); PG8_STAGE(PG8_SB(0, 0), b2, voffB);
            PG8_BAR; PG8_WAIT_L(0); PG8_MMA(0, 1, At, B1); PG8_BAR;
            PG8_LDA(At, 0, 1); PG8_STAGE(PG8_SA(0, 0), a2, voffA);
            PG8_BAR; PG8_WAIT_L(0); PG8_MMA(1, 0, At, B0); PG8_BAR; PG8_SCHED;
            PG8_STAGE(PG8_SB(0, 1), b2 + hstepB, voffB);
            PG8_WAIT_V(6); PG8_BAR; PG8_MMA(1, 1, At, B1); PG8_BAR;
            PG8_LDB(B0, 1, 0); PG8_SCHED; PG8_LDA(At, 1, 0); PG8_STAGE(PG8_SA(0, 1), a2 + hstepA, voffA);
            PG8_WAIT_L(8); PG8_BAR; PG8_WAIT_L(0); PG8_MMA(0, 0, At, B0); PG8_BAR; PG8_SCHED;
            PG8_LDB(B1, 1, 1); PG8_STAGE(PG8_SB(1, 0), b3, voffB);
            PG8_BAR; PG8_WAIT_L(0); PG8_MMA(0, 1, At, B1); PG8_BAR;
            PG8_LDA(At, 1, 1); PG8_STAGE(PG8_SA(1, 0), a3, voffA);
            PG8_BAR; PG8_WAIT_L(0); PG8_MMA(1, 0, At, B0); PG8_BAR; PG8_SCHED;
            PG8_STAGE(PG8_SB(1, 1), b3 + hstepB, voffB);
            PG8_WAIT_V(6); PG8_BAR; PG8_MMA(1, 1, At, B1); PG8_BAR;
            }
        }
        if constexpr (ALIGN_EPI) { if (wr == 0) PG8_BAR; }
        if constexpr (!Epi::AFTER_DRAIN) { E(acc, cur, wr, wc, fr, fq); S.done(cur); }
        if (!has_next) break;
#pragma unroll
        for (int a = 0; a < 2; ++a)
#pragma unroll
            for (int b = 0; b < 2; ++b)
#pragma unroll
                for (int m = 0; m < 4; ++m)
#pragma unroll
                    for (int n = 0; n < 2; ++n) acc[a][b][m][n] = (f32x4){0.f, 0.f, 0.f, 0.f};
        cur = nxt; cA = nA; cB = nB; ++ui;
        if constexpr (ALIGN_EPI) { if (wr == 1) PG8_BAR; }
    }
    PG8_WAIT_V(0);
    if constexpr (!ALIGN_EPI) { if (wr == 0) PG8_BAR; }
    PG8_BAR;
    if constexpr (Epi::AFTER_DRAIN) { E.fused(acc, cur, wr, wc, fr, fq, lds, wid, lane); S.done(cur); }
#undef PG8_SA
#undef PG8_SB
#undef PG8_STAGE
#undef PG8_LDA
#undef PG8_LDB
#undef PG8_MMA
#undef PG8_WAIT_V
#undef PG8_WAIT_L
#undef PG8_BAR
#undef PG8_SCHED
}
}

#include <hip/hip_bf16.h>
#include <cmath>
namespace attn_body {
using bf16=__hip_bfloat16;
using bf16x8=__attribute__((ext_vector_type(8)))short;
using s16x4=__attribute__((ext_vector_type(4)))short;
using f32x16=__attribute__((ext_vector_type(16)))float;
using u32x4=__attribute__((ext_vector_type(4)))unsigned;
constexpr int SEQ=2048,D=64;
constexpr int NW=8,QBLK=32,QB=QBLK*NW,KVBLK=64,NQB=SEQ/QB;
constexpr int ATTN_UNIT_ROWS=QB;
__device__ __forceinline__ int crow(int r,int hi){return (r&3)+8*(r>>2)+4*hi;}
#define SBAR() __builtin_amdgcn_sched_barrier(0)
__device__ __forceinline__ void cmask(f32x16&p0,f32x16&p1,int jb,int qrel,int hi){
  const float NEG=-INFINITY; int kb=64*jb+4*hi;
  #pragma unroll
  for(int r=0;r<16;++r){int kv=kb+(r&3)+8*(r>>2); if(kv>qrel)p0[r]=NEG; if(kv+32>qrel)p1[r]=NEG;}
}

constexpr int NSLOT=3, SLOTB=8192;
constexpr int LDS_K=0, LDS_V=NSLOT*SLOTB, LDS_WS=2*NSLOT*SLOTB, LDS_OST=LDS_WS+NW*64*4, LDS_BYTES=LDS_OST+NW*4096;
constexpr int XOFF=86016; constexpr float SENT=-30000.f; using f32x4=__attribute__((ext_vector_type(4)))float;
constexpr float C2=0.125f*1.4426950408889634f;
__device__ __forceinline__ void glds16(const void*gsrc,unsigned lds_dst){unsigned keep;
  asm volatile("s_mov_b32 %0, m0\n\ts_mov_b32 m0, %2\n\ts_nop 0\n\tglobal_load_lds_dwordx4 %1, off\n\ts_mov_b32 m0, %0":"=&s"(keep):"v"(gsrc),"s"(lds_dst):"memory");}
__device__ __forceinline__ float max3f(float a,float b,float c){float r;asm("v_max3_f32 %0, %1, %2, %3":"=v"(r):"v"(a),"v"(b),"v"(c));return r;}
__device__ __forceinline__ float max2f(float a,float b){float r;asm("v_max_f32_e32 %0, %1, %2":"=v"(r):"v"(a),"v"(b));return r;}
__device__ __forceinline__ float fadd_s(float a,float b){float r;asm("v_add_f32_e32 %0, %1, %2":"=v"(r):"v"(a),"v"(b));return r;}
__device__ __forceinline__ float fsub_s(float a,float b){float r;asm("v_sub_f32_e32 %0, %1, %2":"=v"(r):"v"(a),"v"(b));return r;}
typedef float f32x2_t __attribute__((ext_vector_type(2))); typedef __bf16 bf16x2_t __attribute__((ext_vector_type(2)));
__device__ __forceinline__ unsigned cvtpk_s(float lo,float hi){f32x2_t v={lo,hi};bf16x2_t b=__builtin_convertvector(v,bf16x2_t);return __builtin_bit_cast(unsigned,b);}
#define WAIT_BAR(N) asm volatile("s_waitcnt vmcnt(" #N ") lgkmcnt(0)\n\ts_barrier":::"memory")

__device__ __forceinline__ void qkt(f32x16&p0,f32x16&p1,const char*Kslot,const bf16x8*qr,const f32x16&negm,int r32,int hi){
  const char*kb=Kslot+hi*1024+r32*16;
  #pragma unroll
  for(int d0=0;d0<4;++d0){
    const bf16x8 b0=*reinterpret_cast<const bf16x8*>(kb+d0*2048);
    const bf16x8 b1=*reinterpret_cast<const bf16x8*>(kb+d0*2048+512);
    if(d0==0){p0=__builtin_amdgcn_mfma_f32_32x32x16_bf16(b0,qr[0],negm,0,0,0);p1=__builtin_amdgcn_mfma_f32_32x32x16_bf16(b1,qr[0],negm,0,0,0);}
    else{p0=__builtin_amdgcn_mfma_f32_32x32x16_bf16(b0,qr[d0],p0,0,0,0);p1=__builtin_amdgcn_mfma_f32_32x32x16_bf16(b1,qr[d0],p1,0,0,0);}}
}
typedef __attribute__((address_space(3))) const char* lds_cptr;
typedef short v4i16_t __attribute__((ext_vector_type(4)));
__device__ __forceinline__ void kload8(bf16x8*kf,lds_cptr kp){
  kf[0]=*(const __attribute__((address_space(3))) bf16x8*)(kp);      kf[1]=*(const __attribute__((address_space(3))) bf16x8*)(kp+512);
  kf[2]=*(const __attribute__((address_space(3))) bf16x8*)(kp+2048); kf[3]=*(const __attribute__((address_space(3))) bf16x8*)(kp+2560);
  kf[4]=*(const __attribute__((address_space(3))) bf16x8*)(kp+4096); kf[5]=*(const __attribute__((address_space(3))) bf16x8*)(kp+4608);
  kf[6]=*(const __attribute__((address_space(3))) bf16x8*)(kp+6144); kf[7]=*(const __attribute__((address_space(3))) bf16x8*)(kp+6656);
}
__device__ __forceinline__ void kload2(bf16x8*kf,lds_cptr kp,int j){ kf[2*j]=*(const __attribute__((address_space(3))) bf16x8*)(kp+j*2048); kf[2*j+1]=*(const __attribute__((address_space(3))) bf16x8*)(kp+j*2048+512); }
__device__ __forceinline__ s16x4 vtr(lds_cptr p){ return __builtin_bit_cast(s16x4,__builtin_amdgcn_ds_read_tr16_b64_v4i16((__attribute__((address_space(3))) v4i16_t*)p)); }
__device__ __forceinline__ float rowmax(const f32x16&p0,const f32x16&p1){
  float a=max3f(p0[0],p0[1],p1[0]),b=max3f(p0[2],p0[3],p1[1]);a=max3f(a,p1[2],p1[3]);
  #pragma unroll
  for(int r=4;r<16;r+=4){a=max3f(a,p0[r],p0[r+1]);b=max3f(b,p0[r+2],p0[r+3]);a=max3f(a,p1[r],p1[r+1]);b=max3f(b,p1[r+2],p1[r+3]);}
  const float m=max2f(a,b);
  auto rr=__builtin_amdgcn_permlane32_swap(__float_as_uint(m),__float_as_uint(m),false,false);
  return max2f(__uint_as_float(rr[0]),__uint_as_float(rr[1]));
}
__device__ __forceinline__ void pv(f32x16*o,int vb,bf16x8 pa0,bf16x8 pa1,bf16x8 pa2,bf16x8 pa3){
  #pragma unroll
  for(int d0=0;d0<2;++d0){s16x4 lo[4],hi[4];
    #pragma unroll
    for(int ks=0;ks<4;++ks){
      asm volatile("ds_read_b64_tr_b16 %0,%1 offset:%c2":"=&v"(lo[ks]):"v"(vb),"i"(d0*4096+ks*1024):"memory");
      asm volatile("ds_read_b64_tr_b16 %0,%1 offset:%c2":"=&v"(hi[ks]):"v"(vb),"i"(d0*4096+ks*1024+512):"memory");}
    asm volatile("s_waitcnt lgkmcnt(0)":::"memory");SBAR();
    #define PK(k) (bf16x8){lo[k][0],lo[k][1],lo[k][2],lo[k][3],hi[k][0],hi[k][1],hi[k][2],hi[k][3]}
    o[d0]=__builtin_amdgcn_mfma_f32_32x32x16_bf16(pa0,PK(0),o[d0],0,0,0);
    o[d0]=__builtin_amdgcn_mfma_f32_32x32x16_bf16(pa1,PK(1),o[d0],0,0,0);
    o[d0]=__builtin_amdgcn_mfma_f32_32x32x16_bf16(pa2,PK(2),o[d0],0,0,0);
    o[d0]=__builtin_amdgcn_mfma_f32_32x32x16_bf16(pa3,PK(3),o[d0],0,0,0);
    #undef PK
  }
}

#ifndef ATTN_STORE16
#define ATTN_STORE16(p,v) (*(u32x4*)(p)=(v))
#endif
template<int THRL,int MODE,int DM,bool DRY=false> __device__ __forceinline__ void attn_unit(int b,int h,int qb,const bf16*Q,const bf16*__restrict__ K,const bf16*__restrict__ V,bf16*O,const bf16*__restrict__ Z,const float*__restrict__ XP,const int*__restrict__ TS,volatile unsigned*lw,unsigned nxt,char*shm){
  const int tid=opaque_tid(),lane=tid&63,r32=lane&31,hi=lane>>5; const int wid=__builtin_amdgcn_readfirstlane(tid>>6);
  const long rowbase=(long)b*SEQ; const int q0=qb*QB;
  const bf16*Qw=Q+(rowbase+q0+wid*QBLK)*DM+h*D;
  bf16x8 qr[4];
  #pragma unroll
  for(int d0=0;d0<4;++d0)qr[d0]=*reinterpret_cast<const bf16x8*>(&Qw[(long)r32*DM+d0*16+hi*8]);
  const bf16*Kh=K+rowbase*DM+h*D,*Vh=V+rowbase*DM+h*D;
  const unsigned lds0=(unsigned)(uintptr_t)shm;
  float*wsf=(float*)(shm+LDS_WS)+wid*64;
  const bf16*ksrc_=Kh+(long)lane*DM+wid*8; int tskip=0; const bf16*ksrc=ksrc_;
  const bf16*vsrc_=Vh+(long)(16*(wid&3)+(lane>>2))*DM+(wid>>2)*32+(lane&3)*8; const bf16*vsrc=vsrc_;
  const unsigned kdst=lds0+LDS_K+wid*1024, vdst=lds0+LDS_V+wid*1024;
  #define DMA_K(t,slot) glds16(ksrc+(long)(t)*KVBLK*DM,(unsigned)__builtin_amdgcn_readfirstlane(kdst+(slot)))
  #define DMA_V(t,slot) glds16(vsrc+(long)(t)*KVBLK*DM,(unsigned)__builtin_amdgcn_readfirstlane(vdst+(slot)))
  const int vb0=(int)(lds0+LDS_V)+((lane>>4)&1)*32+(lane&3)*8+(4*hi+((lane&15)>>2))*64;
  const char*Kbase=shm+LDS_K; bf16x8 kf[8];
  const lds_cptr shm3=(lds_cptr)shm; const lds_cptr kp0=shm3+LDS_K+hi*1024+r32*16; const lds_cptr vp0=shm3+LDS_V+((lane>>4)&1)*32+(lane&3)*8+(4*hi+((lane&15)>>2))*64;
  int NT=(q0+QB)/KVBLK;
  const int qrel=wid*QBLK+r32;
  unsigned sel=0u;
  if constexpr(MODE==1){
    tskip=__builtin_amdgcn_readfirstlane(TS[qb]);
    ksrc=ksrc_+(long)tskip*KVBLK*DM; vsrc=vsrc_+(long)tskip*KVBLK*DM; NT-=tskip;
  }
  const lds_cptr fsl=(lds_cptr)shm+XOFF+16*hi+tskip*256;
  #define XMASK(P0,P1,t) do{ if constexpr(MODE==0){ if((t)<NT-4){ const bool keep_=(sel>>((t)>>2))&1u; \
        _Pragma("unroll") for(int r=0;r<16;++r){P0[r]=keep_?P0[r]:SENT;P1[r]=keep_?P1[r]:SENT;} } } \
      else { const lds_cptr fp_=fsl+(t)*256; const float mh_=mhat; \
        _Pragma("unroll") for(int g_=0;g_<4;++g_){ const f32x4 fa_=*(const __attribute__((address_space(3))) f32x4*)(fp_+g_*32)+mh_; const f32x4 fb_=*(const __attribute__((address_space(3))) f32x4*)(fp_+128+g_*32)+mh_; \
          _Pragma("unroll") for(int i_=0;i_<4;++i_){P0[4*g_+i_]-=fa_[i_];P1[4*g_+i_]-=fb_[i_];} } } }while(0)
  DMA_K(0,0);DMA_V(0,0);DMA_K(1,SLOTB);
  float mhat=0.f,l_reg=0.f;f32x16 o[2];o[0]=f32x16{};o[1]=f32x16{};f32x16 negm=f32x16{}; if constexpr(MODE==0){asm volatile("":"+v"(negm));}
  #define CMASK(P0,P1,t) do{int jb_=(t)-(NT-4); if(jb_>=0)cmask(P0,P1,jb_,qrel,hi);}while(0)
  const f32x16 czero_=f32x16{};
  #define NEGM (MODE==1?czero_:negm)
  bool resc=false;
  #define START(P0,P1) do{ const float rm=rowmax(P0,P1); resc=false; \
    { const float dl=rm; mhat=fadd_s(mhat,dl); \
      _Pragma("unroll") for(int r=0;r<16;++r){P0[r]=fsub_s(P0[r],dl);P1[r]=fsub_s(P1[r],dl);} \
      if constexpr(MODE==0){ _Pragma("unroll") for(int r=0;r<16;++r)negm[r]=-mhat; asm volatile("":"+v"(negm)); } } \
    _Pragma("unroll") for(int r=0;r<16;++r)P0[r]=__builtin_amdgcn_exp2f(P0[r]); }while(0)
  #define RESC() do{ if(resc){ asm volatile("s_waitcnt lgkmcnt(0)":::"memory"); \
      _Pragma("unroll") for(int d_=0;d_<2;++d_) _Pragma("unroll") for(int r=0;r<16;++r)o[d_][r]*=wsf[crow(r,hi)]; } }while(0)
  f32x16 pA0,pA1,pB0,pB1;
  int sl_prev=0,sl_cur=0,sl_next=SLOTB;
  #define ROT() do{sl_prev=sl_cur;sl_cur=sl_next;sl_next=(sl_next==(NSLOT-1)*SLOTB)?0:sl_next+SLOTB;}while(0)
  DMA_K(2,2*SLOTB);
  if constexpr(MODE==1){ float*fs=(float*)(shm+XOFF); for(int i=tid+64*tskip;i<q0+QB;i+=NW*64)fs[i]=XP[i]; }
  if constexpr(MODE==0){
    float*kbs=(float*)(shm+XOFF); unsigned*sm=(unsigned*)(shm+XOFF+2048);
    kbs[tid]=XP[tid];
    asm volatile("s_waitcnt vmcnt(0) lgkmcnt(0)\n\ts_barrier":::"memory");
    if(tid<QB){ unsigned m=(1u<<qb)-1u;
      if(qb>3){ const bf16*qp=Q+(rowbase+q0+tid)*DM+h*D; float g[8];
        _Pragma("unroll") for(int n=0;n<8;++n)g[n]=0.f;
        _Pragma("unroll") for(int c=0;c<8;++c){ const bf16x8 qv=*reinterpret_cast<const bf16x8*>(qp+c*8);
          _Pragma("unroll") for(int j=0;j<8;++j){ const float qf=__uint_as_float(((unsigned)(unsigned short)qv[j])<<16);
            _Pragma("unroll") for(int n=0;n<8;++n)g[n]+=qf*kbs[n*64+c*8+j]; } }
        m=0u;
        _Pragma("unroll") for(int it=0;it<3;++it){ float best=-INFINITY; int bi=0;
          _Pragma("unroll") for(int n=0;n<8;++n){ const bool ok=(n<qb)&&!((m>>n)&1u)&&(g[n]>best); best=ok?g[n]:best; bi=ok?n:bi; }
          m|=1u<<bi; } }
      sm[tid]=m; }
    asm volatile("s_waitcnt vmcnt(0) lgkmcnt(0)\n\ts_barrier":::"memory");
    sel=sm[qrel];
  }
  WAIT_BAR(3);
  qkt(pA0,pA1,Kbase,qr,NEGM,r32,hi);asm volatile("s_nop 15\n\ts_nop 7":"+v"(pA0),"+v"(pA1));XMASK(pA0,pA1,0);CMASK(pA0,pA1,0);
  START(pA0,pA1);
  _Pragma("unroll") for(int r=0;r<16;++r)pA1[r]=__builtin_amdgcn_exp2f(pA1[r]);
  WAIT_BAR(0);
  DMA_K(3,0);DMA_V(1,SLOTB);
  ROT();
  kload8(kf,kp0+sl_cur);
  WAIT_BAR(2);
  s16x4 vlo[8],vhi[8]; u32x4 pw0,pw1,pw2,pw3;
  #define PKW(P,B) cvtpk_s(P[B],P[B+1])
  #define PAF(k) __builtin_bit_cast(bf16x8,pw##k)
  #define VFR(i) (bf16x8){vlo[i][0],vlo[i][1],vlo[i][2],vlo[i][3],vhi[i][0],vhi[i][1],vhi[i][2],vhi[i][3]}
  #define PIN(x) asm volatile("":"+v"(x))
  #define MX3(a,b,c) __builtin_fmaxf(__builtin_fmaxf((a),(b)),(c))
  #define GAPA(MF,A0,A1,A2,A3,W0,W1,PW) do{ MF; sacc+=A0; sacc+=A1; sacc+=A2; sacc+=A3; PIN(sacc); W0; W1; PIN(PW); SBAR(); }while(0)
  #define EX(v) __builtin_amdgcn_exp2f(v)
  #define GAPB(MF,X,B) do{ MF; X[B]=EX(X[B]); X[B+1]=EX(X[B+1]); X[B+2]=EX(X[B+2]); X[B+3]=EX(X[B+3]); PIN(X); SBAR(); }while(0)
  #define VRD(i) do{ vlo[i]=vtr(vp_+(((i)>>2)*4096+((i)&3)*1024)); vhi[i]=vtr(vp_+(((i)>>2)*4096+((i)&3)*1024+512)); }while(0)
  #define KRD(G,j) do{ if(G){ kload2(kf,kp0+sl_next,j); SBAR(); } }while(0)
  #define STEP(C0,C1,P0,P1,t,GK,GV,GL) do{ SBAR(); \
    const lds_cptr vp_=vp0+sl_prev; \
    VRD(0); SBAR(); float sacc=(P0[0]+P0[1]); \
    GAPA(C0=__builtin_amdgcn_mfma_f32_32x32x16_bf16(kf[0],qr[0],NEGM,0,0,0), P0[2],P0[3],P0[4],P0[5],     pw0[0]=PKW(P0,0), pw0[1]=PKW(P0,2), pw0); \
    VRD(4); SBAR(); GAPA(C1=__builtin_amdgcn_mfma_f32_32x32x16_bf16(kf[1],qr[0],NEGM,0,0,0), P0[6],P0[7],P0[8],P0[9],     pw0[2]=PKW(P0,4), pw0[3]=PKW(P0,6), pw0); \
    VRD(1); SBAR(); GAPA(C0=__builtin_amdgcn_mfma_f32_32x32x16_bf16(kf[2],qr[1],C0,0,0,0),   P0[10],P0[11],P0[12],P0[13], pw1[0]=PKW(P0,8), pw1[1]=PKW(P0,10), pw1); \
    VRD(5); SBAR(); GAPA(C1=__builtin_amdgcn_mfma_f32_32x32x16_bf16(kf[3],qr[1],C1,0,0,0),   P0[14],P0[15],P1[0],P1[1],   pw1[2]=PKW(P0,12),pw1[3]=PKW(P0,14), pw1); \
    VRD(2); SBAR(); GAPA(C0=__builtin_amdgcn_mfma_f32_32x32x16_bf16(kf[4],qr[2],C0,0,0,0),   P1[2],P1[3],P1[4],P1[5],     pw2[0]=PKW(P1,0), pw2[1]=PKW(P1,2), pw2); \
    VRD(6); SBAR(); GAPA(C1=__builtin_amdgcn_mfma_f32_32x32x16_bf16(kf[5],qr[2],C1,0,0,0),   P1[6],P1[7],P1[8],P1[9],     pw2[2]=PKW(P1,4), pw2[3]=PKW(P1,6), pw2); \
    VRD(3); SBAR(); GAPA(C0=__builtin_amdgcn_mfma_f32_32x32x16_bf16(kf[6],qr[3],C0,0,0,0),   P1[10],P1[11],P1[12],P1[13], pw3[0]=PKW(P1,8), pw3[1]=PKW(P1,10), pw3); \
    VRD(7); SBAR(); GAPA(C1=__builtin_amdgcn_mfma_f32_32x32x16_bf16(kf[7],qr[3],C1,0,0,0),   P1[14],P1[15],0.f,0.f,       pw3[2]=PKW(P1,12),pw3[3]=PKW(P1,14), pw3); \
    l_reg+=sacc; \
    if(GK){DMA_K((t)+3,sl_cur);} if(GV){DMA_V((t)+1,sl_next);} \
    XMASK(C0,C1,t); CMASK(C0,C1,t); \
    { float a=MX3(C0[0],C0[1],C1[0]),b=MX3(C0[2],C0[3],C1[1]); a=MX3(a,C1[2],C1[3]); \
      _Pragma("unroll") for(int r=4;r<16;r+=4){a=MX3(a,C0[r],C0[r+1]);b=MX3(b,C0[r+2],C0[r+3]);a=MX3(a,C1[r],C1[r+1]);b=MX3(b,C1[r+2],C1[r+3]);} \
      float rm=__builtin_fmaxf(a,b); { auto rr=__builtin_amdgcn_permlane32_swap(__float_as_uint(rm),__float_as_uint(rm),false,false); rm=__builtin_fmaxf(__uint_as_float(rr[0]),__uint_as_float(rr[1])); } \
      resc=false; \
      if(__builtin_expect(__any(rm>(float)THRL),0)){ const float dl=__builtin_fmaxf(rm,0.f); mhat+=dl; \
        _Pragma("unroll") for(int r=0;r<16;++r){C0[r]-=dl;C1[r]-=dl;} \
        if constexpr(MODE==0){ _Pragma("unroll") for(int r=0;r<16;++r)negm[r]=-mhat; asm volatile("":"+v"(negm)); } \
        const float f=__builtin_amdgcn_exp2f(-dl); l_reg*=f; if(hi==0)wsf[r32]=f; resc=true; } } \
    SBAR(); \
    GAPB(o[0]=__builtin_amdgcn_mfma_f32_32x32x16_bf16(PAF(0),VFR(0),o[0],0,0,0), C0,0); \
    GAPB(o[1]=__builtin_amdgcn_mfma_f32_32x32x16_bf16(PAF(0),VFR(4),o[1],0,0,0), C0,4); \
    KRD(GL,0); GAPB(o[0]=__builtin_amdgcn_mfma_f32_32x32x16_bf16(PAF(1),VFR(1),o[0],0,0,0), C0,8); \
    KRD(GL,1); GAPB(o[1]=__builtin_amdgcn_mfma_f32_32x32x16_bf16(PAF(1),VFR(5),o[1],0,0,0), C0,12); \
    KRD(GL,2); GAPB(o[0]=__builtin_amdgcn_mfma_f32_32x32x16_bf16(PAF(2),VFR(2),o[0],0,0,0), C1,0); \
    KRD(GL,3); GAPB(o[1]=__builtin_amdgcn_mfma_f32_32x32x16_bf16(PAF(2),VFR(6),o[1],0,0,0), C1,4); \
    GAPB(o[0]=__builtin_amdgcn_mfma_f32_32x32x16_bf16(PAF(3),VFR(3),o[0],0,0,0), C1,8); \
    GAPB(o[1]=__builtin_amdgcn_mfma_f32_32x32x16_bf16(PAF(3),VFR(7),o[1],0,0,0), C1,12); \
    }while(0)
  int t=1;
  #undef CMASK
  #define CMASK(P0,P1,t) do{}while(0)
  for(;t+5<NT;t+=2){
    STEP(pB0,pB1,pA0,pA1,t,true,true,true);     WAIT_BAR(2); RESC(); ROT();
    STEP(pA0,pA1,pB0,pB1,t+1,true,true,true);   WAIT_BAR(2); RESC(); ROT();
  }
  #undef CMASK
  #define CMASK(P0,P1,t) do{int jb_=(t)-(NT-4); if(jb_>=0)cmask(P0,P1,jb_,qrel,hi);}while(0)
  #define ENDW(tt) do{ if((tt)+3<NT){WAIT_BAR(2);} else if((tt)+2<NT){WAIT_BAR(1);} else {WAIT_BAR(0);} }while(0)
  for(;t+1<NT;t+=2){
    STEP(pB0,pB1,pA0,pA1,t,(t+3<NT),(t+1<NT),(t+1<NT));       ENDW(t);   RESC(); ROT();
    STEP(pA0,pA1,pB0,pB1,t+1,(t+4<NT),(t+2<NT),(t+2<NT));     ENDW(t+1); RESC(); ROT();
  }
  STEP(pB0,pB1,pA0,pA1,NT-1,false,false,false); RESC();
  const bf16*Zw=Z+(rowbase+q0+wid*QBLK)*DM+h*D; u32x4 zpre[4];
  #pragma unroll
  for(int i=0;i<4;++i)zpre[i]=*(const u32x4*)(Zw+(long)(i*8+(lane>>3))*DM+(lane&7)*8);
  { float sacc=pB0[0]+pB0[1]; _Pragma("unroll") for(int r=2;r<16;++r)sacc+=pB0[r]; _Pragma("unroll") for(int r=0;r<16;++r)sacc+=pB1[r]; l_reg+=sacc;
    pw0=(u32x4){PKW(pB0,0),PKW(pB0,2),PKW(pB0,4),PKW(pB0,6)};pw1=(u32x4){PKW(pB0,8),PKW(pB0,10),PKW(pB0,12),PKW(pB0,14)};pw2=(u32x4){PKW(pB1,0),PKW(pB1,2),PKW(pB1,4),PKW(pB1,6)};pw3=(u32x4){PKW(pB1,8),PKW(pB1,10),PKW(pB1,12),PKW(pB1,14)};
    SBAR(); pv(o,vb0+sl_cur,PAF(0),PAF(1),PAF(2),PAF(3)); }
  #undef PKW
  #undef PAF
  #undef VFR
  #undef PIN
  #undef MX3
  #undef GAPA
  #undef GAPB
  #undef EX
  #undef VRD
  #undef KRD
  #undef STEP
  #undef ENDW
  if(lw!=nullptr&&tid==0)lw[0]=nxt;
  {auto rr=__builtin_amdgcn_permlane32_swap(__float_as_uint(l_reg),__float_as_uint(l_reg),false,false);l_reg=__uint_as_float(rr[0])+__uint_as_float(rr[1]);}
  if(hi==0)wsf[32+r32]=l_reg;asm volatile("s_waitcnt lgkmcnt(0)":::"memory");
  float rli[16];
  #pragma unroll
  for(int r=0;r<16;++r)rli[r]=__builtin_amdgcn_rcpf(wsf[32+crow(r,hi)]);
  bf16*Ow=O+(rowbase+q0+wid*QBLK)*DM+h*D;
  { bf16*stg=(bf16*)(shm+LDS_OST)+wid*2048;
    #pragma unroll
    for(int r=0;r<16;++r){const int orow=crow(r,hi);
      #pragma unroll
      for(int d0=0;d0<2;++d0)stg[orow*64+d0*32+r32]=__float2bfloat16(o[d0][r]*rli[r]);}
    asm volatile("s_waitcnt lgkmcnt(0)":::"memory");
    #pragma unroll
    for(int i=0;i<4;++i){const int row=i*8+(lane>>3),ch=lane&7; const u32x4 v=*(const u32x4*)(stg+row*64+ch*8); const u32x4 zv=zpre[i]; u32x4 ov;
      #pragma unroll
      for(int e=0;e<4;++e){ const float o0=__uint_as_float(v[e]<<16),o1=__uint_as_float(v[e]&0xffff0000u),z0=__uint_as_float(zv[e]<<16),z1=__uint_as_float(zv[e]&0xffff0000u);
        ov[e]=cvtpk_s(o0*z0/(1.f+__expf(-z0)),o1*z1/(1.f+__expf(-z1))); }
      if(!DRY||ov[0]==0x7fc12345u)ATTN_STORE16(Ow+(long)row*DM+ch*8,ov);} }
  asm volatile("s_waitcnt lgkmcnt(0)\n\ts_barrier":::"memory");
  #undef DMA_K
  #undef DMA_V
  #undef CMASK
  #undef XMASK
  #undef NEGM
  #undef START
  #undef RESC
  #undef ROT
}
constexpr int ATTN_LDS_BYTES=LDS_BYTES;
#undef SBAR
#undef WAIT_BAR
}
constexpr int NWAVES = 8, NTHR = 512;
constexpr int NB = 8, SEQL = 2048, DMOD = 1024, MROWS = NB * SEQL;
constexpr int LD0 = 6656, NP0 = 6912, LD1 = 7168, NP1 = 7424;
constexpr int C0_ZA = 0, C0_Q = 1024, C0_ZB = 2048, C0_XBC = 3072, C0_K = 4608, C0_V = 5632;
constexpr int C1_Q = 0, C1_U = 1536, C1_K = 2048, C1_V = 3584, C1_ZC = 5120, C1_ZD = 6656;
constexpr float RMS_EPS = 1e-6f, LOG2E = 1.4426950408889634f;
constexpr size_t MiB = 1u << 20;
constexpr int KS = 8;
constexpr size_t WS_MODP = 0;
constexpr size_t WS_SSQ = 2 * MiB;
constexpr size_t WS_KBAR = 2 * MiB + 65536;
constexpr size_t WS_DT = 3 * MiB;
constexpr size_t WS_LF = 4 * MiB;
constexpr size_t WS_F2 = 6 * MiB;
constexpr size_t WS_S5P = 7 * MiB + 512 * 1024;
constexpr int S5P_STRIDE = 8704;
constexpr size_t WS_WT1 = 8 * MiB;
constexpr size_t WS_WO1 = WS_WT1 + (size_t)NP1 * 1024 * 2;
constexpr size_t WS_WG = WS_WO1 + 4 * MiB;
constexpr size_t WS_BIG = 27 * MiB;
constexpr size_t WS_WT0 = WS_BIG + (size_t)MROWS * LD0 * 2;
constexpr size_t WS_WO0 = WS_WT0 + (size_t)NP0 * 1024 * 2;
constexpr size_t WS_LFP = 251 * MiB;
constexpr size_t WS_END = WS_WO0 + 4 * MiB;
static_assert(WS_WG + 512 * 1024 <= WS_BIG && WS_END <= 256 * MiB && WS_BIG + (size_t)MROWS * LD1 * 2 <= 256 * MiB, "ws map");
constexpr int LDS_BYTES = 147456;
constexpr size_t WS_CNT = 1835008 + 3584 * 4, WS_UB = 1835008 + 32768, WS_TS = 1835008 + 32768 + 1024;
constexpr size_t WS_BAR = 1835008;
constexpr int BARST_OFF = 132608;

typedef unsigned short bf16;
typedef unsigned v4u __attribute__((ext_vector_type(4)));
typedef unsigned v2u __attribute__((ext_vector_type(2)));
typedef float f32x4 __attribute__((ext_vector_type(4)));
typedef short bf16x8 __attribute__((ext_vector_type(8)));
typedef float f32x16 __attribute__((ext_vector_type(16)));
typedef float f32x2_c __attribute__((ext_vector_type(2))); typedef __bf16 bf16x2_c __attribute__((ext_vector_type(2)));
__device__ __forceinline__ unsigned pk2(float lo, float hi) { f32x2_c v = {lo, hi}; return __builtin_bit_cast(unsigned, __builtin_convertvector(v, bf16x2_c)); }
__device__ __forceinline__ unsigned f2bf(float f) { return pk2(f, f) & 0xffffu; }
__device__ __forceinline__ float bf2f(unsigned short h) { return __uint_as_float(((unsigned)h) << 16); }
template <int CTRL> __device__ __forceinline__ float dppf(float old, float src) { return __builtin_bit_cast(float, __builtin_amdgcn_update_dpp(__builtin_bit_cast(int, old), __builtin_bit_cast(int, src), CTRL, 0xF, 0xF, false)); }
__device__ __forceinline__ float row_sum16(float v) { v += dppf<0xB1>(v, v); v += dppf<0x4E>(v, v); v += dppf<0x141>(v, v); v += dppf<0x140>(v, v); return v; }
__device__ __forceinline__ float rdlane(float v, int l) { return __builtin_bit_cast(float, __builtin_amdgcn_readlane(__builtin_bit_cast(int, v), l)); }
__device__ __forceinline__ float wave_sum(float v) { v = row_sum16(v); return (rdlane(v, 0) + rdlane(v, 16)) + (rdlane(v, 32) + rdlane(v, 48)); }
__device__ __forceinline__ float wave_scan(float x, int lane) {
    x += dppf<0x111>(0.f, x); x += dppf<0x112>(0.f, x); x += dppf<0x114>(0.f, x); x += dppf<0x118>(0.f, x);
    const float t0 = rdlane(x, 15), t1 = rdlane(x, 31), t2 = rdlane(x, 47); const int rw = lane >> 4;
    return x + (rw == 0 ? 0.f : (rw == 1 ? t0 : (rw == 2 ? t0 + t1 : (t0 + t1) + t2)));
}
__device__ __forceinline__ float silu_f(float x) { return x / (1.f + __expf(-x)); }
__device__ __forceinline__ float softplus_g(float x) { return x > 20.f ? x : log1pf(__expf(x)); }

struct Args {
    const float* in[27]; float* out; unsigned char* ws;
};
enum { I_X = 0, I_C, I_ADAW, I_ADAB, I_PREG, I_POSTG, I_EINW, I_ECONVW, I_ECONVB, I_EDTB, I_EALOG, I_EDSKIP, I_ENORMG, I_EOUTW,
       I_OINW, I_OFGB, I_OLRE, I_OLIM, I_OLDT, I_OBRE, I_OBIM, I_OCRE, I_OCIM, I_ODSKIP, I_OGLUW, I_OGLUB, I_OOUTW };

__device__ __forceinline__ int src_col0(int n) {
    if (n < 1024) return n;
    if (n < 2048) return 3600 + (n - 1024);
    if (n < 3072) return 1024 + (n - 2048);
    if (n < 4608) return 2048 + (n - 3072);
    if (n < 5632) return 4624 + (n - 4608);
    if (n < 6656) return 5648 + (n - 5632);
    if (n < 6672) return 3584 + (n - 6656);
    return -1;
}
__device__ __forceinline__ int src_col1(int n) {
    if (n < 1536) return 2048 + n;
    if (n < 2048) return 6680 + (n - 1536);
    if (n < 3584) return 3584 + (n - 2048);
    if (n < 5120) return 5120 + (n - 3584);
    if (n < 6656) return n - 5120;
    if (n < 7168) return 1536 + (n - 6656);
    if (n < 7192) return 6656 + (n - 7168);
    return -1;
}
template <int MAP> __device__ __forceinline__ void transpose_item(const float* __restrict__ W, int K, int NSRC, int NDST, bf16* WT, float* scr, int item, int lane, const float* __restrict__ kscale = nullptr) {
    const int nblk = NDST / 32, kb = item / nblk, nb = item % nblk, k0 = 64 * kb, n0 = 32 * nb;
    const int nn = n0 + (lane & 31); const int sc = MAP == 0 ? src_col0(nn) : (MAP == 1 ? src_col1(nn) : nn);
    float tv[32];
#pragma unroll
    for (int i = 0; i < 32; ++i) { const int kk = 2 * i + (lane >> 5); tv[i] = sc >= 0 ? W[(size_t)(k0 + kk) * NSRC + sc] : 0.f; if (kscale && k0 + kk < 1024) tv[i] *= kscale[k0 + kk]; }
#pragma unroll
    for (int i = 0; i < 32; ++i) { const int kk = 2 * i + (lane >> 5); scr[kk * 33 + (lane & 31)] = tv[i]; }
    asm volatile("s_waitcnt lgkmcnt(0)" ::: "memory");
    const int c = lane & 7;
#pragma unroll
    for (int j = 0; j < 4; ++j) { const int n = (lane >> 3) + 8 * j; const float* s = scr + (8 * c) * 33 + n;
        v4u o; o.x = pk2(s[0 * 33], s[1 * 33]); o.y = pk2(s[2 * 33], s[3 * 33]); o.z = pk2(s[4 * 33], s[5 * 33]); o.w = pk2(s[6 * 33], s[7 * 33]);
        *(v4u*)(WT + (size_t)(n0 + n) * K + k0 + 8 * c) = o; }
    asm volatile("s_waitcnt lgkmcnt(0)" ::: "memory");
}

__device__ __forceinline__ float mod_val(const float* modp, const float* adab, int l, int b, int j) {
    float s = adab[l * 3072 + j];
#pragma unroll
    for (int kc = 0; kc < KS; ++kc) s += modp[((size_t)(kc * 2 + l) * 8 + b) * 3072 + j];
    return s;
}

__device__ __forceinline__ void p0_prologue(const Args& A, char* lds, int vcu, int G) {
    const int tid = opaque_tid(), lane = tid & 63, wave = tid >> 6;
    unsigned char* ws = A.ws;
    float* scr = (float*)(lds + wave * 16384);
    const int gw = vcu * NWAVES + wave, NGW = G * NWAVES;
    constexpr int I0 = 16 * (NP0 / 32), I1 = 16 * (NP1 / 32), IO = 32 * 32, IG = 8 * 16;
    constexpr int NITEMS = I0 + I1 + 2 * IO + IG;
    for (int it = gw; it < NITEMS; it += NGW) {
        int r = it;
        if (r < I0) { transpose_item<0>(A.in[I_EINW], 1024, 6672, NP0, (bf16*)(ws + WS_WT0), scr, r, lane); continue; } r -= I0;
        if (r < I1) { transpose_item<1>(A.in[I_OINW], 1024, 7192, NP1, (bf16*)(ws + WS_WT1), scr, r, lane); continue; } r -= I1;
        if (r < IO) { transpose_item<2>(A.in[I_EOUTW], 2048, 1024, 1024, (bf16*)(ws + WS_WO0), scr, r, lane, G == 256 ? A.in[I_ENORMG] : nullptr); continue; } r -= IO;
        if (r < IO) { transpose_item<2>(A.in[I_OOUTW], 2048, 1024, 1024, (bf16*)(ws + WS_WO1), scr, r, lane); continue; } r -= IO;
        transpose_item<2>(A.in[I_OGLUW], 512, 512, 512, (bf16*)(ws + WS_WG), scr, r, lane);
    }
    __syncthreads();
    float* sc = (float*)lds;
    float* modp = (float*)(ws + WS_MODP);
    for (int item = blockIdx.x; item < 2 * KS * 6; item += G) {
        const int l = item / (KS * 6), r = item % (KS * 6), kc = r / 6, cb = r % 6;
        __syncthreads();
        for (int i = tid; i < 1024; i += NTHR) { const int b = i >> 7, k = i & 127; const float cv = A.in[I_C][b * 1024 + kc * 128 + k]; sc[i] = silu_f(cv); }
        __syncthreads();
        const int col = cb * 512 + tid; float acc[8];
#pragma unroll
        for (int b = 0; b < 8; ++b) acc[b] = 0.f;
        const float* wp = A.in[I_ADAW] + ((size_t)l * 1024 + kc * 128) * 3072 + col;
#pragma unroll 16
        for (int k = 0; k < 128; ++k) { const float w = wp[(size_t)k * 3072];
#pragma unroll
            for (int b = 0; b < 8; ++b) acc[b] += sc[b * 128 + k] * w; }
#pragma unroll
        for (int b = 0; b < 8; ++b) modp[((size_t)(kc * 2 + l) * 8 + b) * 3072 + col] = acc[b];
    }
    const int gt = blockIdx.x * NTHR + tid;
    const int gs = (G >= 128 ? ((int)blockIdx.x - (G - 32)) * 64 + tid : gt);
    if (gs >= 0 && gs < 2048 && (G < 128 || tid < 64)) {
        const int g = gs >> 6, n = gs & 63;
        const float dt = __expf(A.in[I_OLDT][g]);
        const float lr = A.in[I_OLRE][g * 64 + n], li = A.in[I_OLIM][g * 64 + n];
        const float mag = expf(lr * dt); float sn, cs; sincosf(li * dt, &sn, &cs);
        const float ar = mag * cs, ai = mag * sn, den = lr * lr + li * li;
        const float qr = ((ar - 1.f) * lr + ai * li) / den, qi = (ai * lr - (ar - 1.f) * li) / den;
        unsigned char* pg = ws + WS_S5P + (size_t)g * S5P_STRIDE;
        bf16* BbT = (bf16*)pg; bf16* Cm = (bf16*)(pg + 4096); float* ari = (float*)(pg + 8192);
        ari[n] = ar; ari[64 + n] = ai;
        for (int c = 0; c < 16; ++c) { const float br = A.in[I_OBRE][(g * 64 + n) * 16 + c], bi = A.in[I_OBIM][(g * 64 + n) * 16 + c];
            BbT[(2 * n) * 16 + c] = (bf16)f2bf(qr * br - qi * bi); BbT[(2 * n + 1) * 16 + c] = (bf16)f2bf(qr * bi + qi * br);
            Cm[c * 128 + 2 * n] = (bf16)f2bf(A.in[I_OCRE][(g * 16 + c) * 64 + n]); Cm[c * 128 + 2 * n + 1] = (bf16)f2bf(-A.in[I_OCIM][(g * 16 + c) * 64 + n]); }
    }
    float* ssq = (float*)(ws + WS_SSQ);
    for (int i = gt; i < MROWS; i += G * NTHR) ssq[i] = 0.f;
}

__device__ __forceinline__ void p1a_rows(const Args& A, char* lds, int G) {
    const int tid = opaque_tid(), lane = tid & 63, wave = tid >> 6;
    const float* modp = (const float*)(A.ws + WS_MODP); float* mv = (float*)lds;
    for (int rb = blockIdx.x; rb < MROWS / 64; rb += G) {
        const int b = rb >> 5;
        __syncthreads();
#pragma unroll 1
        for (int col = tid; col < 1024; col += NTHR) { mv[col] = A.in[I_PREG][col] * (1.f + mod_val(modp, A.in[I_ADAB], 0, b, 1024 + col)); mv[1024 + col] = mod_val(modp, A.in[I_ADAB], 0, b, col); }
        __syncthreads();
        f32x4 mul[4], add[4];
#pragma unroll
        for (int j = 0; j < 4; ++j) { mul[j] = *(const f32x4*)(mv + 4 * lane + 256 * j); add[j] = *(const f32x4*)(mv + 1024 + 4 * lane + 256 * j); }
        f32x4 nx[4];
        { const f32x4* xr = (const f32x4*)(A.in[I_X] + (size_t)(rb * 64 + wave * 8) * DMOD) + lane;
#pragma unroll
          for (int j = 0; j < 4; ++j) nx[j] = xr[64 * j]; }
#pragma unroll 1
        for (int r = 0; r < 8; ++r) { const int m = rb * 64 + wave * 8 + r;
            f32x4 v[4]; float s = 0.f;
#pragma unroll
            for (int j = 0; j < 4; ++j) { v[j] = nx[j]; s += (v[j].x * v[j].x + v[j].y * v[j].y) + (v[j].z * v[j].z + v[j].w * v[j].w); }
            if (r < 7) { const f32x4* xr = (const f32x4*)(A.in[I_X] + (size_t)(m + 1) * DMOD) + lane;
#pragma unroll
                for (int j = 0; j < 4; ++j) nx[j] = xr[64 * j]; }
            const float rstd = rsqrtf(wave_sum(s) * (1.f / DMOD) + RMS_EPS);
            unsigned long long* o8 = (unsigned long long*)((unsigned char*)A.out + (size_t)m * 4096) + lane;
#pragma unroll
            for (int j = 0; j < 4; ++j) { const f32x4 h = v[j] * rstd * mul[j] + add[j]; o8[64 * j] = (unsigned long long)pk2(h.x, h.y) | ((unsigned long long)pk2(h.z, h.w) << 32); } }
    }
}
__device__ __forceinline__ void p3b_rows(const Args& A, char* lds, int G) {
    const int tid = opaque_tid(), lane = tid & 63, wave = tid >> 6;
    const float* modp = (const float*)(A.ws + WS_MODP); float* mv = (float*)lds;
    for (int rb = blockIdx.x; rb < MROWS / 64; rb += G) {
        const int b = rb >> 5;
        __syncthreads();
#pragma unroll 1
        for (int col = tid; col < 1024; col += NTHR) { mv[col] = A.in[I_POSTG][col] * mod_val(modp, A.in[I_ADAB], 0, b, 2048 + col);
            mv[1024 + col] = A.in[I_PREG][1024 + col] * (1.f + mod_val(modp, A.in[I_ADAB], 1, b, 1024 + col)); mv[2048 + col] = mod_val(modp, A.in[I_ADAB], 1, b, col); }
        __syncthreads();
        f32x4 g0[4], mul[4], add[4];
#pragma unroll
        for (int j = 0; j < 4; ++j) { g0[j] = *(const f32x4*)(mv + 4 * lane + 256 * j); mul[j] = *(const f32x4*)(mv + 1024 + 4 * lane + 256 * j); add[j] = *(const f32x4*)(mv + 2048 + 4 * lane + 256 * j); }
        f32x4 nx[4]; v2u ny[4];
        { const int m = rb * 64 + wave * 8; const f32x4* xr = (const f32x4*)(A.in[I_X] + (size_t)m * DMOD) + lane; const v2u* yr = (const v2u*)((unsigned char*)A.out + (size_t)m * 4096) + lane;
#pragma unroll
          for (int j = 0; j < 4; ++j) { nx[j] = xr[64 * j]; ny[j] = yr[64 * j]; } }
#pragma unroll 1
        for (int r = 0; r < 8; ++r) { const int m = rb * 64 + wave * 8 + r;
            unsigned char* slot = (unsigned char*)A.out + (size_t)m * 4096;
            f32x4 v[4], y[4]; float sy = 0.f; v2u wy[4];
#pragma unroll
            for (int j = 0; j < 4; ++j) { v[j] = nx[j]; wy[j] = ny[j]; }
            if (r < 7) { const f32x4* xr = (const f32x4*)(A.in[I_X] + (size_t)(m + 1) * DMOD) + lane; const v2u* yr = (const v2u*)(slot + 4096) + lane;
#pragma unroll
                for (int j = 0; j < 4; ++j) { nx[j] = xr[64 * j]; ny[j] = yr[64 * j]; } }
#pragma unroll
            for (int j = 0; j < 4; ++j) { const v2u w = wy[j]; y[j] = (f32x4){__uint_as_float(w.x << 16), __uint_as_float(w.x & 0xffff0000u), __uint_as_float(w.y << 16), __uint_as_float(w.y & 0xffff0000u)};
                sy += (y[j].x * y[j].x + y[j].y * y[j].y) + (y[j].z * y[j].z + y[j].w * y[j].w); }
            const float ry = rsqrtf(wave_sum(sy) * (1.f / DMOD) + RMS_EPS); float s = 0.f;
#pragma unroll
            for (int j = 0; j < 4; ++j) { v[j] = v[j] + g0[j] * (y[j] * ry); s += (v[j].x * v[j].x + v[j].y * v[j].y) + (v[j].z * v[j].z + v[j].w * v[j].w); }
            const float rstd = rsqrtf(wave_sum(s) * (1.f / DMOD) + RMS_EPS);
            unsigned long long* o8 = (unsigned long long*)(slot + 2048) + lane;
#pragma unroll
            for (int j = 0; j < 4; ++j) { const f32x4 h = v[j] * rstd * mul[j] + add[j]; o8[64 * j] = (unsigned long long)pk2(h.x, h.y) | ((unsigned long long)pk2(h.z, h.w) << 32); } }
    }
}
__device__ __forceinline__ void p6b_rows(const Args& A, char* lds, int G) {
    const int tid = opaque_tid(), lane = tid & 63, wave = tid >> 6;
    const float* modp = (const float*)(A.ws + WS_MODP); float* mv = (float*)lds;
    for (int rb = blockIdx.x; rb < MROWS / 64; rb += G) {
        const int b = rb >> 5;
        __syncthreads();
#pragma unroll 1
        for (int col = tid; col < 1024; col += NTHR) { mv[col] = A.in[I_POSTG][col] * mod_val(modp, A.in[I_ADAB], 0, b, 2048 + col); mv[1024 + col] = A.in[I_POSTG][1024 + col] * mod_val(modp, A.in[I_ADAB], 1, b, 2048 + col); }
        __syncthreads();
        f32x4 g0[4], g1[4];
#pragma unroll
        for (int j = 0; j < 4; ++j) { g0[j] = *(const f32x4*)(mv + 4 * lane + 256 * j); g1[j] = *(const f32x4*)(mv + 1024 + 4 * lane + 256 * j); }
        f32x4 nx[4]; v2u n0[4], n1[4];
        { const int m = rb * 64 + wave * 8; const f32x4* xr = (const f32x4*)(A.in[I_X] + (size_t)m * DMOD) + lane; const v2u* y1r = (const v2u*)((unsigned char*)A.out + (size_t)m * 4096) + lane;
#pragma unroll
          for (int j = 0; j < 4; ++j) { nx[j] = xr[64 * j]; n0[j] = y1r[64 * j]; n1[j] = y1r[256 + 64 * j]; } }
#pragma unroll 1
        for (int r = 0; r < 8; ++r) { const int m = rb * 64 + wave * 8 + r;
            unsigned char* slot = (unsigned char*)A.out + (size_t)m * 4096;
            f32x4 v[4], y0[4], y1[4]; float s0 = 0.f, s1 = 0.f; v2u w0[4], w1[4];
#pragma unroll
            for (int j = 0; j < 4; ++j) { v[j] = nx[j]; w0[j] = n0[j]; w1[j] = n1[j]; }
            if (r < 7) { const f32x4* xr = (const f32x4*)(A.in[I_X] + (size_t)(m + 1) * DMOD) + lane; const v2u* y1r = (const v2u*)(slot + 4096) + lane;
#pragma unroll
                for (int j = 0; j < 4; ++j) { nx[j] = xr[64 * j]; n0[j] = y1r[64 * j]; n1[j] = y1r[256 + 64 * j]; } }
#pragma unroll
            for (int j = 0; j < 4; ++j) { const v2u w = w0[j], u = w1[j];
                y0[j] = (f32x4){__uint_as_float(w.x << 16), __uint_as_float(w.x & 0xffff0000u), __uint_as_float(w.y << 16), __uint_as_float(w.y & 0xffff0000u)};
                y1[j] = (f32x4){__uint_as_float(u.x << 16), __uint_as_float(u.x & 0xffff0000u), __uint_as_float(u.y << 16), __uint_as_float(u.y & 0xffff0000u)};
                s0 += (y0[j].x * y0[j].x + y0[j].y * y0[j].y) + (y0[j].z * y0[j].z + y0[j].w * y0[j].w);
                s1 += (y1[j].x * y1[j].x + y1[j].y * y1[j].y) + (y1[j].z * y1[j].z + y1[j].w * y1[j].w); }
            const float r0 = rsqrtf(wave_sum(s0) * (1.f / DMOD) + RMS_EPS), r1 = rsqrtf(wave_sum(s1) * (1.f / DMOD) + RMS_EPS);
            f32x4* orow = (f32x4*)slot + lane;
#pragma unroll
            for (int j = 0; j < 4; ++j) { const f32x4 x1 = v[j] + g0[j] * (y0[j] * r0); v[j] = x1 + g1[j] * (y1[j] * r1); }
            asm volatile("" ::: "memory");
#pragma unroll
            for (int j = 0; j < 4; ++j) orow[64 * j] = v[j]; }
    }
}
#define BAR_ALL() asm volatile("s_waitcnt vmcnt(0) lgkmcnt(0)\n\ts_barrier" ::: "memory")
#define BAR_LDS() asm volatile("s_waitcnt lgkmcnt(0)\n\ts_barrier" ::: "memory")
typedef float f32x4m __attribute__((ext_vector_type(4)));
__device__ __forceinline__ void p2a_kbar(const Args& A, char* lds, int G) {
    const int tid = opaque_tid(); const bf16* P0 = (const bf16*)(A.ws + WS_BIG); float* kbar = (float*)(A.ws + WS_KBAR); float* red = (float*)lds;
    for (int item = blockIdx.x; item < NB * 16 * 8; item += G) {
        const int b = item >> 7, h = (item >> 3) & 15, n = item & 7; const int c8 = tid & 7, rg = tid >> 3;
        float acc[8];
#pragma unroll
        for (int e = 0; e < 8; ++e) acc[e] = 0.f;
#pragma unroll
        for (int i = 0; i < 4; ++i) { const bf16x8 kv = *(const bf16x8*)(P0 + (size_t)(b * SEQL + n * 256 + rg + 64 * i) * LD0 + C0_K + h * 64 + c8 * 8);
#pragma unroll
            for (int e = 0; e < 8; ++e) acc[e] += bf2f((unsigned short)kv[e]); }
        __syncthreads();
#pragma unroll
        for (int e = 0; e < 8; ++e) red[rg * 65 + c8 * 8 + e] = acc[e];
        __syncthreads();
        if (tid < 64) { float s = 0.f; for (int r = 0; r < 64; ++r) s += red[r * 65 + tid]; kbar[(size_t)item * 64 + tid] = s * (1.f / 256.f); }
    }
    __syncthreads();
}
__device__ __forceinline__ void p2a_conv(const Args& A, int G) {
    const int tid = opaque_tid(); const bf16* P0 = (const bf16*)(A.ws + WS_BIG); bf16* XC = (bf16*)A.out;
    if (tid >= 384) return;
    const int chg = tid % 192, half = tid / 192, ch = chg * 8;
    float w[4][8], bs[8];
#pragma unroll
    for (int k = 0; k < 4; ++k) { const f32x4 a = *(const f32x4*)(A.in[I_ECONVW] + k * 1536 + ch), b2 = *(const f32x4*)(A.in[I_ECONVW] + k * 1536 + ch + 4);
#pragma unroll
        for (int e = 0; e < 4; ++e) { w[k][e] = a[e]; w[k][4 + e] = b2[e]; } }
    { const f32x4 a = *(const f32x4*)(A.in[I_ECONVB] + ch), b2 = *(const f32x4*)(A.in[I_ECONVB] + ch + 4);
#pragma unroll
      for (int e = 0; e < 4; ++e) { bs[e] = a[e]; bs[4 + e] = b2[e]; } }
    for (int rb = blockIdx.x; rb < MROWS / 64; rb += G) {
        const int m0 = rb * 64 + half * 32; const int tb = m0 & (SEQL - 1);
        bf16x8 r0 = {}, r1 = {}, r2 = {};
        if (tb > 0) { r0 = *(const bf16x8*)(P0 + (size_t)(m0 - 3) * LD0 + C0_XBC + ch); r1 = *(const bf16x8*)(P0 + (size_t)(m0 - 2) * LD0 + C0_XBC + ch); r2 = *(const bf16x8*)(P0 + (size_t)(m0 - 1) * LD0 + C0_XBC + ch); }
#pragma unroll 4
        for (int i = 0; i < 32; ++i) { const bf16x8 r3 = *(const bf16x8*)(P0 + (size_t)(m0 + i) * LD0 + C0_XBC + ch); float o[8];
#pragma unroll
            for (int e = 0; e < 8; ++e) { const float a = bs[e] + w[0][e] * bf2f((unsigned short)r0[e]) + w[1][e] * bf2f((unsigned short)r1[e]) + w[2][e] * bf2f((unsigned short)r2[e]) + w[3][e] * bf2f((unsigned short)r3[e]); o[e] = silu_f(a); }
            v4u pw; pw.x = pk2(o[0], o[1]); pw.y = pk2(o[2], o[3]); pw.z = pk2(o[4], o[5]); pw.w = pk2(o[6], o[7]);
            *(v4u*)(XC + (size_t)(m0 + i) * 2048 + ch) = pw; r0 = r1; r1 = r2; r2 = r3; }
    }
}
constexpr int S_CS = 0, S_BS = 17408, S_BST = 34816, S_XT = 53248, S_XWT = 57856, S_XS = 62464, S_GG = 67584, S_SBF = 76800, S_DTA = 85504;
constexpr int F_CS = 0, F_BS = 17408, F_BST = 34816, F_XT = 53248, F_XWT = 62464, F_XS = 71680, F_GG = 80896, F_SBF = 90112, F_DTA = 107520;
template <bool DRY> __device__ __forceinline__ void ssd_unit(const Args& A, char* lds, int b, int h) {
    const int tid = opaque_tid(), lane = tid & 63, wave = __builtin_amdgcn_readfirstlane(tid >> 6); const int fr = lane & 15, fq = lane >> 4;
    bf16* P0 = (bf16*)(A.ws + WS_BIG); const bf16* XC = (const bf16*)A.out; const float* DT = (const float*)(A.ws + WS_DT);
    const int g = h >> 3; const int xcol = h * 64, bcol = 1024 + g * 128, ccol = 1280 + g * 128;
    bf16* CS = (bf16*)(lds + F_CS); bf16* BS = (bf16*)(lds + F_BS); bf16* BST = (bf16*)(lds + F_BST); bf16* XT = (bf16*)(lds + F_XT); bf16* XWT = (bf16*)(lds + F_XWT);
    bf16* XS = (bf16*)(lds + F_XS); bf16* GG = (bf16*)(lds + F_GG); bf16* SBF = (bf16*)(lds + F_SBF); float* DTA0 = (float*)(lds + F_DTA);
    for (int i = tid; i < 64 * 136; i += NTHR) SBF[i] = 0;
    const float Ah = -__expf(A.in[I_EALOG][h]), Dh = A.in[I_EDSKIP][h];
    const int lt = wave >> 1, pt0 = 2 * (wave & 1), st0 = 2 * (wave & 1), nt0 = (wave >> 1) * 2;
    f32x4m sta[2][2];
#pragma unroll
    for (int pi = 0; pi < 2; ++pi)
#pragma unroll
        for (int ni = 0; ni < 2; ++ni) sta[pi][ni] = (f32x4m){0.f, 0.f, 0.f, 0.f};
    const size_t rb0 = (size_t)b * SEQL;
    const bf16* pB = XC + (rb0 + (tid >> 4)) * 2048 + bcol + (tid & 15) * 8; const bf16* pC = XC + (rb0 + (tid >> 4)) * 2048 + ccol + (tid & 15) * 8; const bf16* pX = XC + (rb0 + (tid >> 3)) * 2048 + xcol + (tid & 7) * 8;
    const bf16* pZ = P0 + (rb0 + lt * 16 + 4 * fq) * LD0 + C0_ZA + h * 64 + pt0 * 16 + fr;
    bf16x8 pre[5]; float dtn = 0.f;
    pre[0] = *(const bf16x8*)pB; pre[1] = *(const bf16x8*)(pB + 32 * 2048); pre[2] = *(const bf16x8*)pC; pre[3] = *(const bf16x8*)(pC + 32 * 2048); pre[4] = *(const bf16x8*)pX;
    unsigned short zn[2][4], gts[2][4]; float sqs[2][4];
#pragma unroll
    for (int pi = 0; pi < 2; ++pi)
#pragma unroll
        for (int r = 0; r < 4; ++r) { zn[pi][r] = pZ[(size_t)r * LD0 + 16 * pi]; gts[pi][r] = 0; sqs[pi][r] = 0.f; }
    if (wave == 0) { dtn = DT[(rb0 + lane) * 16 + h]; const float s = wave_scan(Ah * dtn, lane); const float tot = rdlane(s, 63);
        DTA0[lane] = dtn; DTA0[64 + lane] = s; DTA0[128 + lane] = __expf(s); DTA0[192 + lane] = __expf(tot - s); dtn = DT[(rb0 + 64 + lane) * 16 + h]; }
    BAR_LDS();
    for (int c = 0; c < SEQL / 64; ++c) {
        const size_t m0 = rb0 + c * 64; float* DTA = DTA0 + (c & 1) * 256;
        { const int t = tid >> 4, c8 = tid & 15;
          *(bf16x8*)(BS + t * 136 + c8 * 8) = pre[0]; *(bf16x8*)(BS + (t + 32) * 136 + c8 * 8) = pre[1]; *(bf16x8*)(CS + t * 136 + c8 * 8) = pre[2]; *(bf16x8*)(CS + (t + 32) * 136 + c8 * 8) = pre[3];
          const int sw0 = ((((t >> 3) ^ (c8 & 7)) << 3) + (t & 7)), sw1 = (((((t + 32) >> 3) ^ (c8 & 7)) << 3) + (t & 7));
#pragma unroll
          for (int e = 0; e < 8; ++e) { BST[(c8 * 8 + e) * 72 + sw0] = (bf16)pre[0][e]; BST[(c8 * 8 + e) * 72 + sw1] = (bf16)pre[1][e]; }
          const int tx = tid >> 3, cx = tid & 7; *(bf16x8*)(XS + tx * 72 + cx * 8) = pre[4]; const float dtv = DTA[tx], wv = DTA[192 + tx]; const int sx = ((((tx >> 3) ^ cx) << 3) + (tx & 7));
#pragma unroll
          for (int e = 0; e < 8; ++e) { const float xd = bf2f((unsigned short)pre[4][e]) * dtv; XT[(cx * 8 + e) * 72 + sx] = (bf16)f2bf(xd); XWT[(cx * 8 + e) * 72 + sx] = (bf16)f2bf(xd * wv); } }
        if (c > 0) {
#pragma unroll
            for (int pi = 0; pi < 2; ++pi)
#pragma unroll
                for (int r = 0; r < 4; ++r) { const int l = lt * 16 + 4 * fq + r;
                    if (!DRY || sqs[pi][r] == 1.2345e30f) { ((bf16*)pZ)[((size_t)(c - 1) * 64 + r) * LD0 + 16 * pi] = gts[pi][r];
                        if (fr == 0) ((float*)((unsigned char*)A.out + (m0 - 64 + l) * 4096 + 3072))[h * 4 + pt0 + pi] = sqs[pi][r]; } } }
        if (c + 1 < SEQL / 64) { const size_t o = (size_t)(c + 1) * 64 * 2048;
            pre[0] = *(const bf16x8*)(pB + o); pre[1] = *(const bf16x8*)(pB + o + 32 * 2048); pre[2] = *(const bf16x8*)(pC + o); pre[3] = *(const bf16x8*)(pC + o + 32 * 2048); pre[4] = *(const bf16x8*)(pX + o); }
        unsigned short zv[2][4];
#pragma unroll
        for (int pi = 0; pi < 2; ++pi)
#pragma unroll
            for (int r = 0; r < 4; ++r) zv[pi][r] = zn[pi][r];
        if (c + 1 < SEQL / 64) {
#pragma unroll
            for (int pi = 0; pi < 2; ++pi)
#pragma unroll
                for (int r = 0; r < 4; ++r) zn[pi][r] = pZ[((size_t)(c + 1) * 64 + r) * LD0 + 16 * pi]; }
        BAR_LDS();
        f32x4m cb[2], ya[2]; cb[0] = (f32x4m){0.f, 0.f, 0.f, 0.f}; cb[1] = cb[0]; ya[0] = cb[0]; ya[1] = cb[0];
#pragma unroll
        for (int ks = 0; ks < 4; ++ks) { const bf16x8 af = *(const bf16x8*)(CS + (lt * 16 + fr) * 136 + ks * 32 + 8 * fq);
#pragma unroll
            for (int si = 0; si < 2; ++si) { const bf16x8 bfv = *(const bf16x8*)(BS + ((st0 + si) * 16 + fr) * 136 + ks * 32 + 8 * fq); cb[si] = __builtin_amdgcn_mfma_f32_16x16x32_bf16(af, bfv, cb[si], 0, 0, 0); }
#pragma unroll
            for (int pi = 0; pi < 2; ++pi) { const bf16x8 sf = *(const bf16x8*)(SBF + ((pt0 + pi) * 16 + fr) * 136 + ks * 32 + 8 * fq); ya[pi] = __builtin_amdgcn_mfma_f32_16x16x32_bf16(af, sf, ya[pi], 0, 0, 0); } }
#pragma unroll
        for (int r = 0; r < 4; ++r) { const int l = lt * 16 + 4 * fq + r; const float al = DTA[64 + l];
#pragma unroll
            for (int si = 0; si < 2; ++si) { const int s = (st0 + si) * 16 + fr; const float v = (s <= l) ? cb[si][r] * __expf(al - DTA[64 + s]) : 0.f; GG[l * 72 + s] = (bf16)f2bf(v); }
            const float ea = DTA[128 + l]; ya[0][r] *= ea; ya[1][r] *= ea; }
        const float decay = __expf(DTA[64 + 63]);
        BAR_LDS();
#pragma unroll
        for (int ks = 0; ks < 2; ++ks) { const bf16x8 gf = *(const bf16x8*)(GG + (lt * 16 + fr) * 72 + ks * 32 + 8 * fq);
#pragma unroll
            for (int pi = 0; pi < 2; ++pi) { const int p = (pt0 + pi) * 16 + fr; const bf16x8 xf = *(const bf16x8*)(XT + p * 72 + (((ks * 4 + fq) ^ ((p >> 3) & 7)) << 3)); ya[pi] = __builtin_amdgcn_mfma_f32_16x16x32_bf16(gf, xf, ya[pi], 0, 0, 0); } }
#pragma unroll
        for (int pi = 0; pi < 2; ++pi)
#pragma unroll
            for (int ni = 0; ni < 2; ++ni) sta[pi][ni] = sta[pi][ni] * decay;
#pragma unroll
        for (int ks = 0; ks < 2; ++ks) { bf16x8 bt[2];
#pragma unroll
            for (int ni = 0; ni < 2; ++ni) { const int n = (nt0 + ni) * 16 + fr; bt[ni] = *(const bf16x8*)(BST + n * 72 + (((ks * 4 + fq) ^ ((n >> 3) & 7)) << 3)); }
#pragma unroll
            for (int pi = 0; pi < 2; ++pi) { const int p = (pt0 + pi) * 16 + fr; const bf16x8 xw = *(const bf16x8*)(XWT + p * 72 + (((ks * 4 + fq) ^ ((p >> 3) & 7)) << 3));
#pragma unroll
                for (int ni = 0; ni < 2; ++ni) sta[pi][ni] = __builtin_amdgcn_mfma_f32_16x16x32_bf16(xw, bt[ni], sta[pi][ni], 0, 0, 0); } }
#pragma unroll
        for (int pi = 0; pi < 2; ++pi)
#pragma unroll
            for (int ni = 0; ni < 2; ++ni)
#pragma unroll
                for (int r = 0; r < 4; ++r) SBF[((pt0 + pi) * 16 + 4 * fq + r) * 136 + (nt0 + ni) * 16 + fr] = (bf16)f2bf(sta[pi][ni][r]);
#pragma unroll
        for (int pi = 0; pi < 2; ++pi)
#pragma unroll
            for (int r = 0; r < 4; ++r) { const int l = lt * 16 + 4 * fq + r, p = (pt0 + pi) * 16 + fr;
                const float y = ya[pi][r] + Dh * bf2f(XS[l * 72 + p]);
                const float z = bf2f(zv[pi][r]); const float gt = y * silu_f(z);
                gts[pi][r] = (unsigned short)f2bf(gt); sqs[pi][r] = row_sum16(gt * gt); }
        if (wave == 0 && c + 1 < SEQL / 64) { float* DN = DTA0 + ((c + 1) & 1) * 256; const float s = wave_scan(Ah * dtn, lane); const float tot = rdlane(s, 63);
            DN[lane] = dtn; DN[64 + lane] = s; DN[128 + lane] = __expf(s); DN[192 + lane] = __expf(tot - s);
            if (c + 2 < SEQL / 64) dtn = DT[(m0 + 128 + lane) * 16 + h]; }
        BAR_LDS();
    }
#pragma unroll
    for (int pi = 0; pi < 2; ++pi)
#pragma unroll
        for (int r = 0; r < 4; ++r) { const int l = lt * 16 + 4 * fq + r;
            if (!DRY || sqs[pi][r] == 1.2345e30f) { ((bf16*)pZ)[((size_t)(SEQL / 64 - 1) * 64 + r) * LD0 + 16 * pi] = gts[pi][r];
                if (fr == 0) ((float*)((unsigned char*)A.out + (rb0 + SEQL - 64 + l) * 4096 + 3072))[h * 4 + pt0 + pi] = sqs[pi][r]; } }
}
__device__ __forceinline__ void p2c_fixup(const Args& A, int vcu, int G) {
    const int tid = opaque_tid(), lane = tid & 63, wave = tid >> 6; bf16* P0 = (bf16*)(A.ws + WS_BIG); const float* ssq = (const float*)(A.ws + WS_SSQ);
    f32x4 gn[4];
#pragma unroll
    for (int j = 0; j < 4; ++j) gn[j] = *((const f32x4*)A.in[I_ENORMG] + lane + 64 * j);
    for (int m = vcu * NWAVES + wave; m < MROWS; m += G * NWAVES) { const float r = rsqrtf(wave_sum(((const float*)((const unsigned char*)A.out + (size_t)m * 4096 + 3072))[lane]) * (1.f / 1024.f) + RMS_EPS);
        v2u* p = (v2u*)(P0 + (size_t)m * LD0 + C0_ZA) + lane;
#pragma unroll
        for (int j = 0; j < 4; ++j) { const v2u w = p[64 * j]; v2u o; o.x = pk2(__uint_as_float(w.x << 16) * r * gn[j].x, __uint_as_float(w.x & 0xffff0000u) * r * gn[j].y);
            o.y = pk2(__uint_as_float(w.y << 16) * r * gn[j].z, __uint_as_float(w.y & 0xffff0000u) * r * gn[j].w); p[64 * j] = o; } }
}
__device__ __forceinline__ void p5a_fcum(const Args& A, char* lds, int G) {
    const int tid = opaque_tid(), lane = tid & 63, wave = tid >> 6; const float* LF = (const float*)(A.ws + WS_LF); float* F2 = (float*)(A.ws + WS_F2); float* wtot = (float*)(lds + 120 * 1024);
    for (int item = blockIdx.x; item < NB * 24; item += G) { const int b = item / 24, h = item % 24; const float fb = A.in[I_OFGB][h];
        float v[4]; float run = 0.f;
#pragma unroll
        for (int i = 0; i < 4; ++i) { const size_t ix = ((size_t)b * SEQL + 4 * tid + i) * 24 + h; const float* L1p = (const float*)(A.ws + WS_LFP);
            const float fr_ = (LF[ix] + L1p[ix]) + (L1p[ix + (size_t)MROWS * 24] + L1p[ix + (size_t)2 * MROWS * 24]) + fb; run += -softplus_g(-fr_); v[i] = run; }
        float s = run;
#pragma unroll
        for (int o = 1; o < 64; o <<= 1) { const float x = __shfl_up(s, o); if (lane >= o) s += x; }
        __syncthreads();
        if (lane == 63) wtot[wave] = s;
        __syncthreads();
        float off = s - run; for (int w = 0; w < wave; ++w) off += wtot[w];
#pragma unroll
        for (int i = 0; i < 4; ++i) { const float f2v = (off + v[i]) * LOG2E; const int t = 4 * tid + i; F2[(size_t)item * SEQL + t] = f2v;
            if ((t & 127) == 127) wtot[64 + (t >> 7)] = f2v; if ((t & 255) == 0) wtot[96 + (t >> 8)] = f2v; }
        { const bf16* P1 = (const bf16*)(A.ws + WS_BIG); float qm = 0.f, km = 0.f;
#pragma unroll 8
          for (int i = 0; i < 32; ++i) { const size_t m = (size_t)b * SEQL + (tid >> 3) + 64 * i; const int c8 = tid & 7; float qs = 0.f, ks2 = 0.f;
              const bf16x8 qv = *(const bf16x8*)(P1 + m * LD1 + C1_Q + h * 64 + c8 * 8), kv = *(const bf16x8*)(P1 + m * LD1 + C1_K + h * 64 + c8 * 8);
#pragma unroll
              for (int e = 0; e < 8; ++e) { const float qf = bf2f((unsigned short)qv[e]), kf = bf2f((unsigned short)kv[e]); qs += qf * qf; ks2 += kf * kf; }
              qs += dppf<0xB1>(qs, qs); qs += dppf<0x4E>(qs, qs); qs += dppf<0x141>(qs, qs); ks2 += dppf<0xB1>(ks2, ks2); ks2 += dppf<0x4E>(ks2, ks2); ks2 += dppf<0x141>(ks2, ks2);
              qm = fmaxf(qm, qs); km = fmaxf(km, ks2); }
#pragma unroll
          for (int o = 1; o < 64; o <<= 1) { qm = fmaxf(qm, __shfl_xor(qm, o)); km = fmaxf(km, __shfl_xor(km, o)); }
          __syncthreads();
          if (lane == 0) { wtot[16 + wave] = qm; wtot[32 + wave] = km; }
          __syncthreads();
          if (tid < 8) { float a = 0.f, c = 0.f; for (int w = 0; w < 8; ++w) { a = fmaxf(a, wtot[16 + w]); c = fmaxf(c, wtot[32 + w]); } const float u2 = 2.f * sqrtf(a) * sqrtf(c) * 1.01f;
              const int qb = tid; const float fi0 = wtot[96 + qb]; int ts = 0; while (ts + 2 <= 4 * qb && u2 - (wtot[64 + (ts >> 1)] - fi0) <= -40.f) ts += 2;
              ((int*)(A.ws + WS_TS))[item * 8 + qb] = ts; } }
    }
    __syncthreads();
}
constexpr int S5_BU = 0  , S5_SS = 67584  , S5_US = 102400  ;
__device__ __forceinline__ float gelu_tanh(float x) { const float u = 0.7978845608028654f * (x + 0.044715f * x * x * x); const float e = __expf(2.f * u); const float t = 1.f - 2.f / (e + 1.f); return 0.5f * x * (1.f + t); }
__device__ __forceinline__ void s5_unit(const Args& A, char* lds, int b, int g) {
    const int tid = opaque_tid(), lane = tid & 63, wave = __builtin_amdgcn_readfirstlane(tid >> 6); const int fr = lane & 15, fq = lane >> 4, r32 = lane & 31, hi = lane >> 5;
    const bf16* P1 = (const bf16*)(A.ws + WS_BIG); bf16* YD = (bf16*)A.out;
    const unsigned char* pg = A.ws + WS_S5P + (size_t)g * S5P_STRIDE; const bf16* BbT = (const bf16*)pg; const bf16* Cm = (const bf16*)(pg + 4096); const float* ari = (const float*)(pg + 8192);
    const int ttile = wave >> 2, ntile = wave & 3;
    const bf16x8 bfrag = *(const bf16x8*)(BbT + (ntile * 32 + r32) * 16 + 8 * hi);
    bf16x8 cfrag[4];
#pragma unroll
    for (int ks = 0; ks < 4; ++ks) cfrag[ks] = *(const bf16x8*)(Cm + fr * 128 + ks * 32 + 8 * fq);
    const float ar = ari[lane], ai = ari[64 + lane]; float sr = 0.f, si = 0.f;
    const float dskip = A.in[I_ODSKIP][g * 16 + fr];
    const size_t rb0 = (size_t)b * SEQL; const bf16* pU = P1 + (rb0 + ttile * 32 + r32) * LD1 + C1_U + g * 16 + 8 * hi;
    bf16x8 un = *(const bf16x8*)pU;
    BAR_LDS();
    for (int i = 0; i < SEQL / 64 + 2; ++i) {
        if (i < SEQL / 64) { float* BU = (float*)(lds + S5_BU) + (i & 1) * (64 * 132); f32x16 acc = {};
            acc = __builtin_amdgcn_mfma_f32_32x32x16_bf16(un, bfrag, acc, 0, 0, 0);
            if (ntile == 0) *(bf16x8*)((bf16*)(lds + S5_US) + ((i & 3) * 64 + ttile * 32 + r32) * 16 + 8 * hi) = un;
            if (i + 1 < SEQL / 64) un = *(const bf16x8*)(pU + (size_t)(i + 1) * 64 * LD1);
#pragma unroll
            for (int r = 0; r < 16; ++r) { const int t = ttile * 32 + (r & 3) + 8 * (r >> 2) + 4 * hi; BU[t * 132 + ntile * 32 + r32] = acc[r]; } }
        if (wave == 0 && i >= 1 && i <= SEQL / 64) { const float* BU = (const float*)(lds + S5_BU) + ((i - 1) & 1) * (64 * 132); bf16* SS = (bf16*)(lds + S5_SS) + ((i - 1) & 1) * (64 * 136);
#pragma unroll
            for (int hb = 0; hb < 2; ++hb) { f32x2_c bv[32];
#pragma unroll
                for (int t = 0; t < 32; ++t) bv[t] = *(const f32x2_c*)(BU + (hb * 32 + t) * 132 + 2 * lane);
                const f32x2_c a1 = {ar, ar}, a2 = {-ai, ai}; f32x2_c s2 = {sr, si};
#pragma unroll
                for (int t = 0; t < 32; ++t) { const f32x2_c sw = {s2.y, s2.x}; s2 = a1 * s2 + (a2 * sw + bv[t]);
                    *(unsigned*)(SS + (hb * 32 + t) * 136 + 2 * lane) = pk2(s2.x, s2.y); }
                sr = s2.x; si = s2.y; } }
        if (wave >= 4 && i >= 2) { const bf16* SS = (const bf16*)(lds + S5_SS) + ((i - 2) & 1) * (64 * 136); const int mt = wave - 4; const size_t m0 = rb0 + (size_t)(i - 2) * 64;
            unsigned short uv[4];
#pragma unroll
            for (int r = 0; r < 4; ++r) uv[r] = ((const bf16*)(lds + S5_US))[(((i - 2) & 3) * 64 + mt * 16 + 4 * fq + r) * 16 + fr];
            f32x4m acc = (f32x4m){0.f, 0.f, 0.f, 0.f};
#pragma unroll
            for (int ks = 0; ks < 4; ++ks) { const bf16x8 af = *(const bf16x8*)(SS + (mt * 16 + fr) * 136 + ks * 32 + 8 * fq); acc = __builtin_amdgcn_mfma_f32_16x16x32_bf16(af, cfrag[ks], acc, 0, 0, 0); }
#pragma unroll
            for (int r = 0; r < 4; ++r) { const size_t m = m0 + mt * 16 + 4 * fq + r; YD[m * 2048 + 1024 + g * 16 + fr] = (bf16)f2bf(gelu_tanh(acc[r] + dskip * bf2f(uv[r]))); } }
        BAR_LDS();
    }
}
template <bool DRY> __device__ __forceinline__ void moba_phase(const Args& A, char* lds, int vcu, int G) {
    const bf16* P0 = (const bf16*)(A.ws + WS_BIG); const float* kbar = (const float*)(A.ws + WS_KBAR);
    unsigned* cnt = (unsigned*)(A.ws + WS_CNT) + (DRY ? 192 : 128); volatile unsigned* lw = (volatile unsigned*)(lds + BARST_OFF + 16);
    const int tid = opaque_tid();
    if (tid == 0) lw[0] = atomicAdd(cnt, 1u);
    BAR_ALL();
    int u = __builtin_amdgcn_readfirstlane((int)lw[0]);
    while (u < NB * 16 * 8) {
        unsigned nxt = 0u; if (tid == 0) nxt = atomicAdd(cnt, 1u);
        const int qb = 7 - u / 128, bh = u % 128, b = bh >> 4, h = bh & 15;
        attn_body::attn_unit<8, 0, LD0, DRY>(b, h, qb, (const attn_body::bf16*)(P0 + C0_Q), (const attn_body::bf16*)(P0 + C0_K), (const attn_body::bf16*)(P0 + C0_V), (attn_body::bf16*)(P0 + C0_Q),
                                            (const attn_body::bf16*)(P0 + C0_ZB), kbar + (size_t)bh * 512, nullptr, lw, nxt, lds);
        BAR_LDS();
        u = __builtin_amdgcn_readfirstlane((int)lw[0]);
    }
}
template <bool DRY> __device__ __forceinline__ void fox_phase(const Args& A, char* lds, int vcu, int G) {
    const bf16* P1 = (const bf16*)(A.ws + WS_BIG); const float* F2 = (const float*)(A.ws + WS_F2); const int* TSv = (const int*)(A.ws + WS_TS);
    unsigned* cnt = (unsigned*)(A.ws + WS_CNT) + (DRY ? 64 : 0); volatile unsigned* lw = (volatile unsigned*)(lds + BARST_OFF + 16);
    const int tid = opaque_tid();
    if (tid == 0) lw[0] = atomicAdd(cnt, 1u);
    BAR_ALL();
    int u = __builtin_amdgcn_readfirstlane((int)lw[0]);
    while (u < NB * 24 * 8) {
        unsigned nxt = 0u; if (tid == 0) nxt = atomicAdd(cnt, 1u);
        const int qb = 7 - u / 192, bh = u % 192, b = bh / 24, h = bh % 24;
        attn_body::attn_unit<8, 1, LD1, DRY>(b, h, qb, (const attn_body::bf16*)(P1 + C1_Q), (const attn_body::bf16*)(P1 + C1_K), (const attn_body::bf16*)(P1 + C1_V), (attn_body::bf16*)(P1 + C1_Q),
                                            (const attn_body::bf16*)(P1 + C1_ZC), F2 + (size_t)bh * SEQL, TSv + bh * 8, lw, nxt, lds);
        BAR_LDS();
        u = __builtin_amdgcn_readfirstlane((int)lw[0]);
    }
}
#define LAS __attribute__((address_space(3)))
#define XB_TMO      128
#define XB_XCNT(j)  (256  + 64 * (j))
#define XB_XSUB(j)  (1280 + 64 * (j))
#define XB_XGEN(j)  (2304 + 64 * (j))
#define XB_TOP      3328
#define XB_TOPGEN   3392
#define XCD_BAR_WORDS 3456
#define XB_SPIN_CAP (1u << 18)

__device__ __forceinline__ unsigned xb_ld(unsigned* p)              { return __hip_atomic_load(p, __ATOMIC_RELAXED, __HIP_MEMORY_SCOPE_AGENT); }
__device__ __forceinline__ unsigned xb_add(unsigned* p, unsigned v) { return __hip_atomic_fetch_add(p, v, __ATOMIC_RELAXED, __HIP_MEMORY_SCOPE_AGENT); }
__device__ __forceinline__ unsigned xb_xcc_id() { return (unsigned)__builtin_amdgcn_s_getreg((3 << 11) | 20) & 0xFu; }
#define XB_SPIN(cond, bar) do { unsigned _sp = 0; while (cond) { __builtin_amdgcn_s_sleep(1); \
    if ((++_sp & 255u) == 0u) { if (xb_ld(&(bar)[XB_TMO])) break; if (_sp > XB_SPIN_CAP) { atomicAdd(&(bar)[XB_TMO], 1u); break; } } } } while (0)

struct XcdBarrier {
    unsigned* bar; unsigned x;
    volatile LAS unsigned* st;
};

__device__ __forceinline__ XcdBarrier xcd_barrier_post(unsigned* bar, volatile LAS unsigned* st) {
    XcdBarrier b; b.bar = bar; b.x = xb_xcc_id(); b.st = st;
    if (threadIdx.x == 0) (void)xb_add(&bar[XB_XCNT(b.x)], 1u);
    return b;
}
__device__ __forceinline__ void xcd_barrier_complete(unsigned* bar, unsigned x, unsigned& nloc, unsigned& nx) {
    const unsigned G = gridDim.x * gridDim.y * gridDim.z;
    unsigned sum, cnt, mine, sp = 0u;
    for (;;) {
        sum = 0u; cnt = 0u; mine = 0u;
#pragma unroll
        for (unsigned j = 0; j < 16; ++j) { const unsigned c = xb_ld(&bar[XB_XCNT(j)]); sum += c; cnt += (c > 0u) ? 1u : 0u; mine = (j == x) ? c : mine; }
        if (sum == G) break;
        __builtin_amdgcn_s_sleep(1);
        if ((++sp & 255u) == 0u) { if (xb_ld(&bar[XB_TMO])) break; if (sp > XB_SPIN_CAP) { atomicAdd(&bar[XB_TMO], 1u); break; } }
    }
    nloc = mine > 0u ? mine : 1u; nx = cnt > 0u ? cnt : 1u;
}

__device__ __forceinline__ void xcd_barrier(const XcdBarrier& b) {
    asm volatile("s_waitcnt vmcnt(0)" ::: "memory");
    __syncthreads();
    if (threadIdx.x == 0) {
        unsigned* bar = b.bar;
        __builtin_amdgcn_s_waitcnt(0);
        unsigned nloc = b.st[0], nx = b.st[1];
        if (nloc == 0u) { xcd_barrier_complete(bar, b.x, nloc, nx); b.st[0] = nloc; b.st[1] = nx; }
        const unsigned old = xb_add(&bar[XB_XSUB(b.x)], 1u);
        const unsigned gen = old / nloc;
        if (old + 1u == (gen + 1u) * nloc) {
            __builtin_amdgcn_fence(__ATOMIC_RELEASE, "agent");
            asm volatile("s_waitcnt vmcnt(0)" ::: "memory");
            const unsigned og = xb_add(&bar[XB_TOP], 1u);
            const unsigned tg = og / nx;
            if (og + 1u == (tg + 1u) * nx) xb_add(&bar[XB_TOPGEN], 1u);
            else XB_SPIN(xb_ld(&bar[XB_TOPGEN]) == tg, bar);
            __builtin_amdgcn_fence(__ATOMIC_ACQUIRE, "agent");
            xb_add(&bar[XB_XGEN(b.x)], 1u);
            asm volatile("s_waitcnt vmcnt(0)" ::: "memory");
        } else {
            XB_SPIN(xb_ld(&bar[XB_XGEN(b.x)]) == gen, bar);
            __builtin_amdgcn_fence(__ATOMIC_ACQUIRE, "agent");
            asm volatile("s_waitcnt vmcnt(0)" ::: "memory");
        }
    }
    __syncthreads();
}

constexpr int ARGS_OFF = 132096;
__device__ __forceinline__ Args get_args(const unsigned char* lds) {
    Args a; const unsigned long long* p = (const unsigned long long*)(lds + ARGS_OFF);
#pragma unroll
    for (int i = 0; i < 29; ++i) { const unsigned long long v = p[i]; const unsigned lo = __builtin_amdgcn_readfirstlane((unsigned)v), hi = __builtin_amdgcn_readfirstlane((unsigned)(v >> 32));
        const unsigned long long w = ((unsigned long long)hi << 32) | lo; if (i < 27) a.in[i] = (const float*)w; else if (i == 27) a.out = (float*)w; else a.ws = (unsigned char*)w; }
    return a;
}
#define PHASE_BEGIN { const Args args = get_args(lds); unsigned char* ws = args.ws; bf16* XN = (bf16*)args.out; bf16* PB = (bf16*)(ws + WS_BIG); (void)ws; (void)XN; (void)PB;
#ifdef DUP_SYNC
#define PHASE_END } xcd_barrier(xbar); xcd_barrier(xbar);
#else
#define PHASE_END } xcd_barrier(xbar);
#endif
#define PHASE_END_NOSYNC }
__global__ void __launch_bounds__(NTHR, 2) trunk_fwd(Args kargs_unused) {
    extern __shared__ __attribute__((aligned(16))) unsigned char lds[];
    cg::grid_group grid = cg::this_grid();
    const int G = gridDim.x, bx = blockIdx.x; const int vcu = (G % 8 == 0) ? (bx % 8) * (G / 8) + bx / 8 : bx;
    char* ldsc = (char*)lds; PG8_LAS unsigned char* ldsg = (PG8_LAS unsigned char*)lds;
    { const int t = opaque_tid(); if (t < 29) { const unsigned long long* ka = (const unsigned long long*)__builtin_amdgcn_kernarg_segment_ptr(); ((unsigned long long*)(lds + ARGS_OFF))[t] = ka[t]; }
      if (t < 2) ((unsigned*)(lds + BARST_OFF))[t] = 0u; }
    __syncthreads();
    XcdBarrier xbar;
    {
    const Args args = get_args(lds);
    unsigned* rdy = (unsigned*)(args.ws + WS_BAR) + 4160;
    if (bx == 0) { unsigned* bw = (unsigned*)(args.ws + WS_BAR); for (int i = opaque_tid(); i < 4096; i += NTHR) bw[i] = 0u;
        asm volatile("s_waitcnt vmcnt(0)" ::: "memory"); __syncthreads();
        if (opaque_tid() == 0) { __builtin_amdgcn_fence(__ATOMIC_RELEASE, "agent"); asm volatile("s_waitcnt vmcnt(0)" ::: "memory"); __hip_atomic_store(rdy, 0x600DF00Du, __ATOMIC_RELAXED, __HIP_MEMORY_SCOPE_AGENT); } }
    if (G > 0x40000000) grid.sync();
    p0_prologue(args, ldsc, vcu, G);
    if (opaque_tid() == 0) { unsigned sp = 0; while (__hip_atomic_load(rdy, __ATOMIC_RELAXED, __HIP_MEMORY_SCOPE_AGENT) != 0x600DF00Du && ++sp < (1u << 22)) __builtin_amdgcn_s_sleep(2);
        __builtin_amdgcn_fence(__ATOMIC_ACQUIRE, "agent"); asm volatile("s_waitcnt vmcnt(0)" ::: "memory"); }
    __syncthreads();
    xbar = xcd_barrier_post((unsigned*)(args.ws + WS_BAR), (volatile LAS unsigned*)(lds + BARST_OFF));
    xcd_barrier(xbar);
    if (bx == 0 && opaque_tid() == 0) __hip_atomic_store(rdy, 0u, __ATOMIC_RELAXED, __HIP_MEMORY_SCOPE_AGENT);
    }
    PHASE_BEGIN
    p1a_rows(args, ldsc, G);
#ifdef DUP_MISC
    p1a_rows(args, ldsc, G);
#endif
    PHASE_END
    PHASE_BEGIN
    { pg8::Gemm g{XN, (const bf16*)(ws + WS_WT0), MROWS, NP0, 1024, 2048, 1024, 0}; pg8::StaticOrder S; S.init(MROWS, NP0, G, bx);
      pg8::EpiX<0> E{PB, LD0, args.in[I_EDTB], (float*)(ws + WS_DT), nullptr, nullptr, attn_body::C2};
      pg8::gemm_phase<pg8::EpiX<0>, pg8::StaticOrder, true, true>(ldsg, g, S, E); }
#ifdef DUP_GEMM
    { pg8::Gemm g{XN, (const bf16*)(ws + WS_WT0), MROWS, NP0, 1024, 2048, 1024, 0}; pg8::StaticOrder S; S.init(MROWS, NP0, G, bx);
      pg8::EpiX<0> E{PB, LD0, args.in[I_EDTB], (float*)(ws + WS_DT), nullptr, nullptr, attn_body::C2};
      pg8::gemm_phase<pg8::EpiX<0>, pg8::StaticOrder, true, true>(ldsg, g, S, E); }
#endif
    PHASE_END
    PHASE_BEGIN
    p2a_kbar(args, ldsc, G);
    p2a_conv(args, G);
#ifdef DUP_MISC
    p2a_kbar(args, ldsc, G);
    p2a_conv(args, G);
#endif
    PHASE_END
    PHASE_BEGIN
#ifdef DUP_SSD
    for (int v = vcu; v < 128; v += G) ssd_unit<true>(args, ldsc, v >> 4, v & 15);
#endif
    for (int v = vcu; v < 128; v += G) ssd_unit<false>(args, ldsc, v >> 4, v & 15);
    PHASE_END_NOSYNC
    PHASE_BEGIN
#ifdef DUP_MOBA
    moba_phase<true>(args, ldsc, vcu, G);
#endif
    moba_phase<false>(args, ldsc, vcu, G);
    PHASE_END
    if (G != 256) {
    PHASE_BEGIN
    p2c_fixup(args, vcu, G);
    PHASE_END
    }
    PHASE_BEGIN
    { pg8::Gemm g{PB, (const bf16*)(ws + WS_WO0), MROWS, 1024, 2048, LD0, 2048, 0}; pg8::StaticOrder S; S.init(MROWS, 1024, G, bx);
      { pg8::Unit u0; u0.pm = 0; u0.pn = 0; const bool have = S.next(0, u0); const int pm0 = u0.pm; float* rs = (float*)(lds + 131072); const int t = opaque_tid();
        if (t < 256) { float r = 1.f;
            if (G == 256 && have) { const f32x4* pp = (const f32x4*)((const unsigned char*)args.out + (size_t)(pm0 * 256 + t) * 4096 + 3072); float sm = 0.f;
#pragma unroll
                for (int i = 0; i < 16; ++i) { const f32x4 v = pp[i]; sm += (v.x + v.y) + (v.z + v.w); }
                r = rsqrtf(sm * (1.f / 1024.f) + RMS_EPS); }
            rs[t] = r; }
        __syncthreads(); }
      pg8::EpiX<5> E{XN, 2048, nullptr, nullptr, nullptr, nullptr, 1.f};
      pg8::gemm_phase<pg8::EpiX<5>, pg8::StaticOrder, true, true>(ldsg, g, S, E); }
    PHASE_END
    PHASE_BEGIN
    p3b_rows(args, ldsc, G);
#ifdef DUP_MISC
    p3b_rows(args, ldsc, G);
#endif
    PHASE_END
    PHASE_BEGIN
    { pg8::Gemm g{XN + 1024, (const bf16*)(ws + WS_WT1), MROWS, LD1, 1024, 2048, 1024, 0}; pg8::StaticOrder S; S.init(MROWS, LD1, G, bx);
      pg8::EpiX<1> E{PB, LD1, nullptr, nullptr, nullptr, nullptr, attn_body::C2};
      pg8::gemm_phase<pg8::EpiX<1>, pg8::StaticOrder, true, true>(ldsg, g, S, E); }
    { pg8::Gemm g{XN + 1024, (const bf16*)(ws + WS_WT1) + (size_t)LD1 * 1024, MROWS, 1024, 256, 2048, 1024, 1}; pg8::StaticOrder S; S.init(MROWS, 1024, G, bx);
      pg8::EpiX<4> E{nullptr, 0, nullptr, (float*)(ws + WS_LF), (const bf16*)(ws + WS_LFP), nullptr, 1.f};
      pg8::gemm_phase<pg8::EpiX<4>, pg8::StaticOrder, true, true>(ldsg, g, S, E); }
#ifdef DUP_GEMM
    { pg8::Gemm g{XN + 1024, (const bf16*)(ws + WS_WT1), MROWS, LD1, 1024, 2048, 1024, 0}; pg8::StaticOrder S; S.init(MROWS, LD1, G, bx);
      pg8::EpiX<1> E{PB, LD1, nullptr, nullptr, nullptr, nullptr, attn_body::C2};
      pg8::gemm_phase<pg8::EpiX<1>, pg8::StaticOrder, true, true>(ldsg, g, S, E); }
#endif
    PHASE_END
    PHASE_BEGIN
    p5a_fcum(args, ldsc, G);
#ifdef DUP_S5
    p5a_fcum(args, ldsc, G);
#endif
    for (int v = vcu; v < 256; v += G) s5_unit(args, ldsc, v >> 5, v & 31);
#ifdef DUP_S5
    for (int v = vcu; v < 256; v += G) s5_unit(args, ldsc, v >> 5, v & 31);
#endif
    PHASE_END
    PHASE_BEGIN
#ifdef DUP_FOX
    fox_phase<true>(args, ldsc, vcu, G);
#endif
    if (vcu < 128) { pg8::Gemm g{XN + 1024, (const bf16*)(ws + WS_WG), MROWS, 512, 512, 2048, 512, 0}; pg8::StaticOrder S; S.init(MROWS, 512, 128, vcu);
      pg8::EpiX<3> E{PB + C1_U, LD1, args.in[I_OGLUB], nullptr, XN + 1024, PB + C1_ZD, 1.f};
      pg8::gemm_phase<pg8::EpiX<3>, pg8::StaticOrder, true, true>(ldsg, g, S, E); }
    fox_phase<false>(args, ldsc, vcu, G);
    PHASE_END
    PHASE_BEGIN
    { pg8::Gemm g{PB, (const bf16*)(ws + WS_WO1), MROWS, 1024, 2048, LD1, 2048, 0}; pg8::StaticOrder S; S.init(MROWS, 1024, G, bx);
      pg8::EpiX<2> E{XN + 1024, 2048, nullptr, nullptr, nullptr, nullptr, 1.f};
      pg8::gemm_phase<pg8::EpiX<2>, pg8::StaticOrder, true, true>(ldsg, g, S, E); }
#ifdef DUP_GEMM
    { pg8::Gemm g{PB, (const bf16*)(ws + WS_WO1), MROWS, 1024, 2048, LD1, 2048, 0}; pg8::StaticOrder S; S.init(MROWS, 1024, G, bx);
      pg8::EpiX<2> E{XN + 1024, 2048, nullptr, nullptr, nullptr, nullptr, 1.f};
      pg8::gemm_phase<pg8::EpiX<2>, pg8::StaticOrder, true, true>(ldsg, g, S, E); }
#endif
    PHASE_END
    PHASE_BEGIN
    p6b_rows(args, ldsc, G);
    PHASE_END_NOSYNC
}

extern "C" void kernel_launch(void* const* d_in, const int* in_sizes, int n_in, void* d_out, int out_size, void* d_ws, size_t ws_size, hipStream_t stream) {
    static int grid = 0;
    if (grid == 0) {
        if (n_in != 27 || out_size != MROWS * DMOD || ws_size < (size_t)256 * MiB) { fprintf(stderr, "kernel_launch: unexpected shapes n_in %d out %d ws %zu\n", n_in, out_size, ws_size); grid = -1; return; }
        int dev = 0, cus = 0, per_cu = 0;
        (void)hipGetDevice(&dev); (void)hipDeviceGetAttribute(&cus, hipDeviceAttributeMultiprocessorCount, dev);
        if (hipFuncSetAttribute((const void*)trunk_fwd, hipFuncAttributeMaxDynamicSharedMemorySize, LDS_BYTES) != hipSuccess) { fprintf(stderr, "kernel_launch: hipFuncSetAttribute failed\n"); }
        if (hipOccupancyMaxActiveBlocksPerMultiprocessor(&per_cu, (const void*)trunk_fwd, NTHR, LDS_BYTES) != hipSuccess || per_cu < 1) { fprintf(stderr, "kernel_launch: occupancy query says %d\n", per_cu); per_cu = 1; }
        (void)hipGetLastError();
        grid = cus * per_cu; if (grid > 256) grid = 256; if (grid < 1) grid = 256;
    }
    if (grid < 0) return;
    Args a{};
    for (int i = 0; i < 27; ++i) a.in[i] = (const float*)d_in[i];
    a.out = (float*)d_out; a.ws = (unsigned char*)d_ws;
    void* kargs[] = {&a};
    hipError_t e = hipLaunchCooperativeKernel((const void*)trunk_fwd, dim3(grid), dim3(NTHR), kargs, LDS_BYTES, stream);
    if (e != hipSuccess) fprintf(stderr, "cooperative launch failed: %s (grid %d)\n", hipGetErrorString(e), grid);
}
```

```cpp
#include <hip/hip_runtime.h>
#include <hip/hip_cooperative_groups.h>
#include <cstdio>
#include <cstdint>
namespace cg = cooperative_groups;
__device__ __forceinline__ int opaque_tid() { int t = threadIdx.x; asm volatile("" : "+v"(t)); return t; }
namespace pg8 {
#define PG8_LAS __attribute__((address_space(3)))
typedef unsigned short bf16_t;
typedef short bf16x8 __attribute__((ext_vector_type(8)));
typedef float f32x4 __attribute__((ext_vector_type(4)));
typedef unsigned u32x4 __attribute__((ext_vector_type(4)));
constexpr int BM = 256, BK = 64, HALF = 128, HTB = HALF * BK * 2  , STAGE_BYTES = 8 * HTB, NXCD = 8, WGM = 8;

__host__ __device__ __forceinline__ int lds_byte(int r, int c) { const int st = (r >> 4) * 2 + (c >> 5), rr = r & 15, cc = c & 31, ob = rr * 64 + cc * 2; return st * 1024 + (ob ^ (((ob >> 9) & 1) << 5)); }
__host__ __device__ __forceinline__ void stage_rc(int b, int& R, int& C) { const int st = b / 1024, sb = b % 1024, swz = sb ^ (((sb >> 9) & 1) << 5); R = (st >> 1) * 16 + swz / 64; C = (st & 1) * 32 + (swz % 64) / 2; }
__host__ __device__ __forceinline__ int perm32(int rho) { const int n = rho >> 4, i = rho & 15; return 8 * (i >> 2) + 4 * n + (i & 3); }

struct Unit { int pm, pn; };
struct Gemm { const bf16_t* A; const bf16_t* Bt; int M, N, K, lda, ldb, ksplit; };

struct StaticOrder {
    int nM, nN, nwg, G, c;
    __host__ __device__ __forceinline__ void init(int M, int N, int G_, int c_) { nM = M / BM; nN = N / BM; nwg = nM * nN; G = G_; c = c_; }
    __host__ __device__ __forceinline__ bool next(int i, Unit& u) const {
        const long L = (long)i * G + c; if (L >= nwg) return false;
        int wgid = (int)L; { const int q = nwg / NXCD, r = nwg % NXCD, xcd = wgid % NXCD, off = wgid / NXCD; wgid = (xcd < r ? xcd * (q + 1) : r * (q + 1) + (xcd - r) * q) + off; }
        const int nig = WGM * nN, gid = wgid / nig, fm = gid * WGM, gsz = (nM - fm) < WGM ? (nM - fm) : WGM;
        u.pm = fm + ((wgid % nig) % gsz); u.pn = (wgid % nig) / gsz; return true;
    }
    __device__ __forceinline__ void a_ready(const Unit&) const {}
    __device__ __forceinline__ void done(const Unit&) const {}
};

__device__ __forceinline__ unsigned cvt_pk_bf16(float lo, float hi) { unsigned r; asm volatile("v_cvt_pk_bf16_f32 %0, %1, %2" : "=v"(r) : "v"(lo), "v"(hi)); return r; }
__device__ __forceinline__ float bflo(unsigned w) { return __uint_as_float(w << 16); }
__device__ __forceinline__ float bfhi(unsigned w) { return __uint_as_float(w & 0xffff0000u); }
__device__ __forceinline__ float softplus_f(float x) { return x > 20.f ? x : log1pf(__expf(x)); }
__device__ __forceinline__ float sigmoid_f(float x) { return 1.f / (1.f + __expf(-x)); }
constexpr int MROWS_ = 16384;
template <int MODE> struct EpiX {
    static constexpr bool PERM = true, AFTER_DRAIN = false; static constexpr int MIDT = (MODE == 5) ? 16 : -1;
    bf16_t* O; int ldc; const float* bias; float* F32O; const bf16_t* Y; const bf16_t* Zp; float qscale;
    __device__ __forceinline__ void mid(f32x4 (&acc)[2][2][4][2], int wr, int fr, PG8_LAS unsigned char* lds) const {
        const PG8_LAS float* rs = (const PG8_LAS float*)(lds + 131072);
#pragma unroll
        for (int ai = 0; ai < 2; ++ai)
#pragma unroll
            for (int m = 0; m < 4; ++m) { const float r = rs[ai * HALF + wr * 64 + m * 16 + fr];
#pragma unroll
                for (int bj = 0; bj < 2; ++bj)
#pragma unroll
                    for (int n = 0; n < 2; ++n) acc[ai][bj][m][n] = acc[ai][bj][m][n] * r; }
    }
    __device__ __forceinline__ void operator()(const f32x4 (&acc)[2][2][4][2], const Unit& u, int wr, int wc, int fr, int fq) const {
        const int row0 = u.pm * BM + wr * 64 + fr; const int col0 = u.pn * BM + wc * 32 + 8 * fq;
        float sc = 1.f;
        if (MODE == 0) { if (u.pn >= 4 && u.pn < 8) sc = qscale; }
        if (MODE == 1) { if (u.pn < 6) sc = qscale; }
        const bool special = (MODE == 0 && u.pn == 26);
#pragma unroll
        for (int ai = 0; ai < 2; ++ai)
#pragma unroll
            for (int m = 0; m < 4; ++m) { const int row = row0 + ai * HALF + m * 16;
#pragma unroll
                for (int bj = 0; bj < 2; ++bj) { f32x4 v0 = acc[ai][bj][m][0], v1 = acc[ai][bj][m][1]; const int col = col0 + bj * HALF;
                    if (MODE == 0 || MODE == 1) {
                        if (!special) { v0 = v0 * sc; v1 = v1 * sc; u32x4 w; w.x = cvt_pk_bf16(v0[0], v0[1]); w.y = cvt_pk_bf16(v0[2], v0[3]); w.z = cvt_pk_bf16(v1[0], v1[1]); w.w = cvt_pk_bf16(v1[2], v1[3]);
                            *(u32x4*)(O + (size_t)row * ldc + col) = w; }
                        else { const int lc = col - u.pn * BM; const int NV = (MODE == 0) ? 16 : 24;
                            if (lc < NV) { f32x4 o0, o1;
#pragma unroll
                                for (int i = 0; i < 4; ++i) { const float a0 = v0[i] + bias[lc + i], a1 = v1[i] + bias[lc + 4 + i];
                                    if (MODE == 0) { o0[i] = softplus_f(a0); o1[i] = softplus_f(a1); } else { o0[i] = -softplus_f(-a0); o1[i] = -softplus_f(-a1); } }
                                *(f32x4*)(F32O + (size_t)row * NV + lc) = o0; *(f32x4*)(F32O + (size_t)row * NV + lc + 4) = o1; } }
                    } else if (MODE == 4) {
                        const int lc = col - u.pn * BM;
                        if (lc < 24) { float* dst = (u.pn == 0 ? F32O : (float*)((unsigned char*)Y + (size_t)(u.pn - 1) * (MROWS_ * 24 * 4))) + (size_t)row * 24 + lc; *(f32x4*)dst = v0; *(f32x4*)(dst + 4) = v1; }
                    } else if (MODE == 2 || MODE == 5) {
                        u32x4 w; w.x = cvt_pk_bf16(v0[0], v0[1]); w.y = cvt_pk_bf16(v0[2], v0[3]); w.z = cvt_pk_bf16(v1[0], v1[1]); w.w = cvt_pk_bf16(v1[2], v1[3]);
                        *(u32x4*)(O + (size_t)row * ldc + col) = w;
                    } else {
                        const u32x4 yv = *(const u32x4*)(Y + (size_t)row * 2048 + col); const u32x4 zv = *(const u32x4*)(Zp + (size_t)row * ldc + col);
                        const f32x4 b0 = *(const f32x4*)(bias + col), b1 = *(const f32x4*)(bias + col + 4);
                        float r[8];
#pragma unroll
                        for (int e = 0; e < 4; ++e) { const float y0 = bflo(yv[e]), y1 = bfhi(yv[e]), z0 = bflo(zv[e]), z1 = bfhi(zv[e]);
                            const float a0 = (e < 2 ? v0[2 * e] : v1[2 * e - 4]) + (e < 2 ? b0[2 * e] : b1[2 * e - 4]);
                            const float a1 = (e < 2 ? v0[2 * e + 1] : v1[2 * e - 3]) + (e < 2 ? b0[2 * e + 1] : b1[2 * e - 3]);
                            r[2 * e] = y0 * sigmoid_f(a0) * z0 * sigmoid_f(z0); r[2 * e + 1] = y1 * sigmoid_f(a1) * z1 * sigmoid_f(z1); }
                        u32x4 w; w.x = cvt_pk_bf16(r[0], r[1]); w.y = cvt_pk_bf16(r[2], r[3]); w.z = cvt_pk_bf16(r[4], r[5]); w.w = cvt_pk_bf16(r[6], r[7]);
                        *(u32x4*)(O + (size_t)row * ldc + col) = w;
                    } } }
    }
};
template <class Epi, class Sched, bool ALIGN_EPI = false, bool SP2 = false>
__device__ __forceinline__ void gemm_phase(PG8_LAS unsigned char* lds, const Gemm g, const Sched& S, const Epi& E) {
    const int tid = opaque_tid(), wid = __builtin_amdgcn_readfirstlane(tid >> 6), lane = tid & 63, wr = wid >> 2, wc = wid & 3, fr = lane & 15, fq = lane >> 4;
    const int K = g.K, nt = K / BK;
    unsigned voffA[2], voffB[2];
#pragma unroll
    for (int i = 0; i < 2; ++i) { int R, C; stage_rc(tid * 16 + i * 8192, R, C); const int Rb = Epi::PERM ? ((R & ~31) + perm32(R & 31)) : R;
        voffA[i] = (unsigned)(R * g.lda + C) * 2u; voffB[i] = (unsigned)(Rb * g.ldb + C) * 2u; }
    const size_t kstep = (size_t)(BK * 2);
    const size_t hstepA = (size_t)HALF * g.lda * 2, hstepB = (size_t)HALF * g.ldb * 2;
    const size_t tstepA = 2 * hstepA, tstepB = g.ksplit ? (size_t)K * 2 : 2 * hstepB, kslA = g.ksplit ? (size_t)K * 2 : 0;
    const unsigned ldsw = (unsigned)wid * 1024u;
    const int aoff = lds_byte(wr * 64 + fr, fq * 8), boff = lds_byte(wc * 32 + fr, fq * 8);
#define PG8_SA(b, h) (((b) * 2 + (h)) * HTB)
#define PG8_SB(b, h) ((4 + (b) * 2 + (h)) * HTB)
#define PG8_STAGE(bufoff, gbase, voff) do { _Pragma("unroll") for (int _i = 0; _i < 2; ++_i) \
        __builtin_amdgcn_global_load_lds((const unsigned*)((const char*)(gbase) + (voff)[_i]), (PG8_LAS unsigned*)(lds + (bufoff) + ldsw + _i * 8192), 16, 0, 0); } while (0)
#define PG8_LDA(dst, b, h) do { _Pragma("unroll") for (int m = 0; m < 4; ++m) _Pragma("unroll") for (int k = 0; k < 2; ++k) dst[m][k] = *(const PG8_LAS bf16x8*)(lds + PG8_SA(b, h) + aoff + m * 2048 + k * 1024); } while (0)
#define PG8_LDB(dst, b, h) do { _Pragma("unroll") for (int n = 0; n < 2; ++n) _Pragma("unroll") for (int k = 0; k < 2; ++k) dst[n][k] = *(const PG8_LAS bf16x8*)(lds + PG8_SB(b, h) + boff + n * 2048 + k * 1024); } while (0)
#define PG8_MMA(ai, bj, At, Bt) do { __builtin_amdgcn_s_setprio(1); _Pragma("unroll") for (int m = 0; m < 4; ++m) _Pragma("unroll") for (int n = 0; n < 2; ++n) _Pragma("unroll") for (int k = 0; k < 2; ++k) \
        acc[ai][bj][m][n] = __builtin_amdgcn_mfma_f32_16x16x32_bf16(Bt[n][k], At[m][k], acc[ai][bj][m][n], 0, 0, 0); __builtin_amdgcn_s_setprio(0); } while (0)
#define PG8_WAIT_V(n) asm volatile("s_waitcnt vmcnt(" #n ")" ::: "memory")
#define PG8_WAIT_L(n) asm volatile("s_waitcnt lgkmcnt(" #n ")" ::: "memory")
#define PG8_BAR __builtin_amdgcn_s_barrier()
#define PG8_SCHED __builtin_amdgcn_sched_barrier(0)
    Unit cur, nxt; int ui = 0;
    if (!S.next(0, cur)) return;
    f32x4 acc[2][2][4][2];
#pragma unroll
    for (int a = 0; a < 2; ++a)
#pragma unroll
        for (int b = 0; b < 2; ++b)
#pragma unroll
            for (int m = 0; m < 4; ++m)
#pragma unroll
                for (int n = 0; n < 2; ++n) acc[a][b][m][n] = (f32x4){0.f, 0.f, 0.f, 0.f};
    bf16x8 At[4][2], B0[2][2], B1[2][2];
    const char* cA = (const char*)g.A + (size_t)cur.pm * tstepA + (size_t)cur.pn * kslA; const char* cB = (const char*)g.Bt + (size_t)cur.pn * tstepB;
    S.a_ready(cur);
    if constexpr (SP2) {
        PG8_STAGE(PG8_SB(0, 0), cB, voffB); PG8_STAGE(PG8_SB(0, 1), cB + hstepB, voffB); PG8_STAGE(PG8_SA(0, 0), cA, voffA); PG8_STAGE(PG8_SA(0, 1), cA + hstepA, voffA);
        if (wr == 1) PG8_BAR;
        PG8_WAIT_V(2); PG8_BAR;
        PG8_STAGE(PG8_SB(1, 0), cB + kstep, voffB); PG8_STAGE(PG8_SA(1, 0), cA + kstep, voffA); PG8_STAGE(PG8_SB(1, 1), cB + hstepB + kstep, voffB);
        PG8_WAIT_V(6); PG8_BAR;
    } else {
        PG8_STAGE(PG8_SB(0, 0), cB, voffB); PG8_STAGE(PG8_SA(0, 0), cA, voffA); PG8_STAGE(PG8_SB(0, 1), cB + hstepB, voffB); PG8_STAGE(PG8_SA(0, 1), cA + hstepA, voffA);
        if (wr == 1) PG8_BAR;
        PG8_WAIT_V(4); PG8_BAR;
        PG8_STAGE(PG8_SB(1, 0), cB + kstep, voffB); PG8_STAGE(PG8_SA(1, 0), cA + kstep, voffA); PG8_STAGE(PG8_SB(1, 1), cB + hstepB + kstep, voffB);
        PG8_WAIT_V(6); PG8_BAR;
    }
    for (;;) {
        const bool has_next = S.next(ui + 1, nxt);
        const char* nA = has_next ? (const char*)g.A + (size_t)nxt.pm * tstepA + (size_t)nxt.pn * kslA : cA; const char* nB = has_next ? (const char*)g.Bt + (size_t)nxt.pn * tstepB : cB;
        for (int t = 0; t < nt; t += 2) {
            if constexpr (Epi::MIDT >= 0) { if (t == Epi::MIDT) E.mid(acc, wr, fr, lds); }
            const bool last = (t == nt - 2);
            const char* a1 = cA + (size_t)(t + 1) * kstep;
            const char* a2 = last ? nA : cA + (size_t)(t + 2) * kstep; const char* b2 = last ? nB : cB + (size_t)(t + 2) * kstep;
            const char* a3 = a2 + kstep; const char* b3 = b2 + kstep;
            if (last && has_next) S.a_ready(nxt);
            if constexpr (SP2) {
            PG8_LDB(B0, 0, 0); PG8_LDB(B1, 0, 1); PG8_SCHED; PG8_LDA(At, 0, 0); PG8_STAGE(PG8_SA(1, 1), a1 + hstepA, voffA);
            PG8_WAIT_V(8); PG8_WAIT_L(0); PG8_BAR; PG8_MMA(0, 0, At, B0); PG8_MMA(0, 1, At, B1); PG8_BAR; PG8_SCHED;
            PG8_LDA(At, 0, 1); PG8_STAGE(PG8_SB(0, 0), b2, voffB); PG8_STAGE(PG8_SB(0, 1), b2 + hstepB, voffB); PG8_STAGE(PG8_SA(0, 0), a2, voffA);
            PG8_WAIT_V(8); PG8_WAIT_L(0); PG8_BAR; PG8_MMA(1, 0, At, B0); PG8_MMA(1, 1, At, B1); PG8_BAR; PG8_SCHED;
            PG8_LDB(B0, 1, 0); PG8_LDB(B1, 1, 1); PG8_SCHED; PG8_LDA(At, 1, 0); PG8_STAGE(PG8_SA(0, 1), a2 + hstepA, voffA);
            PG8_WAIT_V(8); PG8_WAIT_L(0); PG8_BAR; PG8_MMA(0, 0, At, B0); PG8_MMA(0, 1, At, B1); PG8_BAR; PG8_SCHED;
            PG8_LDA(At, 1, 1); PG8_STAGE(PG8_SB(1, 0), b3, voffB); PG8_STAGE(PG8_SB(1, 1), b3 + hstepB, voffB); PG8_STAGE(PG8_SA(1, 0), a3, voffA);
            PG8_WAIT_V(8); PG8_WAIT_L(0); PG8_BAR; PG8_MMA(1, 0, At, B0); PG8_MMA(1, 1, At, B1); PG8_BAR; PG8_SCHED;
            } else {
            PG8_LDB(B0, 0, 0); PG8_SCHED; PG8_LDA(At, 0, 0); PG8_STAGE(PG8_SA(1, 1), a1 + hstepA, voffA);
            PG8_WAIT_L(8); PG8_BAR; PG8_WAIT_L(0); PG8_MMA(0, 0, At, B0); PG8_BAR; PG8_SCHED;
            PG8_LDB(B1, 0, 1); PG8_STAGE(PG8_SB(0, 0), b2, voffB);
            PG8_BAR; PG8_WAIT_L(0); PG8_MMA(0, 1, At, B1); PG8_BAR;
            PG8_LDA(At, 0, 1); PG8_STAGE(PG8_SA(0, 0), a2, voffA);
            PG8_BAR; PG8_WAIT_L(0); PG8_MMA(1, 0, At, B0); PG8_BAR; PG8_SCHED;
            PG8_STAGE(PG8_SB(0, 1), b2 + hstepB, voffB);
            PG8_WAIT_V(6); PG8_BAR; PG8_MMA(1, 1, At, B1); PG8_BAR;
            PG8_LDB(B0, 1, 0); PG8_SCHED; PG8_LDA(At, 1, 0); PG8_STAGE(PG8_SA(0, 1), a2 + hstepA, voffA);
            PG8_WAIT_L(8); PG8_BAR; PG8_WAIT_L(0); PG8_MMA(0, 0, At, B0); PG8_BAR; PG8_SCHED;
            PG8_LDB(B1, 1, 1); PG8_STAGE(PG8_SB(1, 0), b3, voffB);
            PG8_BAR; PG8_WAIT_L(0); PG8_MMA(0, 1, At, B1); PG8_BAR;
            PG8_LDA(At, 1, 1); PG8_STAGE(PG8_SA(1, 0), a3, voffA);
            PG8_BAR; PG8_WAIT_L(0); PG8_MMA(1, 0, At, B0); PG8_BAR; PG8_SCHED;
            PG8_STAGE(PG8_SB(1, 1), b3 + hstepB, voffB);
            PG8_WAIT_V(6); PG8_BAR; PG8_MMA(1, 1, At, B1); PG8_BAR;
            }
        }
        if constexpr (ALIGN_EPI) { if (wr == 0) PG8_BAR; }
        if constexpr (!Epi::AFTER_DRAIN) { E(acc, cur, wr, wc, fr, fq); S.done(cur); }
        if (!has_next) break;
#pragma unroll
        for (int a = 0; a < 2; ++a)
#pragma unroll
            for (int b = 0; b < 2; ++b)
#pragma unroll
                for (int m = 0; m < 4; ++m)
#pragma unroll
                    for (int n = 0; n < 2; ++n) acc[a][b][m][n] = (f32x4){0.f, 0.f, 0.f, 0.f};
        cur = nxt; cA = nA; cB = nB; ++ui;
        if constexpr (ALIGN_EPI) { if (wr == 1) PG8_BAR; }
    }
    PG8_WAIT_V(0);
    if constexpr (!ALIGN_EPI) { if (wr == 0) PG8_BAR; }
    PG8_BAR;
    if constexpr (Epi::AFTER_DRAIN) { E.fused(acc, cur, wr, wc, fr, fq, lds, wid, lane); S.done(cur); }
#undef PG8_SA
#undef PG8_SB
#undef PG8_STAGE
#undef PG8_LDA
#undef PG8_LDB
#undef PG8_MMA
#undef PG8_WAIT_V
#undef PG8_WAIT_L
#undef PG8_BAR
#undef PG8_SCHED
}
}

#include <hip/hip_bf16.h>
#include <cmath>
namespace attn_body {
using bf16=__hip_bfloat16;
using bf16x8=__attribute__((ext_vector_type(8)))short;
using s16x4=__attribute__((ext_vector_type(4)))short;
using f32x16=__attribute__((ext_vector_type(16)))float;
using u32x4=__attribute__((ext_vector_type(4)))unsigned;
constexpr int SEQ=2048,D=64;
constexpr int NW=8,QBLK=32,QB=QBLK*NW,KVBLK=64,NQB=SEQ/QB;
constexpr int ATTN_UNIT_ROWS=QB;
__device__ __forceinline__ int crow(int r,int hi){return (r&3)+8*(r>>2)+4*hi;}
#define SBAR() __builtin_amdgcn_sched_barrier(0)
__device__ __forceinline__ void cmask(f32x16&p0,f32x16&p1,int jb,int qrel,int hi){
  const float NEG=-INFINITY; int kb=64*jb+4*hi;
  #pragma unroll
  for(int r=0;r<16;++r){int kv=kb+(r&3)+8*(r>>2); if(kv>qrel)p0[r]=NEG; if(kv+32>qrel)p1[r]=NEG;}
}

constexpr int NSLOT=3, SLOTB=8192;
constexpr int LDS_K=0, LDS_V=NSLOT*SLOTB, LDS_WS=2*NSLOT*SLOTB, LDS_OST=LDS_WS+NW*64*4, LDS_BYTES=LDS_OST+NW*4096;
constexpr int XOFF=86016; constexpr float SENT=-30000.f; using f32x4=__attribute__((ext_vector_type(4)))float;
constexpr float C2=0.125f*1.4426950408889634f;
__device__ __forceinline__ void glds16(const void*gsrc,unsigned lds_dst){unsigned keep;
  asm volatile("s_mov_b32 %0, m0\n\ts_mov_b32 m0, %2\n\ts_nop 0\n\tglobal_load_lds_dwordx4 %1, off\n\ts_mov_b32 m0, %0":"=&s"(keep):"v"(gsrc),"s"(lds_dst):"memory");}
__device__ __forceinline__ float max3f(float a,float b,float c){float r;asm("v_max3_f32 %0, %1, %2, %3":"=v"(r):"v"(a),"v"(b),"v"(c));return r;}
__device__ __forceinline__ float max2f(float a,float b){float r;asm("v_max_f32_e32 %0, %1, %2":"=v"(r):"v"(a),"v"(b));return r;}
__device__ __forceinline__ float fadd_s(float a,float b){float r;asm("v_add_f32_e32 %0, %1, %2":"=v"(r):"v"(a),"v"(b));return r;}
__device__ __forceinline__ float fsub_s(float a,float b){float r;asm("v_sub_f32_e32 %0, %1, %2":"=v"(r):"v"(a),"v"(b));return r;}
typedef float f32x2_t __attribute__((ext_vector_type(2))); typedef __bf16 bf16x2_t __attribute__((ext_vector_type(2)));
__device__ __forceinline__ unsigned cvtpk_s(float lo,float hi){f32x2_t v={lo,hi};bf16x2_t b=__builtin_convertvector(v,bf16x2_t);return __builtin_bit_cast(unsigned,b);}
#define WAIT_BAR(N) asm volatile("s_waitcnt vmcnt(" #N ") lgkmcnt(0)\n\ts_barrier":::"memory")

__device__ __forceinline__ void qkt(f32x16&p0,f32x16&p1,const char*Kslot,const bf16x8*qr,const f32x16&negm,int r32,int hi){
  const char*kb=Kslot+hi*1024+r32*16;
  #pragma unroll
  for(int d0=0;d0<4;++d0){
    const bf16x8 b0=*reinterpret_cast<const bf16x8*>(kb+d0*2048);
    const bf16x8 b1=*reinterpret_cast<const bf16x8*>(kb+d0*2048+512);
    if(d0==0){p0=__builtin_amdgcn_mfma_f32_32x32x16_bf16(b0,qr[0],negm,0,0,0);p1=__builtin_amdgcn_mfma_f32_32x32x16_bf16(b1,qr[0],negm,0,0,0);}
    else{p0=__builtin_amdgcn_mfma_f32_32x32x16_bf16(b0,qr[d0],p0,0,0,0);p1=__builtin_amdgcn_mfma_f32_32x32x16_bf16(b1,qr[d0],p1,0,0,0);}}
}
typedef __attribute__((address_space(3))) const char* lds_cptr;
typedef short v4i16_t __attribute__((ext_vector_type(4)));
__device__ __forceinline__ void kload8(bf16x8*kf,lds_cptr kp){
  kf[0]=*(const __attribute__((address_space(3))) bf16x8*)(kp);      kf[1]=*(const __attribute__((address_space(3))) bf16x8*)(kp+512);
  kf[2]=*(const __attribute__((address_space(3))) bf16x8*)(kp+2048); kf[3]=*(const __attribute__((address_space(3))) bf16x8*)(kp+2560);
  kf[4]=*(const __attribute__((address_space(3))) bf16x8*)(kp+4096); kf[5]=*(const __attribute__((address_space(3))) bf16x8*)(kp+4608);
  kf[6]=*(const __attribute__((address_space(3))) bf16x8*)(kp+6144); kf[7]=*(const __attribute__((address_space(3))) bf16x8*)(kp+6656);
}
__device__ __forceinline__ void kload2(bf16x8*kf,lds_cptr kp,int j){ kf[2*j]=*(const __attribute__((address_space(3))) bf16x8*)(kp+j*2048); kf[2*j+1]=*(const __attribute__((address_space(3))) bf16x8*)(kp+j*2048+512); }
__device__ __forceinline__ s16x4 vtr(lds_cptr p){ return __builtin_bit_cast(s16x4,__builtin_amdgcn_ds_read_tr16_b64_v4i16((__attribute__((address_space(3))) v4i16_t*)p)); }
__device__ __forceinline__ float rowmax(const f32x16&p0,const f32x16&p1){
  float a=max3f(p0[0],p0[1],p1[0]),b=max3f(p0[2],p0[3],p1[1]);a=max3f(a,p1[2],p1[3]);
  #pragma unroll
  for(int r=4;r<16;r+=4){a=max3f(a,p0[r],p0[r+1]);b=max3f(b,p0[r+2],p0[r+3]);a=max3f(a,p1[r],p1[r+1]);b=max3f(b,p1[r+2],p1[r+3]);}
  const float m=max2f(a,b);
  auto rr=__builtin_amdgcn_permlane32_swap(__float_as_uint(m),__float_as_uint(m),false,false);
  return max2f(__uint_as_float(rr[0]),__uint_as_float(rr[1]));
}
__device__ __forceinline__ void pv(f32x16*o,int vb,bf16x8 pa0,bf16x8 pa1,bf16x8 pa2,bf16x8 pa3){
  #pragma unroll
  for(int d0=0;d0<2;++d0){s16x4 lo[4],hi[4];
    #pragma unroll
    for(int ks=0;ks<4;++ks){
      asm volatile("ds_read_b64_tr_b16 %0,%1 offset:%c2":"=&v"(lo[ks]):"v"(vb),"i"(d0*4096+ks*1024):"memory");
      asm volatile("ds_read_b64_tr_b16 %0,%1 offset:%c2":"=&v"(hi[ks]):"v"(vb),"i"(d0*4096+ks*1024+512):"memory");}
    asm volatile("s_waitcnt lgkmcnt(0)":::"memory");SBAR();
    #define PK(k) (bf16x8){lo[k][0],lo[k][1],lo[k][2],lo[k][3],hi[k][0],hi[k][1],hi[k][2],hi[k][3]}
    o[d0]=__builtin_amdgcn_mfma_f32_32x32x16_bf16(pa0,PK(0),o[d0],0,0,0);
    o[d0]=__builtin_amdgcn_mfma_f32_32x32x16_bf16(pa1,PK(1),o[d0],0,0,0);
    o[d0]=__builtin_amdgcn_mfma_f32_32x32x16_bf16(pa2,PK(2),o[d0],0,0,0);
    o[d0]=__builtin_amdgcn_mfma_f32_32x32x16_bf16(pa3,PK(3),o[d0],0,0,0);
    #undef PK
  }
}

#ifndef ATTN_STORE16
#define ATTN_STORE16(p,v) (*(u32x4*)(p)=(v))
#endif
template<int THRL,int MODE,int DM,bool DRY=false> __device__ __forceinline__ void attn_unit(int b,int h,int qb,const bf16*Q,const bf16*__restrict__ K,const bf16*__restrict__ V,bf16*O,const bf16*__restrict__ Z,const float*__restrict__ XP,const int*__restrict__ TS,volatile unsigned*lw,unsigned nxt,char*shm){
  const int tid=opaque_tid(),lane=tid&63,r32=lane&31,hi=lane>>5; const int wid=__builtin_amdgcn_readfirstlane(tid>>6);
  const long rowbase=(long)b*SEQ; const int q0=qb*QB;
  const bf16*Qw=Q+(rowbase+q0+wid*QBLK)*DM+h*D;
  bf16x8 qr[4];
  #pragma unroll
  for(int d0=0;d0<4;++d0)qr[d0]=*reinterpret_cast<const bf16x8*>(&Qw[(long)r32*DM+d0*16+hi*8]);
  const bf16*Kh=K+rowbase*DM+h*D,*Vh=V+rowbase*DM+h*D;
  const unsigned lds0=(unsigned)(uintptr_t)shm;
  float*wsf=(float*)(shm+LDS_WS)+wid*64;
  const bf16*ksrc_=Kh+(long)lane*DM+wid*8; int tskip=0; const bf16*ksrc=ksrc_;
  const bf16*vsrc_=Vh+(long)(16*(wid&3)+(lane>>2))*DM+(wid>>2)*32+(lane&3)*8; const bf16*vsrc=vsrc_;
  const unsigned kdst=lds0+LDS_K+wid*1024, vdst=lds0+LDS_V+wid*1024;
  #define DMA_K(t,slot) glds16(ksrc+(long)(t)*KVBLK*DM,(unsigned)__builtin_amdgcn_readfirstlane(kdst+(slot)))
  #define DMA_V(t,slot) glds16(vsrc+(long)(t)*KVBLK*DM,(unsigned)__builtin_amdgcn_readfirstlane(vdst+(slot)))
  const int vb0=(int)(lds0+LDS_V)+((lane>>4)&1)*32+(lane&3)*8+(4*hi+((lane&15)>>2))*64;
  const char*Kbase=shm+LDS_K; bf16x8 kf[8];
  const lds_cptr shm3=(lds_cptr)shm; const lds_cptr kp0=shm3+LDS_K+hi*1024+r32*16; const lds_cptr vp0=shm3+LDS_V+((lane>>4)&1)*32+(lane&3)*8+(4*hi+((lane&15)>>2))*64;
  int NT=(q0+QB)/KVBLK;
  const int qrel=wid*QBLK+r32;
  unsigned sel=0u;
  if constexpr(MODE==1){
    tskip=__builtin_amdgcn_readfirstlane(TS[qb]);
    ksrc=ksrc_+(long)tskip*KVBLK*DM; vsrc=vsrc_+(long)tskip*KVBLK*DM; NT-=tskip;
  }
  const lds_cptr fsl=(lds_cptr)shm+XOFF+16*hi+tskip*256;
  #define XMASK(P0,P1,t) do{ if constexpr(MODE==0){ if((t)<NT-4){ const bool keep_=(sel>>((t)>>2))&1u; \
        _Pragma("unroll") for(int r=0;r<16;++r){P0[r]=keep_?P0[r]:SENT;P1[r]=keep_?P1[r]:SENT;} } } \
      else { const lds_cptr fp_=fsl+(t)*256; const float mh_=mhat; \
        _Pragma("unroll") for(int g_=0;g_<4;++g_){ const f32x4 fa_=*(const __attribute__((address_space(3))) f32x4*)(fp_+g_*32)+mh_; const f32x4 fb_=*(const __attribute__((address_space(3))) f32x4*)(fp_+128+g_*32)+mh_; \
          _Pragma("unroll") for(int i_=0;i_<4;++i_){P0[4*g_+i_]-=fa_[i_];P1[4*g_+i_]-=fb_[i_];} } } }while(0)
  DMA_K(0,0);DMA_V(0,0);DMA_K(1,SLOTB);
  float mhat=0.f,l_reg=0.f;f32x16 o[2];o[0]=f32x16{};o[1]=f32x16{};f32x16 negm=f32x16{}; if constexpr(MODE==0){asm volatile("":"+v"(negm));}
  #define CMASK(P0,P1,t) do{int jb_=(t)-(NT-4); if(jb_>=0)cmask(P0,P1,jb_,qrel,hi);}while(0)
  const f32x16 czero_=f32x16{};
  #define NEGM (MODE==1?czero_:negm)
  bool resc=false;
  #define START(P0,P1) do{ const float rm=rowmax(P0,P1); resc=false; \
    { const float dl=rm; mhat=fadd_s(mhat,dl); \
      _Pragma("unroll") for(int r=0;r<16;++r){P0[r]=fsub_s(P0[r],dl);P1[r]=fsub_s(P1[r],dl);} \
      if constexpr(MODE==0){ _Pragma("unroll") for(int r=0;r<16;++r)negm[r]=-mhat; asm volatile("":"+v"(negm)); } } \
    _Pragma("unroll") for(int r=0;r<16;++r)P0[r]=__builtin_amdgcn_exp2f(P0[r]); }while(0)
  #define RESC() do{ if(resc){ asm volatile("s_waitcnt lgkmcnt(0)":::"memory"); \
      _Pragma("unroll") for(int d_=0;d_<2;++d_) _Pragma("unroll") for(int r=0;r<16;++r)o[d_][r]*=wsf[crow(r,hi)]; } }while(0)
  f32x16 pA0,pA1,pB0,pB1;
  int sl_prev=0,sl_cur=0,sl_next=SLOTB;
  #define ROT() do{sl_prev=sl_cur;sl_cur=sl_next;sl_next=(sl_next==(NSLOT-1)*SLOTB)?0:sl_next+SLOTB;}while(0)
  DMA_K(2,2*SLOTB);
  if constexpr(MODE==1){ float*fs=(float*)(shm+XOFF); for(int i=tid+64*tskip;i<q0+QB;i+=NW*64)fs[i]=XP[i]; }
  if constexpr(MODE==0){
    float*kbs=(float*)(shm+XOFF); unsigned*sm=(unsigned*)(shm+XOFF+2048);
    kbs[tid]=XP[tid];
    asm volatile("s_waitcnt vmcnt(0) lgkmcnt(0)\n\ts_barrier":::"memory");
    if(tid<QB){ unsigned m=(1u<<qb)-1u;
      if(qb>3){ const bf16*qp=Q+(rowbase+q0+tid)*DM+h*D; float g[8];
        _Pragma("unroll") for(int n=0;n<8;++n)g[n]=0.f;
        _Pragma("unroll") for(int c=0;c<8;++c){ const bf16x8 qv=*reinterpret_cast<const bf16x8*>(qp+c*8);
          _Pragma("unroll") for(int j=0;j<8;++j){ const float qf=__uint_as_float(((unsigned)(unsigned short)qv[j])<<16);
            _Pragma("unroll") for(int n=0;n<8;++n)g[n]+=qf*kbs[n*64+c*8+j]; } }
        m=0u;
        _Pragma("unroll") for(int it=0;it<3;++it){ float best=-INFINITY; int bi=0;
          _Pragma("unroll") for(int n=0;n<8;++n){ const bool ok=(n<qb)&&!((m>>n)&1u)&&(g[n]>best); best=ok?g[n]:best; bi=ok?n:bi; }
          m|=1u<<bi; } }
      sm[tid]=m; }
    asm volatile("s_waitcnt vmcnt(0) lgkmcnt(0)\n\ts_barrier":::"memory");
    sel=sm[qrel];
  }
  WAIT_BAR(3);
  qkt(pA0,pA1,Kbase,qr,NEGM,r32,hi);asm volatile("s_nop 15\n\ts_nop 7":"+v"(pA0),"+v"(pA1));XMASK(pA0,pA1,0);CMASK(pA0,pA1,0);
  START(pA0,pA1);
  _Pragma("unroll") for(int r=0;r<16;++r)pA1[r]=__builtin_amdgcn_exp2f(pA1[r]);
  WAIT_BAR(0);
  DMA_K(3,0);DMA_V(1,SLOTB);
  ROT();
  kload8(kf,kp0+sl_cur);
  WAIT_BAR(2);
  s16x4 vlo[8],vhi[8]; u32x4 pw0,pw1,pw2,pw3;
  #define PKW(P,B) cvtpk_s(P[B],P[B+1])
  #define PAF(k) __builtin_bit_cast(bf16x8,pw##k)
  #define VFR(i) (bf16x8){vlo[i][0],vlo[i][1],vlo[i][2],vlo[i][3],vhi[i][0],vhi[i][1],vhi[i][2],vhi[i][3]}
  #define PIN(x) asm volatile("":"+v"(x))
  #define MX3(a,b,c) __builtin_fmaxf(__builtin_fmaxf((a),(b)),(c))
  #define GAPA(MF,A0,A1,A2,A3,W0,W1,PW) do{ MF; sacc+=A0; sacc+=A1; sacc+=A2; sacc+=A3; PIN(sacc); W0; W1; PIN(PW); SBAR(); }while(0)
  #define EX(v) __builtin_amdgcn_exp2f(v)
  #define GAPB(MF,X,B) do{ MF; X[B]=EX(X[B]); X[B+1]=EX(X[B+1]); X[B+2]=EX(X[B+2]); X[B+3]=EX(X[B+3]); PIN(X); SBAR(); }while(0)
  #define VRD(i) do{ vlo[i]=vtr(vp_+(((i)>>2)*4096+((i)&3)*1024)); vhi[i]=vtr(vp_+(((i)>>2)*4096+((i)&3)*1024+512)); }while(0)
  #define KRD(G,j) do{ if(G){ kload2(kf,kp0+sl_next,j); SBAR(); } }while(0)
  #define STEP(C0,C1,P0,P1,t,GK,GV,GL) do{ SBAR(); \
    const lds_cptr vp_=vp0+sl_prev; \
    VRD(0); SBAR(); float sacc=(P0[0]+P0[1]); \
    GAPA(C0=__builtin_amdgcn_mfma_f32_32x32x16_bf16(kf[0],qr[0],NEGM,0,0,0), P0[2],P0[3],P0[4],P0[5],     pw0[0]=PKW(P0,0), pw0[1]=PKW(P0,2), pw0); \
    VRD(4); SBAR(); GAPA(C1=__builtin_amdgcn_mfma_f32_32x32x16_bf16(kf[1],qr[0],NEGM,0,0,0), P0[6],P0[7],P0[8],P0[9],     pw0[2]=PKW(P0,4), pw0[3]=PKW(P0,6), pw0); \
    VRD(1); SBAR(); GAPA(C0=__builtin_amdgcn_mfma_f32_32x32x16_bf16(kf[2],qr[1],C0,0,0,0),   P0[10],P0[11],P0[12],P0[13], pw1[0]=PKW(P0,8), pw1[1]=PKW(P0,10), pw1); \
    VRD(5); SBAR(); GAPA(C1=__builtin_amdgcn_mfma_f32_32x32x16_bf16(kf[3],qr[1],C1,0,0,0),   P0[14],P0[15],P1[0],P1[1],   pw1[2]=PKW(P0,12),pw1[3]=PKW(P0,14), pw1); \
    VRD(2); SBAR(); GAPA(C0=__builtin_amdgcn_mfma_f32_32x32x16_bf16(kf[4],qr[2],C0,0,0,0),   P1[2],P1[3],P1[4],P1[5],     pw2[0]=PKW(P1,0), pw2[1]=PKW(P1,2), pw2); \
    VRD(6); SBAR(); GAPA(C1=__builtin_amdgcn_mfma_f32_32x32x16_bf16(kf[5],qr[2],C1,0,0,0),   P1[6],P1[7],P1[8],P1[9],     pw2[2]=PKW(P1,4), pw2[3]=PKW(P1,6), pw2); \
    VRD(3); SBAR(); GAPA(C0=__builtin_amdgcn_mfma_f32_32x32x16_bf16(kf[6],qr[3],C0,0,0,0),   P1[10],P1[11],P1[12],P1[13], pw3[0]=PKW(P1,8), pw3[1]=PKW(P1,10), pw3); \
    VRD(7); SBAR(); GAPA(C1=__builtin_amdgcn_mfma_f32_32x32x16_bf16(kf[7],qr[3],C1,0,0,0),   P1[14],P1[15],0.f,0.f,       pw3[2]=PKW(P1,12),pw3[3]=PKW(P1,14), pw3); \
    l_reg+=sacc; \
    if(GK){DMA_K((t)+3,sl_cur);} if(GV){DMA_V((t)+1,sl_next);} \
    XMASK(C0,C1,t); CMASK(C0,C1,t); \
    { float a=MX3(C0[0],C0[1],C1[0]),b=MX3(C0[2],C0[3],C1[1]); a=MX3(a,C1[2],C1[3]); \
      _Pragma("unroll") for(int r=4;r<16;r+=4){a=MX3(a,C0[r],C0[r+1]);b=MX3(b,C0[r+2],C0[r+3]);a=MX3(a,C1[r],C1[r+1]);b=MX3(b,C1[r+2],C1[r+3]);} \
      float rm=__builtin_fmaxf(a,b); { auto rr=__builtin_amdgcn_permlane32_swap(__float_as_uint(rm),__float_as_uint(rm),false,false); rm=__builtin_fmaxf(__uint_as_float(rr[0]),__uint_as_float(rr[1])); } \
      resc=false; \
      if(__builtin_expect(__any(rm>(float)THRL),0)){ const float dl=__builtin_fmaxf(rm,0.f); mhat+=dl; \
        _Pragma("unroll") for(int r=0;r<16;++r){C0[r]-=dl;C1[r]-=dl;} \
        if constexpr(MODE==0){ _Pragma("unroll") for(int r=0;r<16;++r)negm[r]=-mhat; asm volatile("":"+v"(negm)); } \
        const float f=__builtin_amdgcn_exp2f(-dl); l_reg*=f; if(hi==0)wsf[r32]=f; resc=true; } } \
    SBAR(); \
    GAPB(o[0]=__builtin_amdgcn_mfma_f32_32x32x16_bf16(PAF(0),VFR(0),o[0],0,0,0), C0,0); \
    GAPB(o[1]=__builtin_amdgcn_mfma_f32_32x32x16_bf16(PAF(0),VFR(4),o[1],0,0,0), C0,4); \
    KRD(GL,0); GAPB(o[0]=__builtin_amdgcn_mfma_f32_32x32x16_bf16(PAF(1),VFR(1),o[0],0,0,0), C0,8); \
    KRD(GL,1); GAPB(o[1]=__builtin_amdgcn_mfma_f32_32x32x16_bf16(PAF(1),VFR(5),o[1],0,0,0), C0,12); \
    KRD(GL,2); GAPB(o[0]=__builtin_amdgcn_mfma_f32_32x32x16_bf16(PAF(2),VFR(2),o[0],0,0,0), C1,0); \
    KRD(GL,3); GAPB(o[1]=__builtin_amdgcn_mfma_f32_32x32x16_bf16(PAF(2),VFR(6),o[1],0,0,0), C1,4); \
    GAPB(o[0]=__builtin_amdgcn_mfma_f32_32x32x16_bf16(PAF(3),VFR(3),o[0],0,0,0), C1,8); \
    GAPB(o[1]=__builtin_amdgcn_mfma_f32_32x32x16_bf16(PAF(3),VFR(7),o[1],0,0,0), C1,12); \
    }while(0)
  int t=1;
  #undef CMASK
  #define CMASK(P0,P1,t) do{}while(0)
  for(;t+5<NT;t+=2){
    STEP(pB0,pB1,pA0,pA1,t,true,true,true);     WAIT_BAR(2); RESC(); ROT();
    STEP(pA0,pA1,pB0,pB1,t+1,true,true,true);   WAIT_BAR(2); RESC(); ROT();
  }
  #undef CMASK
  #define CMASK(P0,P1,t) do{int jb_=(t)-(NT-4); if(jb_>=0)cmask(P0,P1,jb_,qrel,hi);}while(0)
  #define ENDW(tt) do{ if((tt)+3<NT){WAIT_BAR(2);} else if((tt)+2<NT){WAIT_BAR(1);} else {WAIT_BAR(0);} }while(0)
  for(;t+1<NT;t+=2){
    STEP(pB0,pB1,pA0,pA1,t,(t+3<NT),(t+1<NT),(t+1<NT));       ENDW(t);   RESC(); ROT();
    STEP(pA0,pA1,pB0,pB1,t+1,(t+4<NT),(t+2<NT),(t+2<NT));     ENDW(t+1); RESC(); ROT();
  }
  STEP(pB0,pB1,pA0,pA1,NT-1,false,false,false); RESC();
  const bf16*Zw=Z+(rowbase+q0+wid*QBLK)*DM+h*D; u32x4 zpre[4];
  #pragma unroll
  for(int i=0;i<4;++i)zpre[i]=*(const u32x4*)(Zw+(long)(i*8+(lane>>3))*DM+(lane&7)*8);
  { float sacc=pB0[0]+pB0[1]; _Pragma("unroll") for(int r=2;r<16;++r)sacc+=pB0[r]; _Pragma("unroll") for(int r=0;r<16;++r)sacc+=pB1[r]; l_reg+=sacc;
    pw0=(u32x4){PKW(pB0,0),PKW(pB0,2),PKW(pB0,4),PKW(pB0,6)};pw1=(u32x4){PKW(pB0,8),PKW(pB0,10),PKW(pB0,12),PKW(pB0,14)};pw2=(u32x4){PKW(pB1,0),PKW(pB1,2),PKW(pB1,4),PKW(pB1,6)};pw3=(u32x4){PKW(pB1,8),PKW(pB1,10),PKW(pB1,12),PKW(pB1,14)};
    SBAR(); pv(o,vb0+sl_cur,PAF(0),PAF(1),PAF(2),PAF(3)); }
  #undef PKW
  #undef PAF
  #undef VFR
  #undef PIN
  #undef MX3
  #undef GAPA
  #undef GAPB
  #undef EX
  #undef VRD
  #undef KRD
  #undef STEP
  #undef ENDW
  if(lw!=nullptr&&tid==0)lw[0]=nxt;
  {auto rr=__builtin_amdgcn_permlane32_swap(__float_as_uint(l_reg),__float_as_uint(l_reg),false,false);l_reg=__uint_as_float(rr[0])+__uint_as_float(rr[1]);}
  if(hi==0)wsf[32+r32]=l_reg;asm volatile("s_waitcnt lgkmcnt(0)":::"memory");
  float rli[16];
  #pragma unroll
  for(int r=0;r<16;++r)rli[r]=__builtin_amdgcn_rcpf(wsf[32+crow(r,hi)]);
  bf16*Ow=O+(rowbase+q0+wid*QBLK)*DM+h*D;
  { bf16*stg=(bf16*)(shm+LDS_OST)+wid*2048;
    #pragma unroll
    for(int r=0;r<16;++r){const int orow=crow(r,hi);
      #pragma unroll
      for(int d0=0;d0<2;++d0)stg[orow*64+d0*32+r32]=__float2bfloat16(o[d0][r]*rli[r]);}
    asm volatile("s_waitcnt lgkmcnt(0)":::"memory");
    #pragma unroll
    for(int i=0;i<4;++i){const int row=i*8+(lane>>3),ch=lane&7; const u32x4 v=*(const u32x4*)(stg+row*64+ch*8); const u32x4 zv=zpre[i]; u32x4 ov;
      #pragma unroll
      for(int e=0;e<4;++e){ const float o0=__uint_as_float(v[e]<<16),o1=__uint_as_float(v[e]&0xffff0000u),z0=__uint_as_float(zv[e]<<16),z1=__uint_as_float(zv[e]&0xffff0000u);
        ov[e]=cvtpk_s(o0*z0/(1.f+__expf(-z0)),o1*z1/(1.f+__expf(-z1))); }
      if(!DRY||ov[0]==0x7fc12345u)ATTN_STORE16(Ow+(long)row*DM+ch*8,ov);} }
  asm volatile("s_waitcnt lgkmcnt(0)\n\ts_barrier":::"memory");
  #undef DMA_K
  #undef DMA_V
  #undef CMASK
  #undef XMASK
  #undef NEGM
  #undef START
  #undef RESC
  #undef ROT
}
constexpr int ATTN_LDS_BYTES=LDS_BYTES;
#undef SBAR
#undef WAIT_BAR
}
constexpr int NWAVES = 8, NTHR = 512;
constexpr int NB = 8, SEQL = 2048, DMOD = 1024, MROWS = NB * SEQL;
constexpr int LD0 = 6656, NP0 = 6912, LD1 = 7168, NP1 = 7424;
constexpr int C0_ZA = 0, C0_Q = 1024, C0_ZB = 2048, C0_XBC = 3072, C0_K = 4608, C0_V = 5632;
constexpr int C1_Q = 0, C1_U = 1536, C1_K = 2048, C1_V = 3584, C1_ZC = 5120, C1_ZD = 6656;
constexpr float RMS_EPS = 1e-6f, LOG2E = 1.4426950408889634f;
constexpr size_t MiB = 1u << 20;
constexpr int KS = 8;
constexpr size_t WS_MODP = 0;
constexpr size_t WS_SSQ = 2 * MiB;
constexpr size_t WS_KBAR = 2 * MiB + 65536;
constexpr size_t WS_DT = 3 * MiB;
constexpr size_t WS_LF = 4 * MiB;
constexpr size_t WS_F2 = 6 * MiB;
constexpr size_t WS_S5P = 7 * MiB + 512 * 1024;
constexpr int S5P_STRIDE = 8704;
constexpr size_t WS_WT1 = 8 * MiB;
constexpr size_t WS_WO1 = WS_WT1 + (size_t)NP1 * 1024 * 2;
constexpr size_t WS_WG = WS_WO1 + 4 * MiB;
constexpr size_t WS_BIG = 27 * MiB;
constexpr size_t WS_WT0 = WS_BIG + (size_t)MROWS * LD0 * 2;
constexpr size_t WS_WO0 = WS_WT0 + (size_t)NP0 * 1024 * 2;
constexpr size_t WS_LFP = 251 * MiB;
constexpr size_t WS_END = WS_WO0 + 4 * MiB;
static_assert(WS_WG + 512 * 1024 <= WS_BIG && WS_END <= 256 * MiB && WS_BIG + (size_t)MROWS * LD1 * 2 <= 256 * MiB, "ws map");
constexpr int LDS_BYTES = 147456;
constexpr size_t WS_CNT = 1835008 + 3584 * 4, WS_UB = 1835008 + 32768, WS_TS = 1835008 + 32768 + 1024;
constexpr size_t WS_BAR = 1835008;
constexpr int BARST_OFF = 132608;

typedef unsigned short bf16;
typedef unsigned v4u __attribute__((ext_vector_type(4)));
typedef unsigned v2u __attribute__((ext_vector_type(2)));
typedef float f32x4 __attribute__((ext_vector_type(4)));
typedef short bf16x8 __attribute__((ext_vector_type(8)));
typedef float f32x16 __attribute__((ext_vector_type(16)));
typedef float f32x2_c __attribute__((ext_vector_type(2))); typedef __bf16 bf16x2_c __attribute__((ext_vector_type(2)));
__device__ __forceinline__ unsigned pk2(float lo, float hi) { f32x2_c v = {lo, hi}; return __builtin_bit_cast(unsigned, __builtin_convertvector(v, bf16x2_c)); }
__device__ __forceinline__ unsigned f2bf(float f) { return pk2(f, f) & 0xffffu; }
__device__ __forceinline__ float bf2f(unsigned short h) { return __uint_as_float(((unsigned)h) << 16); }
template <int CTRL> __device__ __forceinline__ float dppf(float old, float src) { return __builtin_bit_cast(float, __builtin_amdgcn_update_dpp(__builtin_bit_cast(int, old), __builtin_bit_cast(int, src), CTRL, 0xF, 0xF, false)); }
__device__ __forceinline__ float row_sum16(float v) { v += dppf<0xB1>(v, v); v += dppf<0x4E>(v, v); v += dppf<0x141>(v, v); v += dppf<0x140>(v, v); return v; }
__device__ __forceinline__ float rdlane(float v, int l) { return __builtin_bit_cast(float, __builtin_amdgcn_readlane(__builtin_bit_cast(int, v), l)); }
__device__ __forceinline__ float wave_sum(float v) { v = row_sum16(v); return (rdlane(v, 0) + rdlane(v, 16)) + (rdlane(v, 32) + rdlane(v, 48)); }
__device__ __forceinline__ float wave_scan(float x, int lane) {
    x += dppf<0x111>(0.f, x); x += dppf<0x112>(0.f, x); x += dppf<0x114>(0.f, x); x += dppf<0x118>(0.f, x);
    const float t0 = rdlane(x, 15), t1 = rdlane(x, 31), t2 = rdlane(x, 47); const int rw = lane >> 4;
    return x + (rw == 0 ? 0.f : (rw == 1 ? t0 : (rw == 2 ? t0 + t1 : (t0 + t1) + t2)));
}
__device__ __forceinline__ float silu_f(float x) { return x / (1.f + __expf(-x)); }
__device__ __forceinline__ float softplus_g(float x) { return x > 20.f ? x : log1pf(__expf(x)); }

struct Args {
    const float* in[27]; float* out; unsigned char* ws;
};
enum { I_X = 0, I_C, I_ADAW, I_ADAB, I_PREG, I_POSTG, I_EINW, I_ECONVW, I_ECONVB, I_EDTB, I_EALOG, I_EDSKIP, I_ENORMG, I_EOUTW,
       I_OINW, I_OFGB, I_OLRE, I_OLIM, I_OLDT, I_OBRE, I_OBIM, I_OCRE, I_OCIM, I_ODSKIP, I_OGLUW, I_OGLUB, I_OOUTW };

__device__ __forceinline__ int src_col0(int n) {
    if (n < 1024) return n;
    if (n < 2048) return 3600 + (n - 1024);
    if (n < 3072) return 1024 + (n - 2048);
    if (n < 4608) return 2048 + (n - 3072);
    if (n < 5632) return 4624 + (n - 4608);
    if (n < 6656) return 5648 + (n - 5632);
    if (n < 6672) return 3584 + (n - 6656);
    return -1;
}
__device__ __forceinline__ int src_col1(int n) {
    if (n < 1536) return 2048 + n;
    if (n < 2048) return 6680 + (n - 1536);
    if (n < 3584) return 3584 + (n - 2048);
    if (n < 5120) return 5120 + (n - 3584);
    if (n < 6656) return n - 5120;
    if (n < 7168) return 1536 + (n - 6656);
    if (n < 7192) return 6656 + (n - 7168);
    return -1;
}
template <int MAP> __device__ __forceinline__ void transpose_item(const float* __restrict__ W, int K, int NSRC, int NDST, bf16* WT, float* scr, int item, int lane, const float* __restrict__ kscale = nullptr) {
    const int nblk = NDST / 32, kb = item / nblk, nb = item % nblk, k0 = 64 * kb, n0 = 32 * nb;
    const int nn = n0 + (lane & 31); const int sc = MAP == 0 ? src_col0(nn) : (MAP == 1 ? src_col1(nn) : nn);
    float tv[32];
#pragma unroll
    for (int i = 0; i < 32; ++i) { const int kk = 2 * i + (lane >> 5); tv[i] = sc >= 0 ? __builtin_nontemporal_load(&W[(size_t)(k0 + kk) * NSRC + sc]) : 0.f; if (kscale && k0 + kk < 1024) tv[i] *= kscale[k0 + kk]; }
#pragma unroll
    for (int i = 0; i < 32; ++i) { const int kk = 2 * i + (lane >> 5); scr[kk * 33 + (lane & 31)] = tv[i]; }
    asm volatile("s_waitcnt lgkmcnt(0)" ::: "memory");
    const int c = lane & 7;
#pragma unroll
    for (int j = 0; j < 4; ++j) { const int n = (lane >> 3) + 8 * j; const float* s = scr + (8 * c) * 33 + n;
        v4u o; o.x = pk2(s[0 * 33], s[1 * 33]); o.y = pk2(s[2 * 33], s[3 * 33]); o.z = pk2(s[4 * 33], s[5 * 33]); o.w = pk2(s[6 * 33], s[7 * 33]);
        *(v4u*)(WT + (size_t)(n0 + n) * K + k0 + 8 * c) = o; }
    asm volatile("s_waitcnt lgkmcnt(0)" ::: "memory");
}

__device__ __forceinline__ float mod_val(const float* modp, const float* adab, int l, int b, int j) {
    float s = adab[l * 3072 + j];
#pragma unroll
    for (int kc = 0; kc < KS; ++kc) s += modp[((size_t)(kc * 2 + l) * 8 + b) * 3072 + j];
    return s;
}

__device__ __forceinline__ void p0_prologue(const Args& A, char* lds, int vcu, int G) {
    const int tid = opaque_tid(), lane = tid & 63, wave = tid >> 6;
    unsigned char* ws = A.ws;
    float* scr = (float*)(lds + wave * 16384);
    const int gw = vcu * NWAVES + wave, NGW = G * NWAVES;
    constexpr int I0 = 16 * (NP0 / 32), I1 = 16 * (NP1 / 32), IO = 32 * 32, IG = 8 * 16;
    constexpr int NITEMS = I0 + I1 + 2 * IO + IG;
    for (int it = gw; it < NITEMS; it += NGW) {
        int r = it;
        if (r < I0) { transpose_item<0>(A.in[I_EINW], 1024, 6672, NP0, (bf16*)(ws + WS_WT0), scr, r, lane); continue; } r -= I0;
        if (r < I1) { transpose_item<1>(A.in[I_OINW], 1024, 7192, NP1, (bf16*)(ws + WS_WT1), scr, r, lane); continue; } r -= I1;
        if (r < IO) { transpose_item<2>(A.in[I_EOUTW], 2048, 1024, 1024, (bf16*)(ws + WS_WO0), scr, r, lane, G == 256 ? A.in[I_ENORMG] : nullptr); continue; } r -= IO;
        if (r < IO) { transpose_item<2>(A.in[I_OOUTW], 2048, 1024, 1024, (bf16*)(ws + WS_WO1), scr, r, lane); continue; } r -= IO;
        transpose_item<2>(A.in[I_OGLUW], 512, 512, 512, (bf16*)(ws + WS_WG), scr, r, lane);
    }
    __syncthreads();
    float* sc = (float*)lds;
    float* modp = (float*)(ws + WS_MODP);
    for (int item = blockIdx.x; item < 2 * KS * 6; item += G) {
        const int l = item / (KS * 6), r = item % (KS * 6), kc = r / 6, cb = r % 6;
        __syncthreads();
        for (int i = tid; i < 1024; i += NTHR) { const int b = i >> 7, k = i & 127; const float cv = A.in[I_C][b * 1024 + kc * 128 + k]; sc[i] = silu_f(cv); }
        __syncthreads();
        const int col = cb * 512 + tid; float acc[8];
#pragma unroll
        for (int b = 0; b < 8; ++b) acc[b] = 0.f;
        const float* wp = A.in[I_ADAW] + ((size_t)l * 1024 + kc * 128) * 3072 + col;
#pragma unroll 16
        for (int k = 0; k < 128; ++k) { const float w = __builtin_nontemporal_load(&wp[(size_t)k * 3072]);
#pragma unroll
            for (int b = 0; b < 8; ++b) acc[b] += sc[b * 128 + k] * w; }
#pragma unroll
        for (int b = 0; b < 8; ++b) modp[((size_t)(kc * 2 + l) * 8 + b) * 3072 + col] = acc[b];
    }
    const int gt = blockIdx.x * NTHR + tid;
    const int gs = (G >= 128 ? ((int)blockIdx.x - (G - 32)) * 64 + tid : gt);
    if (gs >= 0 && gs < 2048 && (G < 128 || tid < 64)) {
        const int g = gs >> 6, n = gs & 63;
        const float dt = __expf(A.in[I_OLDT][g]);
        const float lr = A.in[I_OLRE][g * 64 + n], li = A.in[I_OLIM][g * 64 + n];
        const float mag = expf(lr * dt); float sn, cs; sincosf(li * dt, &sn, &cs);
        const float ar = mag * cs, ai = mag * sn, den = lr * lr + li * li;
        const float qr = ((ar - 1.f) * lr + ai * li) / den, qi = (ai * lr - (ar - 1.f) * li) / den;
        unsigned char* pg = ws + WS_S5P + (size_t)g * S5P_STRIDE;
        bf16* BbT = (bf16*)pg; bf16* Cm = (bf16*)(pg + 4096); float* ari = (float*)(pg + 8192);
        ari[n] = ar; ari[64 + n] = ai;
        for (int c = 0; c < 16; ++c) { const float br = A.in[I_OBRE][(g * 64 + n) * 16 + c], bi = A.in[I_OBIM][(g * 64 + n) * 16 + c];
            BbT[(2 * n) * 16 + c] = (bf16)f2bf(qr * br - qi * bi); BbT[(2 * n + 1) * 16 + c] = (bf16)f2bf(qr * bi + qi * br);
            Cm[c * 128 + 2 * n] = (bf16)f2bf(A.in[I_OCRE][(g * 16 + c) * 64 + n]); Cm[c * 128 + 2 * n + 1] = (bf16)f2bf(-A.in[I_OCIM][(g * 16 + c) * 64 + n]); }
    }
    float* ssq = (float*)(ws + WS_SSQ);
    for (int i = gt; i < MROWS; i += G * NTHR) ssq[i] = 0.f;
}

__device__ __forceinline__ void p1a_rows(const Args& A, char* lds, int G) {
    const int tid = opaque_tid(), lane = tid & 63, wave = tid >> 6;
    const float* modp = (const float*)(A.ws + WS_MODP); float* mv = (float*)lds;
    for (int rb = blockIdx.x; rb < MROWS / 64; rb += G) {
        const int b = rb >> 5;
        __syncthreads();
#pragma unroll 1
        for (int col = tid; col < 1024; col += NTHR) { mv[col] = A.in[I_PREG][col] * (1.f + mod_val(modp, A.in[I_ADAB], 0, b, 1024 + col)); mv[1024 + col] = mod_val(modp, A.in[I_ADAB], 0, b, col); }
        __syncthreads();
        f32x4 mul[4], add[4];
#pragma unroll
        for (int j = 0; j < 4; ++j) { mul[j] = *(const f32x4*)(mv + 4 * lane + 256 * j); add[j] = *(const f32x4*)(mv + 1024 + 4 * lane + 256 * j); }
        f32x4 nx[4];
        { const f32x4* xr = (const f32x4*)(A.in[I_X] + (size_t)(rb * 64 + wave * 8) * DMOD) + lane;
#pragma unroll
          for (int j = 0; j < 4; ++j) nx[j] = __builtin_nontemporal_load(&xr[64 * j]); }
#pragma unroll 1
        for (int r = 0; r < 8; ++r) { const int m = rb * 64 + wave * 8 + r;
            f32x4 v[4]; float s = 0.f;
#pragma unroll
            for (int j = 0; j < 4; ++j) { v[j] = nx[j]; s += (v[j].x * v[j].x + v[j].y * v[j].y) + (v[j].z * v[j].z + v[j].w * v[j].w); }
            if (r < 7) { const f32x4* xr = (const f32x4*)(A.in[I_X] + (size_t)(m + 1) * DMOD) + lane;
#pragma unroll
                for (int j = 0; j < 4; ++j) nx[j] = __builtin_nontemporal_load(&xr[64 * j]); }
            const float rstd = rsqrtf(wave_sum(s) * (1.f / DMOD) + RMS_EPS);
            unsigned long long* o8 = (unsigned long long*)((unsigned char*)A.out + (size_t)m * 4096) + lane;
#pragma unroll
            for (int j = 0; j < 4; ++j) { const f32x4 h = v[j] * rstd * mul[j] + add[j]; o8[64 * j] = (unsigned long long)pk2(h.x, h.y) | ((unsigned long long)pk2(h.z, h.w) << 32); } }
    }
}
__device__ __forceinline__ void p3b_rows(const Args& A, char* lds, int G) {
    const int tid = opaque_tid(), lane = tid & 63, wave = tid >> 6;
    const float* modp = (const float*)(A.ws + WS_MODP); float* mv = (float*)lds;
    for (int rb = blockIdx.x; rb < MROWS / 64; rb += G) {
        const int b = rb >> 5;
        __syncthreads();
#pragma unroll 1
        for (int col = tid; col < 1024; col += NTHR) { mv[col] = A.in[I_POSTG][col] * mod_val(modp, A.in[I_ADAB], 0, b, 2048 + col);
            mv[1024 + col] = A.in[I_PREG][1024 + col] * (1.f + mod_val(modp, A.in[I_ADAB], 1, b, 1024 + col)); mv[2048 + col] = mod_val(modp, A.in[I_ADAB], 1, b, col); }
        __syncthreads();
        f32x4 g0[4], mul[4], add[4];
#pragma unroll
        for (int j = 0; j < 4; ++j) { g0[j] = *(const f32x4*)(mv + 4 * lane + 256 * j); mul[j] = *(const f32x4*)(mv + 1024 + 4 * lane + 256 * j); add[j] = *(const f32x4*)(mv + 2048 + 4 * lane + 256 * j); }
        f32x4 nx[4]; v2u ny[4];
        { const int m = rb * 64 + wave * 8; const f32x4* xr = (const f32x4*)(A.in[I_X] + (size_t)m * DMOD) + lane; const v2u* yr = (const v2u*)((unsigned char*)A.out + (size_t)m * 4096) + lane;
#pragma unroll
          for (int j = 0; j < 4; ++j) { nx[j] = __builtin_nontemporal_load(&xr[64 * j]); ny[j] = yr[64 * j]; } }
#pragma unroll 1
        for (int r = 0; r < 8; ++r) { const int m = rb * 64 + wave * 8 + r;
            unsigned char* slot = (unsigned char*)A.out + (size_t)m * 4096;
            f32x4 v[4], y[4]; float sy = 0.f; v2u wy[4];
#pragma unroll
            for (int j = 0; j < 4; ++j) { v[j] = nx[j]; wy[j] = ny[j]; }
            if (r < 7) { const f32x4* xr = (const f32x4*)(A.in[I_X] + (size_t)(m + 1) * DMOD) + lane; const v2u* yr = (const v2u*)(slot + 4096) + lane;
#pragma unroll
                for (int j = 0; j < 4; ++j) { nx[j] = __builtin_nontemporal_load(&xr[64 * j]); ny[j] = yr[64 * j]; } }
#pragma unroll
            for (int j = 0; j < 4; ++j) { const v2u w = wy[j]; y[j] = (f32x4){__uint_as_float(w.x << 16), __uint_as_float(w.x & 0xffff0000u), __uint_as_float(w.y << 16), __uint_as_float(w.y & 0xffff0000u)};
                sy += (y[j].x * y[j].x + y[j].y * y[j].y) + (y[j].z * y[j].z + y[j].w * y[j].w); }
            const float ry = rsqrtf(wave_sum(sy) * (1.f / DMOD) + RMS_EPS); float s = 0.f;
#pragma unroll
            for (int j = 0; j < 4; ++j) { v[j] = v[j] + g0[j] * (y[j] * ry); s += (v[j].x * v[j].x + v[j].y * v[j].y) + (v[j].z * v[j].z + v[j].w * v[j].w); }
            const float rstd = rsqrtf(wave_sum(s) * (1.f / DMOD) + RMS_EPS);
            unsigned long long* o8 = (unsigned long long*)(slot + 2048) + lane;
#pragma unroll
            for (int j = 0; j < 4; ++j) { const f32x4 h = v[j] * rstd * mul[j] + add[j]; o8[64 * j] = (unsigned long long)pk2(h.x, h.y) | ((unsigned long long)pk2(h.z, h.w) << 32); } }
    }
}
__device__ __forceinline__ void p6b_rows(const Args& A, char* lds, int G) {
    const int tid = opaque_tid(), lane = tid & 63, wave = tid >> 6;
    const float* modp = (const float*)(A.ws + WS_MODP); float* mv = (float*)lds;
    for (int rb = blockIdx.x; rb < MROWS / 64; rb += G) {
        const int b = rb >> 5;
        __syncthreads();
#pragma unroll 1
        for (int col = tid; col < 1024; col += NTHR) { mv[col] = A.in[I_POSTG][col] * mod_val(modp, A.in[I_ADAB], 0, b, 2048 + col); mv[1024 + col] = A.in[I_POSTG][1024 + col] * mod_val(modp, A.in[I_ADAB], 1, b, 2048 + col); }
        __syncthreads();
        f32x4 g0[4], g1[4];
#pragma unroll
        for (int j = 0; j < 4; ++j) { g0[j] = *(const f32x4*)(mv + 4 * lane + 256 * j); g1[j] = *(const f32x4*)(mv + 1024 + 4 * lane + 256 * j); }
        f32x4 nx[4]; v2u n0[4], n1[4];
        { const int m = rb * 64 + wave * 8; const f32x4* xr = (const f32x4*)(A.in[I_X] + (size_t)m * DMOD) + lane; const v2u* y1r = (const v2u*)((unsigned char*)A.out + (size_t)m * 4096) + lane;
#pragma unroll
          for (int j = 0; j < 4; ++j) { nx[j] = __builtin_nontemporal_load(&xr[64 * j]); n0[j] = y1r[64 * j]; n1[j] = y1r[256 + 64 * j]; } }
#pragma unroll 1
        for (int r = 0; r < 8; ++r) { const int m = rb * 64 + wave * 8 + r;
            unsigned char* slot = (unsigned char*)A.out + (size_t)m * 4096;
            f32x4 v[4], y0[4], y1[4]; float s0 = 0.f, s1 = 0.f; v2u w0[4], w1[4];
#pragma unroll
            for (int j = 0; j < 4; ++j) { v[j] = nx[j]; w0[j] = n0[j]; w1[j] = n1[j]; }
            if (r < 7) { const f32x4* xr = (const f32x4*)(A.in[I_X] + (size_t)(m + 1) * DMOD) + lane; const v2u* y1r = (const v2u*)(slot + 4096) + lane;
#pragma unroll
                for (int j = 0; j < 4; ++j) { nx[j] = __builtin_nontemporal_load(&xr[64 * j]); n0[j] = y1r[64 * j]; n1[j] = y1r[256 + 64 * j]; } }
#pragma unroll
            for (int j = 0; j < 4; ++j) { const v2u w = w0[j], u = w1[j];
                y0[j] = (f32x4){__uint_as_float(w.x << 16), __uint_as_float(w.x & 0xffff0000u), __uint_as_float(w.y << 16), __uint_as_float(w.y & 0xffff0000u)};
                y1[j] = (f32x4){__uint_as_float(u.x << 16), __uint_as_float(u.x & 0xffff0000u), __uint_as_float(u.y << 16), __uint_as_float(u.y & 0xffff0000u)};
                s0 += (y0[j].x * y0[j].x + y0[j].y * y0[j].y) + (y0[j].z * y0[j].z + y0[j].w * y0[j].w);
                s1 += (y1[j].x * y1[j].x + y1[j].y * y1[j].y) + (y1[j].z * y1[j].z + y1[j].w * y1[j].w); }
            const float r0 = rsqrtf(wave_sum(s0) * (1.f / DMOD) + RMS_EPS), r1 = rsqrtf(wave_sum(s1) * (1.f / DMOD) + RMS_EPS);
            f32x4* orow = (f32x4*)slot + lane;
#pragma unroll
            for (int j = 0; j < 4; ++j) { const f32x4 x1 = v[j] + g0[j] * (y0[j] * r0); v[j] = x1 + g1[j] * (y1[j] * r1); }
            asm volatile("" ::: "memory");
#pragma unroll
            for (int j = 0; j < 4; ++j) orow[64 * j] = v[j]; }
    }
}
#define BAR_ALL() asm volatile("s_waitcnt vmcnt(0) lgkmcnt(0)\n\ts_barrier" ::: "memory")
#define BAR_LDS() asm volatile("s_waitcnt lgkmcnt(0)\n\ts_barrier" ::: "memory")
typedef float f32x4m __attribute__((ext_vector_type(4)));
__device__ __forceinline__ void p2a_kbar(const Args& A, char* lds, int G) {
    const int tid = opaque_tid(); const bf16* P0 = (const bf16*)(A.ws + WS_BIG); float* kbar = (float*)(A.ws + WS_KBAR); float* red = (float*)lds;
    for (int item = blockIdx.x; item < NB * 16 * 8; item += G) {
        const int b = item >> 7, h = (item >> 3) & 15, n = item & 7; const int c8 = tid & 7, rg = tid >> 3;
        float acc[8];
#pragma unroll
        for (int e = 0; e < 8; ++e) acc[e] = 0.f;
#pragma unroll
        for (int i = 0; i < 4; ++i) { const bf16x8 kv = *(const bf16x8*)(P0 + (size_t)(b * SEQL + n * 256 + rg + 64 * i) * LD0 + C0_K + h * 64 + c8 * 8);
#pragma unroll
            for (int e = 0; e < 8; ++e) acc[e] += bf2f((unsigned short)kv[e]); }
        __syncthreads();
#pragma unroll
        for (int e = 0; e < 8; ++e) red[rg * 65 + c8 * 8 + e] = acc[e];
        __syncthreads();
        if (tid < 64) { float s = 0.f; for (int r = 0; r < 64; ++r) s += red[r * 65 + tid]; kbar[(size_t)item * 64 + tid] = s * (1.f / 256.f); }
    }
    __syncthreads();
}
__device__ __forceinline__ void p2a_conv(const Args& A, int G) {
    const int tid = opaque_tid(); const bf16* P0 = (const bf16*)(A.ws + WS_BIG); bf16* XC = (bf16*)A.out;
    if (tid >= 384) return;
    const int chg = tid % 192, half = tid / 192, ch = chg * 8;
    float w[4][8], bs[8];
#pragma unroll
    for (int k = 0; k < 4; ++k) { const f32x4 a = *(const f32x4*)(A.in[I_ECONVW] + k * 1536 + ch), b2 = *(const f32x4*)(A.in[I_ECONVW] + k * 1536 + ch + 4);
#pragma unroll
        for (int e = 0; e < 4; ++e) { w[k][e] = a[e]; w[k][4 + e] = b2[e]; } }
    { const f32x4 a = *(const f32x4*)(A.in[I_ECONVB] + ch), b2 = *(const f32x4*)(A.in[I_ECONVB] + ch + 4);
#pragma unroll
      for (int e = 0; e < 4; ++e) { bs[e] = a[e]; bs[4 + e] = b2[e]; } }
    for (int rb = blockIdx.x; rb < MROWS / 64; rb += G) {
        const int m0 = rb * 64 + half * 32; const int tb = m0 & (SEQL - 1);
        bf16x8 r0 = {}, r1 = {}, r2 = {};
        if (tb > 0) { r0 = *(const bf16x8*)(P0 + (size_t)(m0 - 3) * LD0 + C0_XBC + ch); r1 = *(const bf16x8*)(P0 + (size_t)(m0 - 2) * LD0 + C0_XBC + ch); r2 = *(const bf16x8*)(P0 + (size_t)(m0 - 1) * LD0 + C0_XBC + ch); }
#pragma unroll 4
        for (int i = 0; i < 32; ++i) { const bf16x8 r3 = *(const bf16x8*)(P0 + (size_t)(m0 + i) * LD0 + C0_XBC + ch); float o[8];
#pragma unroll
            for (int e = 0; e < 8; ++e) { const float a = bs[e] + w[0][e] * bf2f((unsigned short)r0[e]) + w[1][e] * bf2f((unsigned short)r1[e]) + w[2][e] * bf2f((unsigned short)r2[e]) + w[3][e] * bf2f((unsigned short)r3[e]); o[e] = silu_f(a); }
            v4u pw; pw.x = pk2(o[0], o[1]); pw.y = pk2(o[2], o[3]); pw.z = pk2(o[4], o[5]); pw.w = pk2(o[6], o[7]);
            *(v4u*)(XC + (size_t)(m0 + i) * 2048 + ch) = pw; r0 = r1; r1 = r2; r2 = r3; }
    }
}
constexpr int S_CS = 0, S_BS = 17408, S_BST = 34816, S_XT = 53248, S_XWT = 57856, S_XS = 62464, S_GG = 67584, S_SBF = 76800, S_DTA = 85504;
constexpr int F_CS = 0, F_BS = 17408, F_BST = 34816, F_XT = 53248, F_XWT = 62464, F_XS = 71680, F_GG = 80896, F_SBF = 90112, F_DTA = 107520;
template <bool DRY> __device__ __forceinline__ void ssd_unit(const Args& A, char* lds, int b, int h) {
    const int tid = opaque_tid(), lane = tid & 63, wave = __builtin_amdgcn_readfirstlane(tid >> 6); const int fr = lane & 15, fq = lane >> 4;
    bf16* P0 = (bf16*)(A.ws + WS_BIG); const bf16* XC = (const bf16*)A.out; const float* DT = (const float*)(A.ws + WS_DT);
    const int g = h >> 3; const int xcol = h * 64, bcol = 1024 + g * 128, ccol = 1280 + g * 128;
    bf16* CS = (bf16*)(lds + F_CS); bf16* BS = (bf16*)(lds + F_BS); bf16* BST = (bf16*)(lds + F_BST); bf16* XT = (bf16*)(lds + F_XT); bf16* XWT = (bf16*)(lds + F_XWT);
    bf16* XS = (bf16*)(lds + F_XS); bf16* GG = (bf16*)(lds + F_GG); bf16* SBF = (bf16*)(lds + F_SBF); float* DTA0 = (float*)(lds + F_DTA);
    for (int i = tid; i < 64 * 136; i += NTHR) SBF[i] = 0;
    const float Ah = -__expf(A.in[I_EALOG][h]), Dh = A.in[I_EDSKIP][h];
    const int lt = wave >> 1, pt0 = 2 * (wave & 1), st0 = 2 * (wave & 1), nt0 = (wave >> 1) * 2;
    f32x4m sta[2][2];
#pragma unroll
    for (int pi = 0; pi < 2; ++pi)
#pragma unroll
        for (int ni = 0; ni < 2; ++ni) sta[pi][ni] = (f32x4m){0.f, 0.f, 0.f, 0.f};
    const size_t rb0 = (size_t)b * SEQL;
    const bf16* pB = XC + (rb0 + (tid >> 4)) * 2048 + bcol + (tid & 15) * 8; const bf16* pC = XC + (rb0 + (tid >> 4)) * 2048 + ccol + (tid & 15) * 8; const bf16* pX = XC + (rb0 + (tid >> 3)) * 2048 + xcol + (tid & 7) * 8;
    const bf16* pZ = P0 + (rb0 + lt * 16 + 4 * fq) * LD0 + C0_ZA + h * 64 + pt0 * 16 + fr;
    bf16x8 pre[5]; float dtn = 0.f;
    pre[0] = *(const bf16x8*)pB; pre[1] = *(const bf16x8*)(pB + 32 * 2048); pre[2] = *(const bf16x8*)pC; pre[3] = *(const bf16x8*)(pC + 32 * 2048); pre[4] = *(const bf16x8*)pX;
    unsigned short zn[2][4], gts[2][4]; float sqs[2][4];
#pragma unroll
    for (int pi = 0; pi < 2; ++pi)
#pragma unroll
        for (int r = 0; r < 4; ++r) { zn[pi][r] = pZ[(size_t)r * LD0 + 16 * pi]; gts[pi][r] = 0; sqs[pi][r] = 0.f; }
    if (wave == 0) { dtn = DT[(rb0 + lane) * 16 + h]; const float s = wave_scan(Ah * dtn, lane); const float tot = rdlane(s, 63);
        DTA0[lane] = dtn; DTA0[64 + lane] = s; DTA0[128 + lane] = __expf(s); DTA0[192 + lane] = __expf(tot - s); dtn = DT[(rb0 + 64 + lane) * 16 + h]; }
    BAR_LDS();
    for (int c = 0; c < SEQL / 64; ++c) {
        const size_t m0 = rb0 + c * 64; float* DTA = DTA0 + (c & 1) * 256;
        { const int t = tid >> 4, c8 = tid & 15;
          *(bf16x8*)(BS + t * 136 + c8 * 8) = pre[0]; *(bf16x8*)(BS + (t + 32) * 136 + c8 * 8) = pre[1]; *(bf16x8*)(CS + t * 136 + c8 * 8) = pre[2]; *(bf16x8*)(CS + (t + 32) * 136 + c8 * 8) = pre[3];
          const int sw0 = ((((t >> 3) ^ (c8 & 7)) << 3) + (t & 7)), sw1 = (((((t + 32) >> 3) ^ (c8 & 7)) << 3) + (t & 7));
#pragma unroll
          for (int e = 0; e < 8; ++e) { BST[(c8 * 8 + e) * 72 + sw0] = (bf16)pre[0][e]; BST[(c8 * 8 + e) * 72 + sw1] = (bf16)pre[1][e]; }
          const int tx = tid >> 3, cx = tid & 7; *(bf16x8*)(XS + tx * 72 + cx * 8) = pre[4]; const float dtv = DTA[tx], wv = DTA[192 + tx]; const int sx = ((((tx >> 3) ^ cx) << 3) + (tx & 7));
#pragma unroll
          for (int e = 0; e < 8; ++e) { const float xd = bf2f((unsigned short)pre[4][e]) * dtv; XT[(cx * 8 + e) * 72 + sx] = (bf16)f2bf(xd); XWT[(cx * 8 + e) * 72 + sx] = (bf16)f2bf(xd * wv); } }
        if (c > 0) {
#pragma unroll
            for (int pi = 0; pi < 2; ++pi)
#pragma unroll
                for (int r = 0; r < 4; ++r) { const int l = lt * 16 + 4 * fq + r;
                    if (!DRY || sqs[pi][r] == 1.2345e30f) { ((bf16*)pZ)[((size_t)(c - 1) * 64 + r) * LD0 + 16 * pi] = gts[pi][r];
                        if (fr == 0) ((float*)((unsigned char*)A.out + (m0 - 64 + l) * 4096 + 3072))[h * 4 + pt0 + pi] = sqs[pi][r]; } } }
        if (c + 1 < SEQL / 64) { const size_t o = (size_t)(c + 1) * 64 * 2048;
            pre[0] = *(const bf16x8*)(pB + o); pre[1] = *(const bf16x8*)(pB + o + 32 * 2048); pre[2] = *(const bf16x8*)(pC + o); pre[3] = *(const bf16x8*)(pC + o + 32 * 2048); pre[4] = *(const bf16x8*)(pX + o); }
        unsigned short zv[2][4];
#pragma unroll
        for (int pi = 0; pi < 2; ++pi)
#pragma unroll
            for (int r = 0; r < 4; ++r) zv[pi][r] = zn[pi][r];
        if (c + 1 < SEQL / 64) {
#pragma unroll
            for (int pi = 0; pi < 2; ++pi)
#pragma unroll
                for (int r = 0; r < 4; ++r) zn[pi][r] = pZ[((size_t)(c + 1) * 64 + r) * LD0 + 16 * pi]; }
        BAR_LDS();
        f32x4m cb[2], ya[2]; cb[0] = (f32x4m){0.f, 0.f, 0.f, 0.f}; cb[1] = cb[0]; ya[0] = cb[0]; ya[1] = cb[0];
#pragma unroll
        for (int ks = 0; ks < 4; ++ks) { const bf16x8 af = *(const bf16x8*)(CS + (lt * 16 + fr) * 136 + ks * 32 + 8 * fq);
#pragma unroll
            for (int si = 0; si < 2; ++si) { const bf16x8 bfv = *(const bf16x8*)(BS + ((st0 + si) * 16 + fr) * 136 + ks * 32 + 8 * fq); cb[si] = __builtin_amdgcn_mfma_f32_16x16x32_bf16(af, bfv, cb[si], 0, 0, 0); }
#pragma unroll
            for (int pi = 0; pi < 2; ++pi) { const bf16x8 sf = *(const bf16x8*)(SBF + ((pt0 + pi) * 16 + fr) * 136 + ks * 32 + 8 * fq); ya[pi] = __builtin_amdgcn_mfma_f32_16x16x32_bf16(af, sf, ya[pi], 0, 0, 0); } }
#pragma unroll
        for (int r = 0; r < 4; ++r) { const int l = lt * 16 + 4 * fq + r; const float al = DTA[64 + l];
#pragma unroll
            for (int si = 0; si < 2; ++si) { const int s = (st0 + si) * 16 + fr; const float v = (s <= l) ? cb[si][r] * __expf(al - DTA[64 + s]) : 0.f; GG[l * 72 + s] = (bf16)f2bf(v); }
            const float ea = DTA[128 + l]; ya[0][r] *= ea; ya[1][r] *= ea; }
        const float decay = __expf(DTA[64 + 63]);
        BAR_LDS();
#pragma unroll
        for (int ks = 0; ks < 2; ++ks) { const bf16x8 gf = *(const bf16x8*)(GG + (lt * 16 + fr) * 72 + ks * 32 + 8 * fq);
#pragma unroll
            for (int pi = 0; pi < 2; ++pi) { const int p = (pt0 + pi) * 16 + fr; const bf16x8 xf = *(const bf16x8*)(XT + p * 72 + (((ks * 4 + fq) ^ ((p >> 3) & 7)) << 3)); ya[pi] = __builtin_amdgcn_mfma_f32_16x16x32_bf16(gf, xf, ya[pi], 0, 0, 0); } }
#pragma unroll
        for (int pi = 0; pi < 2; ++pi)
#pragma unroll
            for (int ni = 0; ni < 2; ++ni) sta[pi][ni] = sta[pi][ni] * decay;
#pragma unroll
        for (int ks = 0; ks < 2; ++ks) { bf16x8 bt[2];
#pragma unroll
            for (int ni = 0; ni < 2; ++ni) { const int n = (nt0 + ni) * 16 + fr; bt[ni] = *(const bf16x8*)(BST + n * 72 + (((ks * 4 + fq) ^ ((n >> 3) & 7)) << 3)); }
#pragma unroll
            for (int pi = 0; pi < 2; ++pi) { const int p = (pt0 + pi) * 16 + fr; const bf16x8 xw = *(const bf16x8*)(XWT + p * 72 + (((ks * 4 + fq) ^ ((p >> 3) & 7)) << 3));
#pragma unroll
                for (int ni = 0; ni < 2; ++ni) sta[pi][ni] = __builtin_amdgcn_mfma_f32_16x16x32_bf16(xw, bt[ni], sta[pi][ni], 0, 0, 0); } }
#pragma unroll
        for (int pi = 0; pi < 2; ++pi)
#pragma unroll
            for (int ni = 0; ni < 2; ++ni)
#pragma unroll
                for (int r = 0; r < 4; ++r) SBF[((pt0 + pi) * 16 + 4 * fq + r) * 136 + (nt0 + ni) * 16 + fr] = (bf16)f2bf(sta[pi][ni][r]);
#pragma unroll
        for (int pi = 0; pi < 2; ++pi)
#pragma unroll
            for (int r = 0; r < 4; ++r) { const int l = lt * 16 + 4 * fq + r, p = (pt0 + pi) * 16 + fr;
                const float y = ya[pi][r] + Dh * bf2f(XS[l * 72 + p]);
                const float z = bf2f(zv[pi][r]); const float gt = y * silu_f(z);
                gts[pi][r] = (unsigned short)f2bf(gt); sqs[pi][r] = row_sum16(gt * gt); }
        if (wave == 0 && c + 1 < SEQL / 64) { float* DN = DTA0 + ((c + 1) & 1) * 256; const float s = wave_scan(Ah * dtn, lane); const float tot = rdlane(s, 63);
            DN[lane] = dtn; DN[64 + lane] = s; DN[128 + lane] = __expf(s); DN[192 + lane] = __expf(tot - s);
            if (c + 2 < SEQL / 64) dtn = DT[(m0 + 128 + lane) * 16 + h]; }
        BAR_LDS();
    }
#pragma unroll
    for (int pi = 0; pi < 2; ++pi)
#pragma unroll
        for (int r = 0; r < 4; ++r) { const int l = lt * 16 + 4 * fq + r;
            if (!DRY || sqs[pi][r] == 1.2345e30f) { ((bf16*)pZ)[((size_t)(SEQL / 64 - 1) * 64 + r) * LD0 + 16 * pi] = gts[pi][r];
                if (fr == 0) ((float*)((unsigned char*)A.out + (rb0 + SEQL - 64 + l) * 4096 + 3072))[h * 4 + pt0 + pi] = sqs[pi][r]; } }
}
__device__ __forceinline__ void p2c_fixup(const Args& A, int vcu, int G) {
    const int tid = opaque_tid(), lane = tid & 63, wave = tid >> 6; bf16* P0 = (bf16*)(A.ws + WS_BIG); const float* ssq = (const float*)(A.ws + WS_SSQ);
    f32x4 gn[4];
#pragma unroll
    for (int j = 0; j < 4; ++j) gn[j] = *((const f32x4*)A.in[I_ENORMG] + lane + 64 * j);
    for (int m = vcu * NWAVES + wave; m < MROWS; m += G * NWAVES) { const float r = rsqrtf(wave_sum(((const float*)((const unsigned char*)A.out + (size_t)m * 4096 + 3072))[lane]) * (1.f / 1024.f) + RMS_EPS);
        v2u* p = (v2u*)(P0 + (size_t)m * LD0 + C0_ZA) + lane;
#pragma unroll
        for (int j = 0; j < 4; ++j) { const v2u w = p[64 * j]; v2u o; o.x = pk2(__uint_as_float(w.x << 16) * r * gn[j].x, __uint_as_float(w.x & 0xffff0000u) * r * gn[j].y);
            o.y = pk2(__uint_as_float(w.y << 16) * r * gn[j].z, __uint_as_float(w.y & 0xffff0000u) * r * gn[j].w); p[64 * j] = o; } }
}
__device__ __forceinline__ void p5a_fcum(const Args& A, char* lds, int G) {
    const int tid = opaque_tid(), lane = tid & 63, wave = tid >> 6; const float* LF = (const float*)(A.ws + WS_LF); float* F2 = (float*)(A.ws + WS_F2); float* wtot = (float*)(lds + 120 * 1024);
    for (int item = blockIdx.x; item < NB * 24; item += G) { const int b = item / 24, h = item % 24; const float fb = A.in[I_OFGB][h];
        float v[4]; float run = 0.f;
#pragma unroll
        for (int i = 0; i < 4; ++i) { const size_t ix = ((size_t)b * SEQL + 4 * tid + i) * 24 + h; const float* L1p = (const float*)(A.ws + WS_LFP);
            const float fr_ = (LF[ix] + L1p[ix]) + (L1p[ix + (size_t)MROWS * 24] + L1p[ix + (size_t)2 * MROWS * 24]) + fb; run += -softplus_g(-fr_); v[i] = run; }
        float s = run;
#pragma unroll
        for (int o = 1; o < 64; o <<= 1) { const float x = __shfl_up(s, o); if (lane >= o) s += x; }
        __syncthreads();
        if (lane == 63) wtot[wave] = s;
        __syncthreads();
        float off = s - run; for (int w = 0; w < wave; ++w) off += wtot[w];
#pragma unroll
        for (int i = 0; i < 4; ++i) { const float f2v = (off + v[i]) * LOG2E; const int t = 4 * tid + i; F2[(size_t)item * SEQL + t] = f2v;
            if ((t & 127) == 127) wtot[64 + (t >> 7)] = f2v; if ((t & 255) == 0) wtot[96 + (t >> 8)] = f2v; }
        { const bf16* P1 = (const bf16*)(A.ws + WS_BIG); float qm = 0.f, km = 0.f;
#pragma unroll 8
          for (int i = 0; i < 32; ++i) { const size_t m = (size_t)b * SEQL + (tid >> 3) + 64 * i; const int c8 = tid & 7; float qs = 0.f, ks2 = 0.f;
              const bf16x8 qv = *(const bf16x8*)(P1 + m * LD1 + C1_Q + h * 64 + c8 * 8), kv = *(const bf16x8*)(P1 + m * LD1 + C1_K + h * 64 + c8 * 8);
#pragma unroll
              for (int e = 0; e < 8; ++e) { const float qf = bf2f((unsigned short)qv[e]), kf = bf2f((unsigned short)kv[e]); qs += qf * qf; ks2 += kf * kf; }
              qs += dppf<0xB1>(qs, qs); qs += dppf<0x4E>(qs, qs); qs += dppf<0x141>(qs, qs); ks2 += dppf<0xB1>(ks2, ks2); ks2 += dppf<0x4E>(ks2, ks2); ks2 += dppf<0x141>(ks2, ks2);
              qm = fmaxf(qm, qs); km = fmaxf(km, ks2); }
#pragma unroll
          for (int o = 1; o < 64; o <<= 1) { qm = fmaxf(qm, __shfl_xor(qm, o)); km = fmaxf(km, __shfl_xor(km, o)); }
          __syncthreads();
          if (lane == 0) { wtot[16 + wave] = qm; wtot[32 + wave] = km; }
          __syncthreads();
          if (tid < 8) { float a = 0.f, c = 0.f; for (int w = 0; w < 8; ++w) { a = fmaxf(a, wtot[16 + w]); c = fmaxf(c, wtot[32 + w]); } const float u2 = 2.f * sqrtf(a) * sqrtf(c) * 1.01f;
              const int qb = tid; const float fi0 = wtot[96 + qb]; int ts = 0; while (ts + 2 <= 4 * qb && u2 - (wtot[64 + (ts >> 1)] - fi0) <= -40.f) ts += 2;
              ((int*)(A.ws + WS_TS))[item * 8 + qb] = ts; } }
    }
    __syncthreads();
}
constexpr int S5_BU = 0  , S5_SS = 67584  , S5_US = 102400  ;
__device__ __forceinline__ float gelu_tanh(float x) { const float u = 0.7978845608028654f * (x + 0.044715f * x * x * x); const float e = __expf(2.f * u); const float t = 1.f - 2.f / (e + 1.f); return 0.5f * x * (1.f + t); }
__device__ __forceinline__ void s5_unit(const Args& A, char* lds, int b, int g) {
    const int tid = opaque_tid(), lane = tid & 63, wave = __builtin_amdgcn_readfirstlane(tid >> 6); const int fr = lane & 15, fq = lane >> 4, r32 = lane & 31, hi = lane >> 5;
    const bf16* P1 = (const bf16*)(A.ws + WS_BIG); bf16* YD = (bf16*)A.out;
    const unsigned char* pg = A.ws + WS_S5P + (size_t)g * S5P_STRIDE; const bf16* BbT = (const bf16*)pg; const bf16* Cm = (const bf16*)(pg + 4096); const float* ari = (const float*)(pg + 8192);
    const int ttile = wave >> 2, ntile = wave & 3;
    const bf16x8 bfrag = *(const bf16x8*)(BbT + (ntile * 32 + r32) * 16 + 8 * hi);
    bf16x8 cfrag[4];
#pragma unroll
    for (int ks = 0; ks < 4; ++ks) cfrag[ks] = *(const bf16x8*)(Cm + fr * 128 + ks * 32 + 8 * fq);
    const float ar = ari[lane], ai = ari[64 + lane]; float sr = 0.f, si = 0.f;
    const float dskip = A.in[I_ODSKIP][g * 16 + fr];
    const size_t rb0 = (size_t)b * SEQL; const bf16* pU = P1 + (rb0 + ttile * 32 + r32) * LD1 + C1_U + g * 16 + 8 * hi;
    bf16x8 un = *(const bf16x8*)pU;
    BAR_LDS();
    for (int i = 0; i < SEQL / 64 + 2; ++i) {
        if (i < SEQL / 64) { float* BU = (float*)(lds + S5_BU) + (i & 1) * (64 * 132); f32x16 acc = {};
            acc = __builtin_amdgcn_mfma_f32_32x32x16_bf16(un, bfrag, acc, 0, 0, 0);
            if (ntile == 0) *(bf16x8*)((bf16*)(lds + S5_US) + ((i & 3) * 64 + ttile * 32 + r32) * 16 + 8 * hi) = un;
            if (i + 1 < SEQL / 64) un = *(const bf16x8*)(pU + (size_t)(i + 1) * 64 * LD1);
#pragma unroll
            for (int r = 0; r < 16; ++r) { const int t = ttile * 32 + (r & 3) + 8 * (r >> 2) + 4 * hi; BU[t * 132 + ntile * 32 + r32] = acc[r]; } }
        if (wave == 0 && i >= 1 && i <= SEQL / 64) { const float* BU = (const float*)(lds + S5_BU) + ((i - 1) & 1) * (64 * 132); bf16* SS = (bf16*)(lds + S5_SS) + ((i - 1) & 1) * (64 * 136);
#pragma unroll
            for (int hb = 0; hb < 2; ++hb) { f32x2_c bv[32];
#pragma unroll
                for (int t = 0; t < 32; ++t) bv[t] = *(const f32x2_c*)(BU + (hb * 32 + t) * 132 + 2 * lane);
                const f32x2_c a1 = {ar, ar}, a2 = {-ai, ai}; f32x2_c s2 = {sr, si};
#pragma unroll
                for (int t = 0; t < 32; ++t) { const f32x2_c sw = {s2.y, s2.x}; s2 = a1 * s2 + (a2 * sw + bv[t]);
                    *(unsigned*)(SS + (hb * 32 + t) * 136 + 2 * lane) = pk2(s2.x, s2.y); }
                sr = s2.x; si = s2.y; } }
        if (wave >= 4 && i >= 2) { const bf16* SS = (const bf16*)(lds + S5_SS) + ((i - 2) & 1) * (64 * 136); const int mt = wave - 4; const size_t m0 = rb0 + (size_t)(i - 2) * 64;
            unsigned short uv[4];
#pragma unroll
            for (int r = 0; r < 4; ++r) uv[r] = ((const bf16*)(lds + S5_US))[(((i - 2) & 3) * 64 + mt * 16 + 4 * fq + r) * 16 + fr];
            f32x4m acc = (f32x4m){0.f, 0.f, 0.f, 0.f};
#pragma unroll
            for (int ks = 0; ks < 4; ++ks) { const bf16x8 af = *(const bf16x8*)(SS + (mt * 16 + fr) * 136 + ks * 32 + 8 * fq); acc = __builtin_amdgcn_mfma_f32_16x16x32_bf16(af, cfrag[ks], acc, 0, 0, 0); }
#pragma unroll
            for (int r = 0; r < 4; ++r) { const size_t m = m0 + mt * 16 + 4 * fq + r; YD[m * 2048 + 1024 + g * 16 + fr] = (bf16)f2bf(gelu_tanh(acc[r] + dskip * bf2f(uv[r]))); } }
        BAR_LDS();
    }
}
template <bool DRY> __device__ __forceinline__ void moba_phase(const Args& A, char* lds, int vcu, int G) {
    const bf16* P0 = (const bf16*)(A.ws + WS_BIG); const float* kbar = (const float*)(A.ws + WS_KBAR);
    unsigned* cnt = (unsigned*)(A.ws + WS_CNT) + (DRY ? 192 : 128); volatile unsigned* lw = (volatile unsigned*)(lds + BARST_OFF + 16);
    const int tid = opaque_tid();
    if (tid == 0) lw[0] = atomicAdd(cnt, 1u);
    BAR_ALL();
    int u = __builtin_amdgcn_readfirstlane((int)lw[0]);
    while (u < NB * 16 * 8) {
        unsigned nxt = 0u; if (tid == 0) nxt = atomicAdd(cnt, 1u);
        const int qb = 7 - u / 128, bh = u % 128, b = bh >> 4, h = bh & 15;
        attn_body::attn_unit<8, 0, LD0, DRY>(b, h, qb, (const attn_body::bf16*)(P0 + C0_Q), (const attn_body::bf16*)(P0 + C0_K), (const attn_body::bf16*)(P0 + C0_V), (attn_body::bf16*)(P0 + C0_Q),
                                            (const attn_body::bf16*)(P0 + C0_ZB), kbar + (size_t)bh * 512, nullptr, lw, nxt, lds);
        BAR_LDS();
        u = __builtin_amdgcn_readfirstlane((int)lw[0]);
    }
}
template <bool DRY> __device__ __forceinline__ void fox_phase(const Args& A, char* lds, int vcu, int G) {
    const bf16* P1 = (const bf16*)(A.ws + WS_BIG); const float* F2 = (const float*)(A.ws + WS_F2); const int* TSv = (const int*)(A.ws + WS_TS);
    unsigned* cnt = (unsigned*)(A.ws + WS_CNT) + (DRY ? 64 : 0); volatile unsigned* lw = (volatile unsigned*)(lds + BARST_OFF + 16);
    const int tid = opaque_tid();
    if (tid == 0) lw[0] = atomicAdd(cnt, 1u);
    BAR_ALL();
    int u = __builtin_amdgcn_readfirstlane((int)lw[0]);
    while (u < NB * 24 * 8) {
        unsigned nxt = 0u; if (tid == 0) nxt = atomicAdd(cnt, 1u);
        const int qb = 7 - u / 192, bh = u % 192, b = bh / 24, h = bh % 24;
        attn_body::attn_unit<8, 1, LD1, DRY>(b, h, qb, (const attn_body::bf16*)(P1 + C1_Q), (const attn_body::bf16*)(P1 + C1_K), (const attn_body::bf16*)(P1 + C1_V), (attn_body::bf16*)(P1 + C1_Q),
                                            (const attn_body::bf16*)(P1 + C1_ZC), F2 + (size_t)bh * SEQL, TSv + bh * 8, lw, nxt, lds);
        BAR_LDS();
        u = __builtin_amdgcn_readfirstlane((int)lw[0]);
    }
}
#define LAS __attribute__((address_space(3)))
#define XB_TMO      128
#define XB_XCNT(j)  (256  + 64 * (j))
#define XB_XSUB(j)  (1280 + 64 * (j))
#define XB_XGEN(j)  (2304 + 64 * (j))
#define XB_TOP      3328
#define XB_TOPGEN   3392
#define XCD_BAR_WORDS 3456
#define XB_SPIN_CAP (1u << 18)

__device__ __forceinline__ unsigned xb_ld(unsigned* p)              { return __hip_atomic_load(p, __ATOMIC_RELAXED, __HIP_MEMORY_SCOPE_AGENT); }
__device__ __forceinline__ unsigned xb_add(unsigned* p, unsigned v) { return __hip_atomic_fetch_add(p, v, __ATOMIC_RELAXED, __HIP_MEMORY_SCOPE_AGENT); }
__device__ __forceinline__ unsigned xb_xcc_id() { return (unsigned)__builtin_amdgcn_s_getreg((3 << 11) | 20) & 0xFu; }
#define XB_SPIN(cond, bar) do { unsigned _sp = 0; while (cond) { __builtin_amdgcn_s_sleep(1); \
    if ((++_sp & 255u) == 0u) { if (xb_ld(&(bar)[XB_TMO])) break; if (_sp > XB_SPIN_CAP) { atomicAdd(&(bar)[XB_TMO], 1u); break; } } } } while (0)

struct XcdBarrier {
    unsigned* bar; unsigned x;
    volatile LAS unsigned* st;
};

__device__ __forceinline__ XcdBarrier xcd_barrier_post(unsigned* bar, volatile LAS unsigned* st) {
    XcdBarrier b; b.bar = bar; b.x = xb_xcc_id(); b.st = st;
    if (threadIdx.x == 0) (void)xb_add(&bar[XB_XCNT(b.x)], 1u);
    return b;
}
__device__ __forceinline__ void xcd_barrier_complete(unsigned* bar, unsigned x, unsigned& nloc, unsigned& nx) {
    const unsigned G = gridDim.x * gridDim.y * gridDim.z;
    unsigned sum, cnt, mine, sp = 0u;
    for (;;) {
        sum = 0u; cnt = 0u; mine = 0u;
#pragma unroll
        for (unsigned j = 0; j < 16; ++j) { const unsigned c = xb_ld(&bar[XB_XCNT(j)]); sum += c; cnt += (c > 0u) ? 1u : 0u; mine = (j == x) ? c : mine; }
        if (sum == G) break;
        __builtin_amdgcn_s_sleep(1);
        if ((++sp & 255u) == 0u) { if (xb_ld(&bar[XB_TMO])) break; if (sp > XB_SPIN_CAP) { atomicAdd(&bar[XB_TMO], 1u); break; } }
    }
    nloc = mine > 0u ? mine : 1u; nx = cnt > 0u ? cnt : 1u;
}

__device__ __forceinline__ void xcd_barrier(const XcdBarrier& b) {
    asm volatile("s_waitcnt vmcnt(0)" ::: "memory");
    __syncthreads();
    if (threadIdx.x == 0) {
        unsigned* bar = b.bar;
        __builtin_amdgcn_s_waitcnt(0);
        unsigned nloc = b.st[0], nx = b.st[1];
        if (nloc == 0u) { xcd_barrier_complete(bar, b.x, nloc, nx); b.st[0] = nloc; b.st[1] = nx; }
        const unsigned old = xb_add(&bar[XB_XSUB(b.x)], 1u);
        const unsigned gen = old / nloc;
        if (old + 1u == (gen + 1u) * nloc) {
            __builtin_amdgcn_fence(__ATOMIC_RELEASE, "agent");
            asm volatile("s_waitcnt vmcnt(0)" ::: "memory");
            const unsigned og = xb_add(&bar[XB_TOP], 1u);
            const unsigned tg = og / nx;
            if (og + 1u == (tg + 1u) * nx) xb_add(&bar[XB_TOPGEN], 1u);
            else XB_SPIN(xb_ld(&bar[XB_TOPGEN]) == tg, bar);
            __builtin_amdgcn_fence(__ATOMIC_ACQUIRE, "agent");
            xb_add(&bar[XB_XGEN(b.x)], 1u);
            asm volatile("s_waitcnt vmcnt(0)" ::: "memory");
        } else {
            XB_SPIN(xb_ld(&bar[XB_XGEN(b.x)]) == gen, bar);
            __builtin_amdgcn_fence(__ATOMIC_ACQUIRE, "agent");
            asm volatile("s_waitcnt vmcnt(0)" ::: "memory");
        }
    }
    __syncthreads();
}

constexpr int ARGS_OFF = 132096;
__device__ __forceinline__ Args get_args(const unsigned char* lds) {
    Args a; const unsigned long long* p = (const unsigned long long*)(lds + ARGS_OFF);
#pragma unroll
    for (int i = 0; i < 29; ++i) { const unsigned long long v = p[i]; const unsigned lo = __builtin_amdgcn_readfirstlane((unsigned)v), hi = __builtin_amdgcn_readfirstlane((unsigned)(v >> 32));
        const unsigned long long w = ((unsigned long long)hi << 32) | lo; if (i < 27) a.in[i] = (const float*)w; else if (i == 27) a.out = (float*)w; else a.ws = (unsigned char*)w; }
    return a;
}
#define PHASE_BEGIN { const Args args = get_args(lds); unsigned char* ws = args.ws; bf16* XN = (bf16*)args.out; bf16* PB = (bf16*)(ws + WS_BIG); (void)ws; (void)XN; (void)PB;
#ifdef DUP_SYNC
#define PHASE_END } xcd_barrier(xbar); xcd_barrier(xbar);
#else
#define PHASE_END } xcd_barrier(xbar);
#endif
#define PHASE_END_NOSYNC }
__global__ void __launch_bounds__(NTHR, 2) trunk_fwd(Args kargs_unused) {
    extern __shared__ __attribute__((aligned(16))) unsigned char lds[];
    cg::grid_group grid = cg::this_grid();
    const int G = gridDim.x, bx = blockIdx.x; const int vcu = (G % 8 == 0) ? (bx % 8) * (G / 8) + bx / 8 : bx;
    char* ldsc = (char*)lds; PG8_LAS unsigned char* ldsg = (PG8_LAS unsigned char*)lds;
    { const int t = opaque_tid(); if (t < 29) { const unsigned long long* ka = (const unsigned long long*)__builtin_amdgcn_kernarg_segment_ptr(); ((unsigned long long*)(lds + ARGS_OFF))[t] = ka[t]; }
      if (t < 2) ((unsigned*)(lds + BARST_OFF))[t] = 0u; }
    __syncthreads();
    XcdBarrier xbar;
    {
    const Args args = get_args(lds);
    unsigned* rdy = (unsigned*)(args.ws + WS_BAR) + 4160;
    if (bx == 0) { unsigned* bw = (unsigned*)(args.ws + WS_BAR); for (int i = opaque_tid(); i < 4096; i += NTHR) bw[i] = 0u;
        asm volatile("s_waitcnt vmcnt(0)" ::: "memory"); __syncthreads();
        if (opaque_tid() == 0) { __builtin_amdgcn_fence(__ATOMIC_RELEASE, "agent"); asm volatile("s_waitcnt vmcnt(0)" ::: "memory"); __hip_atomic_store(rdy, 0x600DF00Du, __ATOMIC_RELAXED, __HIP_MEMORY_SCOPE_AGENT); } }
    if (G > 0x40000000) grid.sync();
    p0_prologue(args, ldsc, vcu, G);
    if (opaque_tid() == 0) { unsigned sp = 0; while (__hip_atomic_load(rdy, __ATOMIC_RELAXED, __HIP_MEMORY_SCOPE_AGENT) != 0x600DF00Du && ++sp < (1u << 22)) __builtin_amdgcn_s_sleep(2);
        __builtin_amdgcn_fence(__ATOMIC_ACQUIRE, "agent"); asm volatile("s_waitcnt vmcnt(0)" ::: "memory"); }
    __syncthreads();
    xbar = xcd_barrier_post((unsigned*)(args.ws + WS_BAR), (volatile LAS unsigned*)(lds + BARST_OFF));
    xcd_barrier(xbar);
    if (bx == 0 && opaque_tid() == 0) __hip_atomic_store(rdy, 0u, __ATOMIC_RELAXED, __HIP_MEMORY_SCOPE_AGENT);
    }
    PHASE_BEGIN
    p1a_rows(args, ldsc, G);
#ifdef DUP_MISC
    p1a_rows(args, ldsc, G);
#endif
    PHASE_END
    PHASE_BEGIN
    { pg8::Gemm g{XN, (const bf16*)(ws + WS_WT0), MROWS, NP0, 1024, 2048, 1024, 0}; pg8::StaticOrder S; S.init(MROWS, NP0, G, bx);
      pg8::EpiX<0> E{PB, LD0, args.in[I_EDTB], (float*)(ws + WS_DT), nullptr, nullptr, attn_body::C2};
      pg8::gemm_phase<pg8::EpiX<0>, pg8::StaticOrder, true, true>(ldsg, g, S, E); }
#ifdef DUP_GEMM
    { pg8::Gemm g{XN, (const bf16*)(ws + WS_WT0), MROWS, NP0, 1024, 2048, 1024, 0}; pg8::StaticOrder S; S.init(MROWS, NP0, G, bx);
      pg8::EpiX<0> E{PB, LD0, args.in[I_EDTB], (float*)(ws + WS_DT), nullptr, nullptr, attn_body::C2};
      pg8::gemm_phase<pg8::EpiX<0>, pg8::StaticOrder, true, true>(ldsg, g, S, E); }
#endif
    PHASE_END
    PHASE_BEGIN
    p2a_kbar(args, ldsc, G);
    p2a_conv(args, G);
#ifdef DUP_MISC
    p2a_kbar(args, ldsc, G);
    p2a_conv(args, G);
#endif
    PHASE_END
    PHASE_BEGIN
#ifdef DUP_SSD
    for (int v = vcu; v < 128; v += G) ssd_unit<true>(args, ldsc, v >> 4, v & 15);
#endif
    for (int v = vcu; v < 128; v += G) ssd_unit<false>(args, ldsc, v >> 4, v & 15);
    PHASE_END_NOSYNC
    PHASE_BEGIN
#ifdef DUP_MOBA
    moba_phase<true>(args, ldsc, vcu, G);
#endif
    moba_phase<false>(args, ldsc, vcu, G);
    PHASE_END
    if (G != 256) {
    PHASE_BEGIN
    p2c_fixup(args, vcu, G);
    PHASE_END
    }
    PHASE_BEGIN
    { pg8::Gemm g{PB, (const bf16*)(ws + WS_WO0), MROWS, 1024, 2048, LD0, 2048, 0}; pg8::StaticOrder S; S.init(MROWS, 1024, G, bx);
      { pg8::Unit u0; u0.pm = 0; u0.pn = 0; const bool have = S.next(0, u0); const int pm0 = u0.pm; float* rs = (float*)(lds + 131072); const int t = opaque_tid();
        if (t < 256) { float r = 1.f;
            if (G == 256 && have) { const f32x4* pp = (const f32x4*)((const unsigned char*)args.out + (size_t)(pm0 * 256 + t) * 4096 + 3072); float sm = 0.f;
#pragma unroll
                for (int i = 0; i < 16; ++i) { const f32x4 v = pp[i]; sm += (v.x + v.y) + (v.z + v.w); }
                r = rsqrtf(sm * (1.f / 1024.f) + RMS_EPS); }
            rs[t] = r; }
        __syncthreads(); }
      pg8::EpiX<5> E{XN, 2048, nullptr, nullptr, nullptr, nullptr, 1.f};
      pg8::gemm_phase<pg8::EpiX<5>, pg8::StaticOrder, true, true>(ldsg, g, S, E); }
    PHASE_END
    PHASE_BEGIN
    p3b_rows(args, ldsc, G);
#ifdef DUP_MISC
    p3b_rows(args, ldsc, G);
#endif
    PHASE_END
    PHASE_BEGIN
    { pg8::Gemm g{XN + 1024, (const bf16*)(ws + WS_WT1), MROWS, LD1, 1024, 2048, 1024, 0}; pg8::StaticOrder S; S.init(MROWS, LD1, G, bx);
      pg8::EpiX<1> E{PB, LD1, nullptr, nullptr, nullptr, nullptr, attn_body::C2};
      pg8::gemm_phase<pg8::EpiX<1>, pg8::StaticOrder, true, true>(ldsg, g, S, E); }
    { pg8::Gemm g{XN + 1024, (const bf16*)(ws + WS_WT1) + (size_t)LD1 * 1024, MROWS, 1024, 256, 2048, 1024, 1}; pg8::StaticOrder S; S.init(MROWS, 1024, G, bx);
      pg8::EpiX<4> E{nullptr, 0, nullptr, (float*)(ws + WS_LF), (const bf16*)(ws + WS_LFP), nullptr, 1.f};
      pg8::gemm_phase<pg8::EpiX<4>, pg8::StaticOrder, true, true>(ldsg, g, S, E); }
#ifdef DUP_GEMM
    { pg8::Gemm g{XN + 1024, (const bf16*)(ws + WS_WT1), MROWS, LD1, 1024, 2048, 1024, 0}; pg8::StaticOrder S; S.init(MROWS, LD1, G, bx);
      pg8::EpiX<1> E{PB, LD1, nullptr, nullptr, nullptr, nullptr, attn_body::C2};
      pg8::gemm_phase<pg8::EpiX<1>, pg8::StaticOrder, true, true>(ldsg, g, S, E); }
#endif
    PHASE_END
    PHASE_BEGIN
    p5a_fcum(args, ldsc, G);
#ifdef DUP_S5
    p5a_fcum(args, ldsc, G);
#endif
    for (int v = vcu; v < 256; v += G) s5_unit(args, ldsc, v >> 5, v & 31);
#ifdef DUP_S5
    for (int v = vcu; v < 256; v += G) s5_unit(args, ldsc, v >> 5, v & 31);
#endif
    PHASE_END
    PHASE_BEGIN
#ifdef DUP_FOX
    fox_phase<true>(args, ldsc, vcu, G);
#endif
    if (vcu < 128) { pg8::Gemm g{XN + 1024, (const bf16*)(ws + WS_WG), MROWS, 512, 512, 2048, 512, 0}; pg8::StaticOrder S; S.init(MROWS, 512, 128, vcu);
      pg8::EpiX<3> E{PB + C1_U, LD1, args.in[I_OGLUB], nullptr, XN + 1024, PB + C1_ZD, 1.f};
      pg8::gemm_phase<pg8::EpiX<3>, pg8::StaticOrder, true, true>(ldsg, g, S, E); }
    fox_phase<false>(args, ldsc, vcu, G);
    PHASE_END
    PHASE_BEGIN
    { pg8::Gemm g{PB, (const bf16*)(ws + WS_WO1), MROWS, 1024, 2048, LD1, 2048, 0}; pg8::StaticOrder S; S.init(MROWS, 1024, G, bx);
      pg8::EpiX<2> E{XN + 1024, 2048, nullptr, nullptr, nullptr, nullptr, 1.f};
      pg8::gemm_phase<pg8::EpiX<2>, pg8::StaticOrder, true, true>(ldsg, g, S, E); }
#ifdef DUP_GEMM
    { pg8::Gemm g{PB, (const bf16*)(ws + WS_WO1), MROWS, 1024, 2048, LD1, 2048, 0}; pg8::StaticOrder S; S.init(MROWS, 1024, G, bx);
      pg8::EpiX<2> E{XN + 1024, 2048, nullptr, nullptr, nullptr, nullptr, 1.f};
      pg8::gemm_phase<pg8::EpiX<2>, pg8::StaticOrder, true, true>(ldsg, g, S, E); }
#endif
    PHASE_END
    PHASE_BEGIN
    p6b_rows(args, ldsc, G);
    PHASE_END_NOSYNC
}

extern "C" void kernel_launch(void* const* d_in, const int* in_sizes, int n_in, void* d_out, int out_size, void* d_ws, size_t ws_size, hipStream_t stream) {
    static int grid = 0;
    if (grid == 0) {
        if (n_in != 27 || out_size != MROWS * DMOD || ws_size < (size_t)256 * MiB) { fprintf(stderr, "kernel_launch: unexpected shapes n_in %d out %d ws %zu\n", n_in, out_size, ws_size); grid = -1; return; }
        int dev = 0, cus = 0, per_cu = 0;
        (void)hipGetDevice(&dev); (void)hipDeviceGetAttribute(&cus, hipDeviceAttributeMultiprocessorCount, dev);
        if (hipFuncSetAttribute((const void*)trunk_fwd, hipFuncAttributeMaxDynamicSharedMemorySize, LDS_BYTES) != hipSuccess) { fprintf(stderr, "kernel_launch: hipFuncSetAttribute failed\n"); }
        if (hipOccupancyMaxActiveBlocksPerMultiprocessor(&per_cu, (const void*)trunk_fwd, NTHR, LDS_BYTES) != hipSuccess || per_cu < 1) { fprintf(stderr, "kernel_launch: occupancy query says %d\n", per_cu); per_cu = 1; }
        (void)hipGetLastError();
        grid = cus * per_cu; if (grid > 256) grid = 256; if (grid < 1) grid = 256;
    }
    if (grid < 0) return;
    Args a{};
    for (int i = 0; i < 27; ++i) a.in[i] = (const float*)d_in[i];
    a.out = (float*)d_out; a.ws = (unsigned char*)d_ws;
    void* kargs[] = {&a};
    hipError_t e = hipLaunchCooperativeKernel((const void*)trunk_fwd, dim3(grid), dim3(NTHR), kargs, LDS_BYTES, stream);
    if (e != hipSuccess) fprintf(stderr, "cooperative launch failed: %s (grid %d)\n", hipGetErrorString(e), grid);
}
```

```cpp
#include <hip/hip_runtime.h>
#include <hip/hip_cooperative_groups.h>
#include <cstdio>
#include <cstdint>
namespace cg = cooperative_groups;
__device__ __forceinline__ int opaque_tid() { int t = threadIdx.x; asm volatile("" : "+v"(t)); return t; }
namespace pg8 {
#define PG8_LAS __attribute__((address_space(3)))
typedef unsigned short bf16_t;
typedef short bf16x8 __attribute__((ext_vector_type(8)));
typedef float f32x4 __attribute__((ext_vector_type(4)));
typedef unsigned u32x4 __attribute__((ext_vector_type(4)));
constexpr int BM = 256, BK = 64, HALF = 128, HTB = HALF * BK * 2  , STAGE_BYTES = 8 * HTB, NXCD = 8, WGM = 8;

__host__ __device__ __forceinline__ int lds_byte(int r, int c) { const int st = (r >> 4) * 2 + (c >> 5), rr = r & 15, cc = c & 31, ob = rr * 64 + cc * 2; return st * 1024 + (ob ^ (((ob >> 9) & 1) << 5)); }
__host__ __device__ __forceinline__ void stage_rc(int b, int& R, int& C) { const int st = b / 1024, sb = b % 1024, swz = sb ^ (((sb >> 9) & 1) << 5); R = (st >> 1) * 16 + swz / 64; C = (st & 1) * 32 + (swz % 64) / 2; }
__host__ __device__ __forceinline__ int perm32(int rho) { const int n = rho >> 4, i = rho & 15; return 8 * (i >> 2) + 4 * n + (i & 3); }

struct Unit { int pm, pn; };
struct Gemm { const bf16_t* A; const bf16_t* Bt; int M, N, K, lda, ldb, ksplit; };

struct StaticOrder {
    int nM, nN, nwg, G, c;
    __host__ __device__ __forceinline__ void init(int M, int N, int G_, int c_) { nM = M / BM; nN = N / BM; nwg = nM * nN; G = G_; c = c_; }
    __host__ __device__ __forceinline__ bool next(int i, Unit& u) const {
        const long L = (long)i * G + c; if (L >= nwg) return false;
        int wgid = (int)L; { const int q = nwg / NXCD, r = nwg % NXCD, xcd = wgid % NXCD, off = wgid / NXCD; wgid = (xcd < r ? xcd * (q + 1) : r * (q + 1) + (xcd - r) * q) + off; }
        const int nig = WGM * nN, gid = wgid / nig, fm = gid * WGM, gsz = (nM - fm) < WGM ? (nM - fm) : WGM;
        u.pm = fm + ((wgid % nig) % gsz); u.pn = (wgid % nig) / gsz; return true;
    }
    __device__ __forceinline__ void a_ready(const Unit&) const {}
    __device__ __forceinline__ void done(const Unit&) const {}
};

__device__ __forceinline__ unsigned cvt_pk_bf16(float lo, float hi) { unsigned r; asm volatile("v_cvt_pk_bf16_f32 %0, %1, %2" : "=v"(r) : "v"(lo), "v"(hi)); return r; }
__device__ __forceinline__ float bflo(unsigned w) { return __uint_as_float(w << 16); }
__device__ __forceinline__ float bfhi(unsigned w) { return __uint_as_float(w & 0xffff0000u); }
__device__ __forceinline__ float softplus_f(float x) { return x > 15.f ? x : __logf(1.f + __expf(x)); }
__device__ __forceinline__ float sigmoid_f(float x) { return __builtin_amdgcn_rcpf(1.f + __expf(-x)); }
constexpr int MROWS_ = 16384;
template <int MODE> struct EpiX {
    static constexpr bool PERM = true, AFTER_DRAIN = false; static constexpr int MIDT = (MODE == 5) ? 16 : -1;
    bf16_t* O; int ldc; const float* bias; float* F32O; const bf16_t* Y; const bf16_t* Zp; float qscale;
    __device__ __forceinline__ void mid(f32x4 (&acc)[2][2][4][2], int wr, int fr, PG8_LAS unsigned char* lds) const {
        const PG8_LAS float* rs = (const PG8_LAS float*)(lds + 131072);
#pragma unroll
        for (int ai = 0; ai < 2; ++ai)
#pragma unroll
            for (int m = 0; m < 4; ++m) { const float r = rs[ai * HALF + wr * 64 + m * 16 + fr];
#pragma unroll
                for (int bj = 0; bj < 2; ++bj)
#pragma unroll
                    for (int n = 0; n < 2; ++n) acc[ai][bj][m][n] = acc[ai][bj][m][n] * r; }
    }
    __device__ __forceinline__ void operator()(const f32x4 (&acc)[2][2][4][2], const Unit& u, int wr, int wc, int fr, int fq) const {
        const int row0 = u.pm * BM + wr * 64 + fr; const int col0 = u.pn * BM + wc * 32 + 8 * fq;
        float sc = 1.f;
        if (MODE == 0) { if (u.pn >= 4 && u.pn < 8) sc = qscale; }
        if (MODE == 1) { if (u.pn < 6) sc = qscale; }
        const bool special = (MODE == 0 && u.pn == 26);
#pragma unroll
        for (int ai = 0; ai < 2; ++ai)
#pragma unroll
            for (int m = 0; m < 4; ++m) { const int row = row0 + ai * HALF + m * 16;
#pragma unroll
                for (int bj = 0; bj < 2; ++bj) { f32x4 v0 = acc[ai][bj][m][0], v1 = acc[ai][bj][m][1]; const int col = col0 + bj * HALF;
                    if (MODE == 0 || MODE == 1) {
                        if (!special) { v0 = v0 * sc; v1 = v1 * sc; u32x4 w; w.x = cvt_pk_bf16(v0[0], v0[1]); w.y = cvt_pk_bf16(v0[2], v0[3]); w.z = cvt_pk_bf16(v1[0], v1[1]); w.w = cvt_pk_bf16(v1[2], v1[3]);
                            *(u32x4*)(O + (size_t)row * ldc + col) = w; }
                        else { const int lc = col - u.pn * BM; const int NV = (MODE == 0) ? 16 : 24;
                            if (lc < NV) { f32x4 o0, o1;
#pragma unroll
                                for (int i = 0; i < 4; ++i) { const float a0 = v0[i] + bias[lc + i], a1 = v1[i] + bias[lc + 4 + i];
                                    if (MODE == 0) { o0[i] = softplus_f(a0); o1[i] = softplus_f(a1); } else { o0[i] = -softplus_f(-a0); o1[i] = -softplus_f(-a1); } }
                                *(f32x4*)(F32O + (size_t)row * NV + lc) = o0; *(f32x4*)(F32O + (size_t)row * NV + lc + 4) = o1; } }
                    } else if (MODE == 4) {
                        const int lc = col - u.pn * BM;
                        if (lc < 24) { float* dst = (u.pn == 0 ? F32O : (float*)((unsigned char*)Y + (size_t)(u.pn - 1) * (MROWS_ * 24 * 4))) + (size_t)row * 24 + lc; *(f32x4*)dst = v0; *(f32x4*)(dst + 4) = v1; }
                    } else if (MODE == 2 || MODE == 5) {
                        u32x4 w; w.x = cvt_pk_bf16(v0[0], v0[1]); w.y = cvt_pk_bf16(v0[2], v0[3]); w.z = cvt_pk_bf16(v1[0], v1[1]); w.w = cvt_pk_bf16(v1[2], v1[3]);
                        *(u32x4*)(O + (size_t)row * ldc + col) = w;
                    } else {
                        const u32x4 yv = *(const u32x4*)(Y + (size_t)row * 2048 + col); const u32x4 zv = *(const u32x4*)(Zp + (size_t)row * ldc + col);
                        const f32x4 b0 = *(const f32x4*)(bias + col), b1 = *(const f32x4*)(bias + col + 4);
                        float r[8];
#pragma unroll
                        for (int e = 0; e < 4; ++e) { const float y0 = bflo(yv[e]), y1 = bfhi(yv[e]), z0 = bflo(zv[e]), z1 = bfhi(zv[e]);
                            const float a0 = (e < 2 ? v0[2 * e] : v1[2 * e - 4]) + (e < 2 ? b0[2 * e] : b1[2 * e - 4]);
                            const float a1 = (e < 2 ? v0[2 * e + 1] : v1[2 * e - 3]) + (e < 2 ? b0[2 * e + 1] : b1[2 * e - 3]);
                            r[2 * e] = y0 * sigmoid_f(a0) * z0 * sigmoid_f(z0); r[2 * e + 1] = y1 * sigmoid_f(a1) * z1 * sigmoid_f(z1); }
                        u32x4 w; w.x = cvt_pk_bf16(r[0], r[1]); w.y = cvt_pk_bf16(r[2], r[3]); w.z = cvt_pk_bf16(r[4], r[5]); w.w = cvt_pk_bf16(r[6], r[7]);
                        *(u32x4*)(O + (size_t)row * ldc + col) = w;
                    } } }
    }
};
template <class Epi, class Sched, bool ALIGN_EPI = false, bool SP2 = false>
__device__ __forceinline__ void gemm_phase(PG8_LAS unsigned char* lds, const Gemm g, const Sched& S, const Epi& E) {
    const int tid = opaque_tid(), wid = __builtin_amdgcn_readfirstlane(tid >> 6), lane = tid & 63, wr = wid >> 2, wc = wid & 3, fr = lane & 15, fq = lane >> 4;
    const int K = g.K, nt = K / BK;
    unsigned voffA[2], voffB[2];
#pragma unroll
    for (int i = 0; i < 2; ++i) { int R, C; stage_rc(tid * 16 + i * 8192, R, C); const int Rb = Epi::PERM ? ((R & ~31) + perm32(R & 31)) : R;
        voffA[i] = (unsigned)(R * g.lda + C) * 2u; voffB[i] = (unsigned)(Rb * g.ldb + C) * 2u; }
    const size_t kstep = (size_t)(BK * 2);
    const size_t hstepA = (size_t)HALF * g.lda * 2, hstepB = (size_t)HALF * g.ldb * 2;
    const size_t tstepA = 2 * hstepA, tstepB = g.ksplit ? (size_t)K * 2 : 2 * hstepB, kslA = g.ksplit ? (size_t)K * 2 : 0;
    const unsigned ldsw = (unsigned)wid * 1024u;
    const int aoff = lds_byte(wr * 64 + fr, fq * 8), boff = lds_byte(wc * 32 + fr, fq * 8);
#define PG8_SA(b, h) (((b) * 2 + (h)) * HTB)
#define PG8_SB(b, h) ((4 + (b) * 2 + (h)) * HTB)
#define PG8_STAGE(bufoff, gbase, voff) do { _Pragma("unroll") for (int _i = 0; _i < 2; ++_i) \
        __builtin_amdgcn_global_load_lds((const unsigned*)((const char*)(gbase) + (voff)[_i]), (PG8_LAS unsigned*)(lds + (bufoff) + ldsw + _i * 8192), 16, 0, 0); } while (0)
#define PG8_LDA(dst, b, h) do { _Pragma("unroll") for (int m = 0; m < 4; ++m) _Pragma("unroll") for (int k = 0; k < 2; ++k) dst[m][k] = *(const PG8_LAS bf16x8*)(lds + PG8_SA(b, h) + aoff + m * 2048 + k * 1024); } while (0)
#define PG8_LDB(dst, b, h) do { _Pragma("unroll") for (int n = 0; n < 2; ++n) _Pragma("unroll") for (int k = 0; k < 2; ++k) dst[n][k] = *(const PG8_LAS bf16x8*)(lds + PG8_SB(b, h) + boff + n * 2048 + k * 1024); } while (0)
#define PG8_MMA(ai, bj, At, Bt) do { __builtin_amdgcn_s_setprio(1); _Pragma("unroll") for (int m = 0; m < 4; ++m) _Pragma("unroll") for (int n = 0; n < 2; ++n) _Pragma("unroll") for (int k = 0; k < 2; ++k) \
        acc[ai][bj][m][n] = __builtin_amdgcn_mfma_f32_16x16x32_bf16(Bt[n][k], At[m][k], acc[ai][bj][m][n], 0, 0, 0); __builtin_amdgcn_s_setprio(0); } while (0)
#define PG8_WAIT_V(n) asm volatile("s_waitcnt vmcnt(" #n ")" ::: "memory")
#define PG8_WAIT_L(n) asm volatile("s_waitcnt lgkmcnt(" #n ")" ::: "memory")
#define PG8_BAR __builtin_amdgcn_s_barrier()
#define PG8_SCHED __builtin_amdgcn_sched_barrier(0)
    Unit cur, nxt; int ui = 0;
    if (!S.next(0, cur)) return;
    f32x4 acc[2][2][4][2];
#pragma unroll
    for (int a = 0; a < 2; ++a)
#pragma unroll
        for (int b = 0; b < 2; ++b)
#pragma unroll
            for (int m = 0; m < 4; ++m)
#pragma unroll
                for (int n = 0; n < 2; ++n) acc[a][b][m][n] = (f32x4){0.f, 0.f, 0.f, 0.f};
    bf16x8 At[4][2], B0[2][2], B1[2][2];
    const char* cA = (const char*)g.A + (size_t)cur.pm * tstepA + (size_t)cur.pn * kslA; const char* cB = (const char*)g.Bt + (size_t)cur.pn * tstepB;
    S.a_ready(cur);
    if constexpr (SP2) {
        PG8_STAGE(PG8_SB(0, 0), cB, voffB); PG8_STAGE(PG8_SB(0, 1), cB + hstepB, voffB); PG8_STAGE(PG8_SA(0, 0), cA, voffA); PG8_STAGE(PG8_SA(0, 1), cA + hstepA, voffA);
        if (wr == 1) PG8_BAR;
        PG8_WAIT_V(2); PG8_BAR;
        PG8_STAGE(PG8_SB(1, 0), cB + kstep, voffB); PG8_STAGE(PG8_SA(1, 0), cA + kstep, voffA); PG8_STAGE(PG8_SB(1, 1), cB + hstepB + kstep, voffB);
        PG8_WAIT_V(6); PG8_BAR;
    } else {
        PG8_STAGE(PG8_SB(0, 0), cB, voffB); PG8_STAGE(PG8_SA(0, 0), cA, voffA); PG8_STAGE(PG8_SB(0, 1), cB + hstepB, voffB); PG8_STAGE(PG8_SA(0, 1), cA + hstepA, voffA);
        if (wr == 1) PG8_BAR;
        PG8_WAIT_V(4); PG8_BAR;
        PG8_STAGE(PG8_SB(1, 0), cB + kstep, voffB); PG8_STAGE(PG8_SA(1, 0), cA + kstep, voffA); PG8_STAGE(PG8_SB(1, 1), cB + hstepB + kstep, voffB);
        PG8_WAIT_V(6); PG8_BAR;
    }
    for (;;) {
        const bool has_next = S.next(ui + 1, nxt);
        const char* nA = has_next ? (const char*)g.A + (size_t)nxt.pm * tstepA + (size_t)nxt.pn * kslA : cA; const char* nB = has_next ? (const char*)g.Bt + (size_t)nxt.pn * tstepB : cB;
        for (int t = 0; t < nt; t += 2) {
            if constexpr (Epi::MIDT >= 0) { if (t == Epi::MIDT) E.mid(acc, wr, fr, lds); }
            const bool last = (t == nt - 2);
            const char* a1 = cA + (size_t)(t + 1) * kstep;
            const char* a2 = last ? nA : cA + (size_t)(t + 2) * kstep; const char* b2 = last ? nB : cB + (size_t)(t + 2) * kstep;
            const char* a3 = a2 + kstep; const char* b3 = b2 + kstep;
            if (last && has_next) S.a_ready(nxt);
            if constexpr (SP2) {
            PG8_LDB(B0, 0, 0); PG8_LDB(B1, 0, 1); PG8_SCHED; PG8_LDA(At, 0, 0); PG8_STAGE(PG8_SA(1, 1), a1 + hstepA, voffA);
            PG8_WAIT_V(8); PG8_WAIT_L(0); PG8_BAR; PG8_MMA(0, 0, At, B0); PG8_MMA(0, 1, At, B1); PG8_BAR; PG8_SCHED;
            PG8_LDA(At, 0, 1); PG8_STAGE(PG8_SB(0, 0), b2, voffB); PG8_STAGE(PG8_SB(0, 1), b2 + hstepB, voffB); PG8_STAGE(PG8_SA(0, 0), a2, voffA);
            PG8_WAIT_V(8); PG8_WAIT_L(0); PG8_BAR; PG8_MMA(1, 0, At, B0); PG8_MMA(1, 1, At, B1); PG8_BAR; PG8_SCHED;
            PG8_LDB(B0, 1, 0); PG8_LDB(B1, 1, 1); PG8_SCHED; PG8_LDA(At, 1, 0); PG8_STAGE(PG8_SA(0, 1), a2 + hstepA, voffA);
            PG8_WAIT_V(8); PG8_WAIT_L(0); PG8_BAR; PG8_MMA(0, 0, At, B0); PG8_MMA(0, 1, At, B1); PG8_BAR; PG8_SCHED;
            PG8_LDA(At, 1, 1); PG8_STAGE(PG8_SB(1, 0), b3, voffB); PG8_STAGE(PG8_SB(1, 1), b3 + hstepB, voffB); PG8_STAGE(PG8_SA(1, 0), a3, voffA);
            PG8_WAIT_V(8); PG8_WAIT_L(0); PG8_BAR; PG8_MMA(1, 0, At, B0); PG8_MMA(1, 1, At, B1); PG8_BAR; PG8_SCHED;
            } else {
            PG8_LDB(B0, 0, 0); PG8_SCHED; PG8_LDA(At, 0, 0); PG8_STAGE(PG8_SA(1, 1), a1 + hstepA, voffA);
            PG8_WAIT_L(8); PG8_BAR; PG8_WAIT_L(0); PG8_MMA(0, 0, At, B0); PG8_BAR; PG8_SCHED;
            PG8_LDB(B1, 0, 1); PG8_STAGE(PG8_SB(0, 0), b2, voffB);
            PG8_BAR; PG8_WAIT_L(0); PG8_MMA(0, 1, At, B1); PG8_BAR;
            PG8_LDA(At, 0, 1); PG8_STAGE(PG8_SA(0, 0), a2, voffA);
            PG8_BAR; PG8_WAIT_L(0); PG8_MMA(1, 0, At, B0); PG8_BAR; PG8_SCHED;
            PG8_STAGE(PG8_SB(0, 1), b2 + hstepB, voffB);
            PG8_WAIT_V(6); PG8_BAR; PG8_MMA(1, 1, At, B1); PG8_BAR;
            PG8_LDB(B0, 1, 0); PG8_SCHED; PG8_LDA(At, 1, 0); PG8_STAGE(PG8_SA(0, 1), a2 + hstepA, voffA);
            PG8_WAIT_L(8); PG8_BAR; PG8_WAIT_L(0); PG8_MMA(0, 0, At, B0); PG8_BAR; PG8_SCHED;
            PG8_LDB(B1, 1, 1); PG8_STAGE(PG8_SB(1, 0), b3, voffB);
            PG8_BAR; PG8_WAIT_L(0); PG8_MMA(0, 1, At, B1); PG8_BAR;
            PG8_LDA(At, 1, 1); PG8_STAGE(PG8_SA(1, 0), a3, voffA);
            PG8_BAR; PG8_WAIT_L(0); PG8_MMA(1, 0, At, B0); PG8_BAR; PG8_SCHED;
            PG8_STAGE(PG8_SB(1, 1), b3 + hstepB, voffB);
            PG8_WAIT_V(6); PG8_BAR; PG8_MMA(1, 1, At, B1); PG8_BAR;
            }
        }
        if constexpr (ALIGN_EPI) { if (wr == 0) PG8_BAR; }
        if constexpr (!Epi::AFTER_DRAIN) { E(acc, cur, wr, wc, fr, fq); S.done(cur); }
        if (!has_next) break;
#pragma unroll
        for (int a = 0; a < 2; ++a)
#pragma unroll
            for (int b = 0; b < 2; ++b)
#pragma unroll
                for (int m = 0; m < 4; ++m)
#pragma unroll
                    for (int n = 0; n < 2; ++n) acc[a][b][m][n] = (f32x4){0.f, 0.f, 0.f, 0.f};
        cur = nxt; cA = nA; cB = nB; ++ui;
        if constexpr (ALIGN_EPI) { if (wr == 1) PG8_BAR; }
    }
    PG8_WAIT_V(0);
    if constexpr (!ALIGN_EPI) { if (wr == 0) PG8_BAR; }
    PG8_BAR;
    if constexpr (Epi::AFTER_DRAIN) { E.fused(acc, cur, wr, wc, fr, fq, lds, wid, lane); S.done(cur); }
#undef PG8_SA
#undef PG8_SB
#undef PG8_STAGE
#undef PG8_LDA
#undef PG8_LDB
#undef PG8_MMA
#undef PG8_WAIT_V
#undef PG8_WAIT_L
#undef PG8_BAR
#undef PG8_SCHED
}
}

#include <hip/hip_bf16.h>
#include <cmath>
namespace attn_body {
using bf16=__hip_bfloat16;
using bf16x8=__attribute__((ext_vector_type(8)))short;
using s16x4=__attribute__((ext_vector_type(4)))short;
using f32x16=__attribute__((ext_vector_type(16)))float;
using u32x4=__attribute__((ext_vector_type(4)))unsigned;
constexpr int SEQ=2048,D=64;
constexpr int NW=8,QBLK=32,QB=QBLK*NW,KVBLK=64,NQB=SEQ/QB;
constexpr int ATTN_UNIT_ROWS=QB;
__device__ __forceinline__ int crow(int r,int hi){return (r&3)+8*(r>>2)+4*hi;}
#define SBAR() __builtin_amdgcn_sched_barrier(0)
__device__ __forceinline__ void cmask(f32x16&p0,f32x16&p1,int jb,int qrel,int hi){
  const float NEG=-INFINITY; int kb=64*jb+4*hi;
  #pragma unroll
  for(int r=0;r<16;++r){int kv=kb+(r&3)+8*(r>>2); if(kv>qrel)p0[r]=NEG; if(kv+32>qrel)p1[r]=NEG;}
}

constexpr int NSLOT=3, SLOTB=8192;
constexpr int LDS_K=0, LDS_V=NSLOT*SLOTB, LDS_WS=2*NSLOT*SLOTB, LDS_OST=LDS_WS+NW*64*4, LDS_BYTES=LDS_OST+NW*4096;
constexpr int XOFF=86016; constexpr float SENT=-30000.f; using f32x4=__attribute__((ext_vector_type(4)))float;
constexpr float C2=0.125f*1.4426950408889634f;
__device__ __forceinline__ void glds16(const void*gsrc,unsigned lds_dst){unsigned keep;
  asm volatile("s_mov_b32 %0, m0\n\ts_mov_b32 m0, %2\n\ts_nop 0\n\tglobal_load_lds_dwordx4 %1, off\n\ts_mov_b32 m0, %0":"=&s"(keep):"v"(gsrc),"s"(lds_dst):"memory");}
__device__ __forceinline__ float max3f(float a,float b,float c){float r;asm("v_max3_f32 %0, %1, %2, %3":"=v"(r):"v"(a),"v"(b),"v"(c));return r;}
__device__ __forceinline__ float max2f(float a,float b){float r;asm("v_max_f32_e32 %0, %1, %2":"=v"(r):"v"(a),"v"(b));return r;}
__device__ __forceinline__ float fadd_s(float a,float b){float r;asm("v_add_f32_e32 %0, %1, %2":"=v"(r):"v"(a),"v"(b));return r;}
__device__ __forceinline__ float fsub_s(float a,float b){float r;asm("v_sub_f32_e32 %0, %1, %2":"=v"(r):"v"(a),"v"(b));return r;}
typedef float f32x2_t __attribute__((ext_vector_type(2))); typedef __bf16 bf16x2_t __attribute__((ext_vector_type(2)));
__device__ __forceinline__ unsigned cvtpk_s(float lo,float hi){f32x2_t v={lo,hi};bf16x2_t b=__builtin_convertvector(v,bf16x2_t);return __builtin_bit_cast(unsigned,b);}
#define WAIT_BAR(N) asm volatile("s_waitcnt vmcnt(" #N ") lgkmcnt(0)\n\ts_barrier":::"memory")

__device__ __forceinline__ void qkt(f32x16&p0,f32x16&p1,const char*Kslot,const bf16x8*qr,const f32x16&negm,int r32,int hi){
  const char*kb=Kslot+hi*1024+r32*16;
  #pragma unroll
  for(int d0=0;d0<4;++d0){
    const bf16x8 b0=*reinterpret_cast<const bf16x8*>(kb+d0*2048);
    const bf16x8 b1=*reinterpret_cast<const bf16x8*>(kb+d0*2048+512);
    if(d0==0){p0=__builtin_amdgcn_mfma_f32_32x32x16_bf16(b0,qr[0],negm,0,0,0);p1=__builtin_amdgcn_mfma_f32_32x32x16_bf16(b1,qr[0],negm,0,0,0);}
    else{p0=__builtin_amdgcn_mfma_f32_32x32x16_bf16(b0,qr[d0],p0,0,0,0);p1=__builtin_amdgcn_mfma_f32_32x32x16_bf16(b1,qr[d0],p1,0,0,0);}}
}
typedef __attribute__((address_space(3))) const char* lds_cptr;
typedef short v4i16_t __attribute__((ext_vector_type(4)));
__device__ __forceinline__ void kload8(bf16x8*kf,lds_cptr kp){
  kf[0]=*(const __attribute__((address_space(3))) bf16x8*)(kp);      kf[1]=*(const __attribute__((address_space(3))) bf16x8*)(kp+512);
  kf[2]=*(const __attribute__((address_space(3))) bf16x8*)(kp+2048); kf[3]=*(const __attribute__((address_space(3))) bf16x8*)(kp+2560);
  kf[4]=*(const __attribute__((address_space(3))) bf16x8*)(kp+4096); kf[5]=*(const __attribute__((address_space(3))) bf16x8*)(kp+4608);
  kf[6]=*(const __attribute__((address_space(3))) bf16x8*)(kp+6144); kf[7]=*(const __attribute__((address_space(3))) bf16x8*)(kp+6656);
}
__device__ __forceinline__ void kload2(bf16x8*kf,lds_cptr kp,int j){ kf[2*j]=*(const __attribute__((address_space(3))) bf16x8*)(kp+j*2048); kf[2*j+1]=*(const __attribute__((address_space(3))) bf16x8*)(kp+j*2048+512); }
__device__ __forceinline__ s16x4 vtr(lds_cptr p){ return __builtin_bit_cast(s16x4,__builtin_amdgcn_ds_read_tr16_b64_v4i16((__attribute__((address_space(3))) v4i16_t*)p)); }
__device__ __forceinline__ float rowmax(const f32x16&p0,const f32x16&p1){
  float a=max3f(p0[0],p0[1],p1[0]),b=max3f(p0[2],p0[3],p1[1]);a=max3f(a,p1[2],p1[3]);
  #pragma unroll
  for(int r=4;r<16;r+=4){a=max3f(a,p0[r],p0[r+1]);b=max3f(b,p0[r+2],p0[r+3]);a=max3f(a,p1[r],p1[r+1]);b=max3f(b,p1[r+2],p1[r+3]);}
  const float m=max2f(a,b);
  auto rr=__builtin_amdgcn_permlane32_swap(__float_as_uint(m),__float_as_uint(m),false,false);
  return max2f(__uint_as_float(rr[0]),__uint_as_float(rr[1]));
}
__device__ __forceinline__ void pv(f32x16*o,int vb,bf16x8 pa0,bf16x8 pa1,bf16x8 pa2,bf16x8 pa3){
  #pragma unroll
  for(int d0=0;d0<2;++d0){s16x4 lo[4],hi[4];
    #pragma unroll
    for(int ks=0;ks<4;++ks){
      asm volatile("ds_read_b64_tr_b16 %0,%1 offset:%c2":"=&v"(lo[ks]):"v"(vb),"i"(d0*4096+ks*1024):"memory");
      asm volatile("ds_read_b64_tr_b16 %0,%1 offset:%c2":"=&v"(hi[ks]):"v"(vb),"i"(d0*4096+ks*1024+512):"memory");}
    asm volatile("s_waitcnt lgkmcnt(0)":::"memory");SBAR();
    #define PK(k) (bf16x8){lo[k][0],lo[k][1],lo[k][2],lo[k][3],hi[k][0],hi[k][1],hi[k][2],hi[k][3]}
    o[d0]=__builtin_amdgcn_mfma_f32_32x32x16_bf16(pa0,PK(0),o[d0],0,0,0);
    o[d0]=__builtin_amdgcn_mfma_f32_32x32x16_bf16(pa1,PK(1),o[d0],0,0,0);
    o[d0]=__builtin_amdgcn_mfma_f32_32x32x16_bf16(pa2,PK(2),o[d0],0,0,0);
    o[d0]=__builtin_amdgcn_mfma_f32_32x32x16_bf16(pa3,PK(3),o[d0],0,0,0);
    #undef PK
  }
}

#ifndef ATTN_STORE16
#define ATTN_STORE16(p,v) (*(u32x4*)(p)=(v))
#endif
template<int THRL,int MODE,int DM,bool DRY=false> __device__ __forceinline__ void attn_unit(int b,int h,int qb,const bf16*Q,const bf16*__restrict__ K,const bf16*__restrict__ V,bf16*O,const bf16*__restrict__ Z,const float*__restrict__ XP,const int*__restrict__ TS,volatile unsigned*lw,unsigned nxt,char*shm){
  const int tid=opaque_tid(),lane=tid&63,r32=lane&31,hi=lane>>5; const int wid=__builtin_amdgcn_readfirstlane(tid>>6);
  const long rowbase=(long)b*SEQ; const int q0=qb*QB;
  const bf16*Qw=Q+(rowbase+q0+wid*QBLK)*DM+h*D;
  bf16x8 qr[4];
  #pragma unroll
  for(int d0=0;d0<4;++d0)qr[d0]=*reinterpret_cast<const bf16x8*>(&Qw[(long)r32*DM+d0*16+hi*8]);
  const bf16*Kh=K+rowbase*DM+h*D,*Vh=V+rowbase*DM+h*D;
  const unsigned lds0=(unsigned)(uintptr_t)shm;
  float*wsf=(float*)(shm+LDS_WS)+wid*64;
  const bf16*ksrc_=Kh+(long)lane*DM+wid*8; int tskip=0; const bf16*ksrc=ksrc_;
  const bf16*vsrc_=Vh+(long)(16*(wid&3)+(lane>>2))*DM+(wid>>2)*32+(lane&3)*8; const bf16*vsrc=vsrc_;
  const unsigned kdst=lds0+LDS_K+wid*1024, vdst=lds0+LDS_V+wid*1024;
  #define DMA_K(t,slot) glds16(ksrc+(long)(t)*KVBLK*DM,(unsigned)__builtin_amdgcn_readfirstlane(kdst+(slot)))
  #define DMA_V(t,slot) glds16(vsrc+(long)(t)*KVBLK*DM,(unsigned)__builtin_amdgcn_readfirstlane(vdst+(slot)))
  const int vb0=(int)(lds0+LDS_V)+((lane>>4)&1)*32+(lane&3)*8+(4*hi+((lane&15)>>2))*64;
  const char*Kbase=shm+LDS_K; bf16x8 kf[8];
  const lds_cptr shm3=(lds_cptr)shm; const lds_cptr kp0=shm3+LDS_K+hi*1024+r32*16; const lds_cptr vp0=shm3+LDS_V+((lane>>4)&1)*32+(lane&3)*8+(4*hi+((lane&15)>>2))*64;
  int NT=(q0+QB)/KVBLK;
  const int qrel=wid*QBLK+r32;
  unsigned sel=0u;
  if constexpr(MODE==1){
    tskip=__builtin_amdgcn_readfirstlane(TS[qb]);
    ksrc=ksrc_+(long)tskip*KVBLK*DM; vsrc=vsrc_+(long)tskip*KVBLK*DM; NT-=tskip;
  }
  const lds_cptr fsl=(lds_cptr)shm+XOFF+16*hi+tskip*256;
  #define XMASK(P0,P1,t) do{ if constexpr(MODE==0){ if((t)<NT-4){ const bool keep_=(sel>>((t)>>2))&1u; \
        _Pragma("unroll") for(int r=0;r<16;++r){P0[r]=keep_?P0[r]:SENT;P1[r]=keep_?P1[r]:SENT;} } } \
      else { const lds_cptr fp_=fsl+(t)*256; const float mh_=mhat; \
        _Pragma("unroll") for(int g_=0;g_<4;++g_){ const f32x4 fa_=*(const __attribute__((address_space(3))) f32x4*)(fp_+g_*32)+mh_; const f32x4 fb_=*(const __attribute__((address_space(3))) f32x4*)(fp_+128+g_*32)+mh_; \
          _Pragma("unroll") for(int i_=0;i_<4;++i_){P0[4*g_+i_]-=fa_[i_];P1[4*g_+i_]-=fb_[i_];} } } }while(0)
  DMA_K(0,0);DMA_V(0,0);DMA_K(1,SLOTB);
  float mhat=0.f,l_reg=0.f;f32x16 o[2];o[0]=f32x16{};o[1]=f32x16{};f32x16 negm=f32x16{}; if constexpr(MODE==0){asm volatile("":"+v"(negm));}
  #define CMASK(P0,P1,t) do{int jb_=(t)-(NT-4); if(jb_>=0)cmask(P0,P1,jb_,qrel,hi);}while(0)
  const f32x16 czero_=f32x16{};
  #define NEGM (MODE==1?czero_:negm)
  bool resc=false;
  #define START(P0,P1) do{ const float rm=rowmax(P0,P1); resc=false; \
    { const float dl=rm; mhat=fadd_s(mhat,dl); \
      _Pragma("unroll") for(int r=0;r<16;++r){P0[r]=fsub_s(P0[r],dl);P1[r]=fsub_s(P1[r],dl);} \
      if constexpr(MODE==0){ _Pragma("unroll") for(int r=0;r<16;++r)negm[r]=-mhat; asm volatile("":"+v"(negm)); } } \
    _Pragma("unroll") for(int r=0;r<16;++r)P0[r]=__builtin_amdgcn_exp2f(P0[r]); }while(0)
  #define RESC() do{ if(resc){ asm volatile("s_waitcnt lgkmcnt(0)":::"memory"); \
      _Pragma("unroll") for(int d_=0;d_<2;++d_) _Pragma("unroll") for(int r=0;r<16;++r)o[d_][r]*=wsf[crow(r,hi)]; } }while(0)
  f32x16 pA0,pA1,pB0,pB1;
  int sl_prev=0,sl_cur=0,sl_next=SLOTB;
  #define ROT() do{sl_prev=sl_cur;sl_cur=sl_next;sl_next=(sl_next==(NSLOT-1)*SLOTB)?0:sl_next+SLOTB;}while(0)
  DMA_K(2,2*SLOTB);
  if constexpr(MODE==1){ float*fs=(float*)(shm+XOFF); for(int i=tid+64*tskip;i<q0+QB;i+=NW*64)fs[i]=XP[i]; }
  if constexpr(MODE==0){
    float*kbs=(float*)(shm+XOFF); unsigned*sm=(unsigned*)(shm+XOFF+2048);
    kbs[tid]=XP[tid];
    asm volatile("s_waitcnt vmcnt(0) lgkmcnt(0)\n\ts_barrier":::"memory");
    if(tid<QB){ unsigned m=(1u<<qb)-1u;
      if(qb>3){ const bf16*qp=Q+(rowbase+q0+tid)*DM+h*D; float g[8];
        _Pragma("unroll") for(int n=0;n<8;++n)g[n]=0.f;
        _Pragma("unroll") for(int c=0;c<8;++c){ const bf16x8 qv=*reinterpret_cast<const bf16x8*>(qp+c*8);
          _Pragma("unroll") for(int j=0;j<8;++j){ const float qf=__uint_as_float(((unsigned)(unsigned short)qv[j])<<16);
            _Pragma("unroll") for(int n=0;n<8;++n)g[n]+=qf*kbs[n*64+c*8+j]; } }
        m=0u;
        _Pragma("unroll") for(int it=0;it<3;++it){ float best=-INFINITY; int bi=0;
          _Pragma("unroll") for(int n=0;n<8;++n){ const bool ok=(n<qb)&&!((m>>n)&1u)&&(g[n]>best); best=ok?g[n]:best; bi=ok?n:bi; }
          m|=1u<<bi; } }
      sm[tid]=m; }
    asm volatile("s_waitcnt vmcnt(0) lgkmcnt(0)\n\ts_barrier":::"memory");
    sel=sm[qrel];
  }
  WAIT_BAR(3);
  qkt(pA0,pA1,Kbase,qr,NEGM,r32,hi);asm volatile("s_nop 15\n\ts_nop 7":"+v"(pA0),"+v"(pA1));XMASK(pA0,pA1,0);CMASK(pA0,pA1,0);
  START(pA0,pA1);
  _Pragma("unroll") for(int r=0;r<16;++r)pA1[r]=__builtin_amdgcn_exp2f(pA1[r]);
  WAIT_BAR(0);
  DMA_K(3,0);DMA_V(1,SLOTB);
  ROT();
  kload8(kf,kp0+sl_cur);
  WAIT_BAR(2);
  s16x4 vlo[8],vhi[8]; u32x4 pw0,pw1,pw2,pw3;
  #define PKW(P,B) cvtpk_s(P[B],P[B+1])
  #define PAF(k) __builtin_bit_cast(bf16x8,pw##k)
  #define VFR(i) (bf16x8){vlo[i][0],vlo[i][1],vlo[i][2],vlo[i][3],vhi[i][0],vhi[i][1],vhi[i][2],vhi[i][3]}
  #define PIN(x) asm volatile("":"+v"(x))
  #define MX3(a,b,c) __builtin_fmaxf(__builtin_fmaxf((a),(b)),(c))
  #define GAPA(MF,A0,A1,A2,A3,W0,W1,PW) do{ MF; sacc+=A0; sacc+=A1; sacc+=A2; sacc+=A3; PIN(sacc); W0; W1; PIN(PW); SBAR(); }while(0)
  #define EX(v) __builtin_amdgcn_exp2f(v)
  #define GAPB(MF,X,B) do{ MF; X[B]=EX(X[B]); X[B+1]=EX(X[B+1]); X[B+2]=EX(X[B+2]); X[B+3]=EX(X[B+3]); PIN(X); SBAR(); }while(0)
  #define VRD(i) do{ vlo[i]=vtr(vp_+(((i)>>2)*4096+((i)&3)*1024)); vhi[i]=vtr(vp_+(((i)>>2)*4096+((i)&3)*1024+512)); }while(0)
  #define KRD(G,j) do{ if(G){ kload2(kf,kp0+sl_next,j); SBAR(); } }while(0)
  #define STEP(C0,C1,P0,P1,t,GK,GV,GL) do{ SBAR(); \
    const lds_cptr vp_=vp0+sl_prev; \
    VRD(0); SBAR(); float sacc=(P0[0]+P0[1]); \
    GAPA(C0=__builtin_amdgcn_mfma_f32_32x32x16_bf16(kf[0],qr[0],NEGM,0,0,0), P0[2],P0[3],P0[4],P0[5],     pw0[0]=PKW(P0,0), pw0[1]=PKW(P0,2), pw0); \
    VRD(4); SBAR(); GAPA(C1=__builtin_amdgcn_mfma_f32_32x32x16_bf16(kf[1],qr[0],NEGM,0,0,0), P0[6],P0[7],P0[8],P0[9],     pw0[2]=PKW(P0,4), pw0[3]=PKW(P0,6), pw0); \
    VRD(1); SBAR(); GAPA(C0=__builtin_amdgcn_mfma_f32_32x32x16_bf16(kf[2],qr[1],C0,0,0,0),   P0[10],P0[11],P0[12],P0[13], pw1[0]=PKW(P0,8), pw1[1]=PKW(P0,10), pw1); \
    VRD(5); SBAR(); GAPA(C1=__builtin_amdgcn_mfma_f32_32x32x16_bf16(kf[3],qr[1],C1,0,0,0),   P0[14],P0[15],P1[0],P1[1],   pw1[2]=PKW(P0,12),pw1[3]=PKW(P0,14), pw1); \
    VRD(2); SBAR(); GAPA(C0=__builtin_amdgcn_mfma_f32_32x32x16_bf16(kf[4],qr[2],C0,0,0,0),   P1[2],P1[3],P1[4],P1[5],     pw2[0]=PKW(P1,0), pw2[1]=PKW(P1,2), pw2); \
    VRD(6); SBAR(); GAPA(C1=__builtin_amdgcn_mfma_f32_32x32x16_bf16(kf[5],qr[2],C1,0,0,0),   P1[6],P1[7],P1[8],P1[9],     pw2[2]=PKW(P1,4), pw2[3]=PKW(P1,6), pw2); \
    VRD(3); SBAR(); GAPA(C0=__builtin_amdgcn_mfma_f32_32x32x16_bf16(kf[6],qr[3],C0,0,0,0),   P1[10],P1[11],P1[12],P1[13], pw3[0]=PKW(P1,8), pw3[1]=PKW(P1,10), pw3); \
    VRD(7); SBAR(); GAPA(C1=__builtin_amdgcn_mfma_f32_32x32x16_bf16(kf[7],qr[3],C1,0,0,0),   P1[14],P1[15],0.f,0.f,       pw3[2]=PKW(P1,12),pw3[3]=PKW(P1,14), pw3); \
    l_reg+=sacc; \
    if(GK){DMA_K((t)+3,sl_cur);} if(GV){DMA_V((t)+1,sl_next);} \
    XMASK(C0,C1,t); CMASK(C0,C1,t); \
    { float a=MX3(C0[0],C0[1],C1[0]),b=MX3(C0[2],C0[3],C1[1]); a=MX3(a,C1[2],C1[3]); \
      _Pragma("unroll") for(int r=4;r<16;r+=4){a=MX3(a,C0[r],C0[r+1]);b=MX3(b,C0[r+2],C0[r+3]);a=MX3(a,C1[r],C1[r+1]);b=MX3(b,C1[r+2],C1[r+3]);} \
      float rm=__builtin_fmaxf(a,b); { auto rr=__builtin_amdgcn_permlane32_swap(__float_as_uint(rm),__float_as_uint(rm),false,false); rm=__builtin_fmaxf(__uint_as_float(rr[0]),__uint_as_float(rr[1])); } \
      resc=false; \
      if(__builtin_expect(__any(rm>(float)THRL),0)){ const float dl=__builtin_fmaxf(rm,0.f); mhat+=dl; \
        _Pragma("unroll") for(int r=0;r<16;++r){C0[r]-=dl;C1[r]-=dl;} \
        if constexpr(MODE==0){ _Pragma("unroll") for(int r=0;r<16;++r)negm[r]=-mhat; asm volatile("":"+v"(negm)); } \
        const float f=__builtin_amdgcn_exp2f(-dl); l_reg*=f; if(hi==0)wsf[r32]=f; resc=true; } } \
    SBAR(); \
    GAPB(o[0]=__builtin_amdgcn_mfma_f32_32x32x16_bf16(PAF(0),VFR(0),o[0],0,0,0), C0,0); \
    GAPB(o[1]=__builtin_amdgcn_mfma_f32_32x32x16_bf16(PAF(0),VFR(4),o[1],0,0,0), C0,4); \
    KRD(GL,0); GAPB(o[0]=__builtin_amdgcn_mfma_f32_32x32x16_bf16(PAF(1),VFR(1),o[0],0,0,0), C0,8); \
    KRD(GL,1); GAPB(o[1]=__builtin_amdgcn_mfma_f32_32x32x16_bf16(PAF(1),VFR(5),o[1],0,0,0), C0,12); \
    KRD(GL,2); GAPB(o[0]=__builtin_amdgcn_mfma_f32_32x32x16_bf16(PAF(2),VFR(2),o[0],0,0,0), C1,0); \
    KRD(GL,3); GAPB(o[1]=__builtin_amdgcn_mfma_f32_32x32x16_bf16(PAF(2),VFR(6),o[1],0,0,0), C1,4); \
    GAPB(o[0]=__builtin_amdgcn_mfma_f32_32x32x16_bf16(PAF(3),VFR(3),o[0],0,0,0), C1,8); \
    GAPB(o[1]=__builtin_amdgcn_mfma_f32_32x32x16_bf16(PAF(3),VFR(7),o[1],0,0,0), C1,12); \
    }while(0)
  int t=1;
  #undef CMASK
  #define CMASK(P0,P1,t) do{}while(0)
  for(;t+5<NT;t+=2){
    STEP(pB0,pB1,pA0,pA1,t,true,true,true);     WAIT_BAR(2); RESC(); ROT();
    STEP(pA0,pA1,pB0,pB1,t+1,true,true,true);   WAIT_BAR(2); RESC(); ROT();
  }
  #undef CMASK
  #define CMASK(P0,P1,t) do{int jb_=(t)-(NT-4); if(jb_>=0)cmask(P0,P1,jb_,qrel,hi);}while(0)
  #define ENDW(tt) do{ if((tt)+3<NT){WAIT_BAR(2);} else if((tt)+2<NT){WAIT_BAR(1);} else {WAIT_BAR(0);} }while(0)
  for(;t+1<NT;t+=2){
    STEP(pB0,pB1,pA0,pA1,t,(t+3<NT),(t+1<NT),(t+1<NT));       ENDW(t);   RESC(); ROT();
    STEP(pA0,pA1,pB0,pB1,t+1,(t+4<NT),(t+2<NT),(t+2<NT));     ENDW(t+1); RESC(); ROT();
  }
  STEP(pB0,pB1,pA0,pA1,NT-1,false,false,false); RESC();
  const bf16*Zw=Z+(rowbase+q0+wid*QBLK)*DM+h*D; u32x4 zpre[4];
  #pragma unroll
  for(int i=0;i<4;++i)zpre[i]=*(const u32x4*)(Zw+(long)(i*8+(lane>>3))*DM+(lane&7)*8);
  { float sacc=pB0[0]+pB0[1]; _Pragma("unroll") for(int r=2;r<16;++r)sacc+=pB0[r]; _Pragma("unroll") for(int r=0;r<16;++r)sacc+=pB1[r]; l_reg+=sacc;
    pw0=(u32x4){PKW(pB0,0),PKW(pB0,2),PKW(pB0,4),PKW(pB0,6)};pw1=(u32x4){PKW(pB0,8),PKW(pB0,10),PKW(pB0,12),PKW(pB0,14)};pw2=(u32x4){PKW(pB1,0),PKW(pB1,2),PKW(pB1,4),PKW(pB1,6)};pw3=(u32x4){PKW(pB1,8),PKW(pB1,10),PKW(pB1,12),PKW(pB1,14)};
    SBAR(); pv(o,vb0+sl_cur,PAF(0),PAF(1),PAF(2),PAF(3)); }
  #undef PKW
  #undef PAF
  #undef VFR
  #undef PIN
  #undef MX3
  #undef GAPA
  #undef GAPB
  #undef EX
  #undef VRD
  #undef KRD
  #undef STEP
  #undef ENDW
  if(lw!=nullptr&&tid==0)lw[0]=nxt;
  {auto rr=__builtin_amdgcn_permlane32_swap(__float_as_uint(l_reg),__float_as_uint(l_reg),false,false);l_reg=__uint_as_float(rr[0])+__uint_as_float(rr[1]);}
  if(hi==0)wsf[32+r32]=l_reg;asm volatile("s_waitcnt lgkmcnt(0)":::"memory");
  float rli[16];
  #pragma unroll
  for(int r=0;r<16;++r)rli[r]=__builtin_amdgcn_rcpf(wsf[32+crow(r,hi)]);
  bf16*Ow=O+(rowbase+q0+wid*QBLK)*DM+h*D;
  { bf16*stg=(bf16*)(shm+LDS_OST)+wid*2048;
    #pragma unroll
    for(int r=0;r<16;++r){const int orow=crow(r,hi);
      #pragma unroll
      for(int d0=0;d0<2;++d0)stg[orow*64+d0*32+r32]=__float2bfloat16(o[d0][r]*rli[r]);}
    asm volatile("s_waitcnt lgkmcnt(0)":::"memory");
    #pragma unroll
    for(int i=0;i<4;++i){const int row=i*8+(lane>>3),ch=lane&7; const u32x4 v=*(const u32x4*)(stg+row*64+ch*8); const u32x4 zv=zpre[i]; u32x4 ov;
      #pragma unroll
      for(int e=0;e<4;++e){ const float o0=__uint_as_float(v[e]<<16),o1=__uint_as_float(v[e]&0xffff0000u),z0=__uint_as_float(zv[e]<<16),z1=__uint_as_float(zv[e]&0xffff0000u);
        ov[e]=cvtpk_s(o0*z0*__builtin_amdgcn_rcpf(1.f+__expf(-z0)),o1*z1*__builtin_amdgcn_rcpf(1.f+__expf(-z1))); }
      if(!DRY||ov[0]==0x7fc12345u)ATTN_STORE16(Ow+(long)row*DM+ch*8,ov);} }
  asm volatile("s_waitcnt lgkmcnt(0)\n\ts_barrier":::"memory");
  #undef DMA_K
  #undef DMA_V
  #undef CMASK
  #undef XMASK
  #undef NEGM
  #undef START
  #undef RESC
  #undef ROT
}
constexpr int ATTN_LDS_BYTES=LDS_BYTES;
#undef SBAR
#undef WAIT_BAR
}
constexpr int NWAVES = 8, NTHR = 512;
constexpr int NB = 8, SEQL = 2048, DMOD = 1024, MROWS = NB * SEQL;
constexpr int LD0 = 6656, NP0 = 6912, LD1 = 7168, NP1 = 7424;
constexpr int C0_ZA = 0, C0_Q = 1024, C0_ZB = 2048, C0_XBC = 3072, C0_K = 4608, C0_V = 5632;
constexpr int C1_Q = 0, C1_U = 1536, C1_K = 2048, C1_V = 3584, C1_ZC = 5120, C1_ZD = 6656;
constexpr float RMS_EPS = 1e-6f, LOG2E = 1.4426950408889634f;
constexpr size_t MiB = 1u << 20;
constexpr int KS = 8;
constexpr size_t WS_MODP = 0;
constexpr size_t WS_SSQ = 2 * MiB;
constexpr size_t WS_KBAR = 2 * MiB + 65536;
constexpr size_t WS_DT = 3 * MiB;
constexpr size_t WS_LF = 4 * MiB;
constexpr size_t WS_F2 = 6 * MiB;
constexpr size_t WS_S5P = 7 * MiB + 512 * 1024;
constexpr int S5P_STRIDE = 8704;
constexpr size_t WS_WT1 = 8 * MiB;
constexpr size_t WS_WO1 = WS_WT1 + (size_t)NP1 * 1024 * 2;
constexpr size_t WS_WG = WS_WO1 + 4 * MiB;
constexpr size_t WS_BIG = 27 * MiB;
constexpr size_t WS_WT0 = WS_BIG + (size_t)MROWS * LD0 * 2;
constexpr size_t WS_WO0 = WS_WT0 + (size_t)NP0 * 1024 * 2;
constexpr size_t WS_LFP = 251 * MiB;
constexpr size_t WS_END = WS_WO0 + 4 * MiB;
static_assert(WS_WG + 512 * 1024 <= WS_BIG && WS_END <= 256 * MiB && WS_BIG + (size_t)MROWS * LD1 * 2 <= 256 * MiB, "ws map");
constexpr int LDS_BYTES = 147456;
constexpr size_t WS_CNT = 1835008 + 3584 * 4, WS_UB = 1835008 + 32768, WS_TS = 1835008 + 32768 + 1024;
constexpr size_t WS_BAR = 1835008;
constexpr int BARST_OFF = 132608;

typedef unsigned short bf16;
typedef unsigned v4u __attribute__((ext_vector_type(4)));
typedef unsigned v2u __attribute__((ext_vector_type(2)));
typedef float f32x4 __attribute__((ext_vector_type(4)));
typedef short bf16x8 __attribute__((ext_vector_type(8)));
typedef float f32x16 __attribute__((ext_vector_type(16)));
typedef float f32x2_c __attribute__((ext_vector_type(2))); typedef __bf16 bf16x2_c __attribute__((ext_vector_type(2)));
__device__ __forceinline__ unsigned pk2(float lo, float hi) { f32x2_c v = {lo, hi}; return __builtin_bit_cast(unsigned, __builtin_convertvector(v, bf16x2_c)); }
__device__ __forceinline__ unsigned f2bf(float f) { return pk2(f, f) & 0xffffu; }
__device__ __forceinline__ float bf2f(unsigned short h) { return __uint_as_float(((unsigned)h) << 16); }
template <int CTRL> __device__ __forceinline__ float dppf(float old, float src) { return __builtin_bit_cast(float, __builtin_amdgcn_update_dpp(__builtin_bit_cast(int, old), __builtin_bit_cast(int, src), CTRL, 0xF, 0xF, false)); }
__device__ __forceinline__ float row_sum16(float v) { v += dppf<0xB1>(v, v); v += dppf<0x4E>(v, v); v += dppf<0x141>(v, v); v += dppf<0x140>(v, v); return v; }
__device__ __forceinline__ float rdlane(float v, int l) { return __builtin_bit_cast(float, __builtin_amdgcn_readlane(__builtin_bit_cast(int, v), l)); }
__device__ __forceinline__ float wave_sum(float v) { v = row_sum16(v); return (rdlane(v, 0) + rdlane(v, 16)) + (rdlane(v, 32) + rdlane(v, 48)); }
__device__ __forceinline__ float wave_scan(float x, int lane) {
    x += dppf<0x111>(0.f, x); x += dppf<0x112>(0.f, x); x += dppf<0x114>(0.f, x); x += dppf<0x118>(0.f, x);
    const float t0 = rdlane(x, 15), t1 = rdlane(x, 31), t2 = rdlane(x, 47); const int rw = lane >> 4;
    return x + (rw == 0 ? 0.f : (rw == 1 ? t0 : (rw == 2 ? t0 + t1 : (t0 + t1) + t2)));
}
__device__ __forceinline__ float silu_f(float x) { return x * __builtin_amdgcn_rcpf(1.f + __expf(-x)); }
__device__ __forceinline__ float softplus_g(float x) { return x > 20.f ? x : log1pf(__expf(x)); }

struct Args {
    const float* in[27]; float* out; unsigned char* ws;
};
enum { I_X = 0, I_C, I_ADAW, I_ADAB, I_PREG, I_POSTG, I_EINW, I_ECONVW, I_ECONVB, I_EDTB, I_EALOG, I_EDSKIP, I_ENORMG, I_EOUTW,
       I_OINW, I_OFGB, I_OLRE, I_OLIM, I_OLDT, I_OBRE, I_OBIM, I_OCRE, I_OCIM, I_ODSKIP, I_OGLUW, I_OGLUB, I_OOUTW };

__device__ __forceinline__ int src_col0(int n) {
    if (n < 1024) return n;
    if (n < 2048) return 3600 + (n - 1024);
    if (n < 3072) return 1024 + (n - 2048);
    if (n < 4608) return 2048 + (n - 3072);
    if (n < 5632) return 4624 + (n - 4608);
    if (n < 6656) return 5648 + (n - 5632);
    if (n < 6672) return 3584 + (n - 6656);
    return -1;
}
__device__ __forceinline__ int src_col1(int n) {
    if (n < 1536) return 2048 + n;
    if (n < 2048) return 6680 + (n - 1536);
    if (n < 3584) return 3584 + (n - 2048);
    if (n < 5120) return 5120 + (n - 3584);
    if (n < 6656) return n - 5120;
    if (n < 7168) return 1536 + (n - 6656);
    if (n < 7192) return 6656 + (n - 7168);
    return -1;
}
template <int MAP> __device__ __forceinline__ void transpose_item(const float* __restrict__ W, int K, int NSRC, int NDST, bf16* WT, float* scr, int item, int lane, const float* __restrict__ kscale = nullptr) {
    const int nblk = NDST / 32, kb = item / nblk, nb = item % nblk, k0 = 64 * kb, n0 = 32 * nb;
    const int nn = n0 + (lane & 31); const int sc = MAP == 0 ? src_col0(nn) : (MAP == 1 ? src_col1(nn) : nn);
    float tv[32];
#pragma unroll
    for (int i = 0; i < 32; ++i) { const int kk = 2 * i + (lane >> 5); tv[i] = sc >= 0 ? __builtin_nontemporal_load(&W[(size_t)(k0 + kk) * NSRC + sc]) : 0.f; if (kscale && k0 + kk < 1024) tv[i] *= kscale[k0 + kk]; }
#pragma unroll
    for (int i = 0; i < 32; ++i) { const int kk = 2 * i + (lane >> 5); scr[kk * 33 + (lane & 31)] = tv[i]; }
    asm volatile("s_waitcnt lgkmcnt(0)" ::: "memory");
    const int c = lane & 7;
#pragma unroll
    for (int j = 0; j < 4; ++j) { const int n = (lane >> 3) + 8 * j; const float* s = scr + (8 * c) * 33 + n;
        v4u o; o.x = pk2(s[0 * 33], s[1 * 33]); o.y = pk2(s[2 * 33], s[3 * 33]); o.z = pk2(s[4 * 33], s[5 * 33]); o.w = pk2(s[6 * 33], s[7 * 33]);
        *(v4u*)(WT + (size_t)(n0 + n) * K + k0 + 8 * c) = o; }
    asm volatile("s_waitcnt lgkmcnt(0)" ::: "memory");
}

__device__ __forceinline__ float mod_val(const float* modp, const float* adab, int l, int b, int j) {
    float s = adab[l * 3072 + j];
#pragma unroll
    for (int kc = 0; kc < KS; ++kc) s += modp[((size_t)(kc * 2 + l) * 8 + b) * 3072 + j];
    return s;
}

__device__ __forceinline__ void p0_prologue(const Args& A, char* lds, int vcu, int G) {
    const int tid = opaque_tid(), lane = tid & 63, wave = tid >> 6;
    unsigned char* ws = A.ws;
    float* scr = (float*)(lds + wave * 16384);
    const int gw = vcu * NWAVES + wave, NGW = G * NWAVES;
    constexpr int I0 = 16 * (NP0 / 32), I1 = 16 * (NP1 / 32), IO = 32 * 32, IG = 8 * 16;
    constexpr int NITEMS = I0 + I1 + 2 * IO + IG;
    for (int it = gw; it < NITEMS; it += NGW) {
        int r = it;
        if (r < I0) { transpose_item<0>(A.in[I_EINW], 1024, 6672, NP0, (bf16*)(ws + WS_WT0), scr, r, lane); continue; } r -= I0;
        if (r < I1) { transpose_item<1>(A.in[I_OINW], 1024, 7192, NP1, (bf16*)(ws + WS_WT1), scr, r, lane); continue; } r -= I1;
        if (r < IO) { transpose_item<2>(A.in[I_EOUTW], 2048, 1024, 1024, (bf16*)(ws + WS_WO0), scr, r, lane, G == 256 ? A.in[I_ENORMG] : nullptr); continue; } r -= IO;
        if (r < IO) { transpose_item<2>(A.in[I_OOUTW], 2048, 1024, 1024, (bf16*)(ws + WS_WO1), scr, r, lane); continue; } r -= IO;
        transpose_item<2>(A.in[I_OGLUW], 512, 512, 512, (bf16*)(ws + WS_WG), scr, r, lane);
    }
    __syncthreads();
    float* sc = (float*)lds;
    float* modp = (float*)(ws + WS_MODP);
    for (int item = blockIdx.x; item < 2 * KS * 6; item += G) {
        const int l = item / (KS * 6), r = item % (KS * 6), kc = r / 6, cb = r % 6;
        __syncthreads();
        for (int i = tid; i < 1024; i += NTHR) { const int b = i >> 7, k = i & 127; const float cv = A.in[I_C][b * 1024 + kc * 128 + k]; sc[i] = silu_f(cv); }
        __syncthreads();
        const int col = cb * 512 + tid; float acc[8];
#pragma unroll
        for (int b = 0; b < 8; ++b) acc[b] = 0.f;
        const float* wp = A.in[I_ADAW] + ((size_t)l * 1024 + kc * 128) * 3072 + col;
#pragma unroll 16
        for (int k = 0; k < 128; ++k) { const float w = __builtin_nontemporal_load(&wp[(size_t)k * 3072]);
#pragma unroll
            for (int b = 0; b < 8; ++b) acc[b] += sc[b * 128 + k] * w; }
#pragma unroll
        for (int b = 0; b < 8; ++b) modp[((size_t)(kc * 2 + l) * 8 + b) * 3072 + col] = acc[b];
    }
    const int gt = blockIdx.x * NTHR + tid;
    const int gs = (G >= 128 ? ((int)blockIdx.x - (G - 32)) * 64 + tid : gt);
    if (gs >= 0 && gs < 2048 && (G < 128 || tid < 64)) {
        const int g = gs >> 6, n = gs & 63;
        const float dt = __expf(A.in[I_OLDT][g]);
        const float lr = A.in[I_OLRE][g * 64 + n], li = A.in[I_OLIM][g * 64 + n];
        const float mag = expf(lr * dt); float sn, cs; sincosf(li * dt, &sn, &cs);
        const float ar = mag * cs, ai = mag * sn, den = lr * lr + li * li;
        const float qr = ((ar - 1.f) * lr + ai * li) / den, qi = (ai * lr - (ar - 1.f) * li) / den;
        unsigned char* pg = ws + WS_S5P + (size_t)g * S5P_STRIDE;
        bf16* BbT = (bf16*)pg; bf16* Cm = (bf16*)(pg + 4096); float* ari = (float*)(pg + 8192);
        ari[n] = ar; ari[64 + n] = ai;
        for (int c = 0; c < 16; ++c) { const float br = A.in[I_OBRE][(g * 64 + n) * 16 + c], bi = A.in[I_OBIM][(g * 64 + n) * 16 + c];
            BbT[(2 * n) * 16 + c] = (bf16)f2bf(qr * br - qi * bi); BbT[(2 * n + 1) * 16 + c] = (bf16)f2bf(qr * bi + qi * br);
            Cm[c * 128 + 2 * n] = (bf16)f2bf(A.in[I_OCRE][(g * 16 + c) * 64 + n]); Cm[c * 128 + 2 * n + 1] = (bf16)f2bf(-A.in[I_OCIM][(g * 16 + c) * 64 + n]); }
    }
    float* ssq = (float*)(ws + WS_SSQ);
    for (int i = gt; i < MROWS; i += G * NTHR) ssq[i] = 0.f;
}

__device__ __forceinline__ void p1a_rows(const Args& A, char* lds, int G) {
    const int tid = opaque_tid(), lane = tid & 63, wave = tid >> 6;
    const float* modp = (const float*)(A.ws + WS_MODP); float* mv = (float*)lds;
    for (int rb = blockIdx.x; rb < MROWS / 64; rb += G) {
        const int b = rb >> 5;
        __syncthreads();
#pragma unroll 1
        for (int col = tid; col < 1024; col += NTHR) { mv[col] = A.in[I_PREG][col] * (1.f + mod_val(modp, A.in[I_ADAB], 0, b, 1024 + col)); mv[1024 + col] = mod_val(modp, A.in[I_ADAB], 0, b, col); }
        __syncthreads();
        f32x4 mul[4], add[4];
#pragma unroll
        for (int j = 0; j < 4; ++j) { mul[j] = *(const f32x4*)(mv + 4 * lane + 256 * j); add[j] = *(const f32x4*)(mv + 1024 + 4 * lane + 256 * j); }
        f32x4 nx[4];
        { const f32x4* xr = (const f32x4*)(A.in[I_X] + (size_t)(rb * 64 + wave * 8) * DMOD) + lane;
#pragma unroll
          for (int j = 0; j < 4; ++j) nx[j] = __builtin_nontemporal_load(&xr[64 * j]); }
#pragma unroll 1
        for (int r = 0; r < 8; ++r) { const int m = rb * 64 + wave * 8 + r;
            f32x4 v[4]; float s = 0.f;
#pragma unroll
            for (int j = 0; j < 4; ++j) { v[j] = nx[j]; s += (v[j].x * v[j].x + v[j].y * v[j].y) + (v[j].z * v[j].z + v[j].w * v[j].w); }
            if (r < 7) { const f32x4* xr = (const f32x4*)(A.in[I_X] + (size_t)(m + 1) * DMOD) + lane;
#pragma unroll
                for (int j = 0; j < 4; ++j) nx[j] = __builtin_nontemporal_load(&xr[64 * j]); }
            const float rstd = rsqrtf(wave_sum(s) * (1.f / DMOD) + RMS_EPS);
            unsigned long long* o8 = (unsigned long long*)((unsigned char*)A.out + (size_t)m * 4096) + lane;
#pragma unroll
            for (int j = 0; j < 4; ++j) { const f32x4 h = v[j] * rstd * mul[j] + add[j]; o8[64 * j] = (unsigned long long)pk2(h.x, h.y) | ((unsigned long long)pk2(h.z, h.w) << 32); } }
    }
}
__device__ __forceinline__ void p3b_rows(const Args& A, char* lds, int G) {
    const int tid = opaque_tid(), lane = tid & 63, wave = tid >> 6;
    const float* modp = (const float*)(A.ws + WS_MODP); float* mv = (float*)lds;
    for (int rb = blockIdx.x; rb < MROWS / 64; rb += G) {
        const int b = rb >> 5;
        __syncthreads();
#pragma unroll 1
        for (int col = tid; col < 1024; col += NTHR) { mv[col] = A.in[I_POSTG][col] * mod_val(modp, A.in[I_ADAB], 0, b, 2048 + col);
            mv[1024 + col] = A.in[I_PREG][1024 + col] * (1.f + mod_val(modp, A.in[I_ADAB], 1, b, 1024 + col)); mv[2048 + col] = mod_val(modp, A.in[I_ADAB], 1, b, col); }
        __syncthreads();
        f32x4 g0[4], mul[4], add[4];
#pragma unroll
        for (int j = 0; j < 4; ++j) { g0[j] = *(const f32x4*)(mv + 4 * lane + 256 * j); mul[j] = *(const f32x4*)(mv + 1024 + 4 * lane + 256 * j); add[j] = *(const f32x4*)(mv + 2048 + 4 * lane + 256 * j); }
        f32x4 nx[4]; v2u ny[4];
        { const int m = rb * 64 + wave * 8; const f32x4* xr = (const f32x4*)(A.in[I_X] + (size_t)m * DMOD) + lane; const v2u* yr = (const v2u*)((unsigned char*)A.out + (size_t)m * 4096) + lane;
#pragma unroll
          for (int j = 0; j < 4; ++j) { nx[j] = __builtin_nontemporal_load(&xr[64 * j]); ny[j] = yr[64 * j]; } }
#pragma unroll 1
        for (int r = 0; r < 8; ++r) { const int m = rb * 64 + wave * 8 + r;
            unsigned char* slot = (unsigned char*)A.out + (size_t)m * 4096;
            f32x4 v[4], y[4]; float sy = 0.f; v2u wy[4];
#pragma unroll
            for (int j = 0; j < 4; ++j) { v[j] = nx[j]; wy[j] = ny[j]; }
            if (r < 7) { const f32x4* xr = (const f32x4*)(A.in[I_X] + (size_t)(m + 1) * DMOD) + lane; const v2u* yr = (const v2u*)(slot + 4096) + lane;
#pragma unroll
                for (int j = 0; j < 4; ++j) { nx[j] = __builtin_nontemporal_load(&xr[64 * j]); ny[j] = yr[64 * j]; } }
#pragma unroll
            for (int j = 0; j < 4; ++j) { const v2u w = wy[j]; y[j] = (f32x4){__uint_as_float(w.x << 16), __uint_as_float(w.x & 0xffff0000u), __uint_as_float(w.y << 16), __uint_as_float(w.y & 0xffff0000u)};
                sy += (y[j].x * y[j].x + y[j].y * y[j].y) + (y[j].z * y[j].z + y[j].w * y[j].w); }
            const float ry = rsqrtf(wave_sum(sy) * (1.f / DMOD) + RMS_EPS); float s = 0.f;
#pragma unroll
            for (int j = 0; j < 4; ++j) { v[j] = v[j] + g0[j] * (y[j] * ry); s += (v[j].x * v[j].x + v[j].y * v[j].y) + (v[j].z * v[j].z + v[j].w * v[j].w); }
            const float rstd = rsqrtf(wave_sum(s) * (1.f / DMOD) + RMS_EPS);
            unsigned long long* o8 = (unsigned long long*)(slot + 2048) + lane;
#pragma unroll
            for (int j = 0; j < 4; ++j) { const f32x4 h = v[j] * rstd * mul[j] + add[j]; o8[64 * j] = (unsigned long long)pk2(h.x, h.y) | ((unsigned long long)pk2(h.z, h.w) << 32); } }
    }
}
__device__ __forceinline__ void p6b_rows(const Args& A, char* lds, int G) {
    const int tid = opaque_tid(), lane = tid & 63, wave = tid >> 6;
    const float* modp = (const float*)(A.ws + WS_MODP); float* mv = (float*)lds;
    for (int rb = blockIdx.x; rb < MROWS / 64; rb += G) {
        const int b = rb >> 5;
        __syncthreads();
#pragma unroll 1
        for (int col = tid; col < 1024; col += NTHR) { mv[col] = A.in[I_POSTG][col] * mod_val(modp, A.in[I_ADAB], 0, b, 2048 + col); mv[1024 + col] = A.in[I_POSTG][1024 + col] * mod_val(modp, A.in[I_ADAB], 1, b, 2048 + col); }
        __syncthreads();
        f32x4 g0[4], g1[4];
#pragma unroll
        for (int j = 0; j < 4; ++j) { g0[j] = *(const f32x4*)(mv + 4 * lane + 256 * j); g1[j] = *(const f32x4*)(mv + 1024 + 4 * lane + 256 * j); }
        f32x4 nx[4]; v2u n0[4], n1[4];
        { const int m = rb * 64 + wave * 8; const f32x4* xr = (const f32x4*)(A.in[I_X] + (size_t)m * DMOD) + lane; const v2u* y1r = (const v2u*)((unsigned char*)A.out + (size_t)m * 4096) + lane;
#pragma unroll
          for (int j = 0; j < 4; ++j) { nx[j] = __builtin_nontemporal_load(&xr[64 * j]); n0[j] = y1r[64 * j]; n1[j] = y1r[256 + 64 * j]; } }
#pragma unroll 1
        for (int r = 0; r < 8; ++r) { const int m = rb * 64 + wave * 8 + r;
            unsigned char* slot = (unsigned char*)A.out + (size_t)m * 4096;
            f32x4 v[4], y0[4], y1[4]; float s0 = 0.f, s1 = 0.f; v2u w0[4], w1[4];
#pragma unroll
            for (int j = 0; j < 4; ++j) { v[j] = nx[j]; w0[j] = n0[j]; w1[j] = n1[j]; }
            if (r < 7) { const f32x4* xr = (const f32x4*)(A.in[I_X] + (size_t)(m + 1) * DMOD) + lane; const v2u* y1r = (const v2u*)(slot + 4096) + lane;
#pragma unroll
                for (int j = 0; j < 4; ++j) { nx[j] = __builtin_nontemporal_load(&xr[64 * j]); n0[j] = y1r[64 * j]; n1[j] = y1r[256 + 64 * j]; } }
#pragma unroll
            for (int j = 0; j < 4; ++j) { const v2u w = w0[j], u = w1[j];
                y0[j] = (f32x4){__uint_as_float(w.x << 16), __uint_as_float(w.x & 0xffff0000u), __uint_as_float(w.y << 16), __uint_as_float(w.y & 0xffff0000u)};
                y1[j] = (f32x4){__uint_as_float(u.x << 16), __uint_as_float(u.x & 0xffff0000u), __uint_as_float(u.y << 16), __uint_as_float(u.y & 0xffff0000u)};
                s0 += (y0[j].x * y0[j].x + y0[j].y * y0[j].y) + (y0[j].z * y0[j].z + y0[j].w * y0[j].w);
                s1 += (y1[j].x * y1[j].x + y1[j].y * y1[j].y) + (y1[j].z * y1[j].z + y1[j].w * y1[j].w); }
            const float r0 = rsqrtf(wave_sum(s0) * (1.f / DMOD) + RMS_EPS), r1 = rsqrtf(wave_sum(s1) * (1.f / DMOD) + RMS_EPS);
            f32x4* orow = (f32x4*)slot + lane;
#pragma unroll
            for (int j = 0; j < 4; ++j) { const f32x4 x1 = v[j] + g0[j] * (y0[j] * r0); v[j] = x1 + g1[j] * (y1[j] * r1); }
            asm volatile("" ::: "memory");
#pragma unroll
            for (int j = 0; j < 4; ++j) orow[64 * j] = v[j]; }
    }
}
#define BAR_ALL() asm volatile("s_waitcnt vmcnt(0) lgkmcnt(0)\n\ts_barrier" ::: "memory")
#define BAR_LDS() asm volatile("s_waitcnt lgkmcnt(0)\n\ts_barrier" ::: "memory")
typedef float f32x4m __attribute__((ext_vector_type(4)));
__device__ __forceinline__ void p2a_kbar(const Args& A, char* lds, int G) {
    const int tid = opaque_tid(); const bf16* P0 = (const bf16*)(A.ws + WS_BIG); float* kbar = (float*)(A.ws + WS_KBAR); float* red = (float*)lds;
    for (int item = blockIdx.x; item < NB * 16 * 8; item += G) {
        const int b = item >> 7, h = (item >> 3) & 15, n = item & 7; const int c8 = tid & 7, rg = tid >> 3;
        float acc[8];
#pragma unroll
        for (int e = 0; e < 8; ++e) acc[e] = 0.f;
#pragma unroll
        for (int i = 0; i < 4; ++i) { const bf16x8 kv = *(const bf16x8*)(P0 + (size_t)(b * SEQL + n * 256 + rg + 64 * i) * LD0 + C0_K + h * 64 + c8 * 8);
#pragma unroll
            for (int e = 0; e < 8; ++e) acc[e] += bf2f((unsigned short)kv[e]); }
        __syncthreads();
#pragma unroll
        for (int e = 0; e < 8; ++e) red[rg * 65 + c8 * 8 + e] = acc[e];
        __syncthreads();
        if (tid < 64) { float s = 0.f; for (int r = 0; r < 64; ++r) s += red[r * 65 + tid]; kbar[(size_t)item * 64 + tid] = s * (1.f / 256.f); }
    }
    __syncthreads();
}
__device__ __forceinline__ void p2a_conv(const Args& A, int G) {
    const int tid = opaque_tid(); const bf16* P0 = (const bf16*)(A.ws + WS_BIG); bf16* XC = (bf16*)A.out;
    if (tid >= 384) return;
    const int chg = tid % 192, half = tid / 192, ch = chg * 8;
    float w[4][8], bs[8];
#pragma unroll
    for (int k = 0; k < 4; ++k) { const f32x4 a = *(const f32x4*)(A.in[I_ECONVW] + k * 1536 + ch), b2 = *(const f32x4*)(A.in[I_ECONVW] + k * 1536 + ch + 4);
#pragma unroll
        for (int e = 0; e < 4; ++e) { w[k][e] = a[e]; w[k][4 + e] = b2[e]; } }
    { const f32x4 a = *(const f32x4*)(A.in[I_ECONVB] + ch), b2 = *(const f32x4*)(A.in[I_ECONVB] + ch + 4);
#pragma unroll
      for (int e = 0; e < 4; ++e) { bs[e] = a[e]; bs[4 + e] = b2[e]; } }
    for (int rb = blockIdx.x; rb < MROWS / 64; rb += G) {
        const int m0 = rb * 64 + half * 32; const int tb = m0 & (SEQL - 1);
        bf16x8 r0 = {}, r1 = {}, r2 = {};
        if (tb > 0) { r0 = *(const bf16x8*)(P0 + (size_t)(m0 - 3) * LD0 + C0_XBC + ch); r1 = *(const bf16x8*)(P0 + (size_t)(m0 - 2) * LD0 + C0_XBC + ch); r2 = *(const bf16x8*)(P0 + (size_t)(m0 - 1) * LD0 + C0_XBC + ch); }
#pragma unroll 4
        for (int i = 0; i < 32; ++i) { const bf16x8 r3 = *(const bf16x8*)(P0 + (size_t)(m0 + i) * LD0 + C0_XBC + ch); float o[8];
#pragma unroll
            for (int e = 0; e < 8; ++e) { const float a = bs[e] + w[0][e] * bf2f((unsigned short)r0[e]) + w[1][e] * bf2f((unsigned short)r1[e]) + w[2][e] * bf2f((unsigned short)r2[e]) + w[3][e] * bf2f((unsigned short)r3[e]); o[e] = silu_f(a); }
            v4u pw; pw.x = pk2(o[0], o[1]); pw.y = pk2(o[2], o[3]); pw.z = pk2(o[4], o[5]); pw.w = pk2(o[6], o[7]);
            *(v4u*)(XC + (size_t)(m0 + i) * 2048 + ch) = pw; r0 = r1; r1 = r2; r2 = r3; }
    }
}
constexpr int S_CS = 0, S_BS = 17408, S_BST = 34816, S_XT = 53248, S_XWT = 57856, S_XS = 62464, S_GG = 67584, S_SBF = 76800, S_DTA = 85504;
constexpr int F_CS = 0, F_BS = 17408, F_BST = 34816, F_XT = 53248, F_XWT = 62464, F_XS = 71680, F_GG = 80896, F_SBF = 90112, F_DTA = 107520;
template <bool DRY> __device__ __forceinline__ void ssd_unit(const Args& A, char* lds, int b, int h) {
    const int tid = opaque_tid(), lane = tid & 63, wave = __builtin_amdgcn_readfirstlane(tid >> 6); const int fr = lane & 15, fq = lane >> 4;
    bf16* P0 = (bf16*)(A.ws + WS_BIG); const bf16* XC = (const bf16*)A.out; const float* DT = (const float*)(A.ws + WS_DT);
    const int g = h >> 3; const int xcol = h * 64, bcol = 1024 + g * 128, ccol = 1280 + g * 128;
    bf16* CS = (bf16*)(lds + F_CS); bf16* BS = (bf16*)(lds + F_BS); bf16* BST = (bf16*)(lds + F_BST); bf16* XT = (bf16*)(lds + F_XT); bf16* XWT = (bf16*)(lds + F_XWT);
    bf16* XS = (bf16*)(lds + F_XS); bf16* GG = (bf16*)(lds + F_GG); bf16* SBF = (bf16*)(lds + F_SBF); float* DTA0 = (float*)(lds + F_DTA);
    for (int i = tid; i < 64 * 136; i += NTHR) SBF[i] = 0;
    const float Ah = -__expf(A.in[I_EALOG][h]), Dh = A.in[I_EDSKIP][h];
    const int lt = wave >> 1, pt0 = 2 * (wave & 1), st0 = 2 * (wave & 1), nt0 = (wave >> 1) * 2;
    f32x4m sta[2][2];
#pragma unroll
    for (int pi = 0; pi < 2; ++pi)
#pragma unroll
        for (int ni = 0; ni < 2; ++ni) sta[pi][ni] = (f32x4m){0.f, 0.f, 0.f, 0.f};
    const size_t rb0 = (size_t)b * SEQL;
    const bf16* pB = XC + (rb0 + (tid >> 4)) * 2048 + bcol + (tid & 15) * 8; const bf16* pC = XC + (rb0 + (tid >> 4)) * 2048 + ccol + (tid & 15) * 8; const bf16* pX = XC + (rb0 + (tid >> 3)) * 2048 + xcol + (tid & 7) * 8;
    const bf16* pZ = P0 + (rb0 + lt * 16 + 4 * fq) * LD0 + C0_ZA + h * 64 + pt0 * 16 + fr;
    bf16x8 pre[5]; float dtn = 0.f;
    pre[0] = *(const bf16x8*)pB; pre[1] = *(const bf16x8*)(pB + 32 * 2048); pre[2] = *(const bf16x8*)pC; pre[3] = *(const bf16x8*)(pC + 32 * 2048); pre[4] = *(const bf16x8*)pX;
    unsigned short zn[2][4], gts[2][4]; float sqs[2][4];
#pragma unroll
    for (int pi = 0; pi < 2; ++pi)
#pragma unroll
        for (int r = 0; r < 4; ++r) { zn[pi][r] = pZ[(size_t)r * LD0 + 16 * pi]; gts[pi][r] = 0; sqs[pi][r] = 0.f; }
    if (wave == 0) { dtn = DT[(rb0 + lane) * 16 + h]; const float s = wave_scan(Ah * dtn, lane); const float tot = rdlane(s, 63);
        DTA0[lane] = dtn; DTA0[64 + lane] = s; DTA0[128 + lane] = __expf(s); DTA0[192 + lane] = __expf(tot - s); dtn = DT[(rb0 + 64 + lane) * 16 + h]; }
    BAR_LDS();
    for (int c = 0; c < SEQL / 64; ++c) {
        const size_t m0 = rb0 + c * 64; float* DTA = DTA0 + (c & 1) * 256;
        { const int t = tid >> 4, c8 = tid & 15;
          *(bf16x8*)(BS + t * 136 + c8 * 8) = pre[0]; *(bf16x8*)(BS + (t + 32) * 136 + c8 * 8) = pre[1]; *(bf16x8*)(CS + t * 136 + c8 * 8) = pre[2]; *(bf16x8*)(CS + (t + 32) * 136 + c8 * 8) = pre[3];
          const int sw0 = ((((t >> 3) ^ (c8 & 7)) << 3) + (t & 7)), sw1 = (((((t + 32) >> 3) ^ (c8 & 7)) << 3) + (t & 7));
#pragma unroll
          for (int e = 0; e < 8; ++e) { BST[(c8 * 8 + e) * 72 + sw0] = (bf16)pre[0][e]; BST[(c8 * 8 + e) * 72 + sw1] = (bf16)pre[1][e]; }
          const int tx = tid >> 3, cx = tid & 7; *(bf16x8*)(XS + tx * 72 + cx * 8) = pre[4]; const float dtv = DTA[tx], wv = DTA[192 + tx]; const int sx = ((((tx >> 3) ^ cx) << 3) + (tx & 7));
#pragma unroll
          for (int e = 0; e < 8; ++e) { const float xd = bf2f((unsigned short)pre[4][e]) * dtv; XT[(cx * 8 + e) * 72 + sx] = (bf16)f2bf(xd); XWT[(cx * 8 + e) * 72 + sx] = (bf16)f2bf(xd * wv); } }
        if (c > 0) {
#pragma unroll
            for (int pi = 0; pi < 2; ++pi)
#pragma unroll
                for (int r = 0; r < 4; ++r) { const int l = lt * 16 + 4 * fq + r;
                    if (!DRY || sqs[pi][r] == 1.2345e30f) { ((bf16*)pZ)[((size_t)(c - 1) * 64 + r) * LD0 + 16 * pi] = gts[pi][r];
                        if (fr == 0) ((float*)((unsigned char*)A.out + (m0 - 64 + l) * 4096 + 3072))[h * 4 + pt0 + pi] = sqs[pi][r]; } } }
        if (c + 1 < SEQL / 64) { const size_t o = (size_t)(c + 1) * 64 * 2048;
            pre[0] = *(const bf16x8*)(pB + o); pre[1] = *(const bf16x8*)(pB + o + 32 * 2048); pre[2] = *(const bf16x8*)(pC + o); pre[3] = *(const bf16x8*)(pC + o + 32 * 2048); pre[4] = *(const bf16x8*)(pX + o); }
        unsigned short zv[2][4];
#pragma unroll
        for (int pi = 0; pi < 2; ++pi)
#pragma unroll
            for (int r = 0; r < 4; ++r) zv[pi][r] = zn[pi][r];
        if (c + 1 < SEQL / 64) {
#pragma unroll
            for (int pi = 0; pi < 2; ++pi)
#pragma unroll
                for (int r = 0; r < 4; ++r) zn[pi][r] = pZ[((size_t)(c + 1) * 64 + r) * LD0 + 16 * pi]; }
        BAR_LDS();
        f32x4m cb[2], ya[2]; cb[0] = (f32x4m){0.f, 0.f, 0.f, 0.f}; cb[1] = cb[0]; ya[0] = cb[0]; ya[1] = cb[0];
#pragma unroll
        for (int ks = 0; ks < 4; ++ks) { const bf16x8 af = *(const bf16x8*)(CS + (lt * 16 + fr) * 136 + ks * 32 + 8 * fq);
#pragma unroll
            for (int si = 0; si < 2; ++si) { const bf16x8 bfv = *(const bf16x8*)(BS + ((st0 + si) * 16 + fr) * 136 + ks * 32 + 8 * fq); cb[si] = __builtin_amdgcn_mfma_f32_16x16x32_bf16(af, bfv, cb[si], 0, 0, 0); }
#pragma unroll
            for (int pi = 0; pi < 2; ++pi) { const bf16x8 sf = *(const bf16x8*)(SBF + ((pt0 + pi) * 16 + fr) * 136 + ks * 32 + 8 * fq); ya[pi] = __builtin_amdgcn_mfma_f32_16x16x32_bf16(af, sf, ya[pi], 0, 0, 0); } }
#pragma unroll
        for (int r = 0; r < 4; ++r) { const int l = lt * 16 + 4 * fq + r; const float al = DTA[64 + l];
#pragma unroll
            for (int si = 0; si < 2; ++si) { const int s = (st0 + si) * 16 + fr; const float v = (s <= l) ? cb[si][r] * __expf(al - DTA[64 + s]) : 0.f; GG[l * 72 + s] = (bf16)f2bf(v); }
            const float ea = DTA[128 + l]; ya[0][r] *= ea; ya[1][r] *= ea; }
        const float decay = __expf(DTA[64 + 63]);
        BAR_LDS();
#pragma unroll
        for (int ks = 0; ks < 2; ++ks) { const bf16x8 gf = *(const bf16x8*)(GG + (lt * 16 + fr) * 72 + ks * 32 + 8 * fq);
#pragma unroll
            for (int pi = 0; pi < 2; ++pi) { const int p = (pt0 + pi) * 16 + fr; const bf16x8 xf = *(const bf16x8*)(XT + p * 72 + (((ks * 4 + fq) ^ ((p >> 3) & 7)) << 3)); ya[pi] = __builtin_amdgcn_mfma_f32_16x16x32_bf16(gf, xf, ya[pi], 0, 0, 0); } }
#pragma unroll
        for (int pi = 0; pi < 2; ++pi)
#pragma unroll
            for (int ni = 0; ni < 2; ++ni) sta[pi][ni] = sta[pi][ni] * decay;
#pragma unroll
        for (int ks = 0; ks < 2; ++ks) { bf16x8 bt[2];
#pragma unroll
            for (int ni = 0; ni < 2; ++ni) { const int n = (nt0 + ni) * 16 + fr; bt[ni] = *(const bf16x8*)(BST + n * 72 + (((ks * 4 + fq) ^ ((n >> 3) & 7)) << 3)); }
#pragma unroll
            for (int pi = 0; pi < 2; ++pi) { const int p = (pt0 + pi) * 16 + fr; const bf16x8 xw = *(const bf16x8*)(XWT + p * 72 + (((ks * 4 + fq) ^ ((p >> 3) & 7)) << 3));
#pragma unroll
                for (int ni = 0; ni < 2; ++ni) sta[pi][ni] = __builtin_amdgcn_mfma_f32_16x16x32_bf16(xw, bt[ni], sta[pi][ni], 0, 0, 0); } }
#pragma unroll
        for (int pi = 0; pi < 2; ++pi)
#pragma unroll
            for (int ni = 0; ni < 2; ++ni)
#pragma unroll
                for (int r = 0; r < 4; ++r) SBF[((pt0 + pi) * 16 + 4 * fq + r) * 136 + (nt0 + ni) * 16 + fr] = (bf16)f2bf(sta[pi][ni][r]);
#pragma unroll
        for (int pi = 0; pi < 2; ++pi)
#pragma unroll
            for (int r = 0; r < 4; ++r) { const int l = lt * 16 + 4 * fq + r, p = (pt0 + pi) * 16 + fr;
                const float y = ya[pi][r] + Dh * bf2f(XS[l * 72 + p]);
                const float z = bf2f(zv[pi][r]); const float gt = y * silu_f(z);
                gts[pi][r] = (unsigned short)f2bf(gt); sqs[pi][r] = row_sum16(gt * gt); }
        if (wave == 0 && c + 1 < SEQL / 64) { float* DN = DTA0 + ((c + 1) & 1) * 256; const float s = wave_scan(Ah * dtn, lane); const float tot = rdlane(s, 63);
            DN[lane] = dtn; DN[64 + lane] = s; DN[128 + lane] = __expf(s); DN[192 + lane] = __expf(tot - s);
            if (c + 2 < SEQL / 64) dtn = DT[(m0 + 128 + lane) * 16 + h]; }
        BAR_LDS();
    }
#pragma unroll
    for (int pi = 0; pi < 2; ++pi)
#pragma unroll
        for (int r = 0; r < 4; ++r) { const int l = lt * 16 + 4 * fq + r;
            if (!DRY || sqs[pi][r] == 1.2345e30f) { ((bf16*)pZ)[((size_t)(SEQL / 64 - 1) * 64 + r) * LD0 + 16 * pi] = gts[pi][r];
                if (fr == 0) ((float*)((unsigned char*)A.out + (rb0 + SEQL - 64 + l) * 4096 + 3072))[h * 4 + pt0 + pi] = sqs[pi][r]; } }
}
__device__ __forceinline__ void p2c_fixup(const Args& A, int vcu, int G) {
    const int tid = opaque_tid(), lane = tid & 63, wave = tid >> 6; bf16* P0 = (bf16*)(A.ws + WS_BIG); const float* ssq = (const float*)(A.ws + WS_SSQ);
    f32x4 gn[4];
#pragma unroll
    for (int j = 0; j < 4; ++j) gn[j] = *((const f32x4*)A.in[I_ENORMG] + lane + 64 * j);
    for (int m = vcu * NWAVES + wave; m < MROWS; m += G * NWAVES) { const float r = rsqrtf(wave_sum(((const float*)((const unsigned char*)A.out + (size_t)m * 4096 + 3072))[lane]) * (1.f / 1024.f) + RMS_EPS);
        v2u* p = (v2u*)(P0 + (size_t)m * LD0 + C0_ZA) + lane;
#pragma unroll
        for (int j = 0; j < 4; ++j) { const v2u w = p[64 * j]; v2u o; o.x = pk2(__uint_as_float(w.x << 16) * r * gn[j].x, __uint_as_float(w.x & 0xffff0000u) * r * gn[j].y);
            o.y = pk2(__uint_as_float(w.y << 16) * r * gn[j].z, __uint_as_float(w.y & 0xffff0000u) * r * gn[j].w); p[64 * j] = o; } }
}
__device__ __forceinline__ void p5a_fcum(const Args& A, char* lds, int G) {
    const int tid = opaque_tid(), lane = tid & 63, wave = tid >> 6; const float* LF = (const float*)(A.ws + WS_LF); float* F2 = (float*)(A.ws + WS_F2); float* wtot = (float*)(lds + 120 * 1024);
    for (int item = blockIdx.x; item < NB * 24; item += G) { const int b = item / 24, h = item % 24; const float fb = A.in[I_OFGB][h];
        float v[4]; float run = 0.f;
#pragma unroll
        for (int i = 0; i < 4; ++i) { const size_t ix = ((size_t)b * SEQL + 4 * tid + i) * 24 + h; const float* L1p = (const float*)(A.ws + WS_LFP);
            const float fr_ = (LF[ix] + L1p[ix]) + (L1p[ix + (size_t)MROWS * 24] + L1p[ix + (size_t)2 * MROWS * 24]) + fb; run += -softplus_g(-fr_); v[i] = run; }
        float s = run;
#pragma unroll
        for (int o = 1; o < 64; o <<= 1) { const float x = __shfl_up(s, o); if (lane >= o) s += x; }
        __syncthreads();
        if (lane == 63) wtot[wave] = s;
        __syncthreads();
        float off = s - run; for (int w = 0; w < wave; ++w) off += wtot[w];
#pragma unroll
        for (int i = 0; i < 4; ++i) { const float f2v = (off + v[i]) * LOG2E; const int t = 4 * tid + i; F2[(size_t)item * SEQL + t] = f2v;
            if ((t & 127) == 127) wtot[64 + (t >> 7)] = f2v; if ((t & 255) == 0) wtot[96 + (t >> 8)] = f2v; }
        { const bf16* P1 = (const bf16*)(A.ws + WS_BIG); float qm = 0.f, km = 0.f;
#pragma unroll 8
          for (int i = 0; i < 32; ++i) { const size_t m = (size_t)b * SEQL + (tid >> 3) + 64 * i; const int c8 = tid & 7; float qs = 0.f, ks2 = 0.f;
              const bf16x8 qv = *(const bf16x8*)(P1 + m * LD1 + C1_Q + h * 64 + c8 * 8), kv = *(const bf16x8*)(P1 + m * LD1 + C1_K + h * 64 + c8 * 8);
#pragma unroll
              for (int e = 0; e < 8; ++e) { const float qf = bf2f((unsigned short)qv[e]), kf = bf2f((unsigned short)kv[e]); qs += qf * qf; ks2 += kf * kf; }
              qs += dppf<0xB1>(qs, qs); qs += dppf<0x4E>(qs, qs); qs += dppf<0x141>(qs, qs); ks2 += dppf<0xB1>(ks2, ks2); ks2 += dppf<0x4E>(ks2, ks2); ks2 += dppf<0x141>(ks2, ks2);
              qm = fmaxf(qm, qs); km = fmaxf(km, ks2); }
#pragma unroll
          for (int o = 1; o < 64; o <<= 1) { qm = fmaxf(qm, __shfl_xor(qm, o)); km = fmaxf(km, __shfl_xor(km, o)); }
          __syncthreads();
          if (lane == 0) { wtot[16 + wave] = qm; wtot[32 + wave] = km; }
          __syncthreads();
          if (tid < 8) { float a = 0.f, c = 0.f; for (int w = 0; w < 8; ++w) { a = fmaxf(a, wtot[16 + w]); c = fmaxf(c, wtot[32 + w]); } const float u2 = 2.f * sqrtf(a) * sqrtf(c) * 1.01f;
              const int qb = tid; const float fi0 = wtot[96 + qb]; int ts = 0; while (ts + 2 <= 4 * qb && u2 - (wtot[64 + (ts >> 1)] - fi0) <= -40.f) ts += 2;
              ((int*)(A.ws + WS_TS))[item * 8 + qb] = ts; } }
    }
    __syncthreads();
}
constexpr int S5_BU = 0  , S5_SS = 67584  , S5_US = 102400  ;
__device__ __forceinline__ float gelu_tanh(float x) { const float u = 0.7978845608028654f * (x + 0.044715f * x * x * x); const float e = __expf(2.f * u); const float t = 1.f - 2.f * __builtin_amdgcn_rcpf(e + 1.f); return 0.5f * x * (1.f + t); }
__device__ __forceinline__ void s5_unit(const Args& A, char* lds, int b, int g) {
    const int tid = opaque_tid(), lane = tid & 63, wave = __builtin_amdgcn_readfirstlane(tid >> 6); const int fr = lane & 15, fq = lane >> 4, r32 = lane & 31, hi = lane >> 5;
    const bf16* P1 = (const bf16*)(A.ws + WS_BIG); bf16* YD = (bf16*)A.out;
    const unsigned char* pg = A.ws + WS_S5P + (size_t)g * S5P_STRIDE; const bf16* BbT = (const bf16*)pg; const bf16* Cm = (const bf16*)(pg + 4096); const float* ari = (const float*)(pg + 8192);
    const int ttile = wave >> 2, ntile = wave & 3;
    const bf16x8 bfrag = *(const bf16x8*)(BbT + (ntile * 32 + r32) * 16 + 8 * hi);
    bf16x8 cfrag[4];
#pragma unroll
    for (int ks = 0; ks < 4; ++ks) cfrag[ks] = *(const bf16x8*)(Cm + fr * 128 + ks * 32 + 8 * fq);
    const float ar = ari[lane], ai = ari[64 + lane]; float sr = 0.f, si = 0.f;
    const float dskip = A.in[I_ODSKIP][g * 16 + fr];
    const size_t rb0 = (size_t)b * SEQL; const bf16* pU = P1 + (rb0 + ttile * 32 + r32) * LD1 + C1_U + g * 16 + 8 * hi;
    bf16x8 un = *(const bf16x8*)pU;
    BAR_LDS();
    for (int i = 0; i < SEQL / 64 + 2; ++i) {
        if (i < SEQL / 64) { float* BU = (float*)(lds + S5_BU) + (i & 1) * (64 * 132); f32x16 acc = {};
            acc = __builtin_amdgcn_mfma_f32_32x32x16_bf16(un, bfrag, acc, 0, 0, 0);
            if (ntile == 0) *(bf16x8*)((bf16*)(lds + S5_US) + ((i & 3) * 64 + ttile * 32 + r32) * 16 + 8 * hi) = un;
            if (i + 1 < SEQL / 64) un = *(const bf16x8*)(pU + (size_t)(i + 1) * 64 * LD1);
#pragma unroll
            for (int r = 0; r < 16; ++r) { const int t = ttile * 32 + (r & 3) + 8 * (r >> 2) + 4 * hi; BU[t * 132 + ntile * 32 + r32] = acc[r]; } }
        if (wave == 0 && i >= 1 && i <= SEQL / 64) { const float* BU = (const float*)(lds + S5_BU) + ((i - 1) & 1) * (64 * 132); bf16* SS = (bf16*)(lds + S5_SS) + ((i - 1) & 1) * (64 * 136);
#pragma unroll
            for (int hb = 0; hb < 2; ++hb) { f32x2_c bv[32];
#pragma unroll
                for (int t = 0; t < 32; ++t) bv[t] = *(const f32x2_c*)(BU + (hb * 32 + t) * 132 + 2 * lane);
                const f32x2_c a1 = {ar, ar}, a2 = {-ai, ai}; f32x2_c s2 = {sr, si};
#pragma unroll
                for (int t = 0; t < 32; ++t) { const f32x2_c sw = {s2.y, s2.x}; s2 = a1 * s2 + (a2 * sw + bv[t]);
                    *(unsigned*)(SS + (hb * 32 + t) * 136 + 2 * lane) = pk2(s2.x, s2.y); }
                sr = s2.x; si = s2.y; } }
        if (wave >= 4 && i >= 2) { const bf16* SS = (const bf16*)(lds + S5_SS) + ((i - 2) & 1) * (64 * 136); const int mt = wave - 4; const size_t m0 = rb0 + (size_t)(i - 2) * 64;
            unsigned short uv[4];
#pragma unroll
            for (int r = 0; r < 4; ++r) uv[r] = ((const bf16*)(lds + S5_US))[(((i - 2) & 3) * 64 + mt * 16 + 4 * fq + r) * 16 + fr];
            f32x4m acc = (f32x4m){0.f, 0.f, 0.f, 0.f};
#pragma unroll
            for (int ks = 0; ks < 4; ++ks) { const bf16x8 af = *(const bf16x8*)(SS + (mt * 16 + fr) * 136 + ks * 32 + 8 * fq); acc = __builtin_amdgcn_mfma_f32_16x16x32_bf16(af, cfrag[ks], acc, 0, 0, 0); }
#pragma unroll
            for (int r = 0; r < 4; ++r) { const size_t m = m0 + mt * 16 + 4 * fq + r; YD[m * 2048 + 1024 + g * 16 + fr] = (bf16)f2bf(gelu_tanh(acc[r] + dskip * bf2f(uv[r]))); } }
        BAR_LDS();
    }
}
template <bool DRY> __device__ __forceinline__ void moba_phase(const Args& A, char* lds, int vcu, int G) {
    const bf16* P0 = (const bf16*)(A.ws + WS_BIG); const float* kbar = (const float*)(A.ws + WS_KBAR);
    unsigned* cnt = (unsigned*)(A.ws + WS_CNT) + (DRY ? 192 : 128); volatile unsigned* lw = (volatile unsigned*)(lds + BARST_OFF + 16);
    const int tid = opaque_tid();
    if (tid == 0) lw[0] = atomicAdd(cnt, 1u);
    BAR_ALL();
    int u = __builtin_amdgcn_readfirstlane((int)lw[0]);
    while (u < NB * 16 * 8) {
        unsigned nxt = 0u; if (tid == 0) nxt = atomicAdd(cnt, 1u);
        const int qb = 7 - u / 128, bh = u % 128, b = bh >> 4, h = bh & 15;
        attn_body::attn_unit<8, 0, LD0, DRY>(b, h, qb, (const attn_body::bf16*)(P0 + C0_Q), (const attn_body::bf16*)(P0 + C0_K), (const attn_body::bf16*)(P0 + C0_V), (attn_body::bf16*)(P0 + C0_Q),
                                            (const attn_body::bf16*)(P0 + C0_ZB), kbar + (size_t)bh * 512, nullptr, lw, nxt, lds);
        BAR_LDS();
        u = __builtin_amdgcn_readfirstlane((int)lw[0]);
    }
}
template <bool DRY> __device__ __forceinline__ void fox_phase(const Args& A, char* lds, int vcu, int G) {
    const bf16* P1 = (const bf16*)(A.ws + WS_BIG); const float* F2 = (const float*)(A.ws + WS_F2); const int* TSv = (const int*)(A.ws + WS_TS);
    unsigned* cnt = (unsigned*)(A.ws + WS_CNT) + (DRY ? 64 : 0); volatile unsigned* lw = (volatile unsigned*)(lds + BARST_OFF + 16);
    const int tid = opaque_tid();
    if (tid == 0) lw[0] = atomicAdd(cnt, 1u);
    BAR_ALL();
    int u = __builtin_amdgcn_readfirstlane((int)lw[0]);
    while (u < NB * 24 * 8) {
        unsigned nxt = 0u; if (tid == 0) nxt = atomicAdd(cnt, 1u);
        const int qb = 7 - u / 192, bh = u % 192, b = bh / 24, h = bh % 24;
        attn_body::attn_unit<8, 1, LD1, DRY>(b, h, qb, (const attn_body::bf16*)(P1 + C1_Q), (const attn_body::bf16*)(P1 + C1_K), (const attn_body::bf16*)(P1 + C1_V), (attn_body::bf16*)(P1 + C1_Q),
                                            (const attn_body::bf16*)(P1 + C1_ZC), F2 + (size_t)bh * SEQL, TSv + bh * 8, lw, nxt, lds);
        BAR_LDS();
        u = __builtin_amdgcn_readfirstlane((int)lw[0]);
    }
}
#define LAS __attribute__((address_space(3)))
#define XB_TMO      128
#define XB_XCNT(j)  (256  + 64 * (j))
#define XB_XSUB(j)  (1280 + 64 * (j))
#define XB_XGEN(j)  (2304 + 64 * (j))
#define XB_TOP      3328
#define XB_TOPGEN   3392
#define XCD_BAR_WORDS 3456
#define XB_SPIN_CAP (1u << 18)

__device__ __forceinline__ unsigned xb_ld(unsigned* p)              { return __hip_atomic_load(p, __ATOMIC_RELAXED, __HIP_MEMORY_SCOPE_AGENT); }
__device__ __forceinline__ unsigned xb_add(unsigned* p, unsigned v) { return __hip_atomic_fetch_add(p, v, __ATOMIC_RELAXED, __HIP_MEMORY_SCOPE_AGENT); }
__device__ __forceinline__ unsigned xb_xcc_id() { return (unsigned)__builtin_amdgcn_s_getreg((3 << 11) | 20) & 0xFu; }
#define XB_SPIN(cond, bar) do { unsigned _sp = 0; while (cond) { __builtin_amdgcn_s_sleep(1); \
    if ((++_sp & 255u) == 0u) { if (xb_ld(&(bar)[XB_TMO])) break; if (_sp > XB_SPIN_CAP) { atomicAdd(&(bar)[XB_TMO], 1u); break; } } } } while (0)

struct XcdBarrier {
    unsigned* bar; unsigned x;
    volatile LAS unsigned* st;
};

__device__ __forceinline__ XcdBarrier xcd_barrier_post(unsigned* bar, volatile LAS unsigned* st) {
    XcdBarrier b; b.bar = bar; b.x = xb_xcc_id(); b.st = st;
    if (threadIdx.x == 0) (void)xb_add(&bar[XB_XCNT(b.x)], 1u);
    return b;
}
__device__ __forceinline__ void xcd_barrier_complete(unsigned* bar, unsigned x, unsigned& nloc, unsigned& nx) {
    const unsigned G = gridDim.x * gridDim.y * gridDim.z;
    unsigned sum, cnt, mine, sp = 0u;
    for (;;) {
        sum = 0u; cnt = 0u; mine = 0u;
#pragma unroll
        for (unsigned j = 0; j < 16; ++j) { const unsigned c = xb_ld(&bar[XB_XCNT(j)]); sum += c; cnt += (c > 0u) ? 1u : 0u; mine = (j == x) ? c : mine; }
        if (sum == G) break;
        __builtin_amdgcn_s_sleep(1);
        if ((++sp & 255u) == 0u) { if (xb_ld(&bar[XB_TMO])) break; if (sp > XB_SPIN_CAP) { atomicAdd(&bar[XB_TMO], 1u); break; } }
    }
    nloc = mine > 0u ? mine : 1u; nx = cnt > 0u ? cnt : 1u;
}

__device__ __forceinline__ void xcd_barrier(const XcdBarrier& b) {
    asm volatile("s_waitcnt vmcnt(0)" ::: "memory");
    __syncthreads();
    if (threadIdx.x == 0) {
        unsigned* bar = b.bar;
        __builtin_amdgcn_s_waitcnt(0);
        unsigned nloc = b.st[0], nx = b.st[1];
        if (nloc == 0u) { xcd_barrier_complete(bar, b.x, nloc, nx); b.st[0] = nloc; b.st[1] = nx; }
        const unsigned old = xb_add(&bar[XB_XSUB(b.x)], 1u);
        const unsigned gen = old / nloc;
        if (old + 1u == (gen + 1u) * nloc) {
            __builtin_amdgcn_fence(__ATOMIC_RELEASE, "agent");
            asm volatile("s_waitcnt vmcnt(0)" ::: "memory");
            const unsigned og = xb_add(&bar[XB_TOP], 1u);
            const unsigned tg = og / nx;
            if (og + 1u == (tg + 1u) * nx) xb_add(&bar[XB_TOPGEN], 1u);
            else XB_SPIN(xb_ld(&bar[XB_TOPGEN]) == tg, bar);
            __builtin_amdgcn_fence(__ATOMIC_ACQUIRE, "agent");
            xb_add(&bar[XB_XGEN(b.x)], 1u);
            asm volatile("s_waitcnt vmcnt(0)" ::: "memory");
        } else {
            XB_SPIN(xb_ld(&bar[XB_XGEN(b.x)]) == gen, bar);
            __builtin_amdgcn_fence(__ATOMIC_ACQUIRE, "agent");
            asm volatile("s_waitcnt vmcnt(0)" ::: "memory");
        }
    }
    __syncthreads();
}

constexpr int ARGS_OFF = 132096;
__device__ __forceinline__ Args get_args(const unsigned char* lds) {
    Args a; const unsigned long long* p = (const unsigned long long*)(lds + ARGS_OFF);
#pragma unroll
    for (int i = 0; i < 29; ++i) { const unsigned long long v = p[i]; const unsigned lo = __builtin_amdgcn_readfirstlane((unsigned)v), hi = __builtin_amdgcn_readfirstlane((unsigned)(v >> 32));
        const unsigned long long w = ((unsigned long long)hi << 32) | lo; if (i < 27) a.in[i] = (const float*)w; else if (i == 27) a.out = (float*)w; else a.ws = (unsigned char*)w; }
    return a;
}
#define PHASE_BEGIN { const Args args = get_args(lds); unsigned char* ws = args.ws; bf16* XN = (bf16*)args.out; bf16* PB = (bf16*)(ws + WS_BIG); (void)ws; (void)XN; (void)PB;
#ifdef DUP_SYNC
#define PHASE_END } xcd_barrier(xbar); xcd_barrier(xbar);
#else
#define PHASE_END } xcd_barrier(xbar);
#endif
#define PHASE_END_NOSYNC }
__global__ void __launch_bounds__(NTHR, 2) trunk_fwd(Args kargs_unused) {
    extern __shared__ __attribute__((aligned(16))) unsigned char lds[];
    cg::grid_group grid = cg::this_grid();
    const int G = gridDim.x, bx = blockIdx.x; const int vcu = (G % 8 == 0) ? (bx % 8) * (G / 8) + bx / 8 : bx;
    char* ldsc = (char*)lds; PG8_LAS unsigned char* ldsg = (PG8_LAS unsigned char*)lds;
    { const int t = opaque_tid(); if (t < 29) { const unsigned long long* ka = (const unsigned long long*)__builtin_amdgcn_kernarg_segment_ptr(); ((unsigned long long*)(lds + ARGS_OFF))[t] = ka[t]; }
      if (t < 2) ((unsigned*)(lds + BARST_OFF))[t] = 0u; }
    __syncthreads();
    XcdBarrier xbar;
    {
    const Args args = get_args(lds);
    unsigned* rdy = (unsigned*)(args.ws + WS_BAR) + 4160;
    if (bx == 0) { unsigned* bw = (unsigned*)(args.ws + WS_BAR); for (int i = opaque_tid(); i < 4096; i += NTHR) bw[i] = 0u;
        asm volatile("s_waitcnt vmcnt(0)" ::: "memory"); __syncthreads();
        if (opaque_tid() == 0) { __builtin_amdgcn_fence(__ATOMIC_RELEASE, "agent"); asm volatile("s_waitcnt vmcnt(0)" ::: "memory"); __hip_atomic_store(rdy, 0x600DF00Du, __ATOMIC_RELAXED, __HIP_MEMORY_SCOPE_AGENT); } }
    if (G > 0x40000000) grid.sync();
    p0_prologue(args, ldsc, vcu, G);
    if (opaque_tid() == 0) { unsigned sp = 0; while (__hip_atomic_load(rdy, __ATOMIC_RELAXED, __HIP_MEMORY_SCOPE_AGENT) != 0x600DF00Du && ++sp < (1u << 22)) __builtin_amdgcn_s_sleep(2);
        __builtin_amdgcn_fence(__ATOMIC_ACQUIRE, "agent"); asm volatile("s_waitcnt vmcnt(0)" ::: "memory"); }
    __syncthreads();
    xbar = xcd_barrier_post((unsigned*)(args.ws + WS_BAR), (volatile LAS unsigned*)(lds + BARST_OFF));
    xcd_barrier(xbar);
    if (bx == 0 && opaque_tid() == 0) __hip_atomic_store(rdy, 0u, __ATOMIC_RELAXED, __HIP_MEMORY_SCOPE_AGENT);
    }
    PHASE_BEGIN
    p1a_rows(args, ldsc, G);
#ifdef DUP_MISC
    p1a_rows(args, ldsc, G);
#endif
    PHASE_END
    PHASE_BEGIN
    { pg8::Gemm g{XN, (const bf16*)(ws + WS_WT0), MROWS, NP0, 1024, 2048, 1024, 0}; pg8::StaticOrder S; S.init(MROWS, NP0, G, bx);
      pg8::EpiX<0> E{PB, LD0, args.in[I_EDTB], (float*)(ws + WS_DT), nullptr, nullptr, attn_body::C2};
      pg8::gemm_phase<pg8::EpiX<0>, pg8::StaticOrder, true, true>(ldsg, g, S, E); }
#ifdef DUP_GEMM
    { pg8::Gemm g{XN, (const bf16*)(ws + WS_WT0), MROWS, NP0, 1024, 2048, 1024, 0}; pg8::StaticOrder S; S.init(MROWS, NP0, G, bx);
      pg8::EpiX<0> E{PB, LD0, args.in[I_EDTB], (float*)(ws + WS_DT), nullptr, nullptr, attn_body::C2};
      pg8::gemm_phase<pg8::EpiX<0>, pg8::StaticOrder, true, true>(ldsg, g, S, E); }
#endif
    PHASE_END
    PHASE_BEGIN
    p2a_kbar(args, ldsc, G);
    p2a_conv(args, G);
#ifdef DUP_MISC
    p2a_kbar(args, ldsc, G);
    p2a_conv(args, G);
#endif
    PHASE_END
    PHASE_BEGIN
#ifdef DUP_SSD
    for (int v = vcu; v < 128; v += G) ssd_unit<true>(args, ldsc, v >> 4, v & 15);
#endif
    for (int v = vcu; v < 128; v += G) ssd_unit<false>(args, ldsc, v >> 4, v & 15);
    PHASE_END_NOSYNC
    PHASE_BEGIN
#ifdef DUP_MOBA
    moba_phase<true>(args, ldsc, vcu, G);
#endif
    moba_phase<false>(args, ldsc, vcu, G);
    PHASE_END
    if (G != 256) {
    PHASE_BEGIN
    p2c_fixup(args, vcu, G);
    PHASE_END
    }
    PHASE_BEGIN
    { pg8::Gemm g{PB, (const bf16*)(ws + WS_WO0), MROWS, 1024, 2048, LD0, 2048, 0}; pg8::StaticOrder S; S.init(MROWS, 1024, G, bx);
      { pg8::Unit u0; u0.pm = 0; u0.pn = 0; const bool have = S.next(0, u0); const int pm0 = u0.pm; float* rs = (float*)(lds + 131072); const int t = opaque_tid();
        if (t < 256) { float r = 1.f;
            if (G == 256 && have) { const f32x4* pp = (const f32x4*)((const unsigned char*)args.out + (size_t)(pm0 * 256 + t) * 4096 + 3072); float sm = 0.f;
#pragma unroll
                for (int i = 0; i < 16; ++i) { const f32x4 v = pp[i]; sm += (v.x + v.y) + (v.z + v.w); }
                r = rsqrtf(sm * (1.f / 1024.f) + RMS_EPS); }
            rs[t] = r; }
        __syncthreads(); }
      pg8::EpiX<5> E{XN, 2048, nullptr, nullptr, nullptr, nullptr, 1.f};
      pg8::gemm_phase<pg8::EpiX<5>, pg8::StaticOrder, true, true>(ldsg, g, S, E); }
    PHASE_END
    PHASE_BEGIN
    p3b_rows(args, ldsc, G);
#ifdef DUP_MISC
    p3b_rows(args, ldsc, G);
#endif
    PHASE_END
    PHASE_BEGIN
    { pg8::Gemm g{XN + 1024, (const bf16*)(ws + WS_WT1), MROWS, LD1, 1024, 2048, 1024, 0}; pg8::StaticOrder S; S.init(MROWS, LD1, G, bx);
      pg8::EpiX<1> E{PB, LD1, nullptr, nullptr, nullptr, nullptr, attn_body::C2};
      pg8::gemm_phase<pg8::EpiX<1>, pg8::StaticOrder, true, true>(ldsg, g, S, E); }
    { pg8::Gemm g{XN + 1024, (const bf16*)(ws + WS_WT1) + (size_t)LD1 * 1024, MROWS, 1024, 256, 2048, 1024, 1}; pg8::StaticOrder S; S.init(MROWS, 1024, G, bx);
      pg8::EpiX<4> E{nullptr, 0, nullptr, (float*)(ws + WS_LF), (const bf16*)(ws + WS_LFP), nullptr, 1.f};
      pg8::gemm_phase<pg8::EpiX<4>, pg8::StaticOrder, true, true>(ldsg, g, S, E); }
#ifdef DUP_GEMM
    { pg8::Gemm g{XN + 1024, (const bf16*)(ws + WS_WT1), MROWS, LD1, 1024, 2048, 1024, 0}; pg8::StaticOrder S; S.init(MROWS, LD1, G, bx);
      pg8::EpiX<1> E{PB, LD1, nullptr, nullptr, nullptr, nullptr, attn_body::C2};
      pg8::gemm_phase<pg8::EpiX<1>, pg8::StaticOrder, true, true>(ldsg, g, S, E); }
#endif
    PHASE_END
    PHASE_BEGIN
    p5a_fcum(args, ldsc, G);
#ifdef DUP_S5
    p5a_fcum(args, ldsc, G);
#endif
    for (int v = vcu; v < 256; v += G) s5_unit(args, ldsc, v >> 5, v & 31);
#ifdef DUP_S5
    for (int v = vcu; v < 256; v += G) s5_unit(args, ldsc, v >> 5, v & 31);
#endif
    PHASE_END
    PHASE_BEGIN
#ifdef DUP_FOX
    fox_phase<true>(args, ldsc, vcu, G);
#endif
    if (vcu < 128) { pg8::Gemm g{XN + 1024, (const bf16*)(ws + WS_WG), MROWS, 512, 512, 2048, 512, 0}; pg8::StaticOrder S; S.init(MROWS, 512, 128, vcu);
      pg8::EpiX<3> E{PB + C1_U, LD1, args.in[I_OGLUB], nullptr, XN + 1024, PB + C1_ZD, 1.f};
      pg8::gemm_phase<pg8::EpiX<3>, pg8::StaticOrder, true, true>(ldsg, g, S, E); }
    fox_phase<false>(args, ldsc, vcu, G);
    PHASE_END
    PHASE_BEGIN
    { pg8::Gemm g{PB, (const bf16*)(ws + WS_WO1), MROWS, 1024, 2048, LD1, 2048, 0}; pg8::StaticOrder S; S.init(MROWS, 1024, G, bx);
      pg8::EpiX<2> E{XN + 1024, 2048, nullptr, nullptr, nullptr, nullptr, 1.f};
      pg8::gemm_phase<pg8::EpiX<2>, pg8::StaticOrder, true, true>(ldsg, g, S, E); }
#ifdef DUP_GEMM
    { pg8::Gemm g{PB, (const bf16*)(ws + WS_WO1), MROWS, 1024, 2048, LD1, 2048, 0}; pg8::StaticOrder S; S.init(MROWS, 1024, G, bx);
      pg8::EpiX<2> E{XN + 1024, 2048, nullptr, nullptr, nullptr, nullptr, 1.f};
      pg8::gemm_phase<pg8::EpiX<2>, pg8::StaticOrder, true, true>(ldsg, g, S, E); }
#endif
    PHASE_END
    PHASE_BEGIN
    p6b_rows(args, ldsc, G);
    PHASE_END_NOSYNC
}

extern "C" void kernel_launch(void* const* d_in, const int* in_sizes, int n_in, void* d_out, int out_size, void* d_ws, size_t ws_size, hipStream_t stream) {
    static int grid = 0;
    if (grid == 0) {
        if (n_in != 27 || out_size != MROWS * DMOD || ws_size < (size_t)256 * MiB) { fprintf(stderr, "kernel_launch: unexpected shapes n_in %d out %d ws %zu\n", n_in, out_size, ws_size); grid = -1; return; }
        int dev = 0, cus = 0, per_cu = 0;
        (void)hipGetDevice(&dev); (void)hipDeviceGetAttribute(&cus, hipDeviceAttributeMultiprocessorCount, dev);
        if (hipFuncSetAttribute((const void*)trunk_fwd, hipFuncAttributeMaxDynamicSharedMemorySize, LDS_BYTES) != hipSuccess) { fprintf(stderr, "kernel_launch: hipFuncSetAttribute failed\n"); }
        if (hipOccupancyMaxActiveBlocksPerMultiprocessor(&per_cu, (const void*)trunk_fwd, NTHR, LDS_BYTES) != hipSuccess || per_cu < 1) { fprintf(stderr, "kernel_launch: occupancy query says %d\n", per_cu); per_cu = 1; }
        (void)hipGetLastError();
        grid = cus * per_cu; if (grid > 256) grid = 256; if (grid < 1) grid = 256;
    }
    if (grid < 0) return;
    Args a{};
    for (int i = 0; i < 27; ++i) a.in[i] = (const float*)d_in[i];
    a.out = (float*)d_out; a.ws = (unsigned char*)d_ws;
    void* kargs[] = {&a};
    hipError_t e = hipLaunchCooperativeKernel((const void*)trunk_fwd, dim3(grid), dim3(NTHR), kargs, LDS_BYTES, stream);
    if (e != hipSuccess) fprintf(stderr, "cooperative launch failed: %s (grid %d)\n", hipGetErrorString(e), grid);
}
```

```cpp
#include <hip/hip_runtime.h>
#include <hip/hip_cooperative_groups.h>
#include <cstdio>
#include <cstdint>
namespace cg = cooperative_groups;
__device__ __forceinline__ int opaque_tid() { int t = threadIdx.x; asm volatile("" : "+v"(t)); return t; }
namespace pg8 {
#define PG8_LAS __attribute__((address_space(3)))
typedef unsigned short bf16_t;
typedef short bf16x8 __attribute__((ext_vector_type(8)));
typedef float f32x4 __attribute__((ext_vector_type(4)));
typedef unsigned u32x4 __attribute__((ext_vector_type(4)));
constexpr int BM = 256, BK = 64, HALF = 128, HTB = HALF * BK * 2  , STAGE_BYTES = 8 * HTB, NXCD = 8, WGM = 8;

__host__ __device__ __forceinline__ int lds_byte(int r, int c) { const int st = (r >> 4) * 2 + (c >> 5), rr = r & 15, cc = c & 31, ob = rr * 64 + cc * 2; return st * 1024 + (ob ^ (((ob >> 9) & 1) << 5)); }
__host__ __device__ __forceinline__ void stage_rc(int b, int& R, int& C) { const int st = b / 1024, sb = b % 1024, swz = sb ^ (((sb >> 9) & 1) << 5); R = (st >> 1) * 16 + swz / 64; C = (st & 1) * 32 + (swz % 64) / 2; }
__host__ __device__ __forceinline__ int perm32(int rho) { const int n = rho >> 4, i = rho & 15; return 8 * (i >> 2) + 4 * n + (i & 3); }

struct Unit { int pm, pn; };
struct Gemm { const bf16_t* A; const bf16_t* Bt; int M, N, K, lda, ldb, ksplit; };

struct StaticOrder {
    int nM, nN, nwg, G, c;
    __host__ __device__ __forceinline__ void init(int M, int N, int G_, int c_) { nM = M / BM; nN = N / BM; nwg = nM * nN; G = G_; c = c_; }
    __host__ __device__ __forceinline__ bool next(int i, Unit& u) const {
        const long L = (long)i * G + c; if (L >= nwg) return false;
        int wgid = (int)L; { const int q = nwg / NXCD, r = nwg % NXCD, xcd = wgid % NXCD, off = wgid / NXCD; wgid = (xcd < r ? xcd * (q + 1) : r * (q + 1) + (xcd - r) * q) + off; }
        const int nig = WGM * nN, gid = wgid / nig, fm = gid * WGM, gsz = (nM - fm) < WGM ? (nM - fm) : WGM;
        u.pm = fm + ((wgid % nig) % gsz); u.pn = (wgid % nig) / gsz; return true;
    }
    __device__ __forceinline__ void a_ready(const Unit&) const {}
    __device__ __forceinline__ void done(const Unit&) const {}
};

__device__ __forceinline__ unsigned cvt_pk_bf16(float lo, float hi) { unsigned r; asm volatile("v_cvt_pk_bf16_f32 %0, %1, %2" : "=v"(r) : "v"(lo), "v"(hi)); return r; }
__device__ __forceinline__ float bflo(unsigned w) { return __uint_as_float(w << 16); }
__device__ __forceinline__ float bfhi(unsigned w) { return __uint_as_float(w & 0xffff0000u); }
__device__ __forceinline__ float softplus_f(float x) { return x > 15.f ? x : __logf(1.f + __expf(x)); }
__device__ __forceinline__ float sigmoid_f(float x) { return __builtin_amdgcn_rcpf(1.f + __expf(-x)); }
constexpr int MROWS_ = 16384;
template <int MODE> struct EpiX {
    static constexpr bool PERM = true, AFTER_DRAIN = false; static constexpr int MIDT = (MODE == 5) ? 16 : -1;
    bf16_t* O; int ldc; const float* bias; float* F32O; const bf16_t* Y; const bf16_t* Zp; float qscale;
    __device__ __forceinline__ void mid(f32x4 (&acc)[2][2][4][2], int wr, int fr, PG8_LAS unsigned char* lds) const {
        const PG8_LAS float* rs = (const PG8_LAS float*)(lds + 131072);
#pragma unroll
        for (int ai = 0; ai < 2; ++ai)
#pragma unroll
            for (int m = 0; m < 4; ++m) { const float r = rs[ai * HALF + wr * 64 + m * 16 + fr];
#pragma unroll
                for (int bj = 0; bj < 2; ++bj)
#pragma unroll
                    for (int n = 0; n < 2; ++n) acc[ai][bj][m][n] = acc[ai][bj][m][n] * r; }
    }
    __device__ __forceinline__ void operator()(const f32x4 (&acc)[2][2][4][2], const Unit& u, int wr, int wc, int fr, int fq) const {
        const int row0 = u.pm * BM + wr * 64 + fr; const int col0 = u.pn * BM + wc * 32 + 8 * fq;
        float sc = 1.f;
        if (MODE == 0) { if (u.pn >= 4 && u.pn < 8) sc = qscale; }
        if (MODE == 1) { if (u.pn < 6) sc = qscale; }
        const bool special = (MODE == 0 && u.pn == 26);
#pragma unroll
        for (int ai = 0; ai < 2; ++ai)
#pragma unroll
            for (int m = 0; m < 4; ++m) { const int row = row0 + ai * HALF + m * 16;
#pragma unroll
                for (int bj = 0; bj < 2; ++bj) { f32x4 v0 = acc[ai][bj][m][0], v1 = acc[ai][bj][m][1]; const int col = col0 + bj * HALF;
                    if (MODE == 0 || MODE == 1) {
                        if (!special) { v0 = v0 * sc; v1 = v1 * sc; u32x4 w; w.x = cvt_pk_bf16(v0[0], v0[1]); w.y = cvt_pk_bf16(v0[2], v0[3]); w.z = cvt_pk_bf16(v1[0], v1[1]); w.w = cvt_pk_bf16(v1[2], v1[3]);
                            *(u32x4*)(O + (size_t)row * ldc + col) = w; }
                        else { const int lc = col - u.pn * BM; const int NV = (MODE == 0) ? 16 : 24;
                            if (lc < NV) { f32x4 o0, o1;
#pragma unroll
                                for (int i = 0; i < 4; ++i) { const float a0 = v0[i] + bias[lc + i], a1 = v1[i] + bias[lc + 4 + i];
                                    if (MODE == 0) { o0[i] = softplus_f(a0); o1[i] = softplus_f(a1); } else { o0[i] = -softplus_f(-a0); o1[i] = -softplus_f(-a1); } }
                                *(f32x4*)(F32O + (size_t)row * NV + lc) = o0; *(f32x4*)(F32O + (size_t)row * NV + lc + 4) = o1; } }
                    } else if (MODE == 4) {
                        const int lc = col - u.pn * BM;
                        if (lc < 24) { float* dst = (u.pn == 0 ? F32O : (float*)((unsigned char*)Y + (size_t)(u.pn - 1) * (MROWS_ * 24 * 4))) + (size_t)row * 24 + lc; *(f32x4*)dst = v0; *(f32x4*)(dst + 4) = v1; }
                    } else if (MODE == 2 || MODE == 5) {
                        u32x4 w; w.x = cvt_pk_bf16(v0[0], v0[1]); w.y = cvt_pk_bf16(v0[2], v0[3]); w.z = cvt_pk_bf16(v1[0], v1[1]); w.w = cvt_pk_bf16(v1[2], v1[3]);
                        *(u32x4*)(O + (size_t)row * ldc + col) = w;
                    } else {
                        const u32x4 yv = *(const u32x4*)(Y + (size_t)row * 2048 + col); const u32x4 zv = *(const u32x4*)(Zp + (size_t)row * ldc + col);
                        const f32x4 b0 = *(const f32x4*)(bias + col), b1 = *(const f32x4*)(bias + col + 4);
                        float r[8];
#pragma unroll
                        for (int e = 0; e < 4; ++e) { const float y0 = bflo(yv[e]), y1 = bfhi(yv[e]), z0 = bflo(zv[e]), z1 = bfhi(zv[e]);
                            const float a0 = (e < 2 ? v0[2 * e] : v1[2 * e - 4]) + (e < 2 ? b0[2 * e] : b1[2 * e - 4]);
                            const float a1 = (e < 2 ? v0[2 * e + 1] : v1[2 * e - 3]) + (e < 2 ? b0[2 * e + 1] : b1[2 * e - 3]);
                            r[2 * e] = y0 * sigmoid_f(a0) * z0 * sigmoid_f(z0); r[2 * e + 1] = y1 * sigmoid_f(a1) * z1 * sigmoid_f(z1); }
                        u32x4 w; w.x = cvt_pk_bf16(r[0], r[1]); w.y = cvt_pk_bf16(r[2], r[3]); w.z = cvt_pk_bf16(r[4], r[5]); w.w = cvt_pk_bf16(r[6], r[7]);
                        *(u32x4*)(O + (size_t)row * ldc + col) = w;
                    } } }
    }
};
template <class Epi, class Sched, bool ALIGN_EPI = false, bool SP2 = false>
__device__ __forceinline__ void gemm_phase(PG8_LAS unsigned char* lds, const Gemm g, const Sched& S, const Epi& E) {
    const int tid = opaque_tid(), wid = __builtin_amdgcn_readfirstlane(tid >> 6), lane = tid & 63, wr = wid >> 2, wc = wid & 3, fr = lane & 15, fq = lane >> 4;
    const int K = g.K, nt = K / BK;
    unsigned voffA[2], voffB[2];
#pragma unroll
    for (int i = 0; i < 2; ++i) { int R, C; stage_rc(tid * 16 + i * 8192, R, C); const int Rb = Epi::PERM ? ((R & ~31) + perm32(R & 31)) : R;
        voffA[i] = (unsigned)(R * g.lda + C) * 2u; voffB[i] = (unsigned)(Rb * g.ldb + C) * 2u; }
    const size_t kstep = (size_t)(BK * 2);
    const size_t hstepA = (size_t)HALF * g.lda * 2, hstepB = (size_t)HALF * g.ldb * 2;
    const size_t tstepA = 2 * hstepA, tstepB = g.ksplit ? (size_t)K * 2 : 2 * hstepB, kslA = g.ksplit ? (size_t)K * 2 : 0;
    const unsigned ldsw = (unsigned)wid * 1024u;
    const int aoff = lds_byte(wr * 64 + fr, fq * 8), boff = lds_byte(wc * 32 + fr, fq * 8);
#define PG8_SA(b, h) (((b) * 2 + (h)) * HTB)
#define PG8_SB(b, h) ((4 + (b) * 2 + (h)) * HTB)
#define PG8_STAGE(bufoff, gbase, voff) do { _Pragma("unroll") for (int _i = 0; _i < 2; ++_i) \
        __builtin_amdgcn_global_load_lds((const unsigned*)((const char*)(gbase) + (voff)[_i]), (PG8_LAS unsigned*)(lds + (bufoff) + ldsw + _i * 8192), 16, 0, 0); } while (0)
#define PG8_LDA(dst, b, h) do { _Pragma("unroll") for (int m = 0; m < 4; ++m) _Pragma("unroll") for (int k = 0; k < 2; ++k) dst[m][k] = *(const PG8_LAS bf16x8*)(lds + PG8_SA(b, h) + aoff + m * 2048 + k * 1024); } while (0)
#define PG8_LDB(dst, b, h) do { _Pragma("unroll") for (int n = 0; n < 2; ++n) _Pragma("unroll") for (int k = 0; k < 2; ++k) dst[n][k] = *(const PG8_LAS bf16x8*)(lds + PG8_SB(b, h) + boff + n * 2048 + k * 1024); } while (0)
#define PG8_MMA(ai, bj, At, Bt) do { __builtin_amdgcn_s_setprio(1); _Pragma("unroll") for (int m = 0; m < 4; ++m) _Pragma("unroll") for (int n = 0; n < 2; ++n) _Pragma("unroll") for (int k = 0; k < 2; ++k) \
        acc[ai][bj][m][n] = __builtin_amdgcn_mfma_f32_16x16x32_bf16(Bt[n][k], At[m][k], acc[ai][bj][m][n], 0, 0, 0); __builtin_amdgcn_s_setprio(0); } while (0)
#define PG8_WAIT_V(n) asm volatile("s_waitcnt vmcnt(" #n ")" ::: "memory")
#define PG8_WAIT_L(n) asm volatile("s_waitcnt lgkmcnt(" #n ")" ::: "memory")
#define PG8_BAR __builtin_amdgcn_s_barrier()
#define PG8_SCHED __builtin_amdgcn_sched_barrier(0)
    Unit cur, nxt; int ui = 0;
    if (!S.next(0, cur)) return;
    f32x4 acc[2][2][4][2];
#pragma unroll
    for (int a = 0; a < 2; ++a)
#pragma unroll
        for (int b = 0; b < 2; ++b)
#pragma unroll
            for (int m = 0; m < 4; ++m)
#pragma unroll
                for (int n = 0; n < 2; ++n) acc[a][b][m][n] = (f32x4){0.f, 0.f, 0.f, 0.f};
    bf16x8 At[4][2], B0[2][2], B1[2][2];
    const char* cA = (const char*)g.A + (size_t)cur.pm * tstepA + (size_t)cur.pn * kslA; const char* cB = (const char*)g.Bt + (size_t)cur.pn * tstepB;
    S.a_ready(cur);
    if constexpr (SP2) {
        PG8_STAGE(PG8_SB(0, 0), cB, voffB); PG8_STAGE(PG8_SB(0, 1), cB + hstepB, voffB); PG8_STAGE(PG8_SA(0, 0), cA, voffA); PG8_STAGE(PG8_SA(0, 1), cA + hstepA, voffA);
        if (wr == 1) PG8_BAR;
        PG8_WAIT_V(2); PG8_BAR;
        PG8_STAGE(PG8_SB(1, 0), cB + kstep, voffB); PG8_STAGE(PG8_SA(1, 0), cA + kstep, voffA); PG8_STAGE(PG8_SB(1, 1), cB + hstepB + kstep, voffB);
        PG8_WAIT_V(6); PG8_BAR;
    } else {
        PG8_STAGE(PG8_SB(0, 0), cB, voffB); PG8_STAGE(PG8_SA(0, 0), cA, voffA); PG8_STAGE(PG8_SB(0, 1), cB + hstepB, voffB); PG8_STAGE(PG8_SA(0, 1), cA + hstepA, voffA);
        if (wr == 1) PG8_BAR;
        PG8_WAIT_V(4); PG8_BAR;
        PG8_STAGE(PG8_SB(1, 0), cB + kstep, voffB); PG8_STAGE(PG8_SA(1, 0), cA + kstep, voffA); PG8_STAGE(PG8_SB(1, 1), cB + hstepB + kstep, voffB);
        PG8_WAIT_V(6); PG8_BAR;
    }
    for (;;) {
        const bool has_next = S.next(ui + 1, nxt);
        const char* nA = has_next ? (const char*)g.A + (size_t)nxt.pm * tstepA + (size_t)nxt.pn * kslA : cA; const char* nB = has_next ? (const char*)g.Bt + (size_t)nxt.pn * tstepB : cB;
        for (int t = 0; t < nt; t += 2) {
            if constexpr (Epi::MIDT >= 0) { if (t == Epi::MIDT) E.mid(acc, wr, fr, lds); }
            const bool last = (t == nt - 2);
            const char* a1 = cA + (size_t)(t + 1) * kstep;
            const char* a2 = last ? nA : cA + (size_t)(t + 2) * kstep; const char* b2 = last ? nB : cB + (size_t)(t + 2) * kstep;
            const char* a3 = a2 + kstep; const char* b3 = b2 + kstep;
            if (last && has_next) S.a_ready(nxt);
            if constexpr (SP2) {
            PG8_LDB(B0, 0, 0); PG8_LDB(B1, 0, 1); PG8_SCHED; PG8_LDA(At, 0, 0); PG8_STAGE(PG8_SA(1, 1), a1 + hstepA, voffA);
            PG8_WAIT_V(8); PG8_WAIT_L(0); PG8_BAR; PG8_MMA(0, 0, At, B0); PG8_MMA(0, 1, At, B1); PG8_BAR; PG8_SCHED;
            PG8_LDA(At, 0, 1); PG8_STAGE(PG8_SB(0, 0), b2, voffB); PG8_STAGE(PG8_SB(0, 1), b2 + hstepB, voffB); PG8_STAGE(PG8_SA(0, 0), a2, voffA);
            PG8_WAIT_V(8); PG8_WAIT_L(0); PG8_BAR; PG8_MMA(1, 0, At, B0); PG8_MMA(1, 1, At, B1); PG8_BAR; PG8_SCHED;
            PG8_LDB(B0, 1, 0); PG8_LDB(B1, 1, 1); PG8_SCHED; PG8_LDA(At, 1, 0); PG8_STAGE(PG8_SA(0, 1), a2 + hstepA, voffA);
            PG8_WAIT_V(8); PG8_WAIT_L(0); PG8_BAR; PG8_MMA(0, 0, At, B0); PG8_MMA(0, 1, At, B1); PG8_BAR; PG8_SCHED;
            PG8_LDA(At, 1, 1); PG8_STAGE(PG8_SB(1, 0), b3, voffB); PG8_STAGE(PG8_SB(1, 1), b3 + hstepB, voffB); PG8_STAGE(PG8_SA(1, 0), a3, voffA);
            PG8_WAIT_V(8); PG8_WAIT_L(0); PG8_BAR; PG8_MMA(1, 0, At, B0); PG8_MMA(1, 1, At, B1); PG8_BAR; PG8_SCHED;
            } else {
            PG8_LDB(B0, 0, 0); PG8_SCHED; PG8_LDA(At, 0, 0); PG8_STAGE(PG8_SA(1, 1), a1 + hstepA, voffA);
            PG8_WAIT_L(8); PG8_BAR; PG8_WAIT_L(0); PG8_MMA(0, 0, At, B0); PG8_BAR; PG8_SCHED;
            PG8_LDB(B1, 0, 1); PG8_STAGE(PG8_SB(0, 0), b2, voffB);
            PG8_BAR; PG8_WAIT_L(0); PG8_MMA(0, 1, At, B1); PG8_BAR;
            PG8_LDA(At, 0, 1); PG8_STAGE(PG8_SA(0, 0), a2, voffA);
            PG8_BAR; PG8_WAIT_L(0); PG8_MMA(1, 0, At, B0); PG8_BAR; PG8_SCHED;
            PG8_STAGE(PG8_SB(0, 1), b2 + hstepB, voffB);
            PG8_WAIT_V(6); PG8_BAR; PG8_MMA(1, 1, At, B1); PG8_BAR;
            PG8_LDB(B0, 1, 0); PG8_SCHED; PG8_LDA(At, 1, 0); PG8_STAGE(PG8_SA(0, 1), a2 + hstepA, voffA);
            PG8_WAIT_L(8); PG8_BAR; PG8_WAIT_L(0); PG8_MMA(0, 0, At, B0); PG8_BAR; PG8_SCHED;
            PG8_LDB(B1, 1, 1); PG8_STAGE(PG8_SB(1, 0), b3, voffB);
            PG8_BAR; PG8_WAIT_L(0); PG8_MMA(0, 1, At, B1); PG8_BAR;
            PG8_LDA(At, 1, 1); PG8_STAGE(PG8_SA(1, 0), a3, voffA);
            PG8_BAR; PG8_WAIT_L(0); PG8_MMA(1, 0, At, B0); PG8_BAR; PG8_SCHED;
            PG8_STAGE(PG8_SB(1, 1), b3 + hstepB, voffB);
            PG8_WAIT_V(6); PG8_BAR; PG8_MMA(1, 1, At, B1); PG8_BAR;
            }
        }
        if constexpr (ALIGN_EPI) { if (wr == 0) PG8_BAR; }
        if constexpr (!Epi::AFTER_DRAIN) { E(acc, cur, wr, wc, fr, fq); S.done(cur); }
        if (!has_next) break;
#pragma unroll
        for (int a = 0; a < 2; ++a)
#pragma unroll
            for (int b = 0; b < 2; ++b)
#pragma unroll
                for (int m = 0; m < 4; ++m)
#pragma unroll
                    for (int n = 0; n < 2; ++n) acc[a][b][m][n] = (f32x4){0.f, 0.f, 0.f, 0.f};
        cur = nxt; cA = nA; cB = nB; ++ui;
        if constexpr (ALIGN_EPI) { if (wr == 1) PG8_BAR; }
    }
    PG8_WAIT_V(0);
    if constexpr (!ALIGN_EPI) { if (wr == 0) PG8_BAR; }
    PG8_BAR;
    if constexpr (Epi::AFTER_DRAIN) { E.fused(acc, cur, wr, wc, fr, fq, lds, wid, lane); S.done(cur); }
#undef PG8_SA
#undef PG8_SB
#undef PG8_STAGE
#undef PG8_LDA
#undef PG8_LDB
#undef PG8_MMA
#undef PG8_WAIT_V
#undef PG8_WAIT_L
#undef PG8_BAR
#undef PG8_SCHED
}
}

#include <hip/hip_bf16.h>
#include <cmath>
namespace attn_body {
using bf16=__hip_bfloat16;
using bf16x8=__attribute__((ext_vector_type(8)))short;
using s16x4=__attribute__((ext_vector_type(4)))short;
using f32x16=__attribute__((ext_vector_type(16)))float;
using u32x4=__attribute__((ext_vector_type(4)))unsigned;
constexpr int SEQ=2048,D=64;
constexpr int NW=8,QBLK=32,QB=QBLK*NW,KVBLK=64,NQB=SEQ/QB;
constexpr int ATTN_UNIT_ROWS=QB;
__device__ __forceinline__ int crow(int r,int hi){return (r&3)+8*(r>>2)+4*hi;}
#define SBAR() __builtin_amdgcn_sched_barrier(0)
__device__ __forceinline__ void cmask(f32x16&p0,f32x16&p1,int jb,int qrel,int hi){
  const float NEG=-INFINITY; int kb=64*jb+4*hi;
  #pragma unroll
  for(int r=0;r<16;++r){int kv=kb+(r&3)+8*(r>>2); if(kv>qrel)p0[r]=NEG; if(kv+32>qrel)p1[r]=NEG;}
}

constexpr int NSLOT=3, SLOTB=8192;
constexpr int LDS_K=0, LDS_V=NSLOT*SLOTB, LDS_WS=2*NSLOT*SLOTB, LDS_OST=LDS_WS+NW*64*4, LDS_BYTES=LDS_OST+NW*4096;
constexpr int XOFF=86016; constexpr float SENT=-30000.f; using f32x4=__attribute__((ext_vector_type(4)))float;
constexpr float C2=0.125f*1.4426950408889634f;
__device__ __forceinline__ void glds16(const void*gsrc,unsigned lds_dst){unsigned keep;
  asm volatile("s_mov_b32 %0, m0\n\ts_mov_b32 m0, %2\n\ts_nop 0\n\tglobal_load_lds_dwordx4 %1, off\n\ts_mov_b32 m0, %0":"=&s"(keep):"v"(gsrc),"s"(lds_dst):"memory");}
__device__ __forceinline__ float max3f(float a,float b,float c){float r;asm("v_max3_f32 %0, %1, %2, %3":"=v"(r):"v"(a),"v"(b),"v"(c));return r;}
__device__ __forceinline__ float max2f(float a,float b){float r;asm("v_max_f32_e32 %0, %1, %2":"=v"(r):"v"(a),"v"(b));return r;}
__device__ __forceinline__ float fadd_s(float a,float b){float r;asm("v_add_f32_e32 %0, %1, %2":"=v"(r):"v"(a),"v"(b));return r;}
__device__ __forceinline__ float fsub_s(float a,float b){float r;asm("v_sub_f32_e32 %0, %1, %2":"=v"(r):"v"(a),"v"(b));return r;}
typedef float f32x2_t __attribute__((ext_vector_type(2))); typedef __bf16 bf16x2_t __attribute__((ext_vector_type(2)));
__device__ __forceinline__ unsigned cvtpk_s(float lo,float hi){f32x2_t v={lo,hi};bf16x2_t b=__builtin_convertvector(v,bf16x2_t);return __builtin_bit_cast(unsigned,b);}
#define WAIT_BAR(N) asm volatile("s_waitcnt vmcnt(" #N ") lgkmcnt(0)\n\ts_barrier":::"memory")

__device__ __forceinline__ void qkt(f32x16&p0,f32x16&p1,const char*Kslot,const bf16x8*qr,const f32x16&negm,int r32,int hi){
  const char*kb=Kslot+hi*1024+r32*16;
  #pragma unroll
  for(int d0=0;d0<4;++d0){
    const bf16x8 b0=*reinterpret_cast<const bf16x8*>(kb+d0*2048);
    const bf16x8 b1=*reinterpret_cast<const bf16x8*>(kb+d0*2048+512);
    if(d0==0){p0=__builtin_amdgcn_mfma_f32_32x32x16_bf16(b0,qr[0],negm,0,0,0);p1=__builtin_amdgcn_mfma_f32_32x32x16_bf16(b1,qr[0],negm,0,0,0);}
    else{p0=__builtin_amdgcn_mfma_f32_32x32x16_bf16(b0,qr[d0],p0,0,0,0);p1=__builtin_amdgcn_mfma_f32_32x32x16_bf16(b1,qr[d0],p1,0,0,0);}}
}
typedef __attribute__((address_space(3))) const char* lds_cptr;
typedef short v4i16_t __attribute__((ext_vector_type(4)));
__device__ __forceinline__ void kload8(bf16x8*kf,lds_cptr kp){
  kf[0]=*(const __attribute__((address_space(3))) bf16x8*)(kp);      kf[1]=*(const __attribute__((address_space(3))) bf16x8*)(kp+512);
  kf[2]=*(const __attribute__((address_space(3))) bf16x8*)(kp+2048); kf[3]=*(const __attribute__((address_space(3))) bf16x8*)(kp+2560);
  kf[4]=*(const __attribute__((address_space(3))) bf16x8*)(kp+4096); kf[5]=*(const __attribute__((address_space(3))) bf16x8*)(kp+4608);
  kf[6]=*(const __attribute__((address_space(3))) bf16x8*)(kp+6144); kf[7]=*(const __attribute__((address_space(3))) bf16x8*)(kp+6656);
}
__device__ __forceinline__ void kload2(bf16x8*kf,lds_cptr kp,int j){ kf[2*j]=*(const __attribute__((address_space(3))) bf16x8*)(kp+j*2048); kf[2*j+1]=*(const __attribute__((address_space(3))) bf16x8*)(kp+j*2048+512); }
__device__ __forceinline__ s16x4 vtr(lds_cptr p){ return __builtin_bit_cast(s16x4,__builtin_amdgcn_ds_read_tr16_b64_v4i16((__attribute__((address_space(3))) v4i16_t*)p)); }
__device__ __forceinline__ float rowmax(const f32x16&p0,const f32x16&p1){
  float a=max3f(p0[0],p0[1],p1[0]),b=max3f(p0[2],p0[3],p1[1]);a=max3f(a,p1[2],p1[3]);
  #pragma unroll
  for(int r=4;r<16;r+=4){a=max3f(a,p0[r],p0[r+1]);b=max3f(b,p0[r+2],p0[r+3]);a=max3f(a,p1[r],p1[r+1]);b=max3f(b,p1[r+2],p1[r+3]);}
  const float m=max2f(a,b);
  auto rr=__builtin_amdgcn_permlane32_swap(__float_as_uint(m),__float_as_uint(m),false,false);
  return max2f(__uint_as_float(rr[0]),__uint_as_float(rr[1]));
}
__device__ __forceinline__ void pv(f32x16*o,int vb,bf16x8 pa0,bf16x8 pa1,bf16x8 pa2,bf16x8 pa3){
  #pragma unroll
  for(int d0=0;d0<2;++d0){s16x4 lo[4],hi[4];
    #pragma unroll
    for(int ks=0;ks<4;++ks){
      asm volatile("ds_read_b64_tr_b16 %0,%1 offset:%c2":"=&v"(lo[ks]):"v"(vb),"i"(d0*4096+ks*1024):"memory");
      asm volatile("ds_read_b64_tr_b16 %0,%1 offset:%c2":"=&v"(hi[ks]):"v"(vb),"i"(d0*4096+ks*1024+512):"memory");}
    asm volatile("s_waitcnt lgkmcnt(0)":::"memory");SBAR();
    #define PK(k) (bf16x8){lo[k][0],lo[k][1],lo[k][2],lo[k][3],hi[k][0],hi[k][1],hi[k][2],hi[k][3]}
    o[d0]=__builtin_amdgcn_mfma_f32_32x32x16_bf16(pa0,PK(0),o[d0],0,0,0);
    o[d0]=__builtin_amdgcn_mfma_f32_32x32x16_bf16(pa1,PK(1),o[d0],0,0,0);
    o[d0]=__builtin_amdgcn_mfma_f32_32x32x16_bf16(pa2,PK(2),o[d0],0,0,0);
    o[d0]=__builtin_amdgcn_mfma_f32_32x32x16_bf16(pa3,PK(3),o[d0],0,0,0);
    #undef PK
  }
}

#ifndef ATTN_STORE16
#define ATTN_STORE16(p,v) (*(u32x4*)(p)=(v))
#endif
template<int THRL,int MODE,int DM,bool DRY=false> __device__ __forceinline__ void attn_unit(int b,int h,int qb,const bf16*Q,const bf16*__restrict__ K,const bf16*__restrict__ V,bf16*O,const bf16*__restrict__ Z,const float*__restrict__ XP,const int*__restrict__ TS,volatile unsigned*lw,unsigned nxt,char*shm){
  const int tid=opaque_tid(),lane=tid&63,r32=lane&31,hi=lane>>5; const int wid=__builtin_amdgcn_readfirstlane(tid>>6);
  const long rowbase=(long)b*SEQ; const int q0=qb*QB;
  const bf16*Qw=Q+(rowbase+q0+wid*QBLK)*DM+h*D;
  bf16x8 qr[4];
  #pragma unroll
  for(int d0=0;d0<4;++d0)qr[d0]=*reinterpret_cast<const bf16x8*>(&Qw[(long)r32*DM+d0*16+hi*8]);
  const bf16*Kh=K+rowbase*DM+h*D,*Vh=V+rowbase*DM+h*D;
  const unsigned lds0=(unsigned)(uintptr_t)shm;
  float*wsf=(float*)(shm+LDS_WS)+wid*64;
  const bf16*ksrc_=Kh+(long)lane*DM+wid*8; int tskip=0; const bf16*ksrc=ksrc_;
  const bf16*vsrc_=Vh+(long)(16*(wid&3)+(lane>>2))*DM+(wid>>2)*32+(lane&3)*8; const bf16*vsrc=vsrc_;
  const unsigned kdst=lds0+LDS_K+wid*1024, vdst=lds0+LDS_V+wid*1024;
  #define DMA_K(t,slot) glds16(ksrc+(long)(t)*KVBLK*DM,(unsigned)__builtin_amdgcn_readfirstlane(kdst+(slot)))
  #define DMA_V(t,slot) glds16(vsrc+(long)(t)*KVBLK*DM,(unsigned)__builtin_amdgcn_readfirstlane(vdst+(slot)))
  const int vb0=(int)(lds0+LDS_V)+((lane>>4)&1)*32+(lane&3)*8+(4*hi+((lane&15)>>2))*64;
  const char*Kbase=shm+LDS_K; bf16x8 kf[8];
  const lds_cptr shm3=(lds_cptr)shm; const lds_cptr kp0=shm3+LDS_K+hi*1024+r32*16; const lds_cptr vp0=shm3+LDS_V+((lane>>4)&1)*32+(lane&3)*8+(4*hi+((lane&15)>>2))*64;
  int NT=(q0+QB)/KVBLK;
  const int qrel=wid*QBLK+r32;
  unsigned sel=0u;
  if constexpr(MODE==1){
    tskip=__builtin_amdgcn_readfirstlane(TS[qb]);
    ksrc=ksrc_+(long)tskip*KVBLK*DM; vsrc=vsrc_+(long)tskip*KVBLK*DM; NT-=tskip;
  }
  const lds_cptr fsl=(lds_cptr)shm+XOFF+16*hi+tskip*256;
  #define XMASK(P0,P1,t) do{ if constexpr(MODE==0){ if((t)<NT-4){ const bool keep_=(sel>>((t)>>2))&1u; \
        _Pragma("unroll") for(int r=0;r<16;++r){P0[r]=keep_?P0[r]:SENT;P1[r]=keep_?P1[r]:SENT;} } } \
      else { const lds_cptr fp_=fsl+(t)*256; const float mh_=mhat; \
        _Pragma("unroll") for(int g_=0;g_<4;++g_){ const f32x4 fa_=*(const __attribute__((address_space(3))) f32x4*)(fp_+g_*32)+mh_; const f32x4 fb_=*(const __attribute__((address_space(3))) f32x4*)(fp_+128+g_*32)+mh_; \
          _Pragma("unroll") for(int i_=0;i_<4;++i_){P0[4*g_+i_]-=fa_[i_];P1[4*g_+i_]-=fb_[i_];} } } }while(0)
  DMA_K(0,0);DMA_V(0,0);DMA_K(1,SLOTB);
  float mhat=0.f,l_reg=0.f;f32x16 o[2];o[0]=f32x16{};o[1]=f32x16{};f32x16 negm=f32x16{}; if constexpr(MODE==0){asm volatile("":"+v"(negm));}
  #define CMASK(P0,P1,t) do{int jb_=(t)-(NT-4); if(jb_>=0)cmask(P0,P1,jb_,qrel,hi);}while(0)
  const f32x16 czero_=f32x16{};
  #define NEGM (MODE==1?czero_:negm)
  bool resc=false;
  #define START(P0,P1) do{ const float rm=rowmax(P0,P1); resc=false; \
    { const float dl=rm; mhat=fadd_s(mhat,dl); \
      _Pragma("unroll") for(int r=0;r<16;++r){P0[r]=fsub_s(P0[r],dl);P1[r]=fsub_s(P1[r],dl);} \
      if constexpr(MODE==0){ _Pragma("unroll") for(int r=0;r<16;++r)negm[r]=-mhat; asm volatile("":"+v"(negm)); } } \
    _Pragma("unroll") for(int r=0;r<16;++r)P0[r]=__builtin_amdgcn_exp2f(P0[r]); }while(0)
  #define RESC() do{ if(resc){ asm volatile("s_waitcnt lgkmcnt(0)":::"memory"); \
      _Pragma("unroll") for(int d_=0;d_<2;++d_) _Pragma("unroll") for(int r=0;r<16;++r)o[d_][r]*=wsf[crow(r,hi)]; } }while(0)
  f32x16 pA0,pA1,pB0,pB1;
  int sl_prev=0,sl_cur=0,sl_next=SLOTB;
  #define ROT() do{sl_prev=sl_cur;sl_cur=sl_next;sl_next=(sl_next==(NSLOT-1)*SLOTB)?0:sl_next+SLOTB;}while(0)
  DMA_K(2,2*SLOTB);
  if constexpr(MODE==1){ float*fs=(float*)(shm+XOFF); for(int i=tid+64*tskip;i<q0+QB;i+=NW*64)fs[i]=XP[i]; }
  if constexpr(MODE==0){
    float*kbs=(float*)(shm+XOFF); unsigned*sm=(unsigned*)(shm+XOFF+2048);
    kbs[tid]=XP[tid];
    asm volatile("s_waitcnt vmcnt(0) lgkmcnt(0)\n\ts_barrier":::"memory");
    if(tid<QB){ unsigned m=(1u<<qb)-1u;
      if(qb>3){ const bf16*qp=Q+(rowbase+q0+tid)*DM+h*D; float g[8];
        _Pragma("unroll") for(int n=0;n<8;++n)g[n]=0.f;
        _Pragma("unroll") for(int c=0;c<8;++c){ const bf16x8 qv=*reinterpret_cast<const bf16x8*>(qp+c*8);
          _Pragma("unroll") for(int j=0;j<8;++j){ const float qf=__uint_as_float(((unsigned)(unsigned short)qv[j])<<16);
            _Pragma("unroll") for(int n=0;n<8;++n)g[n]+=qf*kbs[n*64+c*8+j]; } }
        m=0u;
        _Pragma("unroll") for(int it=0;it<3;++it){ float best=-INFINITY; int bi=0;
          _Pragma("unroll") for(int n=0;n<8;++n){ const bool ok=(n<qb)&&!((m>>n)&1u)&&(g[n]>best); best=ok?g[n]:best; bi=ok?n:bi; }
          m|=1u<<bi; } }
      sm[tid]=m; }
    asm volatile("s_waitcnt vmcnt(0) lgkmcnt(0)\n\ts_barrier":::"memory");
    sel=sm[qrel];
  }
  WAIT_BAR(3);
  qkt(pA0,pA1,Kbase,qr,NEGM,r32,hi);asm volatile("s_nop 15\n\ts_nop 7":"+v"(pA0),"+v"(pA1));XMASK(pA0,pA1,0);CMASK(pA0,pA1,0);
  START(pA0,pA1);
  _Pragma("unroll") for(int r=0;r<16;++r)pA1[r]=__builtin_amdgcn_exp2f(pA1[r]);
  WAIT_BAR(0);
  DMA_K(3,0);DMA_V(1,SLOTB);
  ROT();
  kload8(kf,kp0+sl_cur);
  WAIT_BAR(2);
  s16x4 vlo[8],vhi[8]; u32x4 pw0,pw1,pw2,pw3;
  #define PKW(P,B) cvtpk_s(P[B],P[B+1])
  #define PAF(k) __builtin_bit_cast(bf16x8,pw##k)
  #define VFR(i) (bf16x8){vlo[i][0],vlo[i][1],vlo[i][2],vlo[i][3],vhi[i][0],vhi[i][1],vhi[i][2],vhi[i][3]}
  #define PIN(x) asm volatile("":"+v"(x))
  #define MX3(a,b,c) __builtin_fmaxf(__builtin_fmaxf((a),(b)),(c))
  #define GAPA(MF,A0,A1,A2,A3,W0,W1,PW) do{ MF; sacc+=A0; sacc+=A1; sacc+=A2; sacc+=A3; PIN(sacc); W0; W1; PIN(PW); SBAR(); }while(0)
  #define EX(v) __builtin_amdgcn_exp2f(v)
  #define GAPB(MF,X,B) do{ MF; X[B]=EX(X[B]); X[B+1]=EX(X[B+1]); X[B+2]=EX(X[B+2]); X[B+3]=EX(X[B+3]); PIN(X); SBAR(); }while(0)
  #define VRD(i) do{ vlo[i]=vtr(vp_+(((i)>>2)*4096+((i)&3)*1024)); vhi[i]=vtr(vp_+(((i)>>2)*4096+((i)&3)*1024+512)); }while(0)
  #define KRD(G,j) do{ if(G){ kload2(kf,kp0+sl_next,j); SBAR(); } }while(0)
  #define STEP(C0,C1,P0,P1,t,GK,GV,GL) do{ SBAR(); \
    const lds_cptr vp_=vp0+sl_prev; \
    VRD(0); SBAR(); float sacc=(P0[0]+P0[1]); \
    GAPA(C0=__builtin_amdgcn_mfma_f32_32x32x16_bf16(kf[0],qr[0],NEGM,0,0,0), P0[2],P0[3],P0[4],P0[5],     pw0[0]=PKW(P0,0), pw0[1]=PKW(P0,2), pw0); \
    VRD(4); SBAR(); GAPA(C1=__builtin_amdgcn_mfma_f32_32x32x16_bf16(kf[1],qr[0],NEGM,0,0,0), P0[6],P0[7],P0[8],P0[9],     pw0[2]=PKW(P0,4), pw0[3]=PKW(P0,6), pw0); \
    VRD(1); SBAR(); GAPA(C0=__builtin_amdgcn_mfma_f32_32x32x16_bf16(kf[2],qr[1],C0,0,0,0),   P0[10],P0[11],P0[12],P0[13], pw1[0]=PKW(P0,8), pw1[1]=PKW(P0,10), pw1); \
    VRD(5); SBAR(); GAPA(C1=__builtin_amdgcn_mfma_f32_32x32x16_bf16(kf[3],qr[1],C1,0,0,0),   P0[14],P0[15],P1[0],P1[1],   pw1[2]=PKW(P0,12),pw1[3]=PKW(P0,14), pw1); \
    VRD(2); SBAR(); GAPA(C0=__builtin_amdgcn_mfma_f32_32x32x16_bf16(kf[4],qr[2],C0,0,0,0),   P1[2],P1[3],P1[4],P1[5],     pw2[0]=PKW(P1,0), pw2[1]=PKW(P1,2), pw2); \
    VRD(6); SBAR(); GAPA(C1=__builtin_amdgcn_mfma_f32_32x32x16_bf16(kf[5],qr[2],C1,0,0,0),   P1[6],P1[7],P1[8],P1[9],     pw2[2]=PKW(P1,4), pw2[3]=PKW(P1,6), pw2); \
    VRD(3); SBAR(); GAPA(C0=__builtin_amdgcn_mfma_f32_32x32x16_bf16(kf[6],qr[3],C0,0,0,0),   P1[10],P1[11],P1[12],P1[13], pw3[0]=PKW(P1,8), pw3[1]=PKW(P1,10), pw3); \
    VRD(7); SBAR(); GAPA(C1=__builtin_amdgcn_mfma_f32_32x32x16_bf16(kf[7],qr[3],C1,0,0,0),   P1[14],P1[15],0.f,0.f,       pw3[2]=PKW(P1,12),pw3[3]=PKW(P1,14), pw3); \
    l_reg+=sacc; \
    if(GK){DMA_K((t)+3,sl_cur);} if(GV){DMA_V((t)+1,sl_next);} \
    XMASK(C0,C1,t); CMASK(C0,C1,t); \
    { float a=MX3(C0[0],C0[1],C1[0]),b=MX3(C0[2],C0[3],C1[1]); a=MX3(a,C1[2],C1[3]); \
      _Pragma("unroll") for(int r=4;r<16;r+=4){a=MX3(a,C0[r],C0[r+1]);b=MX3(b,C0[r+2],C0[r+3]);a=MX3(a,C1[r],C1[r+1]);b=MX3(b,C1[r+2],C1[r+3]);} \
      float rm=__builtin_fmaxf(a,b); { auto rr=__builtin_amdgcn_permlane32_swap(__float_as_uint(rm),__float_as_uint(rm),false,false); rm=__builtin_fmaxf(__uint_as_float(rr[0]),__uint_as_float(rr[1])); } \
      resc=false; \
      if(__builtin_expect(__any(rm>(float)THRL),0)){ const float dl=__builtin_fmaxf(rm,0.f); mhat+=dl; \
        _Pragma("unroll") for(int r=0;r<16;++r){C0[r]-=dl;C1[r]-=dl;} \
        if constexpr(MODE==0){ _Pragma("unroll") for(int r=0;r<16;++r)negm[r]=-mhat; asm volatile("":"+v"(negm)); } \
        const float f=__builtin_amdgcn_exp2f(-dl); l_reg*=f; if(hi==0)wsf[r32]=f; resc=true; } } \
    SBAR(); \
    GAPB(o[0]=__builtin_amdgcn_mfma_f32_32x32x16_bf16(PAF(0),VFR(0),o[0],0,0,0), C0,0); \
    GAPB(o[1]=__builtin_amdgcn_mfma_f32_32x32x16_bf16(PAF(0),VFR(4),o[1],0,0,0), C0,4); \
    KRD(GL,0); GAPB(o[0]=__builtin_amdgcn_mfma_f32_32x32x16_bf16(PAF(1),VFR(1),o[0],0,0,0), C0,8); \
    KRD(GL,1); GAPB(o[1]=__builtin_amdgcn_mfma_f32_32x32x16_bf16(PAF(1),VFR(5),o[1],0,0,0), C0,12); \
    KRD(GL,2); GAPB(o[0]=__builtin_amdgcn_mfma_f32_32x32x16_bf16(PAF(2),VFR(2),o[0],0,0,0), C1,0); \
    KRD(GL,3); GAPB(o[1]=__builtin_amdgcn_mfma_f32_32x32x16_bf16(PAF(2),VFR(6),o[1],0,0,0), C1,4); \
    GAPB(o[0]=__builtin_amdgcn_mfma_f32_32x32x16_bf16(PAF(3),VFR(3),o[0],0,0,0), C1,8); \
    GAPB(o[1]=__builtin_amdgcn_mfma_f32_32x32x16_bf16(PAF(3),VFR(7),o[1],0,0,0), C1,12); \
    }while(0)
  int t=1;
  #undef CMASK
  #define CMASK(P0,P1,t) do{}while(0)
  for(;t+5<NT;t+=2){
    STEP(pB0,pB1,pA0,pA1,t,true,true,true);     WAIT_BAR(2); RESC(); ROT();
    STEP(pA0,pA1,pB0,pB1,t+1,true,true,true);   WAIT_BAR(2); RESC(); ROT();
  }
  #undef CMASK
  #define CMASK(P0,P1,t) do{int jb_=(t)-(NT-4); if(jb_>=0)cmask(P0,P1,jb_,qrel,hi);}while(0)
  #define ENDW(tt) do{ if((tt)+3<NT){WAIT_BAR(2);} else if((tt)+2<NT){WAIT_BAR(1);} else {WAIT_BAR(0);} }while(0)
  for(;t+1<NT;t+=2){
    STEP(pB0,pB1,pA0,pA1,t,(t+3<NT),(t+1<NT),(t+1<NT));       ENDW(t);   RESC(); ROT();
    STEP(pA0,pA1,pB0,pB1,t+1,(t+4<NT),(t+2<NT),(t+2<NT));     ENDW(t+1); RESC(); ROT();
  }
  STEP(pB0,pB1,pA0,pA1,NT-1,false,false,false); RESC();
  const bf16*Zw=Z+(rowbase+q0+wid*QBLK)*DM+h*D; u32x4 zpre[4];
  #pragma unroll
  for(int i=0;i<4;++i)zpre[i]=*(const u32x4*)(Zw+(long)(i*8+(lane>>3))*DM+(lane&7)*8);
  { float sacc=pB0[0]+pB0[1]; _Pragma("unroll") for(int r=2;r<16;++r)sacc+=pB0[r]; _Pragma("unroll") for(int r=0;r<16;++r)sacc+=pB1[r]; l_reg+=sacc;
    pw0=(u32x4){PKW(pB0,0),PKW(pB0,2),PKW(pB0,4),PKW(pB0,6)};pw1=(u32x4){PKW(pB0,8),PKW(pB0,10),PKW(pB0,12),PKW(pB0,14)};pw2=(u32x4){PKW(pB1,0),PKW(pB1,2),PKW(pB1,4),PKW(pB1,6)};pw3=(u32x4){PKW(pB1,8),PKW(pB1,10),PKW(pB1,12),PKW(pB1,14)};
    SBAR(); pv(o,vb0+sl_cur,PAF(0),PAF(1),PAF(2),PAF(3)); }
  #undef PKW
  #undef PAF
  #undef VFR
  #undef PIN
  #undef MX3
  #undef GAPA
  #undef GAPB
  #undef EX
  #undef VRD
  #undef KRD
  #undef STEP
  #undef ENDW
  if(lw!=nullptr&&tid==0)lw[0]=nxt;
  {auto rr=__builtin_amdgcn_permlane32_swap(__float_as_uint(l_reg),__float_as_uint(l_reg),false,false);l_reg=__uint_as_float(rr[0])+__uint_as_float(rr[1]);}
  if(hi==0)wsf[32+r32]=l_reg;asm volatile("s_waitcnt lgkmcnt(0)":::"memory");
  float rli[16];
  #pragma unroll
  for(int r=0;r<16;++r)rli[r]=__builtin_amdgcn_rcpf(wsf[32+crow(r,hi)]);
  bf16*Ow=O+(rowbase+q0+wid*QBLK)*DM+h*D;
  { bf16*stg=(bf16*)(shm+LDS_OST)+wid*2048;
    #pragma unroll
    for(int r=0;r<16;++r){const int orow=crow(r,hi);
      #pragma unroll
      for(int d0=0;d0<2;++d0)stg[orow*64+d0*32+r32]=__float2bfloat16(o[d0][r]*rli[r]);}
    asm volatile("s_waitcnt lgkmcnt(0)":::"memory");
    #pragma unroll
    for(int i=0;i<4;++i){const int row=i*8+(lane>>3),ch=lane&7; const u32x4 v=*(const u32x4*)(stg+row*64+ch*8); const u32x4 zv=zpre[i]; u32x4 ov;
      #pragma unroll
      for(int e=0;e<4;++e){ const float o0=__uint_as_float(v[e]<<16),o1=__uint_as_float(v[e]&0xffff0000u),z0=__uint_as_float(zv[e]<<16),z1=__uint_as_float(zv[e]&0xffff0000u);
        ov[e]=cvtpk_s(o0*z0*__builtin_amdgcn_rcpf(1.f+__expf(-z0)),o1*z1*__builtin_amdgcn_rcpf(1.f+__expf(-z1))); }
      if(!DRY||ov[0]==0x7fc12345u)ATTN_STORE16(Ow+(long)row*DM+ch*8,ov);} }
  asm volatile("s_waitcnt lgkmcnt(0)\n\ts_barrier":::"memory");
  #undef DMA_K
  #undef DMA_V
  #undef CMASK
  #undef XMASK
  #undef NEGM
  #undef START
  #undef RESC
  #undef ROT
}
constexpr int ATTN_LDS_BYTES=LDS_BYTES;
#undef SBAR
#undef WAIT_BAR
}
constexpr int NWAVES = 8, NTHR = 512;
constexpr int NB = 8, SEQL = 2048, DMOD = 1024, MROWS = NB * SEQL;
constexpr int LD0 = 6656, NP0 = 6912, LD1 = 7168, NP1 = 7424;
constexpr int C0_ZA = 0, C0_Q = 1024, C0_ZB = 2048, C0_XBC = 3072, C0_K = 4608, C0_V = 5632;
constexpr int C1_Q = 0, C1_U = 1536, C1_K = 2048, C1_V = 3584, C1_ZC = 5120, C1_ZD = 6656;
constexpr float RMS_EPS = 1e-6f, LOG2E = 1.4426950408889634f;
constexpr size_t MiB = 1u << 20;
constexpr int KS = 8;
constexpr size_t WS_MODP = 0;
constexpr size_t WS_SSQ = 2 * MiB;
constexpr size_t WS_KBAR = 2 * MiB + 65536;
constexpr size_t WS_DT = 3 * MiB;
constexpr size_t WS_LF = 4 * MiB;
constexpr size_t WS_F2 = 6 * MiB;
constexpr size_t WS_S5P = 7 * MiB + 512 * 1024;
constexpr int S5P_STRIDE = 8704;
constexpr size_t WS_WT1 = 8 * MiB;
constexpr size_t WS_WO1 = WS_WT1 + (size_t)NP1 * 1024 * 2;
constexpr size_t WS_WG = WS_WO1 + 4 * MiB;
constexpr size_t WS_BIG = 27 * MiB;
constexpr size_t WS_WT0 = WS_BIG + (size_t)MROWS * LD0 * 2;
constexpr size_t WS_WO0 = WS_WT0 + (size_t)NP0 * 1024 * 2;
constexpr size_t WS_LFP = 251 * MiB;
constexpr size_t WS_END = WS_WO0 + 4 * MiB;
static_assert(WS_WG + 512 * 1024 <= WS_BIG && WS_END <= 256 * MiB && WS_BIG + (size_t)MROWS * LD1 * 2 <= 256 * MiB, "ws map");
constexpr int LDS_BYTES = 147456;
constexpr size_t WS_CNT = 1835008 + 3584 * 4, WS_UB = 1835008 + 32768, WS_TS = 1835008 + 32768 + 1024;
constexpr size_t WS_BAR = 1835008;
constexpr int BARST_OFF = 132608;

typedef unsigned short bf16;
typedef unsigned v4u __attribute__((ext_vector_type(4)));
typedef unsigned v2u __attribute__((ext_vector_type(2)));
typedef float f32x4 __attribute__((ext_vector_type(4)));
typedef short bf16x8 __attribute__((ext_vector_type(8)));
typedef float f32x16 __attribute__((ext_vector_type(16)));
typedef float f32x2_c __attribute__((ext_vector_type(2))); typedef __bf16 bf16x2_c __attribute__((ext_vector_type(2)));
__device__ __forceinline__ unsigned pk2(float lo, float hi) { f32x2_c v = {lo, hi}; return __builtin_bit_cast(unsigned, __builtin_convertvector(v, bf16x2_c)); }
__device__ __forceinline__ unsigned f2bf(float f) { return pk2(f, f) & 0xffffu; }
__device__ __forceinline__ float bf2f(unsigned short h) { return __uint_as_float(((unsigned)h) << 16); }
template <int CTRL> __device__ __forceinline__ float dppf(float old, float src) { return __builtin_bit_cast(float, __builtin_amdgcn_update_dpp(__builtin_bit_cast(int, old), __builtin_bit_cast(int, src), CTRL, 0xF, 0xF, false)); }
__device__ __forceinline__ float row_sum16(float v) { v += dppf<0xB1>(v, v); v += dppf<0x4E>(v, v); v += dppf<0x141>(v, v); v += dppf<0x140>(v, v); return v; }
__device__ __forceinline__ float rdlane(float v, int l) { return __builtin_bit_cast(float, __builtin_amdgcn_readlane(__builtin_bit_cast(int, v), l)); }
__device__ __forceinline__ float wave_sum(float v) { v = row_sum16(v); return (rdlane(v, 0) + rdlane(v, 16)) + (rdlane(v, 32) + rdlane(v, 48)); }
__device__ __forceinline__ float wave_scan(float x, int lane) {
    x += dppf<0x111>(0.f, x); x += dppf<0x112>(0.f, x); x += dppf<0x114>(0.f, x); x += dppf<0x118>(0.f, x);
    const float t0 = rdlane(x, 15), t1 = rdlane(x, 31), t2 = rdlane(x, 47); const int rw = lane >> 4;
    return x + (rw == 0 ? 0.f : (rw == 1 ? t0 : (rw == 2 ? t0 + t1 : (t0 + t1) + t2)));
}
__device__ __forceinline__ float silu_f(float x) { return x * __builtin_amdgcn_rcpf(1.f + __expf(-x)); }
__device__ __forceinline__ float softplus_g(float x) { return x > 20.f ? x : log1pf(__expf(x)); }

struct Args {
    const float* in[27]; float* out; unsigned char* ws;
};
enum { I_X = 0, I_C, I_ADAW, I_ADAB, I_PREG, I_POSTG, I_EINW, I_ECONVW, I_ECONVB, I_EDTB, I_EALOG, I_EDSKIP, I_ENORMG, I_EOUTW,
       I_OINW, I_OFGB, I_OLRE, I_OLIM, I_OLDT, I_OBRE, I_OBIM, I_OCRE, I_OCIM, I_ODSKIP, I_OGLUW, I_OGLUB, I_OOUTW };

__device__ __forceinline__ int src_col0(int n) {
    if (n < 1024) return n;
    if (n < 2048) return 3600 + (n - 1024);
    if (n < 3072) return 1024 + (n - 2048);
    if (n < 4608) return 2048 + (n - 3072);
    if (n < 5632) return 4624 + (n - 4608);
    if (n < 6656) return 5648 + (n - 5632);
    if (n < 6672) return 3584 + (n - 6656);
    return -1;
}
__device__ __forceinline__ int src_col1(int n) {
    if (n < 1536) return 2048 + n;
    if (n < 2048) return 6680 + (n - 1536);
    if (n < 3584) return 3584 + (n - 2048);
    if (n < 5120) return 5120 + (n - 3584);
    if (n < 6656) return n - 5120;
    if (n < 7168) return 1536 + (n - 6656);
    if (n < 7192) return 6656 + (n - 7168);
    return -1;
}
template <int MAP> __device__ __forceinline__ void transpose_item(const float* __restrict__ W, int K, int NSRC, int NDST, bf16* WT, float* scr, int item, int lane, const float* __restrict__ kscale = nullptr) {
    const int nblk = NDST / 32, kb = item / nblk, nb = item % nblk, k0 = 64 * kb, n0 = 32 * nb;
    const int nn = n0 + (lane & 31); const int sc = MAP == 0 ? src_col0(nn) : (MAP == 1 ? src_col1(nn) : nn);
    float tv[32];
#pragma unroll
    for (int i = 0; i < 32; ++i) { const int kk = 2 * i + (lane >> 5); tv[i] = sc >= 0 ? __builtin_nontemporal_load(&W[(size_t)(k0 + kk) * NSRC + sc]) : 0.f; if (kscale && k0 + kk < 1024) tv[i] *= kscale[k0 + kk]; }
#pragma unroll
    for (int i = 0; i < 32; ++i) { const int kk = 2 * i + (lane >> 5); scr[kk * 33 + (lane & 31)] = tv[i]; }
    asm volatile("s_waitcnt lgkmcnt(0)" ::: "memory");
    const int c = lane & 7;
#pragma unroll
    for (int j = 0; j < 4; ++j) { const int n = (lane >> 3) + 8 * j; const float* s = scr + (8 * c) * 33 + n;
        v4u o; o.x = pk2(s[0 * 33], s[1 * 33]); o.y = pk2(s[2 * 33], s[3 * 33]); o.z = pk2(s[4 * 33], s[5 * 33]); o.w = pk2(s[6 * 33], s[7 * 33]);
        *(v4u*)(WT + (size_t)(n0 + n) * K + k0 + 8 * c) = o; }
    asm volatile("s_waitcnt lgkmcnt(0)" ::: "memory");
}

__device__ __forceinline__ float mod_val(const float* modp, const float* adab, int l, int b, int j) {
    float s = adab[l * 3072 + j];
#pragma unroll
    for (int kc = 0; kc < KS; ++kc) s += modp[((size_t)(kc * 2 + l) * 8 + b) * 3072 + j];
    return s;
}

__device__ __forceinline__ void p0_prologue(const Args& A, char* lds, int vcu, int G) {
    const int tid = opaque_tid(), lane = tid & 63, wave = tid >> 6;
    unsigned char* ws = A.ws;
    float* scr = (float*)(lds + wave * 16384);
    const int gw = vcu * NWAVES + wave, NGW = G * NWAVES;
    constexpr int I0 = 16 * (NP0 / 32), I1 = 16 * (NP1 / 32), IO = 32 * 32, IG = 8 * 16;
    constexpr int NITEMS = I0 + I1 + 2 * IO + IG;
    for (int it = gw; it < NITEMS; it += NGW) {
        int r = it;
        if (r < I0) { transpose_item<0>(A.in[I_EINW], 1024, 6672, NP0, (bf16*)(ws + WS_WT0), scr, r, lane); continue; } r -= I0;
        if (r < I1) { transpose_item<1>(A.in[I_OINW], 1024, 7192, NP1, (bf16*)(ws + WS_WT1), scr, r, lane); continue; } r -= I1;
        if (r < IO) { transpose_item<2>(A.in[I_EOUTW], 2048, 1024, 1024, (bf16*)(ws + WS_WO0), scr, r, lane, G == 256 ? A.in[I_ENORMG] : nullptr); continue; } r -= IO;
        if (r < IO) { transpose_item<2>(A.in[I_OOUTW], 2048, 1024, 1024, (bf16*)(ws + WS_WO1), scr, r, lane); continue; } r -= IO;
        transpose_item<2>(A.in[I_OGLUW], 512, 512, 512, (bf16*)(ws + WS_WG), scr, r, lane);
    }
    __syncthreads();
    float* sc = (float*)lds;
    float* modp = (float*)(ws + WS_MODP);
    for (int item = blockIdx.x; item < 2 * KS * 6; item += G) {
        const int l = item / (KS * 6), r = item % (KS * 6), kc = r / 6, cb = r % 6;
        __syncthreads();
        for (int i = tid; i < 1024; i += NTHR) { const int b = i >> 7, k = i & 127; const float cv = A.in[I_C][b * 1024 + kc * 128 + k]; sc[i] = silu_f(cv); }
        __syncthreads();
        const int col = cb * 512 + tid; float acc[8];
#pragma unroll
        for (int b = 0; b < 8; ++b) acc[b] = 0.f;
        const float* wp = A.in[I_ADAW] + ((size_t)l * 1024 + kc * 128) * 3072 + col;
#pragma unroll 16
        for (int k = 0; k < 128; ++k) { const float w = __builtin_nontemporal_load(&wp[(size_t)k * 3072]);
#pragma unroll
            for (int b = 0; b < 8; ++b) acc[b] += sc[b * 128 + k] * w; }
#pragma unroll
        for (int b = 0; b < 8; ++b) modp[((size_t)(kc * 2 + l) * 8 + b) * 3072 + col] = acc[b];
    }
    const int gt = blockIdx.x * NTHR + tid;
    const int gs = (G >= 128 ? ((int)blockIdx.x - (G - 32)) * 64 + tid : gt);
    if (gs >= 0 && gs < 2048 && (G < 128 || tid < 64)) {
        const int g = gs >> 6, n = gs & 63;
        const float dt = __expf(A.in[I_OLDT][g]);
        const float lr = A.in[I_OLRE][g * 64 + n], li = A.in[I_OLIM][g * 64 + n];
        const float mag = expf(lr * dt); float sn, cs; sincosf(li * dt, &sn, &cs);
        const float ar = mag * cs, ai = mag * sn, den = lr * lr + li * li;
        const float qr = ((ar - 1.f) * lr + ai * li) / den, qi = (ai * lr - (ar - 1.f) * li) / den;
        unsigned char* pg = ws + WS_S5P + (size_t)g * S5P_STRIDE;
        bf16* BbT = (bf16*)pg; bf16* Cm = (bf16*)(pg + 4096); float* ari = (float*)(pg + 8192);
        ari[n] = ar; ari[64 + n] = ai;
        for (int c = 0; c < 16; ++c) { const float br = A.in[I_OBRE][(g * 64 + n) * 16 + c], bi = A.in[I_OBIM][(g * 64 + n) * 16 + c];
            BbT[(2 * n) * 16 + c] = (bf16)f2bf(qr * br - qi * bi); BbT[(2 * n + 1) * 16 + c] = (bf16)f2bf(qr * bi + qi * br);
            Cm[c * 128 + 2 * n] = (bf16)f2bf(A.in[I_OCRE][(g * 16 + c) * 64 + n]); Cm[c * 128 + 2 * n + 1] = (bf16)f2bf(-A.in[I_OCIM][(g * 16 + c) * 64 + n]); }
    }
    float* ssq = (float*)(ws + WS_SSQ);
    for (int i = gt; i < MROWS; i += G * NTHR) ssq[i] = 0.f;
}

__device__ __forceinline__ void p1a_rows(const Args& A, char* lds, int G) {
    const int tid = opaque_tid(), lane = tid & 63, wave = tid >> 6;
    const float* modp = (const float*)(A.ws + WS_MODP); float* mv = (float*)lds;
    for (int rb = blockIdx.x; rb < MROWS / 64; rb += G) {
        const int b = rb >> 5;
        __syncthreads();
#pragma unroll 1
        for (int col = tid; col < 1024; col += NTHR) { mv[col] = A.in[I_PREG][col] * (1.f + mod_val(modp, A.in[I_ADAB], 0, b, 1024 + col)); mv[1024 + col] = mod_val(modp, A.in[I_ADAB], 0, b, col); }
        __syncthreads();
        f32x4 mul[4], add[4];
#pragma unroll
        for (int j = 0; j < 4; ++j) { mul[j] = *(const f32x4*)(mv + 4 * lane + 256 * j); add[j] = *(const f32x4*)(mv + 1024 + 4 * lane + 256 * j); }
        f32x4 nx[4];
        { const f32x4* xr = (const f32x4*)(A.in[I_X] + (size_t)(rb * 64 + wave * 8) * DMOD) + lane;
#pragma unroll
          for (int j = 0; j < 4; ++j) nx[j] = __builtin_nontemporal_load(&xr[64 * j]); }
#pragma unroll 1
        for (int r = 0; r < 8; ++r) { const int m = rb * 64 + wave * 8 + r;
            f32x4 v[4]; float s = 0.f;
#pragma unroll
            for (int j = 0; j < 4; ++j) { v[j] = nx[j]; s += (v[j].x * v[j].x + v[j].y * v[j].y) + (v[j].z * v[j].z + v[j].w * v[j].w); }
            if (r < 7) { const f32x4* xr = (const f32x4*)(A.in[I_X] + (size_t)(m + 1) * DMOD) + lane;
#pragma unroll
                for (int j = 0; j < 4; ++j) nx[j] = __builtin_nontemporal_load(&xr[64 * j]); }
            const float rstd = rsqrtf(wave_sum(s) * (1.f / DMOD) + RMS_EPS);
            unsigned long long* o8 = (unsigned long long*)((unsigned char*)A.out + (size_t)m * 4096) + lane;
#pragma unroll
            for (int j = 0; j < 4; ++j) { const f32x4 h = v[j] * rstd * mul[j] + add[j]; o8[64 * j] = (unsigned long long)pk2(h.x, h.y) | ((unsigned long long)pk2(h.z, h.w) << 32); } }
    }
}
__device__ __forceinline__ void p3b_rows(const Args& A, char* lds, int G) {
    const int tid = opaque_tid(), lane = tid & 63, wave = tid >> 6;
    const float* modp = (const float*)(A.ws + WS_MODP); float* mv = (float*)lds;
    for (int rb = blockIdx.x; rb < MROWS / 64; rb += G) {
        const int b = rb >> 5;
        __syncthreads();
#pragma unroll 1
        for (int col = tid; col < 1024; col += NTHR) { mv[col] = A.in[I_POSTG][col] * mod_val(modp, A.in[I_ADAB], 0, b, 2048 + col);
            mv[1024 + col] = A.in[I_PREG][1024 + col] * (1.f + mod_val(modp, A.in[I_ADAB], 1, b, 1024 + col)); mv[2048 + col] = mod_val(modp, A.in[I_ADAB], 1, b, col); }
        __syncthreads();
        f32x4 g0[4], mul[4], add[4];
#pragma unroll
        for (int j = 0; j < 4; ++j) { g0[j] = *(const f32x4*)(mv + 4 * lane + 256 * j); mul[j] = *(const f32x4*)(mv + 1024 + 4 * lane + 256 * j); add[j] = *(const f32x4*)(mv + 2048 + 4 * lane + 256 * j); }
        f32x4 nx[4]; v2u ny[4];
        { const int m = rb * 64 + wave * 8; const f32x4* xr = (const f32x4*)(A.in[I_X] + (size_t)m * DMOD) + lane; const v2u* yr = (const v2u*)((unsigned char*)A.out + (size_t)m * 4096) + lane;
#pragma unroll
          for (int j = 0; j < 4; ++j) { nx[j] = __builtin_nontemporal_load(&xr[64 * j]); ny[j] = yr[64 * j]; } }
#pragma unroll 1
        for (int r = 0; r < 8; ++r) { const int m = rb * 64 + wave * 8 + r;
            unsigned char* slot = (unsigned char*)A.out + (size_t)m * 4096;
            f32x4 v[4], y[4]; float sy = 0.f; v2u wy[4];
#pragma unroll
            for (int j = 0; j < 4; ++j) { v[j] = nx[j]; wy[j] = ny[j]; }
            if (r < 7) { const f32x4* xr = (const f32x4*)(A.in[I_X] + (size_t)(m + 1) * DMOD) + lane; const v2u* yr = (const v2u*)(slot + 4096) + lane;
#pragma unroll
                for (int j = 0; j < 4; ++j) { nx[j] = __builtin_nontemporal_load(&xr[64 * j]); ny[j] = yr[64 * j]; } }
#pragma unroll
            for (int j = 0; j < 4; ++j) { const v2u w = wy[j]; y[j] = (f32x4){__uint_as_float(w.x << 16), __uint_as_float(w.x & 0xffff0000u), __uint_as_float(w.y << 16), __uint_as_float(w.y & 0xffff0000u)};
                sy += (y[j].x * y[j].x + y[j].y * y[j].y) + (y[j].z * y[j].z + y[j].w * y[j].w); }
            const float ry = rsqrtf(wave_sum(sy) * (1.f / DMOD) + RMS_EPS); float s = 0.f;
#pragma unroll
            for (int j = 0; j < 4; ++j) { v[j] = v[j] + g0[j] * (y[j] * ry); s += (v[j].x * v[j].x + v[j].y * v[j].y) + (v[j].z * v[j].z + v[j].w * v[j].w); }
            const float rstd = rsqrtf(wave_sum(s) * (1.f / DMOD) + RMS_EPS);
            unsigned long long* o8 = (unsigned long long*)(slot + 2048) + lane;
#pragma unroll
            for (int j = 0; j < 4; ++j) { const f32x4 h = v[j] * rstd * mul[j] + add[j]; o8[64 * j] = (unsigned long long)pk2(h.x, h.y) | ((unsigned long long)pk2(h.z, h.w) << 32); } }
    }
}
__device__ __forceinline__ void p6b_rows(const Args& A, char* lds, int G) {
    const int tid = opaque_tid(), lane = tid & 63, wave = tid >> 6;
    const float* modp = (const float*)(A.ws + WS_MODP); float* mv = (float*)lds;
    for (int rb = blockIdx.x; rb < MROWS / 64; rb += G) {
        const int b = rb >> 5;
        __syncthreads();
#pragma unroll 1
        for (int col = tid; col < 1024; col += NTHR) { mv[col] = A.in[I_POSTG][col] * mod_val(modp, A.in[I_ADAB], 0, b, 2048 + col); mv[1024 + col] = A.in[I_POSTG][1024 + col] * mod_val(modp, A.in[I_ADAB], 1, b, 2048 + col); }
        __syncthreads();
        f32x4 g0[4], g1[4];
#pragma unroll
        for (int j = 0; j < 4; ++j) { g0[j] = *(const f32x4*)(mv + 4 * lane + 256 * j); g1[j] = *(const f32x4*)(mv + 1024 + 4 * lane + 256 * j); }
        f32x4 nx[4]; v2u n0[4], n1[4];
        { const int m = rb * 64 + wave * 8; const f32x4* xr = (const f32x4*)(A.in[I_X] + (size_t)m * DMOD) + lane; const v2u* y1r = (const v2u*)((unsigned char*)A.out + (size_t)m * 4096) + lane;
#pragma unroll
          for (int j = 0; j < 4; ++j) { nx[j] = __builtin_nontemporal_load(&xr[64 * j]); n0[j] = y1r[64 * j]; n1[j] = y1r[256 + 64 * j]; } }
#pragma unroll 1
        for (int r = 0; r < 8; ++r) { const int m = rb * 64 + wave * 8 + r;
            unsigned char* slot = (unsigned char*)A.out + (size_t)m * 4096;
            f32x4 v[4], y0[4], y1[4]; float s0 = 0.f, s1 = 0.f; v2u w0[4], w1[4];
#pragma unroll
            for (int j = 0; j < 4; ++j) { v[j] = nx[j]; w0[j] = n0[j]; w1[j] = n1[j]; }
            if (r < 7) { const f32x4* xr = (const f32x4*)(A.in[I_X] + (size_t)(m + 1) * DMOD) + lane; const v2u* y1r = (const v2u*)(slot + 4096) + lane;
#pragma unroll
                for (int j = 0; j < 4; ++j) { nx[j] = __builtin_nontemporal_load(&xr[64 * j]); n0[j] = y1r[64 * j]; n1[j] = y1r[256 + 64 * j]; } }
#pragma unroll
            for (int j = 0; j < 4; ++j) { const v2u w = w0[j], u = w1[j];
                y0[j] = (f32x4){__uint_as_float(w.x << 16), __uint_as_float(w.x & 0xffff0000u), __uint_as_float(w.y << 16), __uint_as_float(w.y & 0xffff0000u)};
                y1[j] = (f32x4){__uint_as_float(u.x << 16), __uint_as_float(u.x & 0xffff0000u), __uint_as_float(u.y << 16), __uint_as_float(u.y & 0xffff0000u)};
                s0 += (y0[j].x * y0[j].x + y0[j].y * y0[j].y) + (y0[j].z * y0[j].z + y0[j].w * y0[j].w);
                s1 += (y1[j].x * y1[j].x + y1[j].y * y1[j].y) + (y1[j].z * y1[j].z + y1[j].w * y1[j].w); }
            const float r0 = rsqrtf(wave_sum(s0) * (1.f / DMOD) + RMS_EPS), r1 = rsqrtf(wave_sum(s1) * (1.f / DMOD) + RMS_EPS);
            f32x4* orow = (f32x4*)slot + lane;
#pragma unroll
            for (int j = 0; j < 4; ++j) { const f32x4 x1 = v[j] + g0[j] * (y0[j] * r0); v[j] = x1 + g1[j] * (y1[j] * r1); }
            asm volatile("" ::: "memory");
#pragma unroll
            for (int j = 0; j < 4; ++j) orow[64 * j] = v[j]; }
    }
}
#define BAR_ALL() asm volatile("s_waitcnt vmcnt(0) lgkmcnt(0)\n\ts_barrier" ::: "memory")
#define BAR_LDS() asm volatile("s_waitcnt lgkmcnt(0)\n\ts_barrier" ::: "memory")
typedef float f32x4m __attribute__((ext_vector_type(4)));
__device__ __forceinline__ void p2a_kbar(const Args& A, char* lds, int G) {
    const int tid = opaque_tid(); const bf16* P0 = (const bf16*)(A.ws + WS_BIG); float* kbar = (float*)(A.ws + WS_KBAR); float* red = (float*)lds;
    for (int item = blockIdx.x; item < NB * 16 * 8; item += G) {
        const int b = item >> 7, h = (item >> 3) & 15, n = item & 7; const int c8 = tid & 7, rg = tid >> 3;
        float acc[8];
#pragma unroll
        for (int e = 0; e < 8; ++e) acc[e] = 0.f;
#pragma unroll
        for (int i = 0; i < 4; ++i) { const bf16x8 kv = *(const bf16x8*)(P0 + (size_t)(b * SEQL + n * 256 + rg + 64 * i) * LD0 + C0_K + h * 64 + c8 * 8);
#pragma unroll
            for (int e = 0; e < 8; ++e) acc[e] += bf2f((unsigned short)kv[e]); }
        __syncthreads();
#pragma unroll
        for (int e = 0; e < 8; ++e) red[rg * 65 + c8 * 8 + e] = acc[e];
        __syncthreads();
        if (tid < 64) { float s = 0.f; for (int r = 0; r < 64; ++r) s += red[r * 65 + tid]; kbar[(size_t)item * 64 + tid] = s * (1.f / 256.f); }
    }
    __syncthreads();
}
__device__ __forceinline__ void p2a_conv(const Args& A, int G) {
    const int tid = opaque_tid(); const bf16* __restrict__ P0 = (const bf16*)(A.ws + WS_BIG); bf16* __restrict__ XC = (bf16*)A.out;
    if (tid >= 384) return;
    const int chg = tid % 192, half = tid / 192, ch = chg * 8;
    float w[4][8], bs[8];
#pragma unroll
    for (int k = 0; k < 4; ++k) { const f32x4 a = *(const f32x4*)(A.in[I_ECONVW] + k * 1536 + ch), b2 = *(const f32x4*)(A.in[I_ECONVW] + k * 1536 + ch + 4);
#pragma unroll
        for (int e = 0; e < 4; ++e) { w[k][e] = a[e]; w[k][4 + e] = b2[e]; } }
    { const f32x4 a = *(const f32x4*)(A.in[I_ECONVB] + ch), b2 = *(const f32x4*)(A.in[I_ECONVB] + ch + 4);
#pragma unroll
      for (int e = 0; e < 4; ++e) { bs[e] = a[e]; bs[4 + e] = b2[e]; } }
    for (int rb = blockIdx.x; rb < MROWS / 64; rb += G) {
        const int m0 = rb * 64 + half * 32; const int tb = m0 & (SEQL - 1);
        bf16x8 r0 = {}, r1 = {}, r2 = {};
        if (tb > 0) { r0 = *(const bf16x8*)(P0 + (size_t)(m0 - 3) * LD0 + C0_XBC + ch); r1 = *(const bf16x8*)(P0 + (size_t)(m0 - 2) * LD0 + C0_XBC + ch); r2 = *(const bf16x8*)(P0 + (size_t)(m0 - 1) * LD0 + C0_XBC + ch); }
#pragma unroll 1
        for (int i0 = 0; i0 < 32; i0 += 8) { bf16x8 rr[8];
#pragma unroll
        for (int i = 0; i < 8; ++i) rr[i] = *(const bf16x8*)(P0 + (size_t)(m0 + i0 + i) * LD0 + C0_XBC + ch);
#pragma unroll
        for (int ii = 0; ii < 8; ++ii) { const int i = i0 + ii; const bf16x8 r3 = rr[ii]; float o[8];
#pragma unroll
            for (int e = 0; e < 8; ++e) { const float a = bs[e] + w[0][e] * bf2f((unsigned short)r0[e]) + w[1][e] * bf2f((unsigned short)r1[e]) + w[2][e] * bf2f((unsigned short)r2[e]) + w[3][e] * bf2f((unsigned short)r3[e]); o[e] = silu_f(a); }
            v4u pw; pw.x = pk2(o[0], o[1]); pw.y = pk2(o[2], o[3]); pw.z = pk2(o[4], o[5]); pw.w = pk2(o[6], o[7]);
            *(v4u*)(XC + (size_t)(m0 + i) * 2048 + ch) = pw; r0 = r1; r1 = r2; r2 = r3; } }
    }
}
constexpr int S_CS = 0, S_BS = 17408, S_BST = 34816, S_XT = 53248, S_XWT = 57856, S_XS = 62464, S_GG = 67584, S_SBF = 76800, S_DTA = 85504;
constexpr int F_CS = 0, F_BS = 17408, F_BST = 34816, F_XT = 53248, F_XWT = 62464, F_XS = 71680, F_GG = 80896, F_SBF = 90112, F_DTA = 107520;
template <bool DRY> __device__ __forceinline__ void ssd_unit(const Args& A, char* lds, int b, int h) {
    const int tid = opaque_tid(), lane = tid & 63, wave = __builtin_amdgcn_readfirstlane(tid >> 6); const int fr = lane & 15, fq = lane >> 4;
    bf16* P0 = (bf16*)(A.ws + WS_BIG); const bf16* XC = (const bf16*)A.out; const float* DT = (const float*)(A.ws + WS_DT);
    const int g = h >> 3; const int xcol = h * 64, bcol = 1024 + g * 128, ccol = 1280 + g * 128;
    bf16* CS = (bf16*)(lds + F_CS); bf16* BS = (bf16*)(lds + F_BS); bf16* BST = (bf16*)(lds + F_BST); bf16* XT = (bf16*)(lds + F_XT); bf16* XWT = (bf16*)(lds + F_XWT);
    bf16* XS = (bf16*)(lds + F_XS); bf16* GG = (bf16*)(lds + F_GG); bf16* SBF = (bf16*)(lds + F_SBF); float* DTA0 = (float*)(lds + F_DTA);
    for (int i = tid; i < 64 * 136; i += NTHR) SBF[i] = 0;
    const float Ah = -__expf(A.in[I_EALOG][h]), Dh = A.in[I_EDSKIP][h];
    const int lt = wave >> 1, pt0 = 2 * (wave & 1), st0 = 2 * (wave & 1), nt0 = (wave >> 1) * 2;
    f32x4m sta[2][2];
#pragma unroll
    for (int pi = 0; pi < 2; ++pi)
#pragma unroll
        for (int ni = 0; ni < 2; ++ni) sta[pi][ni] = (f32x4m){0.f, 0.f, 0.f, 0.f};
    const size_t rb0 = (size_t)b * SEQL;
    const bf16* pB = XC + (rb0 + (tid >> 4)) * 2048 + bcol + (tid & 15) * 8; const bf16* pC = XC + (rb0 + (tid >> 4)) * 2048 + ccol + (tid & 15) * 8; const bf16* pX = XC + (rb0 + (tid >> 3)) * 2048 + xcol + (tid & 7) * 8;
    const bf16* pZ = P0 + (rb0 + lt * 16 + 4 * fq) * LD0 + C0_ZA + h * 64 + pt0 * 16 + fr;
    bf16x8 pre[5]; float dtn = 0.f;
    pre[0] = *(const bf16x8*)pB; pre[1] = *(const bf16x8*)(pB + 32 * 2048); pre[2] = *(const bf16x8*)pC; pre[3] = *(const bf16x8*)(pC + 32 * 2048); pre[4] = *(const bf16x8*)pX;
    unsigned short zn[2][4], gts[2][4]; float sqs[2][4];
#pragma unroll
    for (int pi = 0; pi < 2; ++pi)
#pragma unroll
        for (int r = 0; r < 4; ++r) { zn[pi][r] = pZ[(size_t)r * LD0 + 16 * pi]; gts[pi][r] = 0; sqs[pi][r] = 0.f; }
    if (wave == 0) { dtn = DT[(rb0 + lane) * 16 + h]; const float s = wave_scan(Ah * dtn, lane); const float tot = rdlane(s, 63);
        DTA0[lane] = dtn; DTA0[64 + lane] = s; DTA0[128 + lane] = __expf(s); DTA0[192 + lane] = __expf(tot - s); dtn = DT[(rb0 + 64 + lane) * 16 + h]; }
    BAR_LDS();
    for (int c = 0; c < SEQL / 64; ++c) {
        const size_t m0 = rb0 + c * 64; float* DTA = DTA0 + (c & 1) * 256;
        { const int t = tid >> 4, c8 = tid & 15;
          *(bf16x8*)(BS + t * 136 + c8 * 8) = pre[0]; *(bf16x8*)(BS + (t + 32) * 136 + c8 * 8) = pre[1]; *(bf16x8*)(CS + t * 136 + c8 * 8) = pre[2]; *(bf16x8*)(CS + (t + 32) * 136 + c8 * 8) = pre[3];
          const int sw0 = ((((t >> 3) ^ (c8 & 7)) << 3) + (t & 7)), sw1 = (((((t + 32) >> 3) ^ (c8 & 7)) << 3) + (t & 7));
#pragma unroll
          for (int e = 0; e < 8; ++e) { BST[(c8 * 8 + e) * 72 + sw0] = (bf16)pre[0][e]; BST[(c8 * 8 + e) * 72 + sw1] = (bf16)pre[1][e]; }
          const int tx = tid >> 3, cx = tid & 7; *(bf16x8*)(XS + tx * 72 + cx * 8) = pre[4]; const float dtv = DTA[tx], wv = DTA[192 + tx]; const int sx = ((((tx >> 3) ^ cx) << 3) + (tx & 7));
#pragma unroll
          for (int e = 0; e < 8; ++e) { const float xd = bf2f((unsigned short)pre[4][e]) * dtv; XT[(cx * 8 + e) * 72 + sx] = (bf16)f2bf(xd); XWT[(cx * 8 + e) * 72 + sx] = (bf16)f2bf(xd * wv); } }
        if (c > 0) {
#pragma unroll
            for (int pi = 0; pi < 2; ++pi)
#pragma unroll
                for (int r = 0; r < 4; ++r) { const int l = lt * 16 + 4 * fq + r;
                    if (!DRY || sqs[pi][r] == 1.2345e30f) { ((bf16*)pZ)[((size_t)(c - 1) * 64 + r) * LD0 + 16 * pi] = gts[pi][r];
                        if (fr == 0) ((float*)((unsigned char*)A.out + (m0 - 64 + l) * 4096 + 3072))[h * 4 + pt0 + pi] = sqs[pi][r]; } } }
        if (c + 1 < SEQL / 64) { const size_t o = (size_t)(c + 1) * 64 * 2048;
            pre[0] = *(const bf16x8*)(pB + o); pre[1] = *(const bf16x8*)(pB + o + 32 * 2048); pre[2] = *(const bf16x8*)(pC + o); pre[3] = *(const bf16x8*)(pC + o + 32 * 2048); pre[4] = *(const bf16x8*)(pX + o); }
        unsigned short zv[2][4];
#pragma unroll
        for (int pi = 0; pi < 2; ++pi)
#pragma unroll
            for (int r = 0; r < 4; ++r) zv[pi][r] = zn[pi][r];
        if (c + 1 < SEQL / 64) {
#pragma unroll
            for (int pi = 0; pi < 2; ++pi)
#pragma unroll
                for (int r = 0; r < 4; ++r) zn[pi][r] = pZ[((size_t)(c + 1) * 64 + r) * LD0 + 16 * pi]; }
        BAR_LDS();
        f32x4m cb[2], ya[2]; cb[0] = (f32x4m){0.f, 0.f, 0.f, 0.f}; cb[1] = cb[0]; ya[0] = cb[0]; ya[1] = cb[0];
#pragma unroll
        for (int ks = 0; ks < 4; ++ks) { const bf16x8 af = *(const bf16x8*)(CS + (lt * 16 + fr) * 136 + ks * 32 + 8 * fq);
#pragma unroll
            for (int si = 0; si < 2; ++si) { const bf16x8 bfv = *(const bf16x8*)(BS + ((st0 + si) * 16 + fr) * 136 + ks * 32 + 8 * fq); cb[si] = __builtin_amdgcn_mfma_f32_16x16x32_bf16(af, bfv, cb[si], 0, 0, 0); }
#pragma unroll
            for (int pi = 0; pi < 2; ++pi) { const bf16x8 sf = *(const bf16x8*)(SBF + ((pt0 + pi) * 16 + fr) * 136 + ks * 32 + 8 * fq); ya[pi] = __builtin_amdgcn_mfma_f32_16x16x32_bf16(af, sf, ya[pi], 0, 0, 0); } }
#pragma unroll
        for (int r = 0; r < 4; ++r) { const int l = lt * 16 + 4 * fq + r; const float al = DTA[64 + l];
#pragma unroll
            for (int si = 0; si < 2; ++si) { const int s = (st0 + si) * 16 + fr; const float v = (s <= l) ? cb[si][r] * __expf(al - DTA[64 + s]) : 0.f; GG[l * 72 + s] = (bf16)f2bf(v); }
            const float ea = DTA[128 + l]; ya[0][r] *= ea; ya[1][r] *= ea; }
        const float decay = __expf(DTA[64 + 63]);
        BAR_LDS();
#pragma unroll
        for (int ks = 0; ks < 2; ++ks) { const bf16x8 gf = *(const bf16x8*)(GG + (lt * 16 + fr) * 72 + ks * 32 + 8 * fq);
#pragma unroll
            for (int pi = 0; pi < 2; ++pi) { const int p = (pt0 + pi) * 16 + fr; const bf16x8 xf = *(const bf16x8*)(XT + p * 72 + (((ks * 4 + fq) ^ ((p >> 3) & 7)) << 3)); ya[pi] = __builtin_amdgcn_mfma_f32_16x16x32_bf16(gf, xf, ya[pi], 0, 0, 0); } }
#pragma unroll
        for (int pi = 0; pi < 2; ++pi)
#pragma unroll
            for (int ni = 0; ni < 2; ++ni) sta[pi][ni] = sta[pi][ni] * decay;
#pragma unroll
        for (int ks = 0; ks < 2; ++ks) { bf16x8 bt[2];
#pragma unroll
            for (int ni = 0; ni < 2; ++ni) { const int n = (nt0 + ni) * 16 + fr; bt[ni] = *(const bf16x8*)(BST + n * 72 + (((ks * 4 + fq) ^ ((n >> 3) & 7)) << 3)); }
#pragma unroll
            for (int pi = 0; pi < 2; ++pi) { const int p = (pt0 + pi) * 16 + fr; const bf16x8 xw = *(const bf16x8*)(XWT + p * 72 + (((ks * 4 + fq) ^ ((p >> 3) & 7)) << 3));
#pragma unroll
                for (int ni = 0; ni < 2; ++ni) sta[pi][ni] = __builtin_amdgcn_mfma_f32_16x16x32_bf16(xw, bt[ni], sta[pi][ni], 0, 0, 0); } }
#pragma unroll
        for (int pi = 0; pi < 2; ++pi)
#pragma unroll
            for (int ni = 0; ni < 2; ++ni)
#pragma unroll
                for (int r = 0; r < 4; ++r) SBF[((pt0 + pi) * 16 + 4 * fq + r) * 136 + (nt0 + ni) * 16 + fr] = (bf16)f2bf(sta[pi][ni][r]);
#pragma unroll
        for (int pi = 0; pi < 2; ++pi)
#pragma unroll
            for (int r = 0; r < 4; ++r) { const int l = lt * 16 + 4 * fq + r, p = (pt0 + pi) * 16 + fr;
                const float y = ya[pi][r] + Dh * bf2f(XS[l * 72 + p]);
                const float z = bf2f(zv[pi][r]); const float gt = y * silu_f(z);
                gts[pi][r] = (unsigned short)f2bf(gt); sqs[pi][r] = row_sum16(gt * gt); }
        if (wave == 0 && c + 1 < SEQL / 64) { float* DN = DTA0 + ((c + 1) & 1) * 256; const float s = wave_scan(Ah * dtn, lane); const float tot = rdlane(s, 63);
            DN[lane] = dtn; DN[64 + lane] = s; DN[128 + lane] = __expf(s); DN[192 + lane] = __expf(tot - s);
            if (c + 2 < SEQL / 64) dtn = DT[(m0 + 128 + lane) * 16 + h]; }
        BAR_LDS();
    }
#pragma unroll
    for (int pi = 0; pi < 2; ++pi)
#pragma unroll
        for (int r = 0; r < 4; ++r) { const int l = lt * 16 + 4 * fq + r;
            if (!DRY || sqs[pi][r] == 1.2345e30f) { ((bf16*)pZ)[((size_t)(SEQL / 64 - 1) * 64 + r) * LD0 + 16 * pi] = gts[pi][r];
                if (fr == 0) ((float*)((unsigned char*)A.out + (rb0 + SEQL - 64 + l) * 4096 + 3072))[h * 4 + pt0 + pi] = sqs[pi][r]; } }
}
__device__ __forceinline__ void p2c_fixup(const Args& A, int vcu, int G) {
    const int tid = opaque_tid(), lane = tid & 63, wave = tid >> 6; bf16* P0 = (bf16*)(A.ws + WS_BIG); const float* ssq = (const float*)(A.ws + WS_SSQ);
    f32x4 gn[4];
#pragma unroll
    for (int j = 0; j < 4; ++j) gn[j] = *((const f32x4*)A.in[I_ENORMG] + lane + 64 * j);
    for (int m = vcu * NWAVES + wave; m < MROWS; m += G * NWAVES) { const float r = rsqrtf(wave_sum(((const float*)((const unsigned char*)A.out + (size_t)m * 4096 + 3072))[lane]) * (1.f / 1024.f) + RMS_EPS);
        v2u* p = (v2u*)(P0 + (size_t)m * LD0 + C0_ZA) + lane;
#pragma unroll
        for (int j = 0; j < 4; ++j) { const v2u w = p[64 * j]; v2u o; o.x = pk2(__uint_as_float(w.x << 16) * r * gn[j].x, __uint_as_float(w.x & 0xffff0000u) * r * gn[j].y);
            o.y = pk2(__uint_as_float(w.y << 16) * r * gn[j].z, __uint_as_float(w.y & 0xffff0000u) * r * gn[j].w); p[64 * j] = o; } }
}
__device__ __forceinline__ void p5a_fcum(const Args& A, char* lds, int G) {
    const int tid = opaque_tid(), lane = tid & 63, wave = tid >> 6; const float* LF = (const float*)(A.ws + WS_LF); float* F2 = (float*)(A.ws + WS_F2); float* wtot = (float*)(lds + 120 * 1024);
    for (int item = blockIdx.x; item < NB * 24; item += G) { const int b = item / 24, h = item % 24; const float fb = A.in[I_OFGB][h];
        float v[4]; float run = 0.f;
#pragma unroll
        for (int i = 0; i < 4; ++i) { const size_t ix = ((size_t)b * SEQL + 4 * tid + i) * 24 + h; const float* L1p = (const float*)(A.ws + WS_LFP);
            const float fr_ = (LF[ix] + L1p[ix]) + (L1p[ix + (size_t)MROWS * 24] + L1p[ix + (size_t)2 * MROWS * 24]) + fb; run += -softplus_g(-fr_); v[i] = run; }
        float s = run;
#pragma unroll
        for (int o = 1; o < 64; o <<= 1) { const float x = __shfl_up(s, o); if (lane >= o) s += x; }
        __syncthreads();
        if (lane == 63) wtot[wave] = s;
        __syncthreads();
        float off = s - run; for (int w = 0; w < wave; ++w) off += wtot[w];
#pragma unroll
        for (int i = 0; i < 4; ++i) { const float f2v = (off + v[i]) * LOG2E; const int t = 4 * tid + i; F2[(size_t)item * SEQL + t] = f2v;
            if ((t & 127) == 127) wtot[64 + (t >> 7)] = f2v; if ((t & 255) == 0) wtot[96 + (t >> 8)] = f2v; }
        { const bf16* P1 = (const bf16*)(A.ws + WS_BIG); float qm = 0.f, km = 0.f;
#pragma unroll 8
          for (int i = 0; i < 32; ++i) { const size_t m = (size_t)b * SEQL + (tid >> 3) + 64 * i; const int c8 = tid & 7; float qs = 0.f, ks2 = 0.f;
              const bf16x8 qv = *(const bf16x8*)(P1 + m * LD1 + C1_Q + h * 64 + c8 * 8), kv = *(const bf16x8*)(P1 + m * LD1 + C1_K + h * 64 + c8 * 8);
#pragma unroll
              for (int e = 0; e < 8; ++e) { const float qf = bf2f((unsigned short)qv[e]), kf = bf2f((unsigned short)kv[e]); qs += qf * qf; ks2 += kf * kf; }
              qs += dppf<0xB1>(qs, qs); qs += dppf<0x4E>(qs, qs); qs += dppf<0x141>(qs, qs); ks2 += dppf<0xB1>(ks2, ks2); ks2 += dppf<0x4E>(ks2, ks2); ks2 += dppf<0x141>(ks2, ks2);
              qm = fmaxf(qm, qs); km = fmaxf(km, ks2); }
#pragma unroll
          for (int o = 1; o < 64; o <<= 1) { qm = fmaxf(qm, __shfl_xor(qm, o)); km = fmaxf(km, __shfl_xor(km, o)); }
          __syncthreads();
          if (lane == 0) { wtot[16 + wave] = qm; wtot[32 + wave] = km; }
          __syncthreads();
          if (tid < 8) { float a = 0.f, c = 0.f; for (int w = 0; w < 8; ++w) { a = fmaxf(a, wtot[16 + w]); c = fmaxf(c, wtot[32 + w]); } const float u2 = 2.f * sqrtf(a) * sqrtf(c) * 1.01f;
              const int qb = tid; const float fi0 = wtot[96 + qb]; int ts = 0; while (ts + 2 <= 4 * qb && u2 - (wtot[64 + (ts >> 1)] - fi0) <= -40.f) ts += 2;
              ((int*)(A.ws + WS_TS))[item * 8 + qb] = ts; } }
    }
    __syncthreads();
}
constexpr int S5_BU = 0  , S5_SS = 67584  , S5_US = 102400  ;
__device__ __forceinline__ float gelu_tanh(float x) { const float u = 0.7978845608028654f * (x + 0.044715f * x * x * x); const float e = __expf(2.f * u); const float t = 1.f - 2.f * __builtin_amdgcn_rcpf(e + 1.f); return 0.5f * x * (1.f + t); }
__device__ __forceinline__ void s5_unit(const Args& A, char* lds, int b, int g) {
    const int tid = opaque_tid(), lane = tid & 63, wave = __builtin_amdgcn_readfirstlane(tid >> 6); const int fr = lane & 15, fq = lane >> 4, r32 = lane & 31, hi = lane >> 5;
    const bf16* P1 = (const bf16*)(A.ws + WS_BIG); bf16* YD = (bf16*)A.out;
    const unsigned char* pg = A.ws + WS_S5P + (size_t)g * S5P_STRIDE; const bf16* BbT = (const bf16*)pg; const bf16* Cm = (const bf16*)(pg + 4096); const float* ari = (const float*)(pg + 8192);
    const int ttile = wave >> 2, ntile = wave & 3;
    const bf16x8 bfrag = *(const bf16x8*)(BbT + (ntile * 32 + r32) * 16 + 8 * hi);
    bf16x8 cfrag[4];
#pragma unroll
    for (int ks = 0; ks < 4; ++ks) cfrag[ks] = *(const bf16x8*)(Cm + fr * 128 + ks * 32 + 8 * fq);
    const float ar = ari[lane], ai = ari[64 + lane]; float sr = 0.f, si = 0.f;
    const float dskip = A.in[I_ODSKIP][g * 16 + fr];
    const size_t rb0 = (size_t)b * SEQL; const bf16* pU = P1 + (rb0 + ttile * 32 + r32) * LD1 + C1_U + g * 16 + 8 * hi;
    bf16x8 un = *(const bf16x8*)pU;
    BAR_LDS();
    for (int i = 0; i < SEQL / 64 + 2; ++i) {
        if (i < SEQL / 64) { float* BU = (float*)(lds + S5_BU) + (i & 1) * (64 * 132); f32x16 acc = {};
            acc = __builtin_amdgcn_mfma_f32_32x32x16_bf16(un, bfrag, acc, 0, 0, 0);
            if (ntile == 0) *(bf16x8*)((bf16*)(lds + S5_US) + ((i & 3) * 64 + ttile * 32 + r32) * 16 + 8 * hi) = un;
            if (i + 1 < SEQL / 64) un = *(const bf16x8*)(pU + (size_t)(i + 1) * 64 * LD1);
#pragma unroll
            for (int r = 0; r < 16; ++r) { const int t = ttile * 32 + (r & 3) + 8 * (r >> 2) + 4 * hi; BU[t * 132 + ntile * 32 + r32] = acc[r]; } }
        if (wave == 0 && i >= 1 && i <= SEQL / 64) { const float* BU = (const float*)(lds + S5_BU) + ((i - 1) & 1) * (64 * 132); bf16* SS = (bf16*)(lds + S5_SS) + ((i - 1) & 1) * (64 * 136);
#pragma unroll
            for (int hb = 0; hb < 2; ++hb) { f32x2_c bv[32];
#pragma unroll
                for (int t = 0; t < 32; ++t) bv[t] = *(const f32x2_c*)(BU + (hb * 32 + t) * 132 + 2 * lane);
                const f32x2_c a1 = {ar, ar}, a2 = {-ai, ai}; f32x2_c s2 = {sr, si};
#pragma unroll
                for (int t = 0; t < 32; ++t) { const f32x2_c sw = {s2.y, s2.x}; s2 = a1 * s2 + (a2 * sw + bv[t]);
                    *(unsigned*)(SS + (hb * 32 + t) * 136 + 2 * lane) = pk2(s2.x, s2.y); }
                sr = s2.x; si = s2.y; } }
        if (wave >= 4 && i >= 2) { const bf16* SS = (const bf16*)(lds + S5_SS) + ((i - 2) & 1) * (64 * 136); const int mt = wave - 4; const size_t m0 = rb0 + (size_t)(i - 2) * 64;
            unsigned short uv[4];
#pragma unroll
            for (int r = 0; r < 4; ++r) uv[r] = ((const bf16*)(lds + S5_US))[(((i - 2) & 3) * 64 + mt * 16 + 4 * fq + r) * 16 + fr];
            f32x4m acc = (f32x4m){0.f, 0.f, 0.f, 0.f};
#pragma unroll
            for (int ks = 0; ks < 4; ++ks) { const bf16x8 af = *(const bf16x8*)(SS + (mt * 16 + fr) * 136 + ks * 32 + 8 * fq); acc = __builtin_amdgcn_mfma_f32_16x16x32_bf16(af, cfrag[ks], acc, 0, 0, 0); }
#pragma unroll
            for (int r = 0; r < 4; ++r) { const size_t m = m0 + mt * 16 + 4 * fq + r; YD[m * 2048 + 1024 + g * 16 + fr] = (bf16)f2bf(gelu_tanh(acc[r] + dskip * bf2f(uv[r]))); } }
        BAR_LDS();
    }
}
template <bool DRY> __device__ __forceinline__ void moba_phase(const Args& A, char* lds, int vcu, int G) {
    const bf16* P0 = (const bf16*)(A.ws + WS_BIG); const float* kbar = (const float*)(A.ws + WS_KBAR);
    unsigned* cnt = (unsigned*)(A.ws + WS_CNT) + (DRY ? 192 : 128); volatile unsigned* lw = (volatile unsigned*)(lds + BARST_OFF + 16);
    const int tid = opaque_tid();
    if (tid == 0) lw[0] = atomicAdd(cnt, 1u);
    BAR_ALL();
    int u = __builtin_amdgcn_readfirstlane((int)lw[0]);
    while (u < NB * 16 * 8) {
        unsigned nxt = 0u; if (tid == 0) nxt = atomicAdd(cnt, 1u);
        const int qb = 7 - u / 128, bh = u % 128, b = bh >> 4, h = bh & 15;
        attn_body::attn_unit<8, 0, LD0, DRY>(b, h, qb, (const attn_body::bf16*)(P0 + C0_Q), (const attn_body::bf16*)(P0 + C0_K), (const attn_body::bf16*)(P0 + C0_V), (attn_body::bf16*)(P0 + C0_Q),
                                            (const attn_body::bf16*)(P0 + C0_ZB), kbar + (size_t)bh * 512, nullptr, lw, nxt, lds);
        BAR_LDS();
        u = __builtin_amdgcn_readfirstlane((int)lw[0]);
    }
}
template <bool DRY> __device__ __forceinline__ void fox_phase(const Args& A, char* lds, int vcu, int G) {
    const bf16* P1 = (const bf16*)(A.ws + WS_BIG); const float* F2 = (const float*)(A.ws + WS_F2); const int* TSv = (const int*)(A.ws + WS_TS);
    unsigned* cnt = (unsigned*)(A.ws + WS_CNT) + (DRY ? 64 : 0); volatile unsigned* lw = (volatile unsigned*)(lds + BARST_OFF + 16);
    const int tid = opaque_tid();
    if (tid == 0) lw[0] = atomicAdd(cnt, 1u);
    BAR_ALL();
    int u = __builtin_amdgcn_readfirstlane((int)lw[0]);
    while (u < NB * 24 * 8) {
        unsigned nxt = 0u; if (tid == 0) nxt = atomicAdd(cnt, 1u);
        const int qb = 7 - u / 192, bh = u % 192, b = bh / 24, h = bh % 24;
        attn_body::attn_unit<8, 1, LD1, DRY>(b, h, qb, (const attn_body::bf16*)(P1 + C1_Q), (const attn_body::bf16*)(P1 + C1_K), (const attn_body::bf16*)(P1 + C1_V), (attn_body::bf16*)(P1 + C1_Q),
                                            (const attn_body::bf16*)(P1 + C1_ZC), F2 + (size_t)bh * SEQL, TSv + bh * 8, lw, nxt, lds);
        BAR_LDS();
        u = __builtin_amdgcn_readfirstlane((int)lw[0]);
    }
}
#define LAS __attribute__((address_space(3)))
#define XB_TMO      128
#define XB_XCNT(j)  (256  + 64 * (j))
#define XB_XSUB(j)  (1280 + 64 * (j))
#define XB_XGEN(j)  (2304 + 64 * (j))
#define XB_TOP      3328
#define XB_TOPGEN   3392
#define XCD_BAR_WORDS 3456
#define XB_SPIN_CAP (1u << 18)

__device__ __forceinline__ unsigned xb_ld(unsigned* p)              { return __hip_atomic_load(p, __ATOMIC_RELAXED, __HIP_MEMORY_SCOPE_AGENT); }
__device__ __forceinline__ unsigned xb_add(unsigned* p, unsigned v) { return __hip_atomic_fetch_add(p, v, __ATOMIC_RELAXED, __HIP_MEMORY_SCOPE_AGENT); }
__device__ __forceinline__ unsigned xb_xcc_id() { return (unsigned)__builtin_amdgcn_s_getreg((3 << 11) | 20) & 0xFu; }
#define XB_SPIN(cond, bar) do { unsigned _sp = 0; while (cond) { __builtin_amdgcn_s_sleep(1); \
    if ((++_sp & 255u) == 0u) { if (xb_ld(&(bar)[XB_TMO])) break; if (_sp > XB_SPIN_CAP) { atomicAdd(&(bar)[XB_TMO], 1u); break; } } } } while (0)

struct XcdBarrier {
    unsigned* bar; unsigned x;
    volatile LAS unsigned* st;
};

__device__ __forceinline__ XcdBarrier xcd_barrier_post(unsigned* bar, volatile LAS unsigned* st) {
    XcdBarrier b; b.bar = bar; b.x = xb_xcc_id(); b.st = st;
    if (threadIdx.x == 0) (void)xb_add(&bar[XB_XCNT(b.x)], 1u);
    return b;
}
__device__ __forceinline__ void xcd_barrier_complete(unsigned* bar, unsigned x, unsigned& nloc, unsigned& nx) {
    const unsigned G = gridDim.x * gridDim.y * gridDim.z;
    unsigned sum, cnt, mine, sp = 0u;
    for (;;) {
        sum = 0u; cnt = 0u; mine = 0u;
#pragma unroll
        for (unsigned j = 0; j < 16; ++j) { const unsigned c = xb_ld(&bar[XB_XCNT(j)]); sum += c; cnt += (c > 0u) ? 1u : 0u; mine = (j == x) ? c : mine; }
        if (sum == G) break;
        __builtin_amdgcn_s_sleep(1);
        if ((++sp & 255u) == 0u) { if (xb_ld(&bar[XB_TMO])) break; if (sp > XB_SPIN_CAP) { atomicAdd(&bar[XB_TMO], 1u); break; } }
    }
    nloc = mine > 0u ? mine : 1u; nx = cnt > 0u ? cnt : 1u;
}

__device__ __forceinline__ void xcd_barrier(const XcdBarrier& b) {
    asm volatile("s_waitcnt vmcnt(0)" ::: "memory");
    __syncthreads();
    if (threadIdx.x == 0) {
        unsigned* bar = b.bar;
        __builtin_amdgcn_s_waitcnt(0);
        unsigned nloc = b.st[0], nx = b.st[1];
        if (nloc == 0u) { xcd_barrier_complete(bar, b.x, nloc, nx); b.st[0] = nloc; b.st[1] = nx; }
        const unsigned old = xb_add(&bar[XB_XSUB(b.x)], 1u);
        const unsigned gen = old / nloc;
        if (old + 1u == (gen + 1u) * nloc) {
            __builtin_amdgcn_fence(__ATOMIC_RELEASE, "agent");
            asm volatile("s_waitcnt vmcnt(0)" ::: "memory");
            const unsigned og = xb_add(&bar[XB_TOP], 1u);
            const unsigned tg = og / nx;
            if (og + 1u == (tg + 1u) * nx) xb_add(&bar[XB_TOPGEN], 1u);
            else XB_SPIN(xb_ld(&bar[XB_TOPGEN]) == tg, bar);
            __builtin_amdgcn_fence(__ATOMIC_ACQUIRE, "agent");
            xb_add(&bar[XB_XGEN(b.x)], 1u);
            asm volatile("s_waitcnt vmcnt(0)" ::: "memory");
        } else {
            XB_SPIN(xb_ld(&bar[XB_XGEN(b.x)]) == gen, bar);
            __builtin_amdgcn_fence(__ATOMIC_ACQUIRE, "agent");
            asm volatile("s_waitcnt vmcnt(0)" ::: "memory");
        }
    }
    __syncthreads();
}

constexpr int ARGS_OFF = 132096;
__device__ __forceinline__ Args get_args(const unsigned char* lds) {
    Args a; const unsigned long long* p = (const unsigned long long*)(lds + ARGS_OFF);
#pragma unroll
    for (int i = 0; i < 29; ++i) { const unsigned long long v = p[i]; const unsigned lo = __builtin_amdgcn_readfirstlane((unsigned)v), hi = __builtin_amdgcn_readfirstlane((unsigned)(v >> 32));
        const unsigned long long w = ((unsigned long long)hi << 32) | lo; if (i < 27) a.in[i] = (const float*)w; else if (i == 27) a.out = (float*)w; else a.ws = (unsigned char*)w; }
    return a;
}
#define PHASE_BEGIN { const Args args = get_args(lds); unsigned char* ws = args.ws; bf16* XN = (bf16*)args.out; bf16* PB = (bf16*)(ws + WS_BIG); (void)ws; (void)XN; (void)PB;
#ifdef DUP_SYNC
#define PHASE_END } xcd_barrier(xbar); xcd_barrier(xbar);
#else
#define PHASE_END } xcd_barrier(xbar);
#endif
#define PHASE_END_NOSYNC }
__global__ void __launch_bounds__(NTHR, 2) trunk_fwd(Args kargs_unused) {
    extern __shared__ __attribute__((aligned(16))) unsigned char lds[];
    cg::grid_group grid = cg::this_grid();
    const int G = gridDim.x, bx = blockIdx.x; const int vcu = (G % 8 == 0) ? (bx % 8) * (G / 8) + bx / 8 : bx;
    char* ldsc = (char*)lds; PG8_LAS unsigned char* ldsg = (PG8_LAS unsigned char*)lds;
    { const int t = opaque_tid(); if (t < 29) { const unsigned long long* ka = (const unsigned long long*)__builtin_amdgcn_kernarg_segment_ptr(); ((unsigned long long*)(lds + ARGS_OFF))[t] = ka[t]; }
      if (t < 2) ((unsigned*)(lds + BARST_OFF))[t] = 0u; }
    __syncthreads();
    XcdBarrier xbar;
    {
    const Args args = get_args(lds);
    unsigned* rdy = (unsigned*)(args.ws + WS_BAR) + 4160;
    if (bx == 0) { unsigned* bw = (unsigned*)(args.ws + WS_BAR); for (int i = opaque_tid(); i < 4096; i += NTHR) bw[i] = 0u;
        asm volatile("s_waitcnt vmcnt(0)" ::: "memory"); __syncthreads();
        if (opaque_tid() == 0) { __builtin_amdgcn_fence(__ATOMIC_RELEASE, "agent"); asm volatile("s_waitcnt vmcnt(0)" ::: "memory"); __hip_atomic_store(rdy, 0x600DF00Du, __ATOMIC_RELAXED, __HIP_MEMORY_SCOPE_AGENT); } }
    if (G > 0x40000000) grid.sync();
    p0_prologue(args, ldsc, vcu, G);
    if (opaque_tid() == 0) { unsigned sp = 0; while (__hip_atomic_load(rdy, __ATOMIC_RELAXED, __HIP_MEMORY_SCOPE_AGENT) != 0x600DF00Du && ++sp < (1u << 22)) __builtin_amdgcn_s_sleep(2);
        __builtin_amdgcn_fence(__ATOMIC_ACQUIRE, "agent"); asm volatile("s_waitcnt vmcnt(0)" ::: "memory"); }
    __syncthreads();
    xbar = xcd_barrier_post((unsigned*)(args.ws + WS_BAR), (volatile LAS unsigned*)(lds + BARST_OFF));
    xcd_barrier(xbar);
    if (bx == 0 && opaque_tid() == 0) __hip_atomic_store(rdy, 0u, __ATOMIC_RELAXED, __HIP_MEMORY_SCOPE_AGENT);
    }
    PHASE_BEGIN
    p1a_rows(args, ldsc, G);
#ifdef DUP_MISC
    p1a_rows(args, ldsc, G);
#endif
    PHASE_END
    PHASE_BEGIN
    { pg8::Gemm g{XN, (const bf16*)(ws + WS_WT0), MROWS, NP0, 1024, 2048, 1024, 0}; pg8::StaticOrder S; S.init(MROWS, NP0, G, bx);
      pg8::EpiX<0> E{PB, LD0, args.in[I_EDTB], (float*)(ws + WS_DT), nullptr, nullptr, attn_body::C2};
      pg8::gemm_phase<pg8::EpiX<0>, pg8::StaticOrder, true, true>(ldsg, g, S, E); }
#ifdef DUP_GEMM
    { pg8::Gemm g{XN, (const bf16*)(ws + WS_WT0), MROWS, NP0, 1024, 2048, 1024, 0}; pg8::StaticOrder S; S.init(MROWS, NP0, G, bx);
      pg8::EpiX<0> E{PB, LD0, args.in[I_EDTB], (float*)(ws + WS_DT), nullptr, nullptr, attn_body::C2};
      pg8::gemm_phase<pg8::EpiX<0>, pg8::StaticOrder, true, true>(ldsg, g, S, E); }
#endif
    PHASE_END
    PHASE_BEGIN
    p2a_kbar(args, ldsc, G);
    p2a_conv(args, G);
#ifdef DUP_MISC
    p2a_kbar(args, ldsc, G);
    p2a_conv(args, G);
#endif
    PHASE_END
    PHASE_BEGIN
#ifdef DUP_SSD
    for (int v = vcu; v < 128; v += G) ssd_unit<true>(args, ldsc, v >> 4, v & 15);
#endif
    for (int v = vcu; v < 128; v += G) ssd_unit<false>(args, ldsc, v >> 4, v & 15);
    PHASE_END_NOSYNC
    PHASE_BEGIN
#ifdef DUP_MOBA
    moba_phase<true>(args, ldsc, vcu, G);
#endif
    moba_phase<false>(args, ldsc, vcu, G);
    PHASE_END
    if (G != 256) {
    PHASE_BEGIN
    p2c_fixup(args, vcu, G);
    PHASE_END
    }
    PHASE_BEGIN
    { pg8::Gemm g{PB, (const bf16*)(ws + WS_WO0), MROWS, 1024, 2048, LD0, 2048, 0}; pg8::StaticOrder S; S.init(MROWS, 1024, G, bx);
      { pg8::Unit u0; u0.pm = 0; u0.pn = 0; const bool have = S.next(0, u0); const int pm0 = u0.pm; float* rs = (float*)(lds + 131072); const int t = opaque_tid();
        if (t < 256) { float r = 1.f;
            if (G == 256 && have) { const f32x4* pp = (const f32x4*)((const unsigned char*)args.out + (size_t)(pm0 * 256 + t) * 4096 + 3072); float sm = 0.f;
#pragma unroll
                for (int i = 0; i < 16; ++i) { const f32x4 v = pp[i]; sm += (v.x + v.y) + (v.z + v.w); }
                r = rsqrtf(sm * (1.f / 1024.f) + RMS_EPS); }
            rs[t] = r; }
        __syncthreads(); }
      pg8::EpiX<5> E{XN, 2048, nullptr, nullptr, nullptr, nullptr, 1.f};
      pg8::gemm_phase<pg8::EpiX<5>, pg8::StaticOrder, true, true>(ldsg, g, S, E); }
    PHASE_END
    PHASE_BEGIN
    p3b_rows(args, ldsc, G);
#ifdef DUP_MISC
    p3b_rows(args, ldsc, G);
#endif
    PHASE_END
    PHASE_BEGIN
    { pg8::Gemm g{XN + 1024, (const bf16*)(ws + WS_WT1), MROWS, LD1, 1024, 2048, 1024, 0}; pg8::StaticOrder S; S.init(MROWS, LD1, G, bx);
      pg8::EpiX<1> E{PB, LD1, nullptr, nullptr, nullptr, nullptr, attn_body::C2};
      pg8::gemm_phase<pg8::EpiX<1>, pg8::StaticOrder, true, true>(ldsg, g, S, E); }
    { pg8::Gemm g{XN + 1024, (const bf16*)(ws + WS_WT1) + (size_t)LD1 * 1024, MROWS, 1024, 256, 2048, 1024, 1}; pg8::StaticOrder S; S.init(MROWS, 1024, G, bx);
      pg8::EpiX<4> E{nullptr, 0, nullptr, (float*)(ws + WS_LF), (const bf16*)(ws + WS_LFP), nullptr, 1.f};
      pg8::gemm_phase<pg8::EpiX<4>, pg8::StaticOrder, true, true>(ldsg, g, S, E); }
#ifdef DUP_GEMM
    { pg8::Gemm g{XN + 1024, (const bf16*)(ws + WS_WT1), MROWS, LD1, 1024, 2048, 1024, 0}; pg8::StaticOrder S; S.init(MROWS, LD1, G, bx);
      pg8::EpiX<1> E{PB, LD1, nullptr, nullptr, nullptr, nullptr, attn_body::C2};
      pg8::gemm_phase<pg8::EpiX<1>, pg8::StaticOrder, true, true>(ldsg, g, S, E); }
#endif
    PHASE_END
    PHASE_BEGIN
    p5a_fcum(args, ldsc, G);
#ifdef DUP_S5
    p5a_fcum(args, ldsc, G);
#endif
    for (int v = vcu; v < 256; v += G) s5_unit(args, ldsc, v >> 5, v & 31);
#ifdef DUP_S5
    for (int v = vcu; v < 256; v += G) s5_unit(args, ldsc, v >> 5, v & 31);
#endif
    PHASE_END
    PHASE_BEGIN
#ifdef DUP_FOX
    fox_phase<true>(args, ldsc, vcu, G);
#endif
    if (vcu < 128) { pg8::Gemm g{XN + 1024, (const bf16*)(ws + WS_WG), MROWS, 512, 512, 2048, 512, 0}; pg8::StaticOrder S; S.init(MROWS, 512, 128, vcu);
      pg8::EpiX<3> E{PB + C1_U, LD1, args.in[I_OGLUB], nullptr, XN + 1024, PB + C1_ZD, 1.f};
      pg8::gemm_phase<pg8::EpiX<3>, pg8::StaticOrder, true, true>(ldsg, g, S, E); }
    fox_phase<false>(args, ldsc, vcu, G);
    PHASE_END
    PHASE_BEGIN
    { pg8::Gemm g{PB, (const bf16*)(ws + WS_WO1), MROWS, 1024, 2048, LD1, 2048, 0}; pg8::StaticOrder S; S.init(MROWS, 1024, G, bx);
      pg8::EpiX<2> E{XN + 1024, 2048, nullptr, nullptr, nullptr, nullptr, 1.f};
      pg8::gemm_phase<pg8::EpiX<2>, pg8::StaticOrder, true, true>(ldsg, g, S, E); }
#ifdef DUP_GEMM
    { pg8::Gemm g{PB, (const bf16*)(ws + WS_WO1), MROWS, 1024, 2048, LD1, 2048, 0}; pg8::StaticOrder S; S.init(MROWS, 1024, G, bx);
      pg8::EpiX<2> E{XN + 1024, 2048, nullptr, nullptr, nullptr, nullptr, 1.f};
      pg8::gemm_phase<pg8::EpiX<2>, pg8::StaticOrder, true, true>(ldsg, g, S, E); }
#endif
    PHASE_END
    PHASE_BEGIN
    p6b_rows(args, ldsc, G);
    PHASE_END_NOSYNC
}

extern "C" void kernel_launch(void* const* d_in, const int* in_sizes, int n_in, void* d_out, int out_size, void* d_ws, size_t ws_size, hipStream_t stream) {
    static int grid = 0;
    if (grid == 0) {
        if (n_in != 27 || out_size != MROWS * DMOD || ws_size < (size_t)256 * MiB) { fprintf(stderr, "kernel_launch: unexpected shapes n_in %d out %d ws %zu\n", n_in, out_size, ws_size); grid = -1; return; }
        int dev = 0, cus = 0, per_cu = 0;
        (void)hipGetDevice(&dev); (void)hipDeviceGetAttribute(&cus, hipDeviceAttributeMultiprocessorCount, dev);
        if (hipFuncSetAttribute((const void*)trunk_fwd, hipFuncAttributeMaxDynamicSharedMemorySize, LDS_BYTES) != hipSuccess) { fprintf(stderr, "kernel_launch: hipFuncSetAttribute failed\n"); }
        if (hipOccupancyMaxActiveBlocksPerMultiprocessor(&per_cu, (const void*)trunk_fwd, NTHR, LDS_BYTES) != hipSuccess || per_cu < 1) { fprintf(stderr, "kernel_launch: occupancy query says %d\n", per_cu); per_cu = 1; }
        (void)hipGetLastError();
        grid = cus * per_cu; if (grid > 256) grid = 256; if (grid < 1) grid = 256;
    }
    if (grid < 0) return;
    Args a{};
    for (int i = 0; i < 27; ++i) a.in[i] = (const float*)d_in[i];
    a.out = (float*)d_out; a.ws = (unsigned char*)d_ws;
    void* kargs[] = {&a};
    hipError_t e = hipLaunchCooperativeKernel((const void*)trunk_fwd, dim3(grid), dim3(NTHR), kargs, LDS_BYTES, stream);
    if (e != hipSuccess) fprintf(stderr, "cooperative launch failed: %s (grid %d)\n", hipGetErrorString(e), grid);
}
```

```cpp
#include <hip/hip_runtime.h>
#include <hip/hip_cooperative_groups.h>
#include <cstdio>
#include <cstdint>
namespace cg = cooperative_groups;
__device__ __forceinline__ int opaque_tid() { int t = threadIdx.x; asm volatile("" : "+v"(t)); return t; }
namespace pg8 {
#define PG8_LAS __attribute__((address_space(3)))
typedef unsigned short bf16_t;
typedef short bf16x8 __attribute__((ext_vector_type(8)));
typedef float f32x4 __attribute__((ext_vector_type(4)));
typedef unsigned u32x4 __attribute__((ext_vector_type(4)));
constexpr int BM = 256, BK = 64, HALF = 128, HTB = HALF * BK * 2  , STAGE_BYTES = 8 * HTB, NXCD = 8, WGM = 8;

__host__ __device__ __forceinline__ int lds_byte(int r, int c) { const int st = (r >> 4) * 2 + (c >> 5), rr = r & 15, cc = c & 31, ob = rr * 64 + cc * 2; return st * 1024 + (ob ^ (((ob >> 9) & 1) << 5)); }
__host__ __device__ __forceinline__ void stage_rc(int b, int& R, int& C) { const int st = b / 1024, sb = b % 1024, swz = sb ^ (((sb >> 9) & 1) << 5); R = (st >> 1) * 16 + swz / 64; C = (st & 1) * 32 + (swz % 64) / 2; }
__host__ __device__ __forceinline__ int perm32(int rho) { const int n = rho >> 4, i = rho & 15; return 8 * (i >> 2) + 4 * n + (i & 3); }

struct Unit { int pm, pn; };
struct Gemm { const bf16_t* A; const bf16_t* Bt; int M, N, K, lda, ldb, ksplit; };

struct StaticOrder {
    int nM, nN, nwg, G, c;
    __host__ __device__ __forceinline__ void init(int M, int N, int G_, int c_) { nM = M / BM; nN = N / BM; nwg = nM * nN; G = G_; c = c_; }
    __host__ __device__ __forceinline__ bool next(int i, Unit& u) const {
        const long L = (long)i * G + c; if (L >= nwg) return false;
        int wgid = (int)L; { const int q = nwg / NXCD, r = nwg % NXCD, xcd = wgid % NXCD, off = wgid / NXCD; wgid = (xcd < r ? xcd * (q + 1) : r * (q + 1) + (xcd - r) * q) + off; }
        const int nig = WGM * nN, gid = wgid / nig, fm = gid * WGM, gsz = (nM - fm) < WGM ? (nM - fm) : WGM;
        u.pm = fm + ((wgid % nig) % gsz); u.pn = (wgid % nig) / gsz; return true;
    }
    __device__ __forceinline__ void a_ready(const Unit&) const {}
    __device__ __forceinline__ void done(const Unit&) const {}
};

__device__ __forceinline__ unsigned cvt_pk_bf16(float lo, float hi) { unsigned r; asm volatile("v_cvt_pk_bf16_f32 %0, %1, %2" : "=v"(r) : "v"(lo), "v"(hi)); return r; }
__device__ __forceinline__ float bflo(unsigned w) { return __uint_as_float(w << 16); }
__device__ __forceinline__ float bfhi(unsigned w) { return __uint_as_float(w & 0xffff0000u); }
__device__ __forceinline__ float softplus_f(float x) { return x > 15.f ? x : __logf(1.f + __expf(x)); }
__device__ __forceinline__ float sigmoid_f(float x) { return __builtin_amdgcn_rcpf(1.f + __expf(-x)); }
constexpr int MROWS_ = 16384;
template <int MODE> struct EpiX {
    static constexpr bool PERM = true, AFTER_DRAIN = false; static constexpr int MIDT = (MODE == 5) ? 16 : -1;
    bf16_t* O; int ldc; const float* bias; float* F32O; const bf16_t* Y; const bf16_t* Zp; float qscale;
    __device__ __forceinline__ void mid(f32x4 (&acc)[2][2][4][2], int wr, int fr, PG8_LAS unsigned char* lds) const {
        const PG8_LAS float* rs = (const PG8_LAS float*)(lds + 131072);
#pragma unroll
        for (int ai = 0; ai < 2; ++ai)
#pragma unroll
            for (int m = 0; m < 4; ++m) { const float r = rs[ai * HALF + wr * 64 + m * 16 + fr];
#pragma unroll
                for (int bj = 0; bj < 2; ++bj)
#pragma unroll
                    for (int n = 0; n < 2; ++n) acc[ai][bj][m][n] = acc[ai][bj][m][n] * r; }
    }
    __device__ __forceinline__ void operator()(const f32x4 (&acc)[2][2][4][2], const Unit& u, int wr, int wc, int fr, int fq) const {
        const int row0 = u.pm * BM + wr * 64 + fr; const int col0 = u.pn * BM + wc * 32 + 8 * fq;
        float sc = 1.f;
        if (MODE == 0) { if (u.pn >= 4 && u.pn < 8) sc = qscale; }
        if (MODE == 1) { if (u.pn < 6) sc = qscale; }
        const bool special = (MODE == 0 && u.pn == 26);
#pragma unroll
        for (int ai = 0; ai < 2; ++ai)
#pragma unroll
            for (int m = 0; m < 4; ++m) { const int row = row0 + ai * HALF + m * 16;
#pragma unroll
                for (int bj = 0; bj < 2; ++bj) { f32x4 v0 = acc[ai][bj][m][0], v1 = acc[ai][bj][m][1]; const int col = col0 + bj * HALF;
                    if (MODE == 0 || MODE == 1) {
                        if (!special) { v0 = v0 * sc; v1 = v1 * sc; u32x4 w; w.x = cvt_pk_bf16(v0[0], v0[1]); w.y = cvt_pk_bf16(v0[2], v0[3]); w.z = cvt_pk_bf16(v1[0], v1[1]); w.w = cvt_pk_bf16(v1[2], v1[3]);
                            *(u32x4*)(O + (size_t)row * ldc + col) = w; }
                        else { const int lc = col - u.pn * BM; const int NV = (MODE == 0) ? 16 : 24;
                            if (lc < NV) { f32x4 o0, o1;
#pragma unroll
                                for (int i = 0; i < 4; ++i) { const float a0 = v0[i] + bias[lc + i], a1 = v1[i] + bias[lc + 4 + i];
                                    if (MODE == 0) { o0[i] = softplus_f(a0); o1[i] = softplus_f(a1); } else { o0[i] = -softplus_f(-a0); o1[i] = -softplus_f(-a1); } }
                                *(f32x4*)(F32O + (size_t)row * NV + lc) = o0; *(f32x4*)(F32O + (size_t)row * NV + lc + 4) = o1; } }
                    } else if (MODE == 4) {
                        const int lc = col - u.pn * BM;
                        if (lc < 24) { float* dst = (u.pn == 0 ? F32O : (float*)((unsigned char*)Y + (size_t)(u.pn - 1) * (MROWS_ * 24 * 4))) + (size_t)row * 24 + lc; *(f32x4*)dst = v0; *(f32x4*)(dst + 4) = v1; }
                    } else if (MODE == 2 || MODE == 5) {
                        u32x4 w; w.x = cvt_pk_bf16(v0[0], v0[1]); w.y = cvt_pk_bf16(v0[2], v0[3]); w.z = cvt_pk_bf16(v1[0], v1[1]); w.w = cvt_pk_bf16(v1[2], v1[3]);
                        *(u32x4*)(O + (size_t)row * ldc + col) = w;
                    } else {
                        const u32x4 yv = *(const u32x4*)(Y + (size_t)row * 2048 + col); const u32x4 zv = *(const u32x4*)(Zp + (size_t)row * ldc + col);
                        const f32x4 b0 = *(const f32x4*)(bias + col), b1 = *(const f32x4*)(bias + col + 4);
                        float r[8];
#pragma unroll
                        for (int e = 0; e < 4; ++e) { const float y0 = bflo(yv[e]), y1 = bfhi(yv[e]), z0 = bflo(zv[e]), z1 = bfhi(zv[e]);
                            const float a0 = (e < 2 ? v0[2 * e] : v1[2 * e - 4]) + (e < 2 ? b0[2 * e] : b1[2 * e - 4]);
                            const float a1 = (e < 2 ? v0[2 * e + 1] : v1[2 * e - 3]) + (e < 2 ? b0[2 * e + 1] : b1[2 * e - 3]);
                            r[2 * e] = y0 * sigmoid_f(a0) * z0 * sigmoid_f(z0); r[2 * e + 1] = y1 * sigmoid_f(a1) * z1 * sigmoid_f(z1); }
                        u32x4 w; w.x = cvt_pk_bf16(r[0], r[1]); w.y = cvt_pk_bf16(r[2], r[3]); w.z = cvt_pk_bf16(r[4], r[5]); w.w = cvt_pk_bf16(r[6], r[7]);
                        *(u32x4*)(O + (size_t)row * ldc + col) = w;
                    } } }
    }
};
template <class Epi, class Sched, bool ALIGN_EPI = false, bool SP2 = false>
__device__ __forceinline__ void gemm_phase(PG8_LAS unsigned char* lds, const Gemm g, const Sched& S, const Epi& E) {
    const int tid = opaque_tid(), wid = __builtin_amdgcn_readfirstlane(tid >> 6), lane = tid & 63, wr = wid >> 2, wc = wid & 3, fr = lane & 15, fq = lane >> 4;
    const int K = g.K, nt = K / BK;
    unsigned voffA[2], voffB[2];
#pragma unroll
    for (int i = 0; i < 2; ++i) { int R, C; stage_rc(tid * 16 + i * 8192, R, C); const int Rb = Epi::PERM ? ((R & ~31) + perm32(R & 31)) : R;
        voffA[i] = (unsigned)(R * g.lda + C) * 2u; voffB[i] = (unsigned)(Rb * g.ldb + C) * 2u; }
    const size_t kstep = (size_t)(BK * 2);
    const size_t hstepA = (size_t)HALF * g.lda * 2, hstepB = (size_t)HALF * g.ldb * 2;
    const size_t tstepA = 2 * hstepA, tstepB = g.ksplit ? (size_t)K * 2 : 2 * hstepB, kslA = g.ksplit ? (size_t)K * 2 : 0;
    const unsigned ldsw = (unsigned)wid * 1024u;
    const int aoff = lds_byte(wr * 64 + fr, fq * 8), boff = lds_byte(wc * 32 + fr, fq * 8);
#define PG8_SA(b, h) (((b) * 2 + (h)) * HTB)
#define PG8_SB(b, h) ((4 + (b) * 2 + (h)) * HTB)
#define PG8_STAGE(bufoff, gbase, voff) do { _Pragma("unroll") for (int _i = 0; _i < 2; ++_i) \
        __builtin_amdgcn_global_load_lds((const unsigned*)((const char*)(gbase) + (voff)[_i]), (PG8_LAS unsigned*)(lds + (bufoff) + ldsw + _i * 8192), 16, 0, 0); } while (0)
#define PG8_LDA(dst, b, h) do { _Pragma("unroll") for (int m = 0; m < 4; ++m) _Pragma("unroll") for (int k = 0; k < 2; ++k) dst[m][k] = *(const PG8_LAS bf16x8*)(lds + PG8_SA(b, h) + aoff + m * 2048 + k * 1024); } while (0)
#define PG8_LDB(dst, b, h) do { _Pragma("unroll") for (int n = 0; n < 2; ++n) _Pragma("unroll") for (int k = 0; k < 2; ++k) dst[n][k] = *(const PG8_LAS bf16x8*)(lds + PG8_SB(b, h) + boff + n * 2048 + k * 1024); } while (0)
#define PG8_MMA(ai, bj, At, Bt) do { __builtin_amdgcn_s_setprio(1); _Pragma("unroll") for (int m = 0; m < 4; ++m) _Pragma("unroll") for (int n = 0; n < 2; ++n) _Pragma("unroll") for (int k = 0; k < 2; ++k) \
        acc[ai][bj][m][n] = __builtin_amdgcn_mfma_f32_16x16x32_bf16(Bt[n][k], At[m][k], acc[ai][bj][m][n], 0, 0, 0); __builtin_amdgcn_s_setprio(0); } while (0)
#define PG8_WAIT_V(n) asm volatile("s_waitcnt vmcnt(" #n ")" ::: "memory")
#define PG8_WAIT_L(n) asm volatile("s_waitcnt lgkmcnt(" #n ")" ::: "memory")
#define PG8_BAR __builtin_amdgcn_s_barrier()
#define PG8_SCHED __builtin_amdgcn_sched_barrier(0)
    Unit cur, nxt; int ui = 0;
    if (!S.next(0, cur)) return;
    f32x4 acc[2][2][4][2];
#pragma unroll
    for (int a = 0; a < 2; ++a)
#pragma unroll
        for (int b = 0; b < 2; ++b)
#pragma unroll
            for (int m = 0; m < 4; ++m)
#pragma unroll
                for (int n = 0; n < 2; ++n) acc[a][b][m][n] = (f32x4){0.f, 0.f, 0.f, 0.f};
    bf16x8 At[4][2], B0[2][2], B1[2][2];
    const char* cA = (const char*)g.A + (size_t)cur.pm * tstepA + (size_t)cur.pn * kslA; const char* cB = (const char*)g.Bt + (size_t)cur.pn * tstepB;
    S.a_ready(cur);
    if constexpr (SP2) {
        PG8_STAGE(PG8_SB(0, 0), cB, voffB); PG8_STAGE(PG8_SB(0, 1), cB + hstepB, voffB); PG8_STAGE(PG8_SA(0, 0), cA, voffA); PG8_STAGE(PG8_SA(0, 1), cA + hstepA, voffA);
        if (wr == 1) PG8_BAR;
        PG8_WAIT_V(2); PG8_BAR;
        PG8_STAGE(PG8_SB(1, 0), cB + kstep, voffB); PG8_STAGE(PG8_SA(1, 0), cA + kstep, voffA); PG8_STAGE(PG8_SB(1, 1), cB + hstepB + kstep, voffB);
        PG8_WAIT_V(6); PG8_BAR;
    } else {
        PG8_STAGE(PG8_SB(0, 0), cB, voffB); PG8_STAGE(PG8_SA(0, 0), cA, voffA); PG8_STAGE(PG8_SB(0, 1), cB + hstepB, voffB); PG8_STAGE(PG8_SA(0, 1), cA + hstepA, voffA);
        if (wr == 1) PG8_BAR;
        PG8_WAIT_V(4); PG8_BAR;
        PG8_STAGE(PG8_SB(1, 0), cB + kstep, voffB); PG8_STAGE(PG8_SA(1, 0), cA + kstep, voffA); PG8_STAGE(PG8_SB(1, 1), cB + hstepB + kstep, voffB);
        PG8_WAIT_V(6); PG8_BAR;
    }
    for (;;) {
        const bool has_next = S.next(ui + 1, nxt);
        const char* nA = has_next ? (const char*)g.A + (size_t)nxt.pm * tstepA + (size_t)nxt.pn * kslA : cA; const char* nB = has_next ? (const char*)g.Bt + (size_t)nxt.pn * tstepB : cB;
        for (int t = 0; t < nt; t += 2) {
            if constexpr (Epi::MIDT >= 0) { if (t == Epi::MIDT) E.mid(acc, wr, fr, lds); }
            const bool last = (t == nt - 2);
            const char* a1 = cA + (size_t)(t + 1) * kstep;
            const char* a2 = last ? nA : cA + (size_t)(t + 2) * kstep; const char* b2 = last ? nB : cB + (size_t)(t + 2) * kstep;
            const char* a3 = a2 + kstep; const char* b3 = b2 + kstep;
            if (last && has_next) S.a_ready(nxt);
            if constexpr (SP2) {
            PG8_LDB(B0, 0, 0); PG8_LDB(B1, 0, 1); PG8_SCHED; PG8_LDA(At, 0, 0); PG8_STAGE(PG8_SA(1, 1), a1 + hstepA, voffA);
            PG8_WAIT_V(8); PG8_WAIT_L(0); PG8_BAR; PG8_MMA(0, 0, At, B0); PG8_MMA(0, 1, At, B1); PG8_BAR; PG8_SCHED;
            PG8_LDA(At, 0, 1); PG8_STAGE(PG8_SB(0, 0), b2, voffB); PG8_STAGE(PG8_SB(0, 1), b2 + hstepB, voffB); PG8_STAGE(PG8_SA(0, 0), a2, voffA);
            PG8_WAIT_V(8); PG8_WAIT_L(0); PG8_BAR; PG8_MMA(1, 0, At, B0); PG8_MMA(1, 1, At, B1); PG8_BAR; PG8_SCHED;
            PG8_LDB(B0, 1, 0); PG8_LDB(B1, 1, 1); PG8_SCHED; PG8_LDA(At, 1, 0); PG8_STAGE(PG8_SA(0, 1), a2 + hstepA, voffA);
            PG8_WAIT_V(8); PG8_WAIT_L(0); PG8_BAR; PG8_MMA(0, 0, At, B0); PG8_MMA(0, 1, At, B1); PG8_BAR; PG8_SCHED;
            PG8_LDA(At, 1, 1); PG8_STAGE(PG8_SB(1, 0), b3, voffB); PG8_STAGE(PG8_SB(1, 1), b3 + hstepB, voffB); PG8_STAGE(PG8_SA(1, 0), a3, voffA);
            PG8_WAIT_V(8); PG8_WAIT_L(0); PG8_BAR; PG8_MMA(1, 0, At, B0); PG8_MMA(1, 1, At, B1); PG8_BAR; PG8_SCHED;
            } else {
            PG8_LDB(B0, 0, 0); PG8_SCHED; PG8_LDA(At, 0, 0); PG8_STAGE(PG8_SA(1, 1), a1 + hstepA, voffA);
            PG8_WAIT_L(8); PG8_BAR; PG8_WAIT_L(0); PG8_MMA(0, 0, At, B0); PG8_BAR; PG8_SCHED;
            PG8_LDB(B1, 0, 1); PG8_STAGE(PG8_SB(0, 0), b2, voffB);
            PG8_BAR; PG8_WAIT_L(0); PG8_MMA(0, 1, At, B1); PG8_BAR;
            PG8_LDA(At, 0, 1); PG8_STAGE(PG8_SA(0, 0), a2, voffA);
            PG8_BAR; PG8_WAIT_L(0); PG8_MMA(1, 0, At, B0); PG8_BAR; PG8_SCHED;
            PG8_STAGE(PG8_SB(0, 1), b2 + hstepB, voffB);
            PG8_WAIT_V(6); PG8_BAR; PG8_MMA(1, 1, At, B1); PG8_BAR;
            PG8_LDB(B0, 1, 0); PG8_SCHED; PG8_LDA(At, 1, 0); PG8_STAGE(PG8_SA(0, 1), a2 + hstepA, voffA);
            PG8_WAIT_L(8); PG8_BAR; PG8_WAIT_L(0); PG8_MMA(0, 0, At, B0); PG8_BAR; PG8_SCHED;
            PG8_LDB(B1, 1, 1); PG8_STAGE(PG8_SB(1, 0), b3, voffB);
            PG8_BAR; PG8_WAIT_L(0); PG8_MMA(0, 1, At, B1); PG8_BAR;
            PG8_LDA(At, 1, 1); PG8_STAGE(PG8_SA(1, 0), a3, voffA);
            PG8_BAR; PG8_WAIT_L(0); PG8_MMA(1, 0, At, B0); PG8_BAR; PG8_SCHED;
            PG8_STAGE(PG8_SB(1, 1), b3 + hstepB, voffB);
            PG8_WAIT_V(6); PG8_BAR; PG8_MMA(1, 1, At, B1); PG8_BAR;
            }
        }
        if constexpr (ALIGN_EPI) { if (wr == 0) PG8_BAR; }
        if constexpr (!Epi::AFTER_DRAIN) { E(acc, cur, wr, wc, fr, fq); S.done(cur); }
        if (!has_next) break;
#pragma unroll
        for (int a = 0; a < 2; ++a)
#pragma unroll
            for (int b = 0; b < 2; ++b)
#pragma unroll
                for (int m = 0; m < 4; ++m)
#pragma unroll
                    for (int n = 0; n < 2; ++n) acc[a][b][m][n] = (f32x4){0.f, 0.f, 0.f, 0.f};
        cur = nxt; cA = nA; cB = nB; ++ui;
        if constexpr (ALIGN_EPI) { if (wr == 1) PG8_BAR; }
    }
    PG8_WAIT_V(0);
    if constexpr (!ALIGN_EPI) { if (wr == 0) PG8_BAR; }
    PG8_BAR;
    if constexpr (Epi::AFTER_DRAIN) { E.fused(acc, cur, wr, wc, fr, fq, lds, wid, lane); S.done(cur); }
#undef PG8_SA
#undef PG8_SB
#undef PG8_STAGE
#undef PG8_LDA
#undef PG8_LDB
#undef PG8_MMA
#undef PG8_WAIT_V
#undef PG8_WAIT_L
#undef PG8_BAR
#undef PG8_SCHED
}
}

#include <hip/hip_bf16.h>
#include <cmath>
namespace attn_body {
using bf16=__hip_bfloat16;
using bf16x8=__attribute__((ext_vector_type(8)))short;
using s16x4=__attribute__((ext_vector_type(4)))short;
using f32x16=__attribute__((ext_vector_type(16)))float;
using u32x4=__attribute__((ext_vector_type(4)))unsigned;
constexpr int SEQ=2048,D=64;
constexpr int NW=8,QBLK=32,QB=QBLK*NW,KVBLK=64,NQB=SEQ/QB;
constexpr int ATTN_UNIT_ROWS=QB;
__device__ __forceinline__ int crow(int r,int hi){return (r&3)+8*(r>>2)+4*hi;}
#define SBAR() __builtin_amdgcn_sched_barrier(0)
__device__ __forceinline__ void cmask(f32x16&p0,f32x16&p1,int jb,int qrel,int hi){
  const float NEG=-INFINITY; int kb=64*jb+4*hi;
  #pragma unroll
  for(int r=0;r<16;++r){int kv=kb+(r&3)+8*(r>>2); if(kv>qrel)p0[r]=NEG; if(kv+32>qrel)p1[r]=NEG;}
}

constexpr int NSLOT=3, SLOTB=8192;
constexpr int LDS_K=0, LDS_V=NSLOT*SLOTB, LDS_WS=2*NSLOT*SLOTB, LDS_OST=LDS_WS+NW*64*4, LDS_BYTES=LDS_OST+NW*4096;
constexpr int XOFF=86016; constexpr float SENT=-30000.f; using f32x4=__attribute__((ext_vector_type(4)))float;
constexpr float C2=0.125f*1.4426950408889634f;
__device__ __forceinline__ void glds16(const void*gsrc,unsigned lds_dst){unsigned keep;
  asm volatile("s_mov_b32 %0, m0\n\ts_mov_b32 m0, %2\n\ts_nop 0\n\tglobal_load_lds_dwordx4 %1, off\n\ts_mov_b32 m0, %0":"=&s"(keep):"v"(gsrc),"s"(lds_dst):"memory");}
__device__ __forceinline__ float max3f(float a,float b,float c){float r;asm("v_max3_f32 %0, %1, %2, %3":"=v"(r):"v"(a),"v"(b),"v"(c));return r;}
__device__ __forceinline__ float max2f(float a,float b){float r;asm("v_max_f32_e32 %0, %1, %2":"=v"(r):"v"(a),"v"(b));return r;}
__device__ __forceinline__ float fadd_s(float a,float b){float r;asm("v_add_f32_e32 %0, %1, %2":"=v"(r):"v"(a),"v"(b));return r;}
__device__ __forceinline__ float fsub_s(float a,float b){float r;asm("v_sub_f32_e32 %0, %1, %2":"=v"(r):"v"(a),"v"(b));return r;}
typedef float f32x2_t __attribute__((ext_vector_type(2))); typedef __bf16 bf16x2_t __attribute__((ext_vector_type(2)));
__device__ __forceinline__ unsigned cvtpk_s(float lo,float hi){f32x2_t v={lo,hi};bf16x2_t b=__builtin_convertvector(v,bf16x2_t);return __builtin_bit_cast(unsigned,b);}
#define WAIT_BAR(N) asm volatile("s_waitcnt vmcnt(" #N ") lgkmcnt(0)\n\ts_barrier":::"memory")

__device__ __forceinline__ void qkt(f32x16&p0,f32x16&p1,const char*Kslot,const bf16x8*qr,const f32x16&negm,int r32,int hi){
  const char*kb=Kslot+hi*1024+r32*16;
  #pragma unroll
  for(int d0=0;d0<4;++d0){
    const bf16x8 b0=*reinterpret_cast<const bf16x8*>(kb+d0*2048);
    const bf16x8 b1=*reinterpret_cast<const bf16x8*>(kb+d0*2048+512);
    if(d0==0){p0=__builtin_amdgcn_mfma_f32_32x32x16_bf16(b0,qr[0],negm,0,0,0);p1=__builtin_amdgcn_mfma_f32_32x32x16_bf16(b1,qr[0],negm,0,0,0);}
    else{p0=__builtin_amdgcn_mfma_f32_32x32x16_bf16(b0,qr[d0],p0,0,0,0);p1=__builtin_amdgcn_mfma_f32_32x32x16_bf16(b1,qr[d0],p1,0,0,0);}}
}
typedef __attribute__((address_space(3))) const char* lds_cptr;
typedef short v4i16_t __attribute__((ext_vector_type(4)));
__device__ __forceinline__ void kload8(bf16x8*kf,lds_cptr kp){
  kf[0]=*(const __attribute__((address_space(3))) bf16x8*)(kp);      kf[1]=*(const __attribute__((address_space(3))) bf16x8*)(kp+512);
  kf[2]=*(const __attribute__((address_space(3))) bf16x8*)(kp+2048); kf[3]=*(const __attribute__((address_space(3))) bf16x8*)(kp+2560);
  kf[4]=*(const __attribute__((address_space(3))) bf16x8*)(kp+4096); kf[5]=*(const __attribute__((address_space(3))) bf16x8*)(kp+4608);
  kf[6]=*(const __attribute__((address_space(3))) bf16x8*)(kp+6144); kf[7]=*(const __attribute__((address_space(3))) bf16x8*)(kp+6656);
}
__device__ __forceinline__ void kload2(bf16x8*kf,lds_cptr kp,int j){ kf[2*j]=*(const __attribute__((address_space(3))) bf16x8*)(kp+j*2048); kf[2*j+1]=*(const __attribute__((address_space(3))) bf16x8*)(kp+j*2048+512); }
__device__ __forceinline__ s16x4 vtr(lds_cptr p){ return __builtin_bit_cast(s16x4,__builtin_amdgcn_ds_read_tr16_b64_v4i16((__attribute__((address_space(3))) v4i16_t*)p)); }
__device__ __forceinline__ float rowmax(const f32x16&p0,const f32x16&p1){
  float a=max3f(p0[0],p0[1],p1[0]),b=max3f(p0[2],p0[3],p1[1]);a=max3f(a,p1[2],p1[3]);
  #pragma unroll
  for(int r=4;r<16;r+=4){a=max3f(a,p0[r],p0[r+1]);b=max3f(b,p0[r+2],p0[r+3]);a=max3f(a,p1[r],p1[r+1]);b=max3f(b,p1[r+2],p1[r+3]);}
  const float m=max2f(a,b);
  auto rr=__builtin_amdgcn_permlane32_swap(__float_as_uint(m),__float_as_uint(m),false,false);
  return max2f(__uint_as_float(rr[0]),__uint_as_float(rr[1]));
}
__device__ __forceinline__ void pv(f32x16*o,int vb,bf16x8 pa0,bf16x8 pa1,bf16x8 pa2,bf16x8 pa3){
  #pragma unroll
  for(int d0=0;d0<2;++d0){s16x4 lo[4],hi[4];
    #pragma unroll
    for(int ks=0;ks<4;++ks){
      asm volatile("ds_read_b64_tr_b16 %0,%1 offset:%c2":"=&v"(lo[ks]):"v"(vb),"i"(d0*4096+ks*1024):"memory");
      asm volatile("ds_read_b64_tr_b16 %0,%1 offset:%c2":"=&v"(hi[ks]):"v"(vb),"i"(d0*4096+ks*1024+512):"memory");}
    asm volatile("s_waitcnt lgkmcnt(0)":::"memory");SBAR();
    #define PK(k) (bf16x8){lo[k][0],lo[k][1],lo[k][2],lo[k][3],hi[k][0],hi[k][1],hi[k][2],hi[k][3]}
    o[d0]=__builtin_amdgcn_mfma_f32_32x32x16_bf16(pa0,PK(0),o[d0],0,0,0);
    o[d0]=__builtin_amdgcn_mfma_f32_32x32x16_bf16(pa1,PK(1),o[d0],0,0,0);
    o[d0]=__builtin_amdgcn_mfma_f32_32x32x16_bf16(pa2,PK(2),o[d0],0,0,0);
    o[d0]=__builtin_amdgcn_mfma_f32_32x32x16_bf16(pa3,PK(3),o[d0],0,0,0);
    #undef PK
  }
}

#ifndef ATTN_STORE16
#define ATTN_STORE16(p,v) (*(u32x4*)(p)=(v))
#endif
template<int THRL,int MODE,int DM,bool DRY=false> __device__ __forceinline__ void attn_unit(int b,int h,int qb,const bf16*Q,const bf16*__restrict__ K,const bf16*__restrict__ V,bf16*O,const bf16*__restrict__ Z,const float*__restrict__ XP,const int*__restrict__ TS,volatile unsigned*lw,unsigned nxt,char*shm){
  const int tid=opaque_tid(),lane=tid&63,r32=lane&31,hi=lane>>5; const int wid=__builtin_amdgcn_readfirstlane(tid>>6);
  const long rowbase=(long)b*SEQ; const int q0=qb*QB;
  const bf16*Qw=Q+(rowbase+q0+wid*QBLK)*DM+h*D;
  bf16x8 qr[4];
  #pragma unroll
  for(int d0=0;d0<4;++d0)qr[d0]=*reinterpret_cast<const bf16x8*>(&Qw[(long)r32*DM+d0*16+hi*8]);
  const bf16*Kh=K+rowbase*DM+h*D,*Vh=V+rowbase*DM+h*D;
  const unsigned lds0=(unsigned)(uintptr_t)shm;
  float*wsf=(float*)(shm+LDS_WS)+wid*64;
  const bf16*ksrc_=Kh+(long)lane*DM+wid*8; int tskip=0; const bf16*ksrc=ksrc_;
  const bf16*vsrc_=Vh+(long)(16*(wid&3)+(lane>>2))*DM+(wid>>2)*32+(lane&3)*8; const bf16*vsrc=vsrc_;
  const unsigned kdst=lds0+LDS_K+wid*1024, vdst=lds0+LDS_V+wid*1024;
  #define DMA_K(t,slot) glds16(ksrc+(long)(t)*KVBLK*DM,(unsigned)__builtin_amdgcn_readfirstlane(kdst+(slot)))
  #define DMA_V(t,slot) glds16(vsrc+(long)(t)*KVBLK*DM,(unsigned)__builtin_amdgcn_readfirstlane(vdst+(slot)))
  const int vb0=(int)(lds0+LDS_V)+((lane>>4)&1)*32+(lane&3)*8+(4*hi+((lane&15)>>2))*64;
  const char*Kbase=shm+LDS_K; bf16x8 kf[8];
  const lds_cptr shm3=(lds_cptr)shm; const lds_cptr kp0=shm3+LDS_K+hi*1024+r32*16; const lds_cptr vp0=shm3+LDS_V+((lane>>4)&1)*32+(lane&3)*8+(4*hi+((lane&15)>>2))*64;
  int NT=(q0+QB)/KVBLK;
  const int qrel=wid*QBLK+r32;
  unsigned sel=0u;
  if constexpr(MODE==1){
    tskip=__builtin_amdgcn_readfirstlane(TS[qb]);
    ksrc=ksrc_+(long)tskip*KVBLK*DM; vsrc=vsrc_+(long)tskip*KVBLK*DM; NT-=tskip;
  }
  const lds_cptr fsl=(lds_cptr)shm+XOFF+16*hi+tskip*256;
  #define XMASK(P0,P1,t) do{ if constexpr(MODE==0){ if((t)<NT-4){ const bool keep_=(sel>>((t)>>2))&1u; \
        _Pragma("unroll") for(int r=0;r<16;++r){P0[r]=keep_?P0[r]:SENT;P1[r]=keep_?P1[r]:SENT;} } } \
      else { const lds_cptr fp_=fsl+(t)*256; const float mh_=mhat; \
        _Pragma("unroll") for(int g_=0;g_<4;++g_){ const f32x4 fa_=*(const __attribute__((address_space(3))) f32x4*)(fp_+g_*32)+mh_; const f32x4 fb_=*(const __attribute__((address_space(3))) f32x4*)(fp_+128+g_*32)+mh_; \
          _Pragma("unroll") for(int i_=0;i_<4;++i_){P0[4*g_+i_]-=fa_[i_];P1[4*g_+i_]-=fb_[i_];} } } }while(0)
  DMA_K(0,0);DMA_V(0,0);DMA_K(1,SLOTB);
  float mhat=0.f,l_reg=0.f;f32x16 o[2];o[0]=f32x16{};o[1]=f32x16{};f32x16 negm=f32x16{}; if constexpr(MODE==0){asm volatile("":"+v"(negm));}
  #define CMASK(P0,P1,t) do{int jb_=(t)-(NT-4); if(jb_>=0)cmask(P0,P1,jb_,qrel,hi);}while(0)
  const f32x16 czero_=f32x16{};
  #define NEGM (MODE==1?czero_:negm)
  bool resc=false;
  #define START(P0,P1) do{ const float rm=rowmax(P0,P1); resc=false; \
    { const float dl=rm; mhat=fadd_s(mhat,dl); \
      _Pragma("unroll") for(int r=0;r<16;++r){P0[r]=fsub_s(P0[r],dl);P1[r]=fsub_s(P1[r],dl);} \
      if constexpr(MODE==0){ _Pragma("unroll") for(int r=0;r<16;++r)negm[r]=-mhat; asm volatile("":"+v"(negm)); } } \
    _Pragma("unroll") for(int r=0;r<16;++r)P0[r]=__builtin_amdgcn_exp2f(P0[r]); }while(0)
  #define RESC() do{ if(resc){ asm volatile("s_waitcnt lgkmcnt(0)":::"memory"); \
      _Pragma("unroll") for(int d_=0;d_<2;++d_) _Pragma("unroll") for(int r=0;r<16;++r)o[d_][r]*=wsf[crow(r,hi)]; } }while(0)
  f32x16 pA0,pA1,pB0,pB1;
  int sl_prev=0,sl_cur=0,sl_next=SLOTB;
  #define ROT() do{sl_prev=sl_cur;sl_cur=sl_next;sl_next=(sl_next==(NSLOT-1)*SLOTB)?0:sl_next+SLOTB;}while(0)
  DMA_K(2,2*SLOTB);
  if constexpr(MODE==1){ float*fs=(float*)(shm+XOFF); for(int i=tid+64*tskip;i<q0+QB;i+=NW*64)fs[i]=XP[i]; }
  if constexpr(MODE==0){
    float*kbs=(float*)(shm+XOFF); unsigned*sm=(unsigned*)(shm+XOFF+2048);
    kbs[tid]=XP[tid];
    asm volatile("s_waitcnt vmcnt(0) lgkmcnt(0)\n\ts_barrier":::"memory");
    if(tid<QB){ unsigned m=(1u<<qb)-1u;
      if(qb>3){ const bf16*qp=Q+(rowbase+q0+tid)*DM+h*D; float g[8];
        _Pragma("unroll") for(int n=0;n<8;++n)g[n]=0.f;
        _Pragma("unroll") for(int c=0;c<8;++c){ const bf16x8 qv=*reinterpret_cast<const bf16x8*>(qp+c*8);
          _Pragma("unroll") for(int j=0;j<8;++j){ const float qf=__uint_as_float(((unsigned)(unsigned short)qv[j])<<16);
            _Pragma("unroll") for(int n=0;n<8;++n)g[n]+=qf*kbs[n*64+c*8+j]; } }
        m=0u;
        _Pragma("unroll") for(int it=0;it<3;++it){ float best=-INFINITY; int bi=0;
          _Pragma("unroll") for(int n=0;n<8;++n){ const bool ok=(n<qb)&&!((m>>n)&1u)&&(g[n]>best); best=ok?g[n]:best; bi=ok?n:bi; }
          m|=1u<<bi; } }
      sm[tid]=m; }
    asm volatile("s_waitcnt vmcnt(0) lgkmcnt(0)\n\ts_barrier":::"memory");
    sel=sm[qrel];
  }
  WAIT_BAR(3);
  qkt(pA0,pA1,Kbase,qr,NEGM,r32,hi);asm volatile("s_nop 15\n\ts_nop 7":"+v"(pA0),"+v"(pA1));XMASK(pA0,pA1,0);CMASK(pA0,pA1,0);
  START(pA0,pA1);
  _Pragma("unroll") for(int r=0;r<16;++r)pA1[r]=__builtin_amdgcn_exp2f(pA1[r]);
  WAIT_BAR(0);
  DMA_K(3,0);DMA_V(1,SLOTB);
  ROT();
  kload8(kf,kp0+sl_cur);
  WAIT_BAR(2);
  s16x4 vlo[8],vhi[8]; u32x4 pw0,pw1,pw2,pw3;
  #define PKW(P,B) cvtpk_s(P[B],P[B+1])
  #define PAF(k) __builtin_bit_cast(bf16x8,pw##k)
  #define VFR(i) (bf16x8){vlo[i][0],vlo[i][1],vlo[i][2],vlo[i][3],vhi[i][0],vhi[i][1],vhi[i][2],vhi[i][3]}
  #define PIN(x) asm volatile("":"+v"(x))
  #define MX3(a,b,c) __builtin_fmaxf(__builtin_fmaxf((a),(b)),(c))
  #define GAPA(MF,A0,A1,A2,A3,W0,W1,PW) do{ MF; sacc+=A0; sacc+=A1; sacc+=A2; sacc+=A3; PIN(sacc); W0; W1; PIN(PW); SBAR(); }while(0)
  #define EX(v) __builtin_amdgcn_exp2f(v)
  #define GAPB(MF,X,B) do{ MF; X[B]=EX(X[B]); X[B+1]=EX(X[B+1]); X[B+2]=EX(X[B+2]); X[B+3]=EX(X[B+3]); PIN(X); SBAR(); }while(0)
  #define VRD(i) do{ vlo[i]=vtr(vp_+(((i)>>2)*4096+((i)&3)*1024)); vhi[i]=vtr(vp_+(((i)>>2)*4096+((i)&3)*1024+512)); }while(0)
  #define KRD(G,j) do{ if(G){ kload2(kf,kp0+sl_next,j); SBAR(); } }while(0)
  #define STEP(C0,C1,P0,P1,t,GK,GV,GL) do{ SBAR(); \
    const lds_cptr vp_=vp0+sl_prev; \
    VRD(0); SBAR(); float sacc=(P0[0]+P0[1]); \
    GAPA(C0=__builtin_amdgcn_mfma_f32_32x32x16_bf16(kf[0],qr[0],NEGM,0,0,0), P0[2],P0[3],P0[4],P0[5],     pw0[0]=PKW(P0,0), pw0[1]=PKW(P0,2), pw0); \
    VRD(4); SBAR(); GAPA(C1=__builtin_amdgcn_mfma_f32_32x32x16_bf16(kf[1],qr[0],NEGM,0,0,0), P0[6],P0[7],P0[8],P0[9],     pw0[2]=PKW(P0,4), pw0[3]=PKW(P0,6), pw0); \
    VRD(1); SBAR(); GAPA(C0=__builtin_amdgcn_mfma_f32_32x32x16_bf16(kf[2],qr[1],C0,0,0,0),   P0[10],P0[11],P0[12],P0[13], pw1[0]=PKW(P0,8), pw1[1]=PKW(P0,10), pw1); \
    VRD(5); SBAR(); GAPA(C1=__builtin_amdgcn_mfma_f32_32x32x16_bf16(kf[3],qr[1],C1,0,0,0),   P0[14],P0[15],P1[0],P1[1],   pw1[2]=PKW(P0,12),pw1[3]=PKW(P0,14), pw1); \
    VRD(2); SBAR(); GAPA(C0=__builtin_amdgcn_mfma_f32_32x32x16_bf16(kf[4],qr[2],C0,0,0,0),   P1[2],P1[3],P1[4],P1[5],     pw2[0]=PKW(P1,0), pw2[1]=PKW(P1,2), pw2); \
    VRD(6); SBAR(); GAPA(C1=__builtin_amdgcn_mfma_f32_32x32x16_bf16(kf[5],qr[2],C1,0,0,0),   P1[6],P1[7],P1[8],P1[9],     pw2[2]=PKW(P1,4), pw2[3]=PKW(P1,6), pw2); \
    VRD(3); SBAR(); GAPA(C0=__builtin_amdgcn_mfma_f32_32x32x16_bf16(kf[6],qr[3],C0,0,0,0),   P1[10],P1[11],P1[12],P1[13], pw3[0]=PKW(P1,8), pw3[1]=PKW(P1,10), pw3); \
    VRD(7); SBAR(); GAPA(C1=__builtin_amdgcn_mfma_f32_32x32x16_bf16(kf[7],qr[3],C1,0,0,0),   P1[14],P1[15],0.f,0.f,       pw3[2]=PKW(P1,12),pw3[3]=PKW(P1,14), pw3); \
    l_reg+=sacc; \
    if(GK){DMA_K((t)+3,sl_cur);} if(GV){DMA_V((t)+1,sl_next);} \
    XMASK(C0,C1,t); CMASK(C0,C1,t); \
    { float a=MX3(C0[0],C0[1],C1[0]),b=MX3(C0[2],C0[3],C1[1]); a=MX3(a,C1[2],C1[3]); \
      _Pragma("unroll") for(int r=4;r<16;r+=4){a=MX3(a,C0[r],C0[r+1]);b=MX3(b,C0[r+2],C0[r+3]);a=MX3(a,C1[r],C1[r+1]);b=MX3(b,C1[r+2],C1[r+3]);} \
      float rm=__builtin_fmaxf(a,b); { auto rr=__builtin_amdgcn_permlane32_swap(__float_as_uint(rm),__float_as_uint(rm),false,false); rm=__builtin_fmaxf(__uint_as_float(rr[0]),__uint_as_float(rr[1])); } \
      resc=false; \
      if(__builtin_expect(__any(rm>(float)THRL),0)){ const float dl=__builtin_fmaxf(rm,0.f); mhat+=dl; \
        _Pragma("unroll") for(int r=0;r<16;++r){C0[r]-=dl;C1[r]-=dl;} \
        if constexpr(MODE==0){ _Pragma("unroll") for(int r=0;r<16;++r)negm[r]=-mhat; asm volatile("":"+v"(negm)); } \
        const float f=__builtin_amdgcn_exp2f(-dl); l_reg*=f; if(hi==0)wsf[r32]=f; resc=true; } } \
    SBAR(); \
    GAPB(o[0]=__builtin_amdgcn_mfma_f32_32x32x16_bf16(PAF(0),VFR(0),o[0],0,0,0), C0,0); \
    GAPB(o[1]=__builtin_amdgcn_mfma_f32_32x32x16_bf16(PAF(0),VFR(4),o[1],0,0,0), C0,4); \
    KRD(GL,0); GAPB(o[0]=__builtin_amdgcn_mfma_f32_32x32x16_bf16(PAF(1),VFR(1),o[0],0,0,0), C0,8); \
    KRD(GL,1); GAPB(o[1]=__builtin_amdgcn_mfma_f32_32x32x16_bf16(PAF(1),VFR(5),o[1],0,0,0), C0,12); \
    KRD(GL,2); GAPB(o[0]=__builtin_amdgcn_mfma_f32_32x32x16_bf16(PAF(2),VFR(2),o[0],0,0,0), C1,0); \
    KRD(GL,3); GAPB(o[1]=__builtin_amdgcn_mfma_f32_32x32x16_bf16(PAF(2),VFR(6),o[1],0,0,0), C1,4); \
    GAPB(o[0]=__builtin_amdgcn_mfma_f32_32x32x16_bf16(PAF(3),VFR(3),o[0],0,0,0), C1,8); \
    GAPB(o[1]=__builtin_amdgcn_mfma_f32_32x32x16_bf16(PAF(3),VFR(7),o[1],0,0,0), C1,12); \
    }while(0)
  int t=1;
  #undef CMASK
  #define CMASK(P0,P1,t) do{}while(0)
  for(;t+5<NT;t+=2){
    STEP(pB0,pB1,pA0,pA1,t,true,true,true);     WAIT_BAR(2); RESC(); ROT();
    STEP(pA0,pA1,pB0,pB1,t+1,true,true,true);   WAIT_BAR(2); RESC(); ROT();
  }
  #undef CMASK
  #define CMASK(P0,P1,t) do{int jb_=(t)-(NT-4); if(jb_>=0)cmask(P0,P1,jb_,qrel,hi);}while(0)
  #define ENDW(tt) do{ if((tt)+3<NT){WAIT_BAR(2);} else if((tt)+2<NT){WAIT_BAR(1);} else {WAIT_BAR(0);} }while(0)
  for(;t+1<NT;t+=2){
    STEP(pB0,pB1,pA0,pA1,t,(t+3<NT),(t+1<NT),(t+1<NT));       ENDW(t);   RESC(); ROT();
    STEP(pA0,pA1,pB0,pB1,t+1,(t+4<NT),(t+2<NT),(t+2<NT));     ENDW(t+1); RESC(); ROT();
  }
  STEP(pB0,pB1,pA0,pA1,NT-1,false,false,false); RESC();
  const bf16*Zw=Z+(rowbase+q0+wid*QBLK)*DM+h*D; u32x4 zpre[4];
  #pragma unroll
  for(int i=0;i<4;++i)zpre[i]=*(const u32x4*)(Zw+(long)(i*8+(lane>>3))*DM+(lane&7)*8);
  { float sacc=pB0[0]+pB0[1]; _Pragma("unroll") for(int r=2;r<16;++r)sacc+=pB0[r]; _Pragma("unroll") for(int r=0;r<16;++r)sacc+=pB1[r]; l_reg+=sacc;
    pw0=(u32x4){PKW(pB0,0),PKW(pB0,2),PKW(pB0,4),PKW(pB0,6)};pw1=(u32x4){PKW(pB0,8),PKW(pB0,10),PKW(pB0,12),PKW(pB0,14)};pw2=(u32x4){PKW(pB1,0),PKW(pB1,2),PKW(pB1,4),PKW(pB1,6)};pw3=(u32x4){PKW(pB1,8),PKW(pB1,10),PKW(pB1,12),PKW(pB1,14)};
    SBAR(); pv(o,vb0+sl_cur,PAF(0),PAF(1),PAF(2),PAF(3)); }
  #undef PKW
  #undef PAF
  #undef VFR
  #undef PIN
  #undef MX3
  #undef GAPA
  #undef GAPB
  #undef EX
  #undef VRD
  #undef KRD
  #undef STEP
  #undef ENDW
  if(lw!=nullptr&&tid==0)lw[0]=nxt;
  {auto rr=__builtin_amdgcn_permlane32_swap(__float_as_uint(l_reg),__float_as_uint(l_reg),false,false);l_reg=__uint_as_float(rr[0])+__uint_as_float(rr[1]);}
  if(hi==0)wsf[32+r32]=l_reg;asm volatile("s_waitcnt lgkmcnt(0)":::"memory");
  float rli[16];
  #pragma unroll
  for(int r=0;r<16;++r)rli[r]=__builtin_amdgcn_rcpf(wsf[32+crow(r,hi)]);
  bf16*Ow=O+(rowbase+q0+wid*QBLK)*DM+h*D;
  { bf16*stg=(bf16*)(shm+LDS_OST)+wid*2048;
    #pragma unroll
    for(int r=0;r<16;++r){const int orow=crow(r,hi);
      #pragma unroll
      for(int d0=0;d0<2;++d0)stg[orow*64+d0*32+r32]=__float2bfloat16(o[d0][r]*rli[r]);}
    asm volatile("s_waitcnt lgkmcnt(0)":::"memory");
    #pragma unroll
    for(int i=0;i<4;++i){const int row=i*8+(lane>>3),ch=lane&7; const u32x4 v=*(const u32x4*)(stg+row*64+ch*8); const u32x4 zv=zpre[i]; u32x4 ov;
      #pragma unroll
      for(int e=0;e<4;++e){ const float o0=__uint_as_float(v[e]<<16),o1=__uint_as_float(v[e]&0xffff0000u),z0=__uint_as_float(zv[e]<<16),z1=__uint_as_float(zv[e]&0xffff0000u);
        ov[e]=cvtpk_s(o0*z0*__builtin_amdgcn_rcpf(1.f+__expf(-z0)),o1*z1*__builtin_amdgcn_rcpf(1.f+__expf(-z1))); }
      if(!DRY||ov[0]==0x7fc12345u)ATTN_STORE16(Ow+(long)row*DM+ch*8,ov);} }
  asm volatile("s_waitcnt lgkmcnt(0)\n\ts_barrier":::"memory");
  #undef DMA_K
  #undef DMA_V
  #undef CMASK
  #undef XMASK
  #undef NEGM
  #undef START
  #undef RESC
  #undef ROT
}
constexpr int ATTN_LDS_BYTES=LDS_BYTES;
#undef SBAR
#undef WAIT_BAR
}
constexpr int NWAVES = 8, NTHR = 512;
constexpr int NB = 8, SEQL = 2048, DMOD = 1024, MROWS = NB * SEQL;
constexpr int LD0 = 6656, NP0 = 6912, LD1 = 7168, NP1 = 7424;
constexpr int C0_ZA = 0, C0_Q = 1024, C0_ZB = 2048, C0_XBC = 3072, C0_K = 4608, C0_V = 5632;
constexpr int C1_Q = 0, C1_U = 1536, C1_K = 2048, C1_V = 3584, C1_ZC = 5120, C1_ZD = 6656;
constexpr float RMS_EPS = 1e-6f, LOG2E = 1.4426950408889634f;
constexpr size_t MiB = 1u << 20;
constexpr int KS = 8;
constexpr size_t WS_MODP = 0;
constexpr size_t WS_SSQ = 2 * MiB;
constexpr size_t WS_KBAR = 2 * MiB + 65536;
constexpr size_t WS_DT = 3 * MiB;
constexpr size_t WS_LF = 4 * MiB;
constexpr size_t WS_F2 = 6 * MiB;
constexpr size_t WS_S5P = 7 * MiB + 512 * 1024;
constexpr int S5P_STRIDE = 8704;
constexpr size_t WS_WT1 = 8 * MiB;
constexpr size_t WS_WO1 = WS_WT1 + (size_t)NP1 * 1024 * 2;
constexpr size_t WS_WG = WS_WO1 + 4 * MiB;
constexpr size_t WS_BIG = 27 * MiB;
constexpr size_t WS_WT0 = WS_BIG + (size_t)MROWS * LD0 * 2;
constexpr size_t WS_WO0 = WS_WT0 + (size_t)NP0 * 1024 * 2;
constexpr size_t WS_LFP = 251 * MiB;
constexpr size_t WS_END = WS_WO0 + 4 * MiB;
static_assert(WS_WG + 512 * 1024 <= WS_BIG && WS_END <= 256 * MiB && WS_BIG + (size_t)MROWS * LD1 * 2 <= 256 * MiB, "ws map");
constexpr int LDS_BYTES = 147456;
constexpr size_t WS_CNT = 1835008 + 3584 * 4, WS_UB = 1835008 + 32768, WS_TS = 1835008 + 32768 + 1024;
constexpr size_t WS_BAR = 1835008;
constexpr int BARST_OFF = 132608;

typedef unsigned short bf16;
typedef unsigned v4u __attribute__((ext_vector_type(4)));
typedef unsigned v2u __attribute__((ext_vector_type(2)));
typedef float f32x4 __attribute__((ext_vector_type(4)));
typedef short bf16x8 __attribute__((ext_vector_type(8)));
typedef float f32x16 __attribute__((ext_vector_type(16)));
typedef float f32x2_c __attribute__((ext_vector_type(2))); typedef __bf16 bf16x2_c __attribute__((ext_vector_type(2)));
__device__ __forceinline__ unsigned pk2(float lo, float hi) { f32x2_c v = {lo, hi}; return __builtin_bit_cast(unsigned, __builtin_convertvector(v, bf16x2_c)); }
__device__ __forceinline__ unsigned f2bf(float f) { return pk2(f, f) & 0xffffu; }
__device__ __forceinline__ float bf2f(unsigned short h) { return __uint_as_float(((unsigned)h) << 16); }
template <int CTRL> __device__ __forceinline__ float dppf(float old, float src) { return __builtin_bit_cast(float, __builtin_amdgcn_update_dpp(__builtin_bit_cast(int, old), __builtin_bit_cast(int, src), CTRL, 0xF, 0xF, false)); }
__device__ __forceinline__ float row_sum16(float v) { v += dppf<0xB1>(v, v); v += dppf<0x4E>(v, v); v += dppf<0x141>(v, v); v += dppf<0x140>(v, v); return v; }
__device__ __forceinline__ float rdlane(float v, int l) { return __builtin_bit_cast(float, __builtin_amdgcn_readlane(__builtin_bit_cast(int, v), l)); }
__device__ __forceinline__ float wave_sum(float v) { v = row_sum16(v); return (rdlane(v, 0) + rdlane(v, 16)) + (rdlane(v, 32) + rdlane(v, 48)); }
__device__ __forceinline__ float wave_scan(float x, int lane) {
    x += dppf<0x111>(0.f, x); x += dppf<0x112>(0.f, x); x += dppf<0x114>(0.f, x); x += dppf<0x118>(0.f, x);
    const float t0 = rdlane(x, 15), t1 = rdlane(x, 31), t2 = rdlane(x, 47); const int rw = lane >> 4;
    return x + (rw == 0 ? 0.f : (rw == 1 ? t0 : (rw == 2 ? t0 + t1 : (t0 + t1) + t2)));
}
__device__ __forceinline__ float silu_f(float x) { return x * __builtin_amdgcn_rcpf(1.f + __expf(-x)); }
__device__ __forceinline__ float softplus_g(float x) { return x > 20.f ? x : log1pf(__expf(x)); }

struct Args {
    const float* in[27]; float* out; unsigned char* ws;
};
enum { I_X = 0, I_C, I_ADAW, I_ADAB, I_PREG, I_POSTG, I_EINW, I_ECONVW, I_ECONVB, I_EDTB, I_EALOG, I_EDSKIP, I_ENORMG, I_EOUTW,
       I_OINW, I_OFGB, I_OLRE, I_OLIM, I_OLDT, I_OBRE, I_OBIM, I_OCRE, I_OCIM, I_ODSKIP, I_OGLUW, I_OGLUB, I_OOUTW };

__device__ __forceinline__ int src_col0(int n) {
    if (n < 1024) return n;
    if (n < 2048) return 3600 + (n - 1024);
    if (n < 3072) return 1024 + (n - 2048);
    if (n < 4608) return 2048 + (n - 3072);
    if (n < 5632) return 4624 + (n - 4608);
    if (n < 6656) return 5648 + (n - 5632);
    if (n < 6672) return 3584 + (n - 6656);
    return -1;
}
__device__ __forceinline__ int src_col1(int n) {
    if (n < 1536) return 2048 + n;
    if (n < 2048) return 6680 + (n - 1536);
    if (n < 3584) return 3584 + (n - 2048);
    if (n < 5120) return 5120 + (n - 3584);
    if (n < 6656) return n - 5120;
    if (n < 7168) return 1536 + (n - 6656);
    if (n < 7192) return 6656 + (n - 7168);
    return -1;
}
template <int MAP> __device__ __forceinline__ void transpose_item(const float* __restrict__ W, int K, int NSRC, int NDST, bf16* WT, float* scr, int item, int lane, const float* __restrict__ kscale = nullptr) {
    const int nblk = NDST / 32, kb = item / nblk, nb = item % nblk, k0 = 64 * kb, n0 = 32 * nb;
    const int nn = n0 + (lane & 31); const int sc = MAP == 0 ? src_col0(nn) : (MAP == 1 ? src_col1(nn) : nn);
    float tv[32];
#pragma unroll
    for (int i = 0; i < 32; ++i) { const int kk = 2 * i + (lane >> 5); tv[i] = sc >= 0 ? __builtin_nontemporal_load(&W[(size_t)(k0 + kk) * NSRC + sc]) : 0.f; if (kscale && k0 + kk < 1024) tv[i] *= kscale[k0 + kk]; }
#pragma unroll
    for (int i = 0; i < 32; ++i) { const int kk = 2 * i + (lane >> 5); scr[kk * 33 + (lane & 31)] = tv[i]; }
    asm volatile("s_waitcnt lgkmcnt(0)" ::: "memory");
    const int c = lane & 7;
#pragma unroll
    for (int j = 0; j < 4; ++j) { const int n = (lane >> 3) + 8 * j; const float* s = scr + (8 * c) * 33 + n;
        v4u o; o.x = pk2(s[0 * 33], s[1 * 33]); o.y = pk2(s[2 * 33], s[3 * 33]); o.z = pk2(s[4 * 33], s[5 * 33]); o.w = pk2(s[6 * 33], s[7 * 33]);
        *(v4u*)(WT + (size_t)(n0 + n) * K + k0 + 8 * c) = o; }
    asm volatile("s_waitcnt lgkmcnt(0)" ::: "memory");
}

__device__ __forceinline__ float mod_val(const float* modp, const float* adab, int l, int b, int j) {
    float s = adab[l * 3072 + j];
#pragma unroll
    for (int kc = 0; kc < KS; ++kc) s += modp[((size_t)(kc * 2 + l) * 8 + b) * 3072 + j];
    return s;
}

__device__ __forceinline__ void p0_prologue(const Args& A, char* lds, int vcu, int G) {
    const int tid = opaque_tid(), lane = tid & 63, wave = tid >> 6;
    unsigned char* ws = A.ws;
    float* scr = (float*)(lds + wave * 16384);
    const int gw = vcu * NWAVES + wave, NGW = G * NWAVES;
    constexpr int I0 = 16 * (NP0 / 32), I1 = 16 * (NP1 / 32), IO = 32 * 32, IG = 8 * 16;
    constexpr int NITEMS = I0 + I1 + 2 * IO + IG;
    for (int it = gw; it < NITEMS; it += NGW) {
        int r = it;
        if (r < I0) { transpose_item<0>(A.in[I_EINW], 1024, 6672, NP0, (bf16*)(ws + WS_WT0), scr, r, lane); continue; } r -= I0;
        if (r < I1) { transpose_item<1>(A.in[I_OINW], 1024, 7192, NP1, (bf16*)(ws + WS_WT1), scr, r, lane); continue; } r -= I1;
        if (r < IO) { transpose_item<2>(A.in[I_EOUTW], 2048, 1024, 1024, (bf16*)(ws + WS_WO0), scr, r, lane, G == 256 ? A.in[I_ENORMG] : nullptr); continue; } r -= IO;
        if (r < IO) { transpose_item<2>(A.in[I_OOUTW], 2048, 1024, 1024, (bf16*)(ws + WS_WO1), scr, r, lane); continue; } r -= IO;
        transpose_item<2>(A.in[I_OGLUW], 512, 512, 512, (bf16*)(ws + WS_WG), scr, r, lane);
    }
    __syncthreads();
    float* sc = (float*)lds;
    float* modp = (float*)(ws + WS_MODP);
    for (int item = blockIdx.x; item < 2 * KS * 6; item += G) {
        const int l = item / (KS * 6), r = item % (KS * 6), kc = r / 6, cb = r % 6;
        __syncthreads();
        for (int i = tid; i < 1024; i += NTHR) { const int b = i >> 7, k = i & 127; const float cv = A.in[I_C][b * 1024 + kc * 128 + k]; sc[i] = silu_f(cv); }
        __syncthreads();
        const int col = cb * 512 + tid; float acc[8];
#pragma unroll
        for (int b = 0; b < 8; ++b) acc[b] = 0.f;
        const float* wp = A.in[I_ADAW] + ((size_t)l * 1024 + kc * 128) * 3072 + col;
#pragma unroll 16
        for (int k = 0; k < 128; ++k) { const float w = __builtin_nontemporal_load(&wp[(size_t)k * 3072]);
#pragma unroll
            for (int b = 0; b < 8; ++b) acc[b] += sc[b * 128 + k] * w; }
#pragma unroll
        for (int b = 0; b < 8; ++b) modp[((size_t)(kc * 2 + l) * 8 + b) * 3072 + col] = acc[b];
    }
    const int gt = blockIdx.x * NTHR + tid;
    const int gs = (G >= 128 ? ((int)blockIdx.x - (G - 32)) * 64 + tid : gt);
    if (gs >= 0 && gs < 2048 && (G < 128 || tid < 64)) {
        const int g = gs >> 6, n = gs & 63;
        const float dt = __expf(A.in[I_OLDT][g]);
        const float lr = A.in[I_OLRE][g * 64 + n], li = A.in[I_OLIM][g * 64 + n];
        const float mag = expf(lr * dt); float sn, cs; sincosf(li * dt, &sn, &cs);
        const float ar = mag * cs, ai = mag * sn, den = lr * lr + li * li;
        const float qr = ((ar - 1.f) * lr + ai * li) / den, qi = (ai * lr - (ar - 1.f) * li) / den;
        unsigned char* pg = ws + WS_S5P + (size_t)g * S5P_STRIDE;
        bf16* BbT = (bf16*)pg; bf16* Cm = (bf16*)(pg + 4096); float* ari = (float*)(pg + 8192);
        ari[n] = ar; ari[64 + n] = ai;
        for (int c = 0; c < 16; ++c) { const float br = A.in[I_OBRE][(g * 64 + n) * 16 + c], bi = A.in[I_OBIM][(g * 64 + n) * 16 + c];
            BbT[(2 * n) * 16 + c] = (bf16)f2bf(qr * br - qi * bi); BbT[(2 * n + 1) * 16 + c] = (bf16)f2bf(qr * bi + qi * br);
            Cm[c * 128 + 2 * n] = (bf16)f2bf(A.in[I_OCRE][(g * 16 + c) * 64 + n]); Cm[c * 128 + 2 * n + 1] = (bf16)f2bf(-A.in[I_OCIM][(g * 16 + c) * 64 + n]); }
    }
    float* ssq = (float*)(ws + WS_SSQ);
    for (int i = gt; i < MROWS; i += G * NTHR) ssq[i] = 0.f;
}

__device__ __forceinline__ void p1a_rows(const Args& A, char* lds, int G) {
    const int tid = opaque_tid(), lane = tid & 63, wave = tid >> 6;
    const float* modp = (const float*)(A.ws + WS_MODP); float* mv = (float*)lds;
    for (int rb = blockIdx.x; rb < MROWS / 64; rb += G) {
        const int b = rb >> 5;
        __syncthreads();
#pragma unroll 1
        for (int col = tid; col < 1024; col += NTHR) { mv[col] = A.in[I_PREG][col] * (1.f + mod_val(modp, A.in[I_ADAB], 0, b, 1024 + col)); mv[1024 + col] = mod_val(modp, A.in[I_ADAB], 0, b, col); }
        __syncthreads();
        f32x4 mul[4], add[4];
#pragma unroll
        for (int j = 0; j < 4; ++j) { mul[j] = *(const f32x4*)(mv + 4 * lane + 256 * j); add[j] = *(const f32x4*)(mv + 1024 + 4 * lane + 256 * j); }
        f32x4 nx[4];
        { const f32x4* xr = (const f32x4*)(A.in[I_X] + (size_t)(rb * 64 + wave * 8) * DMOD) + lane;
#pragma unroll
          for (int j = 0; j < 4; ++j) nx[j] = __builtin_nontemporal_load(&xr[64 * j]); }
#pragma unroll 1
        for (int r = 0; r < 8; ++r) { const int m = rb * 64 + wave * 8 + r;
            f32x4 v[4]; float s = 0.f;
#pragma unroll
            for (int j = 0; j < 4; ++j) { v[j] = nx[j]; s += (v[j].x * v[j].x + v[j].y * v[j].y) + (v[j].z * v[j].z + v[j].w * v[j].w); }
            if (r < 7) { const f32x4* xr = (const f32x4*)(A.in[I_X] + (size_t)(m + 1) * DMOD) + lane;
#pragma unroll
                for (int j = 0; j < 4; ++j) nx[j] = __builtin_nontemporal_load(&xr[64 * j]); }
            const float rstd = rsqrtf(wave_sum(s) * (1.f / DMOD) + RMS_EPS);
            unsigned long long* o8 = (unsigned long long*)((unsigned char*)A.out + (size_t)m * 4096) + lane;
#pragma unroll
            for (int j = 0; j < 4; ++j) { const f32x4 h = v[j] * rstd * mul[j] + add[j]; o8[64 * j] = (unsigned long long)pk2(h.x, h.y) | ((unsigned long long)pk2(h.z, h.w) << 32); } }
    }
}
__device__ __forceinline__ void p3b_rows(const Args& A, char* lds, int G) {
    const int tid = opaque_tid(), lane = tid & 63, wave = tid >> 6;
    const float* modp = (const float*)(A.ws + WS_MODP); float* mv = (float*)lds;
    for (int rb = blockIdx.x; rb < MROWS / 64; rb += G) {
        const int b = rb >> 5;
        __syncthreads();
#pragma unroll 1
        for (int col = tid; col < 1024; col += NTHR) { mv[col] = A.in[I_POSTG][col] * mod_val(modp, A.in[I_ADAB], 0, b, 2048 + col);
            mv[1024 + col] = A.in[I_PREG][1024 + col] * (1.f + mod_val(modp, A.in[I_ADAB], 1, b, 1024 + col)); mv[2048 + col] = mod_val(modp, A.in[I_ADAB], 1, b, col); }
        __syncthreads();
        f32x4 g0[4], mul[4], add[4];
#pragma unroll
        for (int j = 0; j < 4; ++j) { g0[j] = *(const f32x4*)(mv + 4 * lane + 256 * j); mul[j] = *(const f32x4*)(mv + 1024 + 4 * lane + 256 * j); add[j] = *(const f32x4*)(mv + 2048 + 4 * lane + 256 * j); }
        f32x4 nx[4]; v2u ny[4];
        { const int m = rb * 64 + wave * 8; const f32x4* xr = (const f32x4*)(A.in[I_X] + (size_t)m * DMOD) + lane; const v2u* yr = (const v2u*)((unsigned char*)A.out + (size_t)m * 4096) + lane;
#pragma unroll
          for (int j = 0; j < 4; ++j) { nx[j] = __builtin_nontemporal_load(&xr[64 * j]); ny[j] = yr[64 * j]; } }
#pragma unroll 1
        for (int r = 0; r < 8; ++r) { const int m = rb * 64 + wave * 8 + r;
            unsigned char* slot = (unsigned char*)A.out + (size_t)m * 4096;
            f32x4 v[4], y[4]; float sy = 0.f; v2u wy[4];
#pragma unroll
            for (int j = 0; j < 4; ++j) { v[j] = nx[j]; wy[j] = ny[j]; }
            if (r < 7) { const f32x4* xr = (const f32x4*)(A.in[I_X] + (size_t)(m + 1) * DMOD) + lane; const v2u* yr = (const v2u*)(slot + 4096) + lane;
#pragma unroll
                for (int j = 0; j < 4; ++j) { nx[j] = __builtin_nontemporal_load(&xr[64 * j]); ny[j] = yr[64 * j]; } }
#pragma unroll
            for (int j = 0; j < 4; ++j) { const v2u w = wy[j]; y[j] = (f32x4){__uint_as_float(w.x << 16), __uint_as_float(w.x & 0xffff0000u), __uint_as_float(w.y << 16), __uint_as_float(w.y & 0xffff0000u)};
                sy += (y[j].x * y[j].x + y[j].y * y[j].y) + (y[j].z * y[j].z + y[j].w * y[j].w); }
            const float ry = rsqrtf(wave_sum(sy) * (1.f / DMOD) + RMS_EPS); float s = 0.f;
#pragma unroll
            for (int j = 0; j < 4; ++j) { v[j] = v[j] + g0[j] * (y[j] * ry); s += (v[j].x * v[j].x + v[j].y * v[j].y) + (v[j].z * v[j].z + v[j].w * v[j].w); }
            const float rstd = rsqrtf(wave_sum(s) * (1.f / DMOD) + RMS_EPS);
            unsigned long long* o8 = (unsigned long long*)(slot + 2048) + lane;
#pragma unroll
            for (int j = 0; j < 4; ++j) { const f32x4 h = v[j] * rstd * mul[j] + add[j]; o8[64 * j] = (unsigned long long)pk2(h.x, h.y) | ((unsigned long long)pk2(h.z, h.w) << 32); } }
    }
}
__device__ __forceinline__ void p6b_rows(const Args& A, char* lds, int G) {
    const int tid = opaque_tid(), lane = tid & 63, wave = tid >> 6;
    const float* modp = (const float*)(A.ws + WS_MODP); float* mv = (float*)lds;
    for (int rb = blockIdx.x; rb < MROWS / 64; rb += G) {
        const int b = rb >> 5;
        __syncthreads();
#pragma unroll 1
        for (int col = tid; col < 1024; col += NTHR) { mv[col] = A.in[I_POSTG][col] * mod_val(modp, A.in[I_ADAB], 0, b, 2048 + col); mv[1024 + col] = A.in[I_POSTG][1024 + col] * mod_val(modp, A.in[I_ADAB], 1, b, 2048 + col); }
        __syncthreads();
        f32x4 g0[4], g1[4];
#pragma unroll
        for (int j = 0; j < 4; ++j) { g0[j] = *(const f32x4*)(mv + 4 * lane + 256 * j); g1[j] = *(const f32x4*)(mv + 1024 + 4 * lane + 256 * j); }
        f32x4 nx[4]; v2u n0[4], n1[4];
        { const int m = rb * 64 + wave * 8; const f32x4* xr = (const f32x4*)(A.in[I_X] + (size_t)m * DMOD) + lane; const v2u* y1r = (const v2u*)((unsigned char*)A.out + (size_t)m * 4096) + lane;
#pragma unroll
          for (int j = 0; j < 4; ++j) { nx[j] = __builtin_nontemporal_load(&xr[64 * j]); n0[j] = y1r[64 * j]; n1[j] = y1r[256 + 64 * j]; } }
#pragma unroll 1
        for (int r = 0; r < 8; ++r) { const int m = rb * 64 + wave * 8 + r;
            unsigned char* slot = (unsigned char*)A.out + (size_t)m * 4096;
            f32x4 v[4], y0[4], y1[4]; float s0 = 0.f, s1 = 0.f; v2u w0[4], w1[4];
#pragma unroll
            for (int j = 0; j < 4; ++j) { v[j] = nx[j]; w0[j] = n0[j]; w1[j] = n1[j]; }
            if (r < 7) { const f32x4* xr = (const f32x4*)(A.in[I_X] + (size_t)(m + 1) * DMOD) + lane; const v2u* y1r = (const v2u*)(slot + 4096) + lane;
#pragma unroll
                for (int j = 0; j < 4; ++j) { nx[j] = __builtin_nontemporal_load(&xr[64 * j]); n0[j] = y1r[64 * j]; n1[j] = y1r[256 + 64 * j]; } }
#pragma unroll
            for (int j = 0; j < 4; ++j) { const v2u w = w0[j], u = w1[j];
                y0[j] = (f32x4){__uint_as_float(w.x << 16), __uint_as_float(w.x & 0xffff0000u), __uint_as_float(w.y << 16), __uint_as_float(w.y & 0xffff0000u)};
                y1[j] = (f32x4){__uint_as_float(u.x << 16), __uint_as_float(u.x & 0xffff0000u), __uint_as_float(u.y << 16), __uint_as_float(u.y & 0xffff0000u)};
                s0 += (y0[j].x * y0[j].x + y0[j].y * y0[j].y) + (y0[j].z * y0[j].z + y0[j].w * y0[j].w);
                s1 += (y1[j].x * y1[j].x + y1[j].y * y1[j].y) + (y1[j].z * y1[j].z + y1[j].w * y1[j].w); }
            const float r0 = rsqrtf(wave_sum(s0) * (1.f / DMOD) + RMS_EPS), r1 = rsqrtf(wave_sum(s1) * (1.f / DMOD) + RMS_EPS);
            f32x4* orow = (f32x4*)slot + lane;
#pragma unroll
            for (int j = 0; j < 4; ++j) { const f32x4 x1 = v[j] + g0[j] * (y0[j] * r0); v[j] = x1 + g1[j] * (y1[j] * r1); }
            asm volatile("" ::: "memory");
#pragma unroll
            for (int j = 0; j < 4; ++j) orow[64 * j] = v[j]; }
    }
}
#define BAR_ALL() asm volatile("s_waitcnt vmcnt(0) lgkmcnt(0)\n\ts_barrier" ::: "memory")
#define BAR_LDS() asm volatile("s_waitcnt lgkmcnt(0)\n\ts_barrier" ::: "memory")
typedef float f32x4m __attribute__((ext_vector_type(4)));
__device__ __forceinline__ void p2a_kbar(const Args& A, char* lds, int G) {
    const int tid = opaque_tid(); const bf16* P0 = (const bf16*)(A.ws + WS_BIG); float* kbar = (float*)(A.ws + WS_KBAR); float* red = (float*)lds;
    for (int item = blockIdx.x; item < NB * 16 * 8; item += G) {
        const int b = item >> 7, h = (item >> 3) & 15, n = item & 7; const int c8 = tid & 7, rg = tid >> 3;
        float acc[8];
#pragma unroll
        for (int e = 0; e < 8; ++e) acc[e] = 0.f;
#pragma unroll
        for (int i = 0; i < 4; ++i) { const bf16x8 kv = *(const bf16x8*)(P0 + (size_t)(b * SEQL + n * 256 + rg + 64 * i) * LD0 + C0_K + h * 64 + c8 * 8);
#pragma unroll
            for (int e = 0; e < 8; ++e) acc[e] += bf2f((unsigned short)kv[e]); }
        __syncthreads();
#pragma unroll
        for (int e = 0; e < 8; ++e) red[rg * 65 + c8 * 8 + e] = acc[e];
        __syncthreads();
        if (tid < 64) { float s = 0.f; for (int r = 0; r < 64; ++r) s += red[r * 65 + tid]; kbar[(size_t)item * 64 + tid] = s * (1.f / 256.f); }
    }
    __syncthreads();
}
__device__ __forceinline__ void p2a_conv(const Args& A, int G) {
    const int tid = opaque_tid(); const bf16* __restrict__ P0 = (const bf16*)(A.ws + WS_BIG); bf16* __restrict__ XC = (bf16*)A.out;
    if (tid >= 384) return;
    const int chg = tid % 192, half = tid / 192, ch = chg * 8;
    float w[4][8], bs[8];
#pragma unroll
    for (int k = 0; k < 4; ++k) { const f32x4 a = *(const f32x4*)(A.in[I_ECONVW] + k * 1536 + ch), b2 = *(const f32x4*)(A.in[I_ECONVW] + k * 1536 + ch + 4);
#pragma unroll
        for (int e = 0; e < 4; ++e) { w[k][e] = a[e]; w[k][4 + e] = b2[e]; } }
    { const f32x4 a = *(const f32x4*)(A.in[I_ECONVB] + ch), b2 = *(const f32x4*)(A.in[I_ECONVB] + ch + 4);
#pragma unroll
      for (int e = 0; e < 4; ++e) { bs[e] = a[e]; bs[4 + e] = b2[e]; } }
    for (int rb = blockIdx.x; rb < MROWS / 64; rb += G) {
        const int m0 = rb * 64 + half * 32; const int tb = m0 & (SEQL - 1);
        bf16x8 r0 = {}, r1 = {}, r2 = {};
        if (tb > 0) { r0 = *(const bf16x8*)(P0 + (size_t)(m0 - 3) * LD0 + C0_XBC + ch); r1 = *(const bf16x8*)(P0 + (size_t)(m0 - 2) * LD0 + C0_XBC + ch); r2 = *(const bf16x8*)(P0 + (size_t)(m0 - 1) * LD0 + C0_XBC + ch); }
#pragma unroll 1
        for (int i0 = 0; i0 < 32; i0 += 8) { bf16x8 rr[8];
#pragma unroll
        for (int i = 0; i < 8; ++i) rr[i] = *(const bf16x8*)(P0 + (size_t)(m0 + i0 + i) * LD0 + C0_XBC + ch);
#pragma unroll
        for (int ii = 0; ii < 8; ++ii) { const int i = i0 + ii; const bf16x8 r3 = rr[ii]; float o[8];
#pragma unroll
            for (int e = 0; e < 8; ++e) { const float a = bs[e] + w[0][e] * bf2f((unsigned short)r0[e]) + w[1][e] * bf2f((unsigned short)r1[e]) + w[2][e] * bf2f((unsigned short)r2[e]) + w[3][e] * bf2f((unsigned short)r3[e]); o[e] = silu_f(a); }
            v4u pw; pw.x = pk2(o[0], o[1]); pw.y = pk2(o[2], o[3]); pw.z = pk2(o[4], o[5]); pw.w = pk2(o[6], o[7]);
            *(v4u*)(XC + (size_t)(m0 + i) * 2048 + ch) = pw; r0 = r1; r1 = r2; r2 = r3; } }
    }
}
constexpr int S_CS = 0, S_BS = 17408, S_BST = 34816, S_XT = 53248, S_XWT = 57856, S_XS = 62464, S_GG = 67584, S_SBF = 76800, S_DTA = 85504;
constexpr int F_CS = 0, F_BS = 17408, F_BST = 34816, F_XT = 53248, F_XWT = 62464, F_XS = 71680, F_GG = 80896, F_SBF = 90112, F_DTA = 107520;
template <bool DRY> __device__ __forceinline__ void ssd_unit(const Args& A, char* lds, int b, int h) {
    const int tid = opaque_tid(), lane = tid & 63, wave = __builtin_amdgcn_readfirstlane(tid >> 6); const int fr = lane & 15, fq = lane >> 4;
    bf16* P0 = (bf16*)(A.ws + WS_BIG); const bf16* XC = (const bf16*)A.out; const float* DT = (const float*)(A.ws + WS_DT);
    const int g = h >> 3; const int xcol = h * 64, bcol = 1024 + g * 128, ccol = 1280 + g * 128;
    bf16* CS = (bf16*)(lds + F_CS); bf16* BS = (bf16*)(lds + F_BS); bf16* BST = (bf16*)(lds + F_BST); bf16* XT = (bf16*)(lds + F_XT); bf16* XWT = (bf16*)(lds + F_XWT);
    bf16* XS = (bf16*)(lds + F_XS); bf16* GG = (bf16*)(lds + F_GG); bf16* SBF = (bf16*)(lds + F_SBF); float* DTA0 = (float*)(lds + F_DTA);
    for (int i = tid; i < 64 * 136; i += NTHR) SBF[i] = 0;
    const float Ah = -__expf(A.in[I_EALOG][h]), Dh = A.in[I_EDSKIP][h];
    const int lt = wave >> 1, pt0 = 2 * (wave & 1), st0 = 2 * (wave & 1), nt0 = (wave >> 1) * 2;
    f32x4m sta[2][2];
#pragma unroll
    for (int pi = 0; pi < 2; ++pi)
#pragma unroll
        for (int ni = 0; ni < 2; ++ni) sta[pi][ni] = (f32x4m){0.f, 0.f, 0.f, 0.f};
    const size_t rb0 = (size_t)b * SEQL;
    const bf16* pB = XC + (rb0 + (tid >> 4)) * 2048 + bcol + (tid & 15) * 8; const bf16* pC = XC + (rb0 + (tid >> 4)) * 2048 + ccol + (tid & 15) * 8; const bf16* pX = XC + (rb0 + (tid >> 3)) * 2048 + xcol + (tid & 7) * 8;
    const bf16* pZ = P0 + (rb0 + lt * 16 + 4 * fq) * LD0 + C0_ZA + h * 64 + pt0 * 16 + fr;
    bf16x8 pre[5]; float dtn = 0.f;
    pre[0] = *(const bf16x8*)pB; pre[1] = *(const bf16x8*)(pB + 32 * 2048); pre[2] = *(const bf16x8*)pC; pre[3] = *(const bf16x8*)(pC + 32 * 2048); pre[4] = *(const bf16x8*)pX;
    unsigned short zn[2][4], gts[2][4]; float sqs[2][4];
#pragma unroll
    for (int pi = 0; pi < 2; ++pi)
#pragma unroll
        for (int r = 0; r < 4; ++r) { zn[pi][r] = pZ[(size_t)r * LD0 + 16 * pi]; gts[pi][r] = 0; sqs[pi][r] = 0.f; }
    if (wave == 0) { dtn = DT[(rb0 + lane) * 16 + h]; const float s = wave_scan(Ah * dtn, lane); const float tot = rdlane(s, 63);
        DTA0[lane] = dtn; DTA0[64 + lane] = s; DTA0[128 + lane] = __expf(s); DTA0[192 + lane] = __expf(tot - s); dtn = DT[(rb0 + 64 + lane) * 16 + h]; }
    BAR_LDS();
    for (int c = 0; c < SEQL / 64; ++c) {
        const size_t m0 = rb0 + c * 64; float* DTA = DTA0 + (c & 1) * 256;
        { const int t = tid >> 4, c8 = tid & 15;
          *(bf16x8*)(BS + t * 136 + c8 * 8) = pre[0]; *(bf16x8*)(BS + (t + 32) * 136 + c8 * 8) = pre[1]; *(bf16x8*)(CS + t * 136 + c8 * 8) = pre[2]; *(bf16x8*)(CS + (t + 32) * 136 + c8 * 8) = pre[3];
          const int sw0 = ((((t >> 3) ^ (c8 & 7)) << 3) + (t & 7)), sw1 = (((((t + 32) >> 3) ^ (c8 & 7)) << 3) + (t & 7));
#pragma unroll
          for (int e = 0; e < 8; ++e) { BST[(c8 * 8 + e) * 72 + sw0] = (bf16)pre[0][e]; BST[(c8 * 8 + e) * 72 + sw1] = (bf16)pre[1][e]; }
          const int tx = tid >> 3, cx = tid & 7; *(bf16x8*)(XS + tx * 72 + cx * 8) = pre[4]; const float dtv = DTA[tx], wv = DTA[192 + tx]; const int sx = ((((tx >> 3) ^ cx) << 3) + (tx & 7));
#pragma unroll
          for (int e = 0; e < 8; ++e) { const float xd = bf2f((unsigned short)pre[4][e]) * dtv; XT[(cx * 8 + e) * 72 + sx] = (bf16)f2bf(xd); XWT[(cx * 8 + e) * 72 + sx] = (bf16)f2bf(xd * wv); } }
        if (c > 0) {
#pragma unroll
            for (int pi = 0; pi < 2; ++pi)
#pragma unroll
                for (int r = 0; r < 4; ++r) { const int l = lt * 16 + 4 * fq + r;
                    if (!DRY || sqs[pi][r] == 1.2345e30f) { ((bf16*)pZ)[((size_t)(c - 1) * 64 + r) * LD0 + 16 * pi] = gts[pi][r];
                        if (fr == 0) ((float*)((unsigned char*)A.out + (m0 - 64 + l) * 4096 + 3072))[h * 4 + pt0 + pi] = sqs[pi][r]; } } }
        if (c + 1 < SEQL / 64) { const size_t o = (size_t)(c + 1) * 64 * 2048;
            pre[0] = *(const bf16x8*)(pB + o); pre[1] = *(const bf16x8*)(pB + o + 32 * 2048); pre[2] = *(const bf16x8*)(pC + o); pre[3] = *(const bf16x8*)(pC + o + 32 * 2048); pre[4] = *(const bf16x8*)(pX + o); }
        unsigned short zv[2][4];
#pragma unroll
        for (int pi = 0; pi < 2; ++pi)
#pragma unroll
            for (int r = 0; r < 4; ++r) zv[pi][r] = zn[pi][r];
        if (c + 1 < SEQL / 64) {
#pragma unroll
            for (int pi = 0; pi < 2; ++pi)
#pragma unroll
                for (int r = 0; r < 4; ++r) zn[pi][r] = pZ[((size_t)(c + 1) * 64 + r) * LD0 + 16 * pi]; }
        BAR_LDS();
        f32x4m cb[2], ya[2]; cb[0] = (f32x4m){0.f, 0.f, 0.f, 0.f}; cb[1] = cb[0]; ya[0] = cb[0]; ya[1] = cb[0];
#pragma unroll
        for (int ks = 0; ks < 4; ++ks) { const bf16x8 af = *(const bf16x8*)(CS + (lt * 16 + fr) * 136 + ks * 32 + 8 * fq);
#pragma unroll
            for (int si = 0; si < 2; ++si) { const bf16x8 bfv = *(const bf16x8*)(BS + ((st0 + si) * 16 + fr) * 136 + ks * 32 + 8 * fq); cb[si] = __builtin_amdgcn_mfma_f32_16x16x32_bf16(af, bfv, cb[si], 0, 0, 0); }
#pragma unroll
            for (int pi = 0; pi < 2; ++pi) { const bf16x8 sf = *(const bf16x8*)(SBF + ((pt0 + pi) * 16 + fr) * 136 + ks * 32 + 8 * fq); ya[pi] = __builtin_amdgcn_mfma_f32_16x16x32_bf16(af, sf, ya[pi], 0, 0, 0); } }
#pragma unroll
        for (int r = 0; r < 4; ++r) { const int l = lt * 16 + 4 * fq + r; const float al = DTA[64 + l];
#pragma unroll
            for (int si = 0; si < 2; ++si) { const int s = (st0 + si) * 16 + fr; const float v = (s <= l) ? cb[si][r] * __expf(al - DTA[64 + s]) : 0.f; GG[l * 72 + s] = (bf16)f2bf(v); }
            const float ea = DTA[128 + l]; ya[0][r] *= ea; ya[1][r] *= ea; }
        const float decay = __expf(DTA[64 + 63]);
        BAR_LDS();
#pragma unroll
        for (int ks = 0; ks < 2; ++ks) { const bf16x8 gf = *(const bf16x8*)(GG + (lt * 16 + fr) * 72 + ks * 32 + 8 * fq);
#pragma unroll
            for (int pi = 0; pi < 2; ++pi) { const int p = (pt0 + pi) * 16 + fr; const bf16x8 xf = *(const bf16x8*)(XT + p * 72 + (((ks * 4 + fq) ^ ((p >> 3) & 7)) << 3)); ya[pi] = __builtin_amdgcn_mfma_f32_16x16x32_bf16(gf, xf, ya[pi], 0, 0, 0); } }
#pragma unroll
        for (int pi = 0; pi < 2; ++pi)
#pragma unroll
            for (int ni = 0; ni < 2; ++ni) sta[pi][ni] = sta[pi][ni] * decay;
#pragma unroll
        for (int ks = 0; ks < 2; ++ks) { bf16x8 bt[2];
#pragma unroll
            for (int ni = 0; ni < 2; ++ni) { const int n = (nt0 + ni) * 16 + fr; bt[ni] = *(const bf16x8*)(BST + n * 72 + (((ks * 4 + fq) ^ ((n >> 3) & 7)) << 3)); }
#pragma unroll
            for (int pi = 0; pi < 2; ++pi) { const int p = (pt0 + pi) * 16 + fr; const bf16x8 xw = *(const bf16x8*)(XWT + p * 72 + (((ks * 4 + fq) ^ ((p >> 3) & 7)) << 3));
#pragma unroll
                for (int ni = 0; ni < 2; ++ni) sta[pi][ni] = __builtin_amdgcn_mfma_f32_16x16x32_bf16(xw, bt[ni], sta[pi][ni], 0, 0, 0); } }
#pragma unroll
        for (int pi = 0; pi < 2; ++pi)
#pragma unroll
            for (int ni = 0; ni < 2; ++ni)
#pragma unroll
                for (int r = 0; r < 4; ++r) SBF[((pt0 + pi) * 16 + 4 * fq + r) * 136 + (nt0 + ni) * 16 + fr] = (bf16)f2bf(sta[pi][ni][r]);
#pragma unroll
        for (int pi = 0; pi < 2; ++pi)
#pragma unroll
            for (int r = 0; r < 4; ++r) { const int l = lt * 16 + 4 * fq + r, p = (pt0 + pi) * 16 + fr;
                const float y = ya[pi][r] + Dh * bf2f(XS[l * 72 + p]);
                const float z = bf2f(zv[pi][r]); const float gt = y * silu_f(z);
                gts[pi][r] = (unsigned short)f2bf(gt); sqs[pi][r] = row_sum16(gt * gt); }
        if (wave == 0 && c + 1 < SEQL / 64) { float* DN = DTA0 + ((c + 1) & 1) * 256; const float s = wave_scan(Ah * dtn, lane); const float tot = rdlane(s, 63);
            DN[lane] = dtn; DN[64 + lane] = s; DN[128 + lane] = __expf(s); DN[192 + lane] = __expf(tot - s);
            if (c + 2 < SEQL / 64) dtn = DT[(m0 + 128 + lane) * 16 + h]; }
        BAR_LDS();
    }
#pragma unroll
    for (int pi = 0; pi < 2; ++pi)
#pragma unroll
        for (int r = 0; r < 4; ++r) { const int l = lt * 16 + 4 * fq + r;
            if (!DRY || sqs[pi][r] == 1.2345e30f) { ((bf16*)pZ)[((size_t)(SEQL / 64 - 1) * 64 + r) * LD0 + 16 * pi] = gts[pi][r];
                if (fr == 0) ((float*)((unsigned char*)A.out + (rb0 + SEQL - 64 + l) * 4096 + 3072))[h * 4 + pt0 + pi] = sqs[pi][r]; } }
}
__device__ __forceinline__ void p2c_fixup(const Args& A, int vcu, int G) {
    const int tid = opaque_tid(), lane = tid & 63, wave = tid >> 6; bf16* P0 = (bf16*)(A.ws + WS_BIG); const float* ssq = (const float*)(A.ws + WS_SSQ);
    f32x4 gn[4];
#pragma unroll
    for (int j = 0; j < 4; ++j) gn[j] = *((const f32x4*)A.in[I_ENORMG] + lane + 64 * j);
    for (int m = vcu * NWAVES + wave; m < MROWS; m += G * NWAVES) { const float r = rsqrtf(wave_sum(((const float*)((const unsigned char*)A.out + (size_t)m * 4096 + 3072))[lane]) * (1.f / 1024.f) + RMS_EPS);
        v2u* p = (v2u*)(P0 + (size_t)m * LD0 + C0_ZA) + lane;
#pragma unroll
        for (int j = 0; j < 4; ++j) { const v2u w = p[64 * j]; v2u o; o.x = pk2(__uint_as_float(w.x << 16) * r * gn[j].x, __uint_as_float(w.x & 0xffff0000u) * r * gn[j].y);
            o.y = pk2(__uint_as_float(w.y << 16) * r * gn[j].z, __uint_as_float(w.y & 0xffff0000u) * r * gn[j].w); p[64 * j] = o; } }
}
__device__ __forceinline__ void p5a_fcum(const Args& A, char* lds, int G) {
    const int tid = opaque_tid(), lane = tid & 63, wave = tid >> 6; const float* LF = (const float*)(A.ws + WS_LF); float* F2 = (float*)(A.ws + WS_F2); float* wtot = (float*)(lds + 120 * 1024);
    for (int item = blockIdx.x; item < NB * 24; item += G) { const int b = item / 24, h = item % 24; const float fb = A.in[I_OFGB][h];
        float v[4]; float run = 0.f;
#pragma unroll
        for (int i = 0; i < 4; ++i) { const size_t ix = ((size_t)b * SEQL + 4 * tid + i) * 24 + h; const float* L1p = (const float*)(A.ws + WS_LFP);
            const float fr_ = (LF[ix] + L1p[ix]) + (L1p[ix + (size_t)MROWS * 24] + L1p[ix + (size_t)2 * MROWS * 24]) + fb; run += -softplus_g(-fr_); v[i] = run; }
        float s = run;
#pragma unroll
        for (int o = 1; o < 64; o <<= 1) { const float x = __shfl_up(s, o); if (lane >= o) s += x; }
        __syncthreads();
        if (lane == 63) wtot[wave] = s;
        __syncthreads();
        float off = s - run; for (int w = 0; w < wave; ++w) off += wtot[w];
#pragma unroll
        for (int i = 0; i < 4; ++i) { const float f2v = (off + v[i]) * LOG2E; const int t = 4 * tid + i; F2[(size_t)item * SEQL + t] = f2v;
            if ((t & 127) == 127) wtot[64 + (t >> 7)] = f2v; if ((t & 255) == 0) wtot[96 + (t >> 8)] = f2v; }
        { const bf16* P1 = (const bf16*)(A.ws + WS_BIG); float qm = 0.f, km = 0.f;
#pragma unroll 8
          for (int i = 0; i < 32; ++i) { const size_t m = (size_t)b * SEQL + (tid >> 3) + 64 * i; const int c8 = tid & 7; float qs = 0.f, ks2 = 0.f;
              const bf16x8 qv = *(const bf16x8*)(P1 + m * LD1 + C1_Q + h * 64 + c8 * 8), kv = *(const bf16x8*)(P1 + m * LD1 + C1_K + h * 64 + c8 * 8);
#pragma unroll
              for (int e = 0; e < 8; ++e) { const float qf = bf2f((unsigned short)qv[e]), kf = bf2f((unsigned short)kv[e]); qs += qf * qf; ks2 += kf * kf; }
              qs += dppf<0xB1>(qs, qs); qs += dppf<0x4E>(qs, qs); qs += dppf<0x141>(qs, qs); ks2 += dppf<0xB1>(ks2, ks2); ks2 += dppf<0x4E>(ks2, ks2); ks2 += dppf<0x141>(ks2, ks2);
              qm = fmaxf(qm, qs); km = fmaxf(km, ks2); }
#pragma unroll
          for (int o = 1; o < 64; o <<= 1) { qm = fmaxf(qm, __shfl_xor(qm, o)); km = fmaxf(km, __shfl_xor(km, o)); }
          __syncthreads();
          if (lane == 0) { wtot[16 + wave] = qm; wtot[32 + wave] = km; }
          __syncthreads();
          if (tid < 8) { float a = 0.f, c = 0.f; for (int w = 0; w < 8; ++w) { a = fmaxf(a, wtot[16 + w]); c = fmaxf(c, wtot[32 + w]); } const float u2 = 2.f * sqrtf(a) * sqrtf(c) * 1.01f;
              const int qb = tid; const float fi0 = wtot[96 + qb]; int ts = 0; while (ts + 2 <= 4 * qb && u2 - (wtot[64 + (ts >> 1)] - fi0) <= -40.f) ts += 2;
              ((int*)(A.ws + WS_TS))[item * 8 + qb] = ts; } }
    }
    __syncthreads();
}
constexpr int S5_BU = 0  , S5_SS = 67584  , S5_US = 102400  ;
__device__ __forceinline__ float gelu_tanh(float x) { const float u = 0.7978845608028654f * (x + 0.044715f * x * x * x); const float e = __expf(2.f * u); const float t = 1.f - 2.f * __builtin_amdgcn_rcpf(e + 1.f); return 0.5f * x * (1.f + t); }
__device__ __forceinline__ void s5_unit(const Args& A, char* lds, int b, int g) {
    const int tid = opaque_tid(), lane = tid & 63, wave = __builtin_amdgcn_readfirstlane(tid >> 6); const int fr = lane & 15, fq = lane >> 4, r32 = lane & 31, hi = lane >> 5;
    const bf16* P1 = (const bf16*)(A.ws + WS_BIG); bf16* YD = (bf16*)A.out;
    const unsigned char* pg = A.ws + WS_S5P + (size_t)g * S5P_STRIDE; const bf16* BbT = (const bf16*)pg; const bf16* Cm = (const bf16*)(pg + 4096); const float* ari = (const float*)(pg + 8192);
    const int ttile = wave >> 2, ntile = wave & 3;
    const bf16x8 bfrag = *(const bf16x8*)(BbT + (ntile * 32 + r32) * 16 + 8 * hi);
    bf16x8 cfrag[4];
#pragma unroll
    for (int ks = 0; ks < 4; ++ks) cfrag[ks] = *(const bf16x8*)(Cm + fr * 128 + ks * 32 + 8 * fq);
    const float ar = ari[lane], ai = ari[64 + lane]; float sr = 0.f, si = 0.f;
    const float dskip = A.in[I_ODSKIP][g * 16 + fr];
    const size_t rb0 = (size_t)b * SEQL; const bf16* pU = P1 + (rb0 + ttile * 32 + r32) * LD1 + C1_U + g * 16 + 8 * hi;
    bf16x8 un = *(const bf16x8*)pU;
    BAR_LDS();
    for (int i = 0; i < SEQL / 64 + 2; ++i) {
        if (i < SEQL / 64) { float* BU = (float*)(lds + S5_BU) + (i & 1) * (64 * 132); f32x16 acc = {};
            acc = __builtin_amdgcn_mfma_f32_32x32x16_bf16(un, bfrag, acc, 0, 0, 0);
            if (ntile == 0) *(bf16x8*)((bf16*)(lds + S5_US) + ((i & 3) * 64 + ttile * 32 + r32) * 16 + 8 * hi) = un;
            if (i + 1 < SEQL / 64) un = *(const bf16x8*)(pU + (size_t)(i + 1) * 64 * LD1);
#pragma unroll
            for (int r = 0; r < 16; ++r) { const int t = ttile * 32 + (r & 3) + 8 * (r >> 2) + 4 * hi; BU[t * 132 + ntile * 32 + r32] = acc[r]; } }
        if (wave == 0 && i >= 1 && i <= SEQL / 64) { const float* BU = (const float*)(lds + S5_BU) + ((i - 1) & 1) * (64 * 132); bf16* SS = (bf16*)(lds + S5_SS) + ((i - 1) & 1) * (64 * 136);
#pragma unroll
            for (int hb = 0; hb < 2; ++hb) { f32x2_c bv[32];
#pragma unroll
                for (int t = 0; t < 32; ++t) bv[t] = *(const f32x2_c*)(BU + (hb * 32 + t) * 132 + 2 * lane);
                const f32x2_c a1 = {ar, ar}, a2 = {-ai, ai}; f32x2_c s2 = {sr, si};
#pragma unroll
                for (int t = 0; t < 32; ++t) { const f32x2_c sw = {s2.y, s2.x}; s2 = a1 * s2 + (a2 * sw + bv[t]);
                    *(unsigned*)(SS + (hb * 32 + t) * 136 + 2 * lane) = pk2(s2.x, s2.y); }
                sr = s2.x; si = s2.y; } }
        if (wave >= 4 && i >= 2) { const bf16* SS = (const bf16*)(lds + S5_SS) + ((i - 2) & 1) * (64 * 136); const int mt = wave - 4; const size_t m0 = rb0 + (size_t)(i - 2) * 64;
            unsigned short uv[4];
#pragma unroll
            for (int r = 0; r < 4; ++r) uv[r] = ((const bf16*)(lds + S5_US))[(((i - 2) & 3) * 64 + mt * 16 + 4 * fq + r) * 16 + fr];
            f32x4m acc = (f32x4m){0.f, 0.f, 0.f, 0.f};
#pragma unroll
            for (int ks = 0; ks < 4; ++ks) { const bf16x8 af = *(const bf16x8*)(SS + (mt * 16 + fr) * 136 + ks * 32 + 8 * fq); acc = __builtin_amdgcn_mfma_f32_16x16x32_bf16(af, cfrag[ks], acc, 0, 0, 0); }
#pragma unroll
            for (int r = 0; r < 4; ++r) { const size_t m = m0 + mt * 16 + 4 * fq + r; YD[m * 2048 + 1024 + g * 16 + fr] = (bf16)f2bf(gelu_tanh(acc[r] + dskip * bf2f(uv[r]))); } }
        BAR_LDS();
    }
}
template <bool DRY> __device__ __forceinline__ void moba_phase(const Args& A, char* lds, int vcu, int G) {
    const bf16* P0 = (const bf16*)(A.ws + WS_BIG); const float* kbar = (const float*)(A.ws + WS_KBAR);
    unsigned* cnt = (unsigned*)(A.ws + WS_CNT) + (DRY ? 192 : 128); volatile unsigned* lw = (volatile unsigned*)(lds + BARST_OFF + 16);
    const int tid = opaque_tid();
    if (tid == 0) lw[0] = atomicAdd(cnt, 1u);
    BAR_ALL();
    int u = __builtin_amdgcn_readfirstlane((int)lw[0]);
    while (u < NB * 16 * 8) {
        unsigned nxt = 0u; if (tid == 0) nxt = atomicAdd(cnt, 1u);
        const int qb = 7 - u / 128, bh = u % 128, b = bh >> 4, h = bh & 15;
        attn_body::attn_unit<8, 0, LD0, DRY>(b, h, qb, (const attn_body::bf16*)(P0 + C0_Q), (const attn_body::bf16*)(P0 + C0_K), (const attn_body::bf16*)(P0 + C0_V), (attn_body::bf16*)(P0 + C0_Q),
                                            (const attn_body::bf16*)(P0 + C0_ZB), kbar + (size_t)bh * 512, nullptr, lw, nxt, lds);
        BAR_LDS();
        u = __builtin_amdgcn_readfirstlane((int)lw[0]);
    }
}
template <bool DRY> __device__ __forceinline__ void fox_phase(const Args& A, char* lds, int vcu, int G) {
    const bf16* P1 = (const bf16*)(A.ws + WS_BIG); const float* F2 = (const float*)(A.ws + WS_F2); const int* TSv = (const int*)(A.ws + WS_TS);
    unsigned* cnt = (unsigned*)(A.ws + WS_CNT) + (DRY ? 64 : 0); volatile unsigned* lw = (volatile unsigned*)(lds + BARST_OFF + 16);
    const int tid = opaque_tid();
    if (tid == 0) lw[0] = atomicAdd(cnt, 1u);
    BAR_ALL();
    int u = __builtin_amdgcn_readfirstlane((int)lw[0]);
    while (u < NB * 24 * 8) {
        unsigned nxt = 0u; if (tid == 0) nxt = atomicAdd(cnt, 1u);
        const int qb = 7 - u / 192, bh = u % 192, b = bh / 24, h = bh % 24;
        attn_body::attn_unit<8, 1, LD1, DRY>(b, h, qb, (const attn_body::bf16*)(P1 + C1_Q), (const attn_body::bf16*)(P1 + C1_K), (const attn_body::bf16*)(P1 + C1_V), (attn_body::bf16*)(P1 + C1_Q),
                                            (const attn_body::bf16*)(P1 + C1_ZC), F2 + (size_t)bh * SEQL, TSv + bh * 8, lw, nxt, lds);
        BAR_LDS();
        u = __builtin_amdgcn_readfirstlane((int)lw[0]);
    }
}
#define LAS __attribute__((address_space(3)))
#define XB_TMO      128
#define XB_XCNT(j)  (256  + 64 * (j))
#define XB_XSUB(j)  (1280 + 64 * (j))
#define XB_XGEN(j)  (2304 + 64 * (j))
#define XB_TOP      3328
#define XB_TOPGEN   3392
#define XCD_BAR_WORDS 3456
#define XB_SPIN_CAP (1u << 18)

__device__ __forceinline__ unsigned xb_ld(unsigned* p)              { return __hip_atomic_load(p, __ATOMIC_RELAXED, __HIP_MEMORY_SCOPE_AGENT); }
__device__ __forceinline__ unsigned xb_add(unsigned* p, unsigned v) { return __hip_atomic_fetch_add(p, v, __ATOMIC_RELAXED, __HIP_MEMORY_SCOPE_AGENT); }
__device__ __forceinline__ unsigned xb_xcc_id() { return (unsigned)__builtin_amdgcn_s_getreg((3 << 11) | 20) & 0xFu; }
#define XB_SPIN(cond, bar) do { unsigned _sp = 0; while (cond) { __builtin_amdgcn_s_sleep(1); \
    if ((++_sp & 255u) == 0u) { if (xb_ld(&(bar)[XB_TMO])) break; if (_sp > XB_SPIN_CAP) { atomicAdd(&(bar)[XB_TMO], 1u); break; } } } } while (0)

struct XcdBarrier {
    unsigned* bar; unsigned x;
    volatile LAS unsigned* st;
};

__device__ __forceinline__ XcdBarrier xcd_barrier_post(unsigned* bar, volatile LAS unsigned* st) {
    XcdBarrier b; b.bar = bar; b.x = xb_xcc_id(); b.st = st;
    if (threadIdx.x == 0) (void)xb_add(&bar[XB_XCNT(b.x)], 1u);
    return b;
}
__device__ __forceinline__ void xcd_barrier_complete(unsigned* bar, unsigned x, unsigned& nloc, unsigned& nx) {
    const unsigned G = gridDim.x * gridDim.y * gridDim.z;
    unsigned sum, cnt, mine, sp = 0u;
    for (;;) {
        sum = 0u; cnt = 0u; mine = 0u;
#pragma unroll
        for (unsigned j = 0; j < 16; ++j) { const unsigned c = xb_ld(&bar[XB_XCNT(j)]); sum += c; cnt += (c > 0u) ? 1u : 0u; mine = (j == x) ? c : mine; }
        if (sum == G) break;
        __builtin_amdgcn_s_sleep(1);
        if ((++sp & 255u) == 0u) { if (xb_ld(&bar[XB_TMO])) break; if (sp > XB_SPIN_CAP) { atomicAdd(&bar[XB_TMO], 1u); break; } }
    }
    nloc = mine > 0u ? mine : 1u; nx = cnt > 0u ? cnt : 1u;
}

__device__ __forceinline__ void xcd_barrier(const XcdBarrier& b) {
    asm volatile("s_waitcnt vmcnt(0)" ::: "memory");
    __syncthreads();
    if (threadIdx.x == 0) {
        unsigned* bar = b.bar;
        __builtin_amdgcn_s_waitcnt(0);
        unsigned nloc = b.st[0], nx = b.st[1];
        if (nloc == 0u) { xcd_barrier_complete(bar, b.x, nloc, nx); b.st[0] = nloc; b.st[1] = nx; }
        const unsigned old = xb_add(&bar[XB_XSUB(b.x)], 1u);
        const unsigned gen = old / nloc;
        if (old + 1u == (gen + 1u) * nloc) {
            __builtin_amdgcn_fence(__ATOMIC_RELEASE, "agent");
            asm volatile("s_waitcnt vmcnt(0)" ::: "memory");
            const unsigned og = xb_add(&bar[XB_TOP], 1u);
            const unsigned tg = og / nx;
            if (og + 1u == (tg + 1u) * nx) xb_add(&bar[XB_TOPGEN], 1u);
            else XB_SPIN(xb_ld(&bar[XB_TOPGEN]) == tg, bar);
            __builtin_amdgcn_fence(__ATOMIC_ACQUIRE, "agent");
            xb_add(&bar[XB_XGEN(b.x)], 1u);
            asm volatile("s_waitcnt vmcnt(0)" ::: "memory");
        } else {
            XB_SPIN(xb_ld(&bar[XB_XGEN(b.x)]) == gen, bar);
            __builtin_amdgcn_fence(__ATOMIC_ACQUIRE, "agent");
            asm volatile("s_waitcnt vmcnt(0)" ::: "memory");
        }
    }
    __syncthreads();
}

constexpr int ARGS_OFF = 132096;
__device__ __forceinline__ Args get_args(const unsigned char* lds) {
    Args a; const unsigned long long* p = (const unsigned long long*)(lds + ARGS_OFF);
#pragma unroll
    for (int i = 0; i < 29; ++i) { const unsigned long long v = p[i]; const unsigned lo = __builtin_amdgcn_readfirstlane((unsigned)v), hi = __builtin_amdgcn_readfirstlane((unsigned)(v >> 32));
        const unsigned long long w = ((unsigned long long)hi << 32) | lo; if (i < 27) a.in[i] = (const float*)w; else if (i == 27) a.out = (float*)w; else a.ws = (unsigned char*)w; }
    return a;
}
#define PHASE_BEGIN { const Args args = get_args(lds); unsigned char* ws = args.ws; bf16* XN = (bf16*)args.out; bf16* PB = (bf16*)(ws + WS_BIG); (void)ws; (void)XN; (void)PB;
#ifdef DUP_SYNC
#define PHASE_END } xcd_barrier(xbar); xcd_barrier(xbar);
#else
#define PHASE_END } xcd_barrier(xbar);
#endif
#define PHASE_END_NOSYNC }
__global__ void __launch_bounds__(NTHR, 2) trunk_fwd(Args kargs_unused) {
    extern __shared__ __attribute__((aligned(16))) unsigned char lds[];
    cg::grid_group grid = cg::this_grid();
    const int G = gridDim.x, bx = blockIdx.x; const int vcu = (G % 8 == 0) ? (bx % 8) * (G / 8) + bx / 8 : bx;
    char* ldsc = (char*)lds; PG8_LAS unsigned char* ldsg = (PG8_LAS unsigned char*)lds;
    { const int t = opaque_tid(); if (t < 29) { const unsigned long long* ka = (const unsigned long long*)__builtin_amdgcn_kernarg_segment_ptr(); ((unsigned long long*)(lds + ARGS_OFF))[t] = ka[t]; }
      if (t < 2) ((unsigned*)(lds + BARST_OFF))[t] = 0u; }
    __syncthreads();
    XcdBarrier xbar;
    {
    const Args args = get_args(lds);
    unsigned* rdy = (unsigned*)(args.ws + WS_BAR) + 4160;
    if (bx == 0) { unsigned* bw = (unsigned*)(args.ws + WS_BAR); for (int i = opaque_tid(); i < 4096; i += NTHR) bw[i] = 0u;
        asm volatile("s_waitcnt vmcnt(0)" ::: "memory"); __syncthreads();
        if (opaque_tid() == 0) { __builtin_amdgcn_fence(__ATOMIC_RELEASE, "agent"); asm volatile("s_waitcnt vmcnt(0)" ::: "memory"); __hip_atomic_store(rdy, 0x600DF00Du, __ATOMIC_RELAXED, __HIP_MEMORY_SCOPE_AGENT); } }
    if (G > 0x40000000) grid.sync();
    p0_prologue(args, ldsc, vcu, G);
    if (opaque_tid() == 0) { unsigned sp = 0; while (__hip_atomic_load(rdy, __ATOMIC_RELAXED, __HIP_MEMORY_SCOPE_AGENT) != 0x600DF00Du && ++sp < (1u << 22)) __builtin_amdgcn_s_sleep(2);
        __builtin_amdgcn_fence(__ATOMIC_ACQUIRE, "agent"); asm volatile("s_waitcnt vmcnt(0)" ::: "memory"); }
    __syncthreads();
    xbar = xcd_barrier_post((unsigned*)(args.ws + WS_BAR), (volatile LAS unsigned*)(lds + BARST_OFF));
    xcd_barrier(xbar);
    if (bx == 0 && opaque_tid() == 0) __hip_atomic_store(rdy, 0u, __ATOMIC_RELAXED, __HIP_MEMORY_SCOPE_AGENT);
    }
    PHASE_BEGIN
    p1a_rows(args, ldsc, G);
#ifdef DUP_MISC
    p1a_rows(args, ldsc, G);
#endif
    PHASE_END
    PHASE_BEGIN
    { pg8::Gemm g{XN, (const bf16*)(ws + WS_WT0), MROWS, NP0, 1024, 2048, 1024, 0}; pg8::StaticOrder S; S.init(MROWS, NP0, G, bx);
      pg8::EpiX<0> E{PB, LD0, args.in[I_EDTB], (float*)(ws + WS_DT), nullptr, nullptr, attn_body::C2};
      pg8::gemm_phase<pg8::EpiX<0>, pg8::StaticOrder, true, true>(ldsg, g, S, E); }
#ifdef DUP_GEMM
    { pg8::Gemm g{XN, (const bf16*)(ws + WS_WT0), MROWS, NP0, 1024, 2048, 1024, 0}; pg8::StaticOrder S; S.init(MROWS, NP0, G, bx);
      pg8::EpiX<0> E{PB, LD0, args.in[I_EDTB], (float*)(ws + WS_DT), nullptr, nullptr, attn_body::C2};
      pg8::gemm_phase<pg8::EpiX<0>, pg8::StaticOrder, true, true>(ldsg, g, S, E); }
#endif
    PHASE_END
    PHASE_BEGIN
    p2a_kbar(args, ldsc, G);
    p2a_conv(args, G);
#ifdef DUP_MISC
    p2a_kbar(args, ldsc, G);
    p2a_conv(args, G);
#endif
    PHASE_END
    PHASE_BEGIN
    if (G == 256) { if ((bx >> 3) < 16) ssd_unit<false>(args, ldsc, bx & 7, bx >> 3); }
    else for (int v = vcu; v < 128; v += G) ssd_unit<false>(args, ldsc, v >> 4, v & 15);
    PHASE_END_NOSYNC
    PHASE_BEGIN
#ifdef DUP_MOBA
    moba_phase<true>(args, ldsc, vcu, G);
#endif
    moba_phase<false>(args, ldsc, vcu, G);
    PHASE_END
    if (G != 256) {
    PHASE_BEGIN
    p2c_fixup(args, vcu, G);
    PHASE_END
    }
    PHASE_BEGIN
    { pg8::Gemm g{PB, (const bf16*)(ws + WS_WO0), MROWS, 1024, 2048, LD0, 2048, 0}; pg8::StaticOrder S; S.init(MROWS, 1024, G, bx);
      { pg8::Unit u0; u0.pm = 0; u0.pn = 0; const bool have = S.next(0, u0); const int pm0 = u0.pm; float* rs = (float*)(lds + 131072); const int t = opaque_tid();
        if (t < 256) { float r = 1.f;
            if (G == 256 && have) { const f32x4* pp = (const f32x4*)((const unsigned char*)args.out + (size_t)(pm0 * 256 + t) * 4096 + 3072); float sm = 0.f;
#pragma unroll
                for (int i = 0; i < 16; ++i) { const f32x4 v = pp[i]; sm += (v.x + v.y) + (v.z + v.w); }
                r = rsqrtf(sm * (1.f / 1024.f) + RMS_EPS); }
            rs[t] = r; }
        __syncthreads(); }
      pg8::EpiX<5> E{XN, 2048, nullptr, nullptr, nullptr, nullptr, 1.f};
      pg8::gemm_phase<pg8::EpiX<5>, pg8::StaticOrder, true, true>(ldsg, g, S, E); }
    PHASE_END
    PHASE_BEGIN
    p3b_rows(args, ldsc, G);
#ifdef DUP_MISC
    p3b_rows(args, ldsc, G);
#endif
    PHASE_END
    PHASE_BEGIN
    { pg8::Gemm g{XN + 1024, (const bf16*)(ws + WS_WT1), MROWS, LD1, 1024, 2048, 1024, 0}; pg8::StaticOrder S; S.init(MROWS, LD1, G, bx);
      pg8::EpiX<1> E{PB, LD1, nullptr, nullptr, nullptr, nullptr, attn_body::C2};
      pg8::gemm_phase<pg8::EpiX<1>, pg8::StaticOrder, true, true>(ldsg, g, S, E); }
    { pg8::Gemm g{XN + 1024, (const bf16*)(ws + WS_WT1) + (size_t)LD1 * 1024, MROWS, 1024, 256, 2048, 1024, 1}; pg8::StaticOrder S; S.init(MROWS, 1024, G, bx);
      pg8::EpiX<4> E{nullptr, 0, nullptr, (float*)(ws + WS_LF), (const bf16*)(ws + WS_LFP), nullptr, 1.f};
      pg8::gemm_phase<pg8::EpiX<4>, pg8::StaticOrder, true, true>(ldsg, g, S, E); }
#ifdef DUP_GEMM
    { pg8::Gemm g{XN + 1024, (const bf16*)(ws + WS_WT1), MROWS, LD1, 1024, 2048, 1024, 0}; pg8::StaticOrder S; S.init(MROWS, LD1, G, bx);
      pg8::EpiX<1> E{PB, LD1, nullptr, nullptr, nullptr, nullptr, attn_body::C2};
      pg8::gemm_phase<pg8::EpiX<1>, pg8::StaticOrder, true, true>(ldsg, g, S, E); }
#endif
    PHASE_END
    PHASE_BEGIN
    p5a_fcum(args, ldsc, G);
#ifdef DUP_S5
    p5a_fcum(args, ldsc, G);
#endif
    for (int v = vcu; v < 256; v += G) s5_unit(args, ldsc, v >> 5, v & 31);
#ifdef DUP_S5
    for (int v = vcu; v < 256; v += G) s5_unit(args, ldsc, v >> 5, v & 31);
#endif
    PHASE_END
    PHASE_BEGIN
#ifdef DUP_FOX
    fox_phase<true>(args, ldsc, vcu, G);
#endif
    if (vcu < 128) { pg8::Gemm g{XN + 1024, (const bf16*)(ws + WS_WG), MROWS, 512, 512, 2048, 512, 0}; pg8::StaticOrder S; S.init(MROWS, 512, 128, vcu);
      pg8::EpiX<3> E{PB + C1_U, LD1, args.in[I_OGLUB], nullptr, XN + 1024, PB + C1_ZD, 1.f};
      pg8::gemm_phase<pg8::EpiX<3>, pg8::StaticOrder, true, true>(ldsg, g, S, E); }
    fox_phase<false>(args, ldsc, vcu, G);
    PHASE_END
    PHASE_BEGIN
    { pg8::Gemm g{PB, (const bf16*)(ws + WS_WO1), MROWS, 1024, 2048, LD1, 2048, 0}; pg8::StaticOrder S; S.init(MROWS, 1024, G, bx);
      pg8::EpiX<2> E{XN + 1024, 2048, nullptr, nullptr, nullptr, nullptr, 1.f};
      pg8::gemm_phase<pg8::EpiX<2>, pg8::StaticOrder, true, true>(ldsg, g, S, E); }
#ifdef DUP_GEMM
    { pg8::Gemm g{PB, (const bf16*)(ws + WS_WO1), MROWS, 1024, 2048, LD1, 2048, 0}; pg8::StaticOrder S; S.init(MROWS, 1024, G, bx);
      pg8::EpiX<2> E{XN + 1024, 2048, nullptr, nullptr, nullptr, nullptr, 1.f};
      pg8::gemm_phase<pg8::EpiX<2>, pg8::StaticOrder, true, true>(ldsg, g, S, E); }
#endif
    PHASE_END
    PHASE_BEGIN
    p6b_rows(args, ldsc, G);
    PHASE_END_NOSYNC
}

extern "C" void kernel_launch(void* const* d_in, const int* in_sizes, int n_in, void* d_out, int out_size, void* d_ws, size_t ws_size, hipStream_t stream) {
    static int grid = 0;
    if (grid == 0) {
        if (n_in != 27 || out_size != MROWS * DMOD || ws_size < (size_t)256 * MiB) { fprintf(stderr, "kernel_launch: unexpected shapes n_in %d out %d ws %zu\n", n_in, out_size, ws_size); grid = -1; return; }
        int dev = 0, cus = 0, per_cu = 0;
        (void)hipGetDevice(&dev); (void)hipDeviceGetAttribute(&cus, hipDeviceAttributeMultiprocessorCount, dev);
        if (hipFuncSetAttribute((const void*)trunk_fwd, hipFuncAttributeMaxDynamicSharedMemorySize, LDS_BYTES) != hipSuccess) { fprintf(stderr, "kernel_launch: hipFuncSetAttribute failed\n"); }
        if (hipOccupancyMaxActiveBlocksPerMultiprocessor(&per_cu, (const void*)trunk_fwd, NTHR, LDS_BYTES) != hipSuccess || per_cu < 1) { fprintf(stderr, "kernel_launch: occupancy query says %d\n", per_cu); per_cu = 1; }
        (void)hipGetLastError();
        grid = cus * per_cu; if (grid > 256) grid = 256; if (grid < 1) grid = 256;
    }
    if (grid < 0) return;
    Args a{};
    for (int i = 0; i < 27; ++i) a.in[i] = (const float*)d_in[i];
    a.out = (float*)d_out; a.ws = (unsigned char*)d_ws;
    void* kargs[] = {&a};
    hipError_t e = hipLaunchCooperativeKernel((const void*)trunk_fwd, dim3(grid), dim3(NTHR), kargs, LDS_BYTES, stream);
    if (e != hipSuccess) fprintf(stderr, "cooperative launch failed: %s (grid %d)\n", hipGetErrorString(e), grid);
}
```

```cpp
#include <hip/hip_runtime.h>
#include <hip/hip_cooperative_groups.h>
#include <cstdio>
#include <cstdint>
namespace cg = cooperative_groups;
__device__ __forceinline__ int opaque_tid() { int t = threadIdx.x; asm volatile("" : "+v"(t)); return t; }
namespace pg8 {
#define PG8_LAS __attribute__((address_space(3)))
typedef unsigned short bf16_t;
typedef short bf16x8 __attribute__((ext_vector_type(8)));
typedef float f32x4 __attribute__((ext_vector_type(4)));
typedef unsigned u32x4 __attribute__((ext_vector_type(4)));
constexpr int BM = 256, BK = 64, HALF = 128, HTB = HALF * BK * 2  , STAGE_BYTES = 8 * HTB, NXCD = 8, WGM = 8;

__host__ __device__ __forceinline__ int lds_byte(int r, int c) { const int st = (r >> 4) * 2 + (c >> 5), rr = r & 15, cc = c & 31, ob = rr * 64 + cc * 2; return st * 1024 + (ob ^ (((ob >> 9) & 1) << 5)); }
__host__ __device__ __forceinline__ void stage_rc(int b, int& R, int& C) { const int st = b / 1024, sb = b % 1024, swz = sb ^ (((sb >> 9) & 1) << 5); R = (st >> 1) * 16 + swz / 64; C = (st & 1) * 32 + (swz % 64) / 2; }
__host__ __device__ __forceinline__ int perm32(int rho) { const int n = rho >> 4, i = rho & 15; return 8 * (i >> 2) + 4 * n + (i & 3); }

struct Unit { int pm, pn; };
struct Gemm { const bf16_t* A; const bf16_t* Bt; int M, N, K, lda, ldb, ksplit; };

struct StaticOrder {
    int nM, nN, nwg, G, c;
    __host__ __device__ __forceinline__ void init(int M, int N, int G_, int c_) { nM = M / BM; nN = N / BM; nwg = nM * nN; G = G_; c = c_; }
    __host__ __device__ __forceinline__ bool next(int i, Unit& u) const {
        const long L = (long)i * G + c; if (L >= nwg) return false;
        int wgid = (int)L; { const int q = nwg / NXCD, r = nwg % NXCD, xcd = wgid % NXCD, off = wgid / NXCD; wgid = (xcd < r ? xcd * (q + 1) : r * (q + 1) + (xcd - r) * q) + off; }
        const int nig = WGM * nN, gid = wgid / nig, fm = gid * WGM, gsz = (nM - fm) < WGM ? (nM - fm) : WGM;
        u.pm = fm + ((wgid % nig) % gsz); u.pn = (wgid % nig) / gsz; return true;
    }
    __device__ __forceinline__ void a_ready(const Unit&) const {}
    __device__ __forceinline__ void done(const Unit&) const {}
};

__device__ __forceinline__ unsigned cvt_pk_bf16(float lo, float hi) { unsigned r; asm volatile("v_cvt_pk_bf16_f32 %0, %1, %2" : "=v"(r) : "v"(lo), "v"(hi)); return r; }
__device__ __forceinline__ float bflo(unsigned w) { return __uint_as_float(w << 16); }
__device__ __forceinline__ float bfhi(unsigned w) { return __uint_as_float(w & 0xffff0000u); }
__device__ __forceinline__ float softplus_f(float x) { return x > 15.f ? x : __logf(1.f + __expf(x)); }
__device__ __forceinline__ float sigmoid_f(float x) { return __builtin_amdgcn_rcpf(1.f + __expf(-x)); }
constexpr int MROWS_ = 16384;
template <int MODE> struct EpiX {
    static constexpr bool PERM = true, AFTER_DRAIN = false; static constexpr int MIDT = (MODE == 5) ? 16 : -1;
    bf16_t* O; int ldc; const float* bias; float* F32O; const bf16_t* Y; const bf16_t* Zp; float qscale;
    __device__ __forceinline__ void mid(f32x4 (&acc)[2][2][4][2], int wr, int fr, PG8_LAS unsigned char* lds) const {
        const PG8_LAS float* rs = (const PG8_LAS float*)(lds + 131072);
#pragma unroll
        for (int ai = 0; ai < 2; ++ai)
#pragma unroll
            for (int m = 0; m < 4; ++m) { const float r = rs[ai * HALF + wr * 64 + m * 16 + fr];
#pragma unroll
                for (int bj = 0; bj < 2; ++bj)
#pragma unroll
                    for (int n = 0; n < 2; ++n) acc[ai][bj][m][n] = acc[ai][bj][m][n] * r; }
    }
    __device__ __forceinline__ void operator()(const f32x4 (&acc)[2][2][4][2], const Unit& u, int wr, int wc, int fr, int fq) const {
        const int row0 = u.pm * BM + wr * 64 + fr; const int col0 = u.pn * BM + wc * 32 + 8 * fq;
        float sc = 1.f;
        if (MODE == 0) { if (u.pn >= 4 && u.pn < 8) sc = qscale; }
        if (MODE == 1) { if (u.pn < 6) sc = qscale; }
        const bool special = (MODE == 0 && u.pn == 26);
#pragma unroll
        for (int ai = 0; ai < 2; ++ai)
#pragma unroll
            for (int m = 0; m < 4; ++m) { const int row = row0 + ai * HALF + m * 16;
#pragma unroll
                for (int bj = 0; bj < 2; ++bj) { f32x4 v0 = acc[ai][bj][m][0], v1 = acc[ai][bj][m][1]; const int col = col0 + bj * HALF;
                    if (MODE == 0 || MODE == 1) {
                        if (!special) { v0 = v0 * sc; v1 = v1 * sc; u32x4 w; w.x = cvt_pk_bf16(v0[0], v0[1]); w.y = cvt_pk_bf16(v0[2], v0[3]); w.z = cvt_pk_bf16(v1[0], v1[1]); w.w = cvt_pk_bf16(v1[2], v1[3]);
                            *(u32x4*)(O + (size_t)row * ldc + col) = w; }
                        else { const int lc = col - u.pn * BM; const int NV = (MODE == 0) ? 16 : 24;
                            if (lc < NV) { f32x4 o0, o1;
#pragma unroll
                                for (int i = 0; i < 4; ++i) { const float a0 = v0[i] + bias[lc + i], a1 = v1[i] + bias[lc + 4 + i];
                                    if (MODE == 0) { o0[i] = softplus_f(a0); o1[i] = softplus_f(a1); } else { o0[i] = -softplus_f(-a0); o1[i] = -softplus_f(-a1); } }
                                *(f32x4*)(F32O + (size_t)row * NV + lc) = o0; *(f32x4*)(F32O + (size_t)row * NV + lc + 4) = o1; } }
                    } else if (MODE == 4) {
                        const int lc = col - u.pn * BM;
                        if (lc < 24) { float* dst = (u.pn == 0 ? F32O : (float*)((unsigned char*)Y + (size_t)(u.pn - 1) * (MROWS_ * 24 * 4))) + (size_t)row * 24 + lc; *(f32x4*)dst = v0; *(f32x4*)(dst + 4) = v1; }
                    } else if (MODE == 2 || MODE == 5) {
                        u32x4 w; w.x = cvt_pk_bf16(v0[0], v0[1]); w.y = cvt_pk_bf16(v0[2], v0[3]); w.z = cvt_pk_bf16(v1[0], v1[1]); w.w = cvt_pk_bf16(v1[2], v1[3]);
                        *(u32x4*)(O + (size_t)row * ldc + col) = w;
                    } else {
                        const u32x4 yv = *(const u32x4*)(Y + (size_t)row * 2048 + col); const u32x4 zv = *(const u32x4*)(Zp + (size_t)row * ldc + col);
                        const f32x4 b0 = *(const f32x4*)(bias + col), b1 = *(const f32x4*)(bias + col + 4);
                        float r[8];
#pragma unroll
                        for (int e = 0; e < 4; ++e) { const float y0 = bflo(yv[e]), y1 = bfhi(yv[e]), z0 = bflo(zv[e]), z1 = bfhi(zv[e]);
                            const float a0 = (e < 2 ? v0[2 * e] : v1[2 * e - 4]) + (e < 2 ? b0[2 * e] : b1[2 * e - 4]);
                            const float a1 = (e < 2 ? v0[2 * e + 1] : v1[2 * e - 3]) + (e < 2 ? b0[2 * e + 1] : b1[2 * e - 3]);
                            r[2 * e] = y0 * sigmoid_f(a0) * z0 * sigmoid_f(z0); r[2 * e + 1] = y1 * sigmoid_f(a1) * z1 * sigmoid_f(z1); }
                        u32x4 w; w.x = cvt_pk_bf16(r[0], r[1]); w.y = cvt_pk_bf16(r[2], r[3]); w.z = cvt_pk_bf16(r[4], r[5]); w.w = cvt_pk_bf16(r[6], r[7]);
                        *(u32x4*)(O + (size_t)row * ldc + col) = w;
                    } } }
    }
};
template <class Epi, class Sched, bool ALIGN_EPI = false, bool SP2 = false>
__device__ __forceinline__ void gemm_phase(PG8_LAS unsigned char* lds, const Gemm g, const Sched& S, const Epi& E) {
    const int tid = opaque_tid(), wid = __builtin_amdgcn_readfirstlane(tid >> 6), lane = tid & 63, wr = wid >> 2, wc = wid & 3, fr = lane & 15, fq = lane >> 4;
    const int K = g.K, nt = K / BK;
    unsigned voffA[2], voffB[2];
#pragma unroll
    for (int i = 0; i < 2; ++i) { int R, C; stage_rc(tid * 16 + i * 8192, R, C); const int Rb = Epi::PERM ? ((R & ~31) + perm32(R & 31)) : R;
        voffA[i] = (unsigned)(R * g.lda + C) * 2u; voffB[i] = (unsigned)(Rb * g.ldb + C) * 2u; }
    const size_t kstep = (size_t)(BK * 2);
    const size_t hstepA = (size_t)HALF * g.lda * 2, hstepB = (size_t)HALF * g.ldb * 2;
    const size_t tstepA = 2 * hstepA, tstepB = g.ksplit ? (size_t)K * 2 : 2 * hstepB, kslA = g.ksplit ? (size_t)K * 2 : 0;
    const unsigned ldsw = (unsigned)wid * 1024u;
    const int aoff = lds_byte(wr * 64 + fr, fq * 8), boff = lds_byte(wc * 32 + fr, fq * 8);
#define PG8_SA(b, h) (((b) * 2 + (h)) * HTB)
#define PG8_SB(b, h) ((4 + (b) * 2 + (h)) * HTB)
#define PG8_STAGE(bufoff, gbase, voff) do { _Pragma("unroll") for (int _i = 0; _i < 2; ++_i) \
        __builtin_amdgcn_global_load_lds((const unsigned*)((const char*)(gbase) + (voff)[_i]), (PG8_LAS unsigned*)(lds + (bufoff) + ldsw + _i * 8192), 16, 0, 0); } while (0)
#define PG8_LDA(dst, b, h) do { _Pragma("unroll") for (int m = 0; m < 4; ++m) _Pragma("unroll") for (int k = 0; k < 2; ++k) dst[m][k] = *(const PG8_LAS bf16x8*)(lds + PG8_SA(b, h) + aoff + m * 2048 + k * 1024); } while (0)
#define PG8_LDB(dst, b, h) do { _Pragma("unroll") for (int n = 0; n < 2; ++n) _Pragma("unroll") for (int k = 0; k < 2; ++k) dst[n][k] = *(const PG8_LAS bf16x8*)(lds + PG8_SB(b, h) + boff + n * 2048 + k * 1024); } while (0)
#define PG8_MMA(ai, bj, At, Bt) do { __builtin_amdgcn_s_setprio(1); _Pragma("unroll") for (int m = 0; m < 4; ++m) _Pragma("unroll") for (int n = 0; n < 2; ++n) _Pragma("unroll") for (int k = 0; k < 2; ++k) \
        acc[ai][bj][m][n] = __builtin_amdgcn_mfma_f32_16x16x32_bf16(Bt[n][k], At[m][k], acc[ai][bj][m][n], 0, 0, 0); __builtin_amdgcn_s_setprio(0); } while (0)
#define PG8_WAIT_V(n) asm volatile("s_waitcnt vmcnt(" #n ")" ::: "memory")
#define PG8_WAIT_L(n) asm volatile("s_waitcnt lgkmcnt(" #n ")" ::: "memory")
#define PG8_BAR __builtin_amdgcn_s_barrier()
#define PG8_SCHED __builtin_amdgcn_sched_barrier(0)
    Unit cur, nxt; int ui = 0;
    if (!S.next(0, cur)) return;
    f32x4 acc[2][2][4][2];
#pragma unroll
    for (int a = 0; a < 2; ++a)
#pragma unroll
        for (int b = 0; b < 2; ++b)
#pragma unroll
            for (int m = 0; m < 4; ++m)
#pragma unroll
                for (int n = 0; n < 2; ++n) acc[a][b][m][n] = (f32x4){0.f, 0.f, 0.f, 0.f};
    bf16x8 At[4][2], B0[2][2], B1[2][2];
    const char* cA = (const char*)g.A + (size_t)cur.pm * tstepA + (size_t)cur.pn * kslA; const char* cB = (const char*)g.Bt + (size_t)cur.pn * tstepB;
    S.a_ready(cur);
    if constexpr (SP2) {
        PG8_STAGE(PG8_SB(0, 0), cB, voffB); PG8_STAGE(PG8_SB(0, 1), cB + hstepB, voffB); PG8_STAGE(PG8_SA(0, 0), cA, voffA); PG8_STAGE(PG8_SA(0, 1), cA + hstepA, voffA);
        if (wr == 1) PG8_BAR;
        PG8_WAIT_V(2); PG8_BAR;
        PG8_STAGE(PG8_SB(1, 0), cB + kstep, voffB); PG8_STAGE(PG8_SA(1, 0), cA + kstep, voffA); PG8_STAGE(PG8_SB(1, 1), cB + hstepB + kstep, voffB);
        PG8_WAIT_V(6); PG8_BAR;
    } else {
        PG8_STAGE(PG8_SB(0, 0), cB, voffB); PG8_STAGE(PG8_SA(0, 0), cA, voffA); PG8_STAGE(PG8_SB(0, 1), cB + hstepB, voffB); PG8_STAGE(PG8_SA(0, 1), cA + hstepA, voffA);
        if (wr == 1) PG8_BAR;
        PG8_WAIT_V(4); PG8_BAR;
        PG8_STAGE(PG8_SB(1, 0), cB + kstep, voffB); PG8_STAGE(PG8_SA(1, 0), cA + kstep, voffA); PG8_STAGE(PG8_SB(1, 1), cB + hstepB + kstep, voffB);
        PG8_WAIT_V(6); PG8_BAR;
    }
    for (;;) {
        const bool has_next = S.next(ui + 1, nxt);
        const char* nA = has_next ? (const char*)g.A + (size_t)nxt.pm * tstepA + (size_t)nxt.pn * kslA : cA; const char* nB = has_next ? (const char*)g.Bt + (size_t)nxt.pn * tstepB : cB;
        for (int t = 0; t < nt; t += 2) {
            if constexpr (Epi::MIDT >= 0) { if (t == Epi::MIDT) E.mid(acc, wr, fr, lds); }
            const bool last = (t == nt - 2);
            const char* a1 = cA + (size_t)(t + 1) * kstep;
            const char* a2 = last ? nA : cA + (size_t)(t + 2) * kstep; const char* b2 = last ? nB : cB + (size_t)(t + 2) * kstep;
            const char* a3 = a2 + kstep; const char* b3 = b2 + kstep;
            if (last && has_next) S.a_ready(nxt);
            if constexpr (SP2) {
            PG8_LDB(B0, 0, 0); PG8_LDB(B1, 0, 1); PG8_SCHED; PG8_LDA(At, 0, 0); PG8_STAGE(PG8_SA(1, 1), a1 + hstepA, voffA);
            PG8_WAIT_V(8); PG8_WAIT_L(0); PG8_BAR; PG8_MMA(0, 0, At, B0); PG8_MMA(0, 1, At, B1); PG8_BAR; PG8_SCHED;
            PG8_LDA(At, 0, 1); PG8_STAGE(PG8_SB(0, 0), b2, voffB); PG8_STAGE(PG8_SB(0, 1), b2 + hstepB, voffB); PG8_STAGE(PG8_SA(0, 0), a2, voffA);
            PG8_WAIT_V(8); PG8_WAIT_L(0); PG8_BAR; PG8_MMA(1, 0, At, B0); PG8_MMA(1, 1, At, B1); PG8_BAR; PG8_SCHED;
            PG8_LDB(B0, 1, 0); PG8_LDB(B1, 1, 1); PG8_SCHED; PG8_LDA(At, 1, 0); PG8_STAGE(PG8_SA(0, 1), a2 + hstepA, voffA);
            PG8_WAIT_V(8); PG8_WAIT_L(0); PG8_BAR; PG8_MMA(0, 0, At, B0); PG8_MMA(0, 1, At, B1); PG8_BAR; PG8_SCHED;
            PG8_LDA(At, 1, 1); PG8_STAGE(PG8_SB(1, 0), b3, voffB); PG8_STAGE(PG8_SB(1, 1), b3 + hstepB, voffB); PG8_STAGE(PG8_SA(1, 0), a3, voffA);
            PG8_WAIT_V(8); PG8_WAIT_L(0); PG8_BAR; PG8_MMA(1, 0, At, B0); PG8_MMA(1, 1, At, B1); PG8_BAR; PG8_SCHED;
            } else {
            PG8_LDB(B0, 0, 0); PG8_SCHED; PG8_LDA(At, 0, 0); PG8_STAGE(PG8_SA(1, 1), a1 + hstepA, voffA);
            PG8_WAIT_L(8); PG8_BAR; PG8_WAIT_L(0); PG8_MMA(0, 0, At, B0); PG8_BAR; PG8_SCHED;
            PG8_LDB(B1, 0, 1); PG8_STAGE(PG8_SB(0, 0), b2, voffB);
            PG8_BAR; PG8_WAIT_L(0); PG8_MMA(0, 1, At, B1); PG8_BAR;
            PG8_LDA(At, 0, 1); PG8_STAGE(PG8_SA(0, 0), a2, voffA);
            PG8_BAR; PG8_WAIT_L(0); PG8_MMA(1, 0, At, B0); PG8_BAR; PG8_SCHED;
            PG8_STAGE(PG8_SB(0, 1), b2 + hstepB, voffB);
            PG8_WAIT_V(6); PG8_BAR; PG8_MMA(1, 1, At, B1); PG8_BAR;
            PG8_LDB(B0, 1, 0); PG8_SCHED; PG8_LDA(At, 1, 0); PG8_STAGE(PG8_SA(0, 1), a2 + hstepA, voffA);
            PG8_WAIT_L(8); PG8_BAR; PG8_WAIT_L(0); PG8_MMA(0, 0, At, B0); PG8_BAR; PG8_SCHED;
            PG8_LDB(B1, 1, 1); PG8_STAGE(PG8_SB(1, 0), b3, voffB);
            PG8_BAR; PG8_WAIT_L(0); PG8_MMA(0, 1, At, B1); PG8_BAR;
            PG8_LDA(At, 1, 1); PG8_STAGE(PG8_SA(1, 0), a3, voffA);
            PG8_BAR; PG8_WAIT_L(0); PG8_MMA(1, 0, At, B0); PG8_BAR; PG8_SCHED;
            PG8_STAGE(PG8_SB(1, 1), b3 + hstepB, voffB);
            PG8_WAIT_V(6); PG8_BAR; PG8_MMA(1, 1, At, B1); PG8_BAR;
            }
        }
        if constexpr (ALIGN_EPI) { if (wr == 0) PG8_BAR; }
        if constexpr (!Epi::AFTER_DRAIN) { E(acc, cur, wr, wc, fr, fq); S.done(cur); }
        if (!has_next) break;
#pragma unroll
        for (int a = 0; a < 2; ++a)
#pragma unroll
            for (int b = 0; b < 2; ++b)
#pragma unroll
                for (int m = 0; m < 4; ++m)
#pragma unroll
                    for (int n = 0; n < 2; ++n) acc[a][b][m][n] = (f32x4){0.f, 0.f, 0.f, 0.f};
        cur = nxt; cA = nA; cB = nB; ++ui;
        if constexpr (ALIGN_EPI) { if (wr == 1) PG8_BAR; }
    }
    PG8_WAIT_V(0);
    if constexpr (!ALIGN_EPI) { if (wr == 0) PG8_BAR; }
    PG8_BAR;
    if constexpr (Epi::AFTER_DRAIN) { E.fused(acc, cur, wr, wc, fr, fq, lds, wid, lane); S.done(cur); }
#undef PG8_SA
#undef PG8_SB
#undef PG8_STAGE
#undef PG8_LDA
#undef PG8_LDB
#undef PG8_MMA
#undef PG8_WAIT_V
#undef PG8_WAIT_L
#undef PG8_BAR
#undef PG8_SCHED
}
}

#include <hip/hip_bf16.h>
#include <cmath>
namespace attn_body {
using bf16=__hip_bfloat16;
using bf16x8=__attribute__((ext_vector_type(8)))short;
using s16x4=__attribute__((ext_vector_type(4)))short;
using f32x16=__attribute__((ext_vector_type(16)))float;
using u32x4=__attribute__((ext_vector_type(4)))unsigned;
constexpr int SEQ=2048,D=64;
constexpr int NW=8,QBLK=32,QB=QBLK*NW,KVBLK=64,NQB=SEQ/QB;
constexpr int ATTN_UNIT_ROWS=QB;
__device__ __forceinline__ int crow(int r,int hi){return (r&3)+8*(r>>2)+4*hi;}
#define SBAR() __builtin_amdgcn_sched_barrier(0)
__device__ __forceinline__ void cmask(f32x16&p0,f32x16&p1,int jb,int qrel,int hi){
  const float NEG=-INFINITY; int kb=64*jb+4*hi;
  #pragma unroll
  for(int r=0;r<16;++r){int kv=kb+(r&3)+8*(r>>2); if(kv>qrel)p0[r]=NEG; if(kv+32>qrel)p1[r]=NEG;}
}

constexpr int NSLOT=3, SLOTB=8192;
constexpr int LDS_K=0, LDS_V=NSLOT*SLOTB, LDS_WS=2*NSLOT*SLOTB, LDS_OST=LDS_WS+NW*64*4, LDS_BYTES=LDS_OST+NW*4096;
constexpr int XOFF=86016; constexpr float SENT=-30000.f; using f32x4=__attribute__((ext_vector_type(4)))float;
constexpr float C2=0.125f*1.4426950408889634f;
__device__ __forceinline__ void glds16(const void*gsrc,unsigned lds_dst){unsigned keep;
  asm volatile("s_mov_b32 %0, m0\n\ts_mov_b32 m0, %2\n\ts_nop 0\n\tglobal_load_lds_dwordx4 %1, off\n\ts_mov_b32 m0, %0":"=&s"(keep):"v"(gsrc),"s"(lds_dst):"memory");}
__device__ __forceinline__ float max3f(float a,float b,float c){float r;asm("v_max3_f32 %0, %1, %2, %3":"=v"(r):"v"(a),"v"(b),"v"(c));return r;}
__device__ __forceinline__ float max2f(float a,float b){float r;asm("v_max_f32_e32 %0, %1, %2":"=v"(r):"v"(a),"v"(b));return r;}
__device__ __forceinline__ float fadd_s(float a,float b){float r;asm("v_add_f32_e32 %0, %1, %2":"=v"(r):"v"(a),"v"(b));return r;}
__device__ __forceinline__ float fsub_s(float a,float b){float r;asm("v_sub_f32_e32 %0, %1, %2":"=v"(r):"v"(a),"v"(b));return r;}
typedef float f32x2_t __attribute__((ext_vector_type(2))); typedef __bf16 bf16x2_t __attribute__((ext_vector_type(2)));
__device__ __forceinline__ unsigned cvtpk_s(float lo,float hi){f32x2_t v={lo,hi};bf16x2_t b=__builtin_convertvector(v,bf16x2_t);return __builtin_bit_cast(unsigned,b);}
#define WAIT_BAR(N) asm volatile("s_waitcnt vmcnt(" #N ") lgkmcnt(0)\n\ts_barrier":::"memory")

__device__ __forceinline__ void qkt(f32x16&p0,f32x16&p1,const char*Kslot,const bf16x8*qr,const f32x16&negm,int r32,int hi){
  const char*kb=Kslot+hi*1024+r32*16;
  #pragma unroll
  for(int d0=0;d0<4;++d0){
    const bf16x8 b0=*reinterpret_cast<const bf16x8*>(kb+d0*2048);
    const bf16x8 b1=*reinterpret_cast<const bf16x8*>(kb+d0*2048+512);
    if(d0==0){p0=__builtin_amdgcn_mfma_f32_32x32x16_bf16(b0,qr[0],negm,0,0,0);p1=__builtin_amdgcn_mfma_f32_32x32x16_bf16(b1,qr[0],negm,0,0,0);}
    else{p0=__builtin_amdgcn_mfma_f32_32x32x16_bf16(b0,qr[d0],p0,0,0,0);p1=__builtin_amdgcn_mfma_f32_32x32x16_bf16(b1,qr[d0],p1,0,0,0);}}
}
typedef __attribute__((address_space(3))) const char* lds_cptr;
typedef short v4i16_t __attribute__((ext_vector_type(4)));
__device__ __forceinline__ void kload8(bf16x8*kf,lds_cptr kp){
  kf[0]=*(const __attribute__((address_space(3))) bf16x8*)(kp);      kf[1]=*(const __attribute__((address_space(3))) bf16x8*)(kp+512);
  kf[2]=*(const __attribute__((address_space(3))) bf16x8*)(kp+2048); kf[3]=*(const __attribute__((address_space(3))) bf16x8*)(kp+2560);
  kf[4]=*(const __attribute__((address_space(3))) bf16x8*)(kp+4096); kf[5]=*(const __attribute__((address_space(3))) bf16x8*)(kp+4608);
  kf[6]=*(const __attribute__((address_space(3))) bf16x8*)(kp+6144); kf[7]=*(const __attribute__((address_space(3))) bf16x8*)(kp+6656);
}
__device__ __forceinline__ void kload2(bf16x8*kf,lds_cptr kp,int j){ kf[2*j]=*(const __attribute__((address_space(3))) bf16x8*)(kp+j*2048); kf[2*j+1]=*(const __attribute__((address_space(3))) bf16x8*)(kp+j*2048+512); }
__device__ __forceinline__ s16x4 vtr(lds_cptr p){ return __builtin_bit_cast(s16x4,__builtin_amdgcn_ds_read_tr16_b64_v4i16((__attribute__((address_space(3))) v4i16_t*)p)); }
__device__ __forceinline__ float rowmax(const f32x16&p0,const f32x16&p1){
  float a=max3f(p0[0],p0[1],p1[0]),b=max3f(p0[2],p0[3],p1[1]);a=max3f(a,p1[2],p1[3]);
  #pragma unroll
  for(int r=4;r<16;r+=4){a=max3f(a,p0[r],p0[r+1]);b=max3f(b,p0[r+2],p0[r+3]);a=max3f(a,p1[r],p1[r+1]);b=max3f(b,p1[r+2],p1[r+3]);}
  const float m=max2f(a,b);
  auto rr=__builtin_amdgcn_permlane32_swap(__float_as_uint(m),__float_as_uint(m),false,false);
  return max2f(__uint_as_float(rr[0]),__uint_as_float(rr[1]));
}
__device__ __forceinline__ void pv(f32x16*o,int vb,bf16x8 pa0,bf16x8 pa1,bf16x8 pa2,bf16x8 pa3){
  #pragma unroll
  for(int d0=0;d0<2;++d0){s16x4 lo[4],hi[4];
    #pragma unroll
    for(int ks=0;ks<4;++ks){
      asm volatile("ds_read_b64_tr_b16 %0,%1 offset:%c2":"=&v"(lo[ks]):"v"(vb),"i"(d0*4096+ks*1024):"memory");
      asm volatile("ds_read_b64_tr_b16 %0,%1 offset:%c2":"=&v"(hi[ks]):"v"(vb),"i"(d0*4096+ks*1024+512):"memory");}
    asm volatile("s_waitcnt lgkmcnt(0)":::"memory");SBAR();
    #define PK(k) (bf16x8){lo[k][0],lo[k][1],lo[k][2],lo[k][3],hi[k][0],hi[k][1],hi[k][2],hi[k][3]}
    o[d0]=__builtin_amdgcn_mfma_f32_32x32x16_bf16(pa0,PK(0),o[d0],0,0,0);
    o[d0]=__builtin_amdgcn_mfma_f32_32x32x16_bf16(pa1,PK(1),o[d0],0,0,0);
    o[d0]=__builtin_amdgcn_mfma_f32_32x32x16_bf16(pa2,PK(2),o[d0],0,0,0);
    o[d0]=__builtin_amdgcn_mfma_f32_32x32x16_bf16(pa3,PK(3),o[d0],0,0,0);
    #undef PK
  }
}

#ifndef ATTN_STORE16
#define ATTN_STORE16(p,v) (*(u32x4*)(p)=(v))
#endif
template<int THRL,int MODE,int DM,bool DRY=false> __device__ __forceinline__ void attn_unit(int b,int h,int qb,const bf16*Q,const bf16*__restrict__ K,const bf16*__restrict__ V,bf16*O,const bf16*__restrict__ Z,const float*__restrict__ XP,const int*__restrict__ TS,volatile unsigned*lw,unsigned nxt,char*shm){
  const int tid=opaque_tid(),lane=tid&63,r32=lane&31,hi=lane>>5; const int wid=__builtin_amdgcn_readfirstlane(tid>>6);
  const long rowbase=(long)b*SEQ; const int q0=qb*QB;
  const bf16*Qw=Q+(rowbase+q0+wid*QBLK)*DM+h*D;
  bf16x8 qr[4];
  #pragma unroll
  for(int d0=0;d0<4;++d0)qr[d0]=*reinterpret_cast<const bf16x8*>(&Qw[(long)r32*DM+d0*16+hi*8]);
  const bf16*Kh=K+rowbase*DM+h*D,*Vh=V+rowbase*DM+h*D;
  const unsigned lds0=(unsigned)(uintptr_t)shm;
  float*wsf=(float*)(shm+LDS_WS)+wid*64;
  const bf16*ksrc_=Kh+(long)lane*DM+wid*8; int tskip=0; const bf16*ksrc=ksrc_;
  const bf16*vsrc_=Vh+(long)(16*(wid&3)+(lane>>2))*DM+(wid>>2)*32+(lane&3)*8; const bf16*vsrc=vsrc_;
  const unsigned kdst=lds0+LDS_K+wid*1024, vdst=lds0+LDS_V+wid*1024;
  #define DMA_K(t,slot) glds16(ksrc+(long)(t)*KVBLK*DM,(unsigned)__builtin_amdgcn_readfirstlane(kdst+(slot)))
  #define DMA_V(t,slot) glds16(vsrc+(long)(t)*KVBLK*DM,(unsigned)__builtin_amdgcn_readfirstlane(vdst+(slot)))
  const int vb0=(int)(lds0+LDS_V)+((lane>>4)&1)*32+(lane&3)*8+(4*hi+((lane&15)>>2))*64;
  const char*Kbase=shm+LDS_K; bf16x8 kf[8];
  const lds_cptr shm3=(lds_cptr)shm; const lds_cptr kp0=shm3+LDS_K+hi*1024+r32*16; const lds_cptr vp0=shm3+LDS_V+((lane>>4)&1)*32+(lane&3)*8+(4*hi+((lane&15)>>2))*64;
  int NT=(q0+QB)/KVBLK;
  const int qrel=wid*QBLK+r32;
  unsigned sel=0u;
  if constexpr(MODE==1){
    tskip=__builtin_amdgcn_readfirstlane(TS[qb]);
    ksrc=ksrc_+(long)tskip*KVBLK*DM; vsrc=vsrc_+(long)tskip*KVBLK*DM; NT-=tskip;
  }
  const lds_cptr fsl=(lds_cptr)shm+XOFF+16*hi+tskip*256;
  #define XMASK(P0,P1,t) do{ if constexpr(MODE==0){ if((t)<NT-4){ const bool keep_=(sel>>((t)>>2))&1u; \
        _Pragma("unroll") for(int r=0;r<16;++r){P0[r]=keep_?P0[r]:SENT;P1[r]=keep_?P1[r]:SENT;} } } \
      else { const lds_cptr fp_=fsl+(t)*256; const float mh_=mhat; \
        _Pragma("unroll") for(int g_=0;g_<4;++g_){ const f32x4 fa_=*(const __attribute__((address_space(3))) f32x4*)(fp_+g_*32)+mh_; const f32x4 fb_=*(const __attribute__((address_space(3))) f32x4*)(fp_+128+g_*32)+mh_; \
          _Pragma("unroll") for(int i_=0;i_<4;++i_){P0[4*g_+i_]-=fa_[i_];P1[4*g_+i_]-=fb_[i_];} } } }while(0)
  DMA_K(0,0);DMA_V(0,0);DMA_K(1,SLOTB);
  float mhat=0.f,l_reg=0.f;f32x16 o[2];o[0]=f32x16{};o[1]=f32x16{};f32x16 negm=f32x16{}; if constexpr(MODE==0){asm volatile("":"+v"(negm));}
  #define CMASK(P0,P1,t) do{int jb_=(t)-(NT-4); if(jb_>=0)cmask(P0,P1,jb_,qrel,hi);}while(0)
  const f32x16 czero_=f32x16{};
  #define NEGM (MODE==1?czero_:negm)
  bool resc=false;
  #define START(P0,P1) do{ const float rm=rowmax(P0,P1); resc=false; \
    { const float dl=rm; mhat=fadd_s(mhat,dl); \
      _Pragma("unroll") for(int r=0;r<16;++r){P0[r]=fsub_s(P0[r],dl);P1[r]=fsub_s(P1[r],dl);} \
      if constexpr(MODE==0){ _Pragma("unroll") for(int r=0;r<16;++r)negm[r]=-mhat; asm volatile("":"+v"(negm)); } } \
    _Pragma("unroll") for(int r=0;r<16;++r)P0[r]=__builtin_amdgcn_exp2f(P0[r]); }while(0)
  #define RESC() do{ if(resc){ asm volatile("s_waitcnt lgkmcnt(0)":::"memory"); \
      _Pragma("unroll") for(int d_=0;d_<2;++d_) _Pragma("unroll") for(int r=0;r<16;++r)o[d_][r]*=wsf[crow(r,hi)]; } }while(0)
  f32x16 pA0,pA1,pB0,pB1;
  int sl_prev=0,sl_cur=0,sl_next=SLOTB;
  #define ROT() do{sl_prev=sl_cur;sl_cur=sl_next;sl_next=(sl_next==(NSLOT-1)*SLOTB)?0:sl_next+SLOTB;}while(0)
  DMA_K(2,2*SLOTB);
  if constexpr(MODE==1){ float*fs=(float*)(shm+XOFF); for(int i=tid+64*tskip;i<q0+QB;i+=NW*64)fs[i]=XP[i]; }
  if constexpr(MODE==0){
    float*kbs=(float*)(shm+XOFF); unsigned*sm=(unsigned*)(shm+XOFF+2048);
    kbs[tid]=XP[tid];
    asm volatile("s_waitcnt vmcnt(0) lgkmcnt(0)\n\ts_barrier":::"memory");
    if(tid<QB){ unsigned m=(1u<<qb)-1u;
      if(qb>3){ const bf16*qp=Q+(rowbase+q0+tid)*DM+h*D; float g[8];
        _Pragma("unroll") for(int n=0;n<8;++n)g[n]=0.f;
        _Pragma("unroll") for(int c=0;c<8;++c){ const bf16x8 qv=*reinterpret_cast<const bf16x8*>(qp+c*8);
          _Pragma("unroll") for(int j=0;j<8;++j){ const float qf=__uint_as_float(((unsigned)(unsigned short)qv[j])<<16);
            _Pragma("unroll") for(int n=0;n<8;++n)g[n]+=qf*kbs[n*64+c*8+j]; } }
        m=0u;
        _Pragma("unroll") for(int it=0;it<3;++it){ float best=-INFINITY; int bi=0;
          _Pragma("unroll") for(int n=0;n<8;++n){ const bool ok=(n<qb)&&!((m>>n)&1u)&&(g[n]>best); best=ok?g[n]:best; bi=ok?n:bi; }
          m|=1u<<bi; } }
      sm[tid]=m; }
    asm volatile("s_waitcnt vmcnt(0) lgkmcnt(0)\n\ts_barrier":::"memory");
    sel=sm[qrel];
  }
  WAIT_BAR(3);
  qkt(pA0,pA1,Kbase,qr,NEGM,r32,hi);asm volatile("s_nop 15\n\ts_nop 7":"+v"(pA0),"+v"(pA1));XMASK(pA0,pA1,0);CMASK(pA0,pA1,0);
  START(pA0,pA1);
  _Pragma("unroll") for(int r=0;r<16;++r)pA1[r]=__builtin_amdgcn_exp2f(pA1[r]);
  WAIT_BAR(0);
  DMA_K(3,0);DMA_V(1,SLOTB);
  ROT();
  kload8(kf,kp0+sl_cur);
  WAIT_BAR(2);
  s16x4 vlo[8],vhi[8]; u32x4 pw0,pw1,pw2,pw3;
  #define PKW(P,B) cvtpk_s(P[B],P[B+1])
  #define PAF(k) __builtin_bit_cast(bf16x8,pw##k)
  #define VFR(i) (bf16x8){vlo[i][0],vlo[i][1],vlo[i][2],vlo[i][3],vhi[i][0],vhi[i][1],vhi[i][2],vhi[i][3]}
  #define PIN(x) asm volatile("":"+v"(x))
  #define MX3(a,b,c) __builtin_fmaxf(__builtin_fmaxf((a),(b)),(c))
  #define GAPA(MF,A0,A1,A2,A3,W0,W1,PW) do{ MF; sacc+=A0; sacc+=A1; sacc+=A2; sacc+=A3; PIN(sacc); W0; W1; PIN(PW); SBAR(); }while(0)
  #define EX(v) __builtin_amdgcn_exp2f(v)
  #define GAPB(MF,X,B) do{ MF; X[B]=EX(X[B]); X[B+1]=EX(X[B+1]); X[B+2]=EX(X[B+2]); X[B+3]=EX(X[B+3]); PIN(X); SBAR(); }while(0)
  #define VRD(i) do{ vlo[i]=vtr(vp_+(((i)>>2)*4096+((i)&3)*1024)); vhi[i]=vtr(vp_+(((i)>>2)*4096+((i)&3)*1024+512)); }while(0)
  #define KRD(G,j) do{ if(G){ kload2(kf,kp0+sl_next,j); SBAR(); } }while(0)
  #define STEP(C0,C1,P0,P1,t,GK,GV,GL) do{ SBAR(); \
    const lds_cptr vp_=vp0+sl_prev; \
    VRD(0); SBAR(); float sacc=(P0[0]+P0[1]); \
    GAPA(C0=__builtin_amdgcn_mfma_f32_32x32x16_bf16(kf[0],qr[0],NEGM,0,0,0), P0[2],P0[3],P0[4],P0[5],     pw0[0]=PKW(P0,0), pw0[1]=PKW(P0,2), pw0); \
    VRD(4); SBAR(); GAPA(C1=__builtin_amdgcn_mfma_f32_32x32x16_bf16(kf[1],qr[0],NEGM,0,0,0), P0[6],P0[7],P0[8],P0[9],     pw0[2]=PKW(P0,4), pw0[3]=PKW(P0,6), pw0); \
    VRD(1); SBAR(); GAPA(C0=__builtin_amdgcn_mfma_f32_32x32x16_bf16(kf[2],qr[1],C0,0,0,0),   P0[10],P0[11],P0[12],P0[13], pw1[0]=PKW(P0,8), pw1[1]=PKW(P0,10), pw1); \
    VRD(5); SBAR(); GAPA(C1=__builtin_amdgcn_mfma_f32_32x32x16_bf16(kf[3],qr[1],C1,0,0,0),   P0[14],P0[15],P1[0],P1[1],   pw1[2]=PKW(P0,12),pw1[3]=PKW(P0,14), pw1); \
    VRD(2); SBAR(); GAPA(C0=__builtin_amdgcn_mfma_f32_32x32x16_bf16(kf[4],qr[2],C0,0,0,0),   P1[2],P1[3],P1[4],P1[5],     pw2[0]=PKW(P1,0), pw2[1]=PKW(P1,2), pw2); \
    VRD(6); SBAR(); GAPA(C1=__builtin_amdgcn_mfma_f32_32x32x16_bf16(kf[5],qr[2],C1,0,0,0),   P1[6],P1[7],P1[8],P1[9],     pw2[2]=PKW(P1,4), pw2[3]=PKW(P1,6), pw2); \
    VRD(3); SBAR(); GAPA(C0=__builtin_amdgcn_mfma_f32_32x32x16_bf16(kf[6],qr[3],C0,0,0,0),   P1[10],P1[11],P1[12],P1[13], pw3[0]=PKW(P1,8), pw3[1]=PKW(P1,10), pw3); \
    VRD(7); SBAR(); GAPA(C1=__builtin_amdgcn_mfma_f32_32x32x16_bf16(kf[7],qr[3],C1,0,0,0),   P1[14],P1[15],0.f,0.f,       pw3[2]=PKW(P1,12),pw3[3]=PKW(P1,14), pw3); \
    l_reg+=sacc; \
    if(GK){DMA_K((t)+3,sl_cur);} if(GV){DMA_V((t)+1,sl_next);} \
    XMASK(C0,C1,t); CMASK(C0,C1,t); \
    { float a=MX3(C0[0],C0[1],C1[0]),b=MX3(C0[2],C0[3],C1[1]); a=MX3(a,C1[2],C1[3]); \
      _Pragma("unroll") for(int r=4;r<16;r+=4){a=MX3(a,C0[r],C0[r+1]);b=MX3(b,C0[r+2],C0[r+3]);a=MX3(a,C1[r],C1[r+1]);b=MX3(b,C1[r+2],C1[r+3]);} \
      float rm=__builtin_fmaxf(a,b); { auto rr=__builtin_amdgcn_permlane32_swap(__float_as_uint(rm),__float_as_uint(rm),false,false); rm=__builtin_fmaxf(__uint_as_float(rr[0]),__uint_as_float(rr[1])); } \
      resc=false; \
      if(__builtin_expect(__any(rm>(float)THRL),0)){ const float dl=__builtin_fmaxf(rm,0.f); mhat+=dl; \
        _Pragma("unroll") for(int r=0;r<16;++r){C0[r]-=dl;C1[r]-=dl;} \
        if constexpr(MODE==0){ _Pragma("unroll") for(int r=0;r<16;++r)negm[r]=-mhat; asm volatile("":"+v"(negm)); } \
        const float f=__builtin_amdgcn_exp2f(-dl); l_reg*=f; if(hi==0)wsf[r32]=f; resc=true; } } \
    SBAR(); \
    GAPB(o[0]=__builtin_amdgcn_mfma_f32_32x32x16_bf16(PAF(0),VFR(0),o[0],0,0,0), C0,0); \
    GAPB(o[1]=__builtin_amdgcn_mfma_f32_32x32x16_bf16(PAF(0),VFR(4),o[1],0,0,0), C0,4); \
    KRD(GL,0); GAPB(o[0]=__builtin_amdgcn_mfma_f32_32x32x16_bf16(PAF(1),VFR(1),o[0],0,0,0), C0,8); \
    KRD(GL,1); GAPB(o[1]=__builtin_amdgcn_mfma_f32_32x32x16_bf16(PAF(1),VFR(5),o[1],0,0,0), C0,12); \
    KRD(GL,2); GAPB(o[0]=__builtin_amdgcn_mfma_f32_32x32x16_bf16(PAF(2),VFR(2),o[0],0,0,0), C1,0); \
    KRD(GL,3); GAPB(o[1]=__builtin_amdgcn_mfma_f32_32x32x16_bf16(PAF(2),VFR(6),o[1],0,0,0), C1,4); \
    GAPB(o[0]=__builtin_amdgcn_mfma_f32_32x32x16_bf16(PAF(3),VFR(3),o[0],0,0,0), C1,8); \
    GAPB(o[1]=__builtin_amdgcn_mfma_f32_32x32x16_bf16(PAF(3),VFR(7),o[1],0,0,0), C1,12); \
    }while(0)
  int t=1;
  #undef CMASK
  #define CMASK(P0,P1,t) do{}while(0)
  for(;t+5<NT;t+=2){
    STEP(pB0,pB1,pA0,pA1,t,true,true,true);     WAIT_BAR(2); RESC(); ROT();
    STEP(pA0,pA1,pB0,pB1,t+1,true,true,true);   WAIT_BAR(2); RESC(); ROT();
  }
  #undef CMASK
  #define CMASK(P0,P1,t) do{int jb_=(t)-(NT-4); if(jb_>=0)cmask(P0,P1,jb_,qrel,hi);}while(0)
  #define ENDW(tt) do{ if((tt)+3<NT){WAIT_BAR(2);} else if((tt)+2<NT){WAIT_BAR(1);} else {WAIT_BAR(0);} }while(0)
  for(;t+1<NT;t+=2){
    STEP(pB0,pB1,pA0,pA1,t,(t+3<NT),(t+1<NT),(t+1<NT));       ENDW(t);   RESC(); ROT();
    STEP(pA0,pA1,pB0,pB1,t+1,(t+4<NT),(t+2<NT),(t+2<NT));     ENDW(t+1); RESC(); ROT();
  }
  STEP(pB0,pB1,pA0,pA1,NT-1,false,false,false); RESC();
  const bf16*Zw=Z+(rowbase+q0+wid*QBLK)*DM+h*D; u32x4 zpre[4];
  #pragma unroll
  for(int i=0;i<4;++i)zpre[i]=*(const u32x4*)(Zw+(long)(i*8+(lane>>3))*DM+(lane&7)*8);
  { float sacc=pB0[0]+pB0[1]; _Pragma("unroll") for(int r=2;r<16;++r)sacc+=pB0[r]; _Pragma("unroll") for(int r=0;r<16;++r)sacc+=pB1[r]; l_reg+=sacc;
    pw0=(u32x4){PKW(pB0,0),PKW(pB0,2),PKW(pB0,4),PKW(pB0,6)};pw1=(u32x4){PKW(pB0,8),PKW(pB0,10),PKW(pB0,12),PKW(pB0,14)};pw2=(u32x4){PKW(pB1,0),PKW(pB1,2),PKW(pB1,4),PKW(pB1,6)};pw3=(u32x4){PKW(pB1,8),PKW(pB1,10),PKW(pB1,12),PKW(pB1,14)};
    SBAR(); pv(o,vb0+sl_cur,PAF(0),PAF(1),PAF(2),PAF(3)); }
  #undef PKW
  #undef PAF
  #undef VFR
  #undef PIN
  #undef MX3
  #undef GAPA
  #undef GAPB
  #undef EX
  #undef VRD
  #undef KRD
  #undef STEP
  #undef ENDW
  if(lw!=nullptr&&tid==0)lw[0]=nxt;
  {auto rr=__builtin_amdgcn_permlane32_swap(__float_as_uint(l_reg),__float_as_uint(l_reg),false,false);l_reg=__uint_as_float(rr[0])+__uint_as_float(rr[1]);}
  if(hi==0)wsf[32+r32]=l_reg;asm volatile("s_waitcnt lgkmcnt(0)":::"memory");
  float rli[16];
  #pragma unroll
  for(int r=0;r<16;++r)rli[r]=__builtin_amdgcn_rcpf(wsf[32+crow(r,hi)]);
  bf16*Ow=O+(rowbase+q0+wid*QBLK)*DM+h*D;
  { bf16*stg=(bf16*)(shm+LDS_OST)+wid*2048;
    #pragma unroll
    for(int r=0;r<16;++r){const int orow=crow(r,hi);
      #pragma unroll
      for(int d0=0;d0<2;++d0)stg[orow*64+d0*32+r32]=__float2bfloat16(o[d0][r]*rli[r]);}
    asm volatile("s_waitcnt lgkmcnt(0)":::"memory");
    #pragma unroll
    for(int i=0;i<4;++i){const int row=i*8+(lane>>3),ch=lane&7; const u32x4 v=*(const u32x4*)(stg+row*64+ch*8); const u32x4 zv=zpre[i]; u32x4 ov;
      #pragma unroll
      for(int e=0;e<4;++e){ const float o0=__uint_as_float(v[e]<<16),o1=__uint_as_float(v[e]&0xffff0000u),z0=__uint_as_float(zv[e]<<16),z1=__uint_as_float(zv[e]&0xffff0000u);
        ov[e]=cvtpk_s(o0*z0*__builtin_amdgcn_rcpf(1.f+__expf(-z0)),o1*z1*__builtin_amdgcn_rcpf(1.f+__expf(-z1))); }
      if(!DRY||ov[0]==0x7fc12345u)ATTN_STORE16(Ow+(long)row*DM+ch*8,ov);} }
  asm volatile("s_waitcnt lgkmcnt(0)\n\ts_barrier":::"memory");
  #undef DMA_K
  #undef DMA_V
  #undef CMASK
  #undef XMASK
  #undef NEGM
  #undef START
  #undef RESC
  #undef ROT
}
constexpr int ATTN_LDS_BYTES=LDS_BYTES;
#undef SBAR
#undef WAIT_BAR
}
constexpr int NWAVES = 8, NTHR = 512;
constexpr int NB = 8, SEQL = 2048, DMOD = 1024, MROWS = NB * SEQL;
constexpr int LD0 = 6656, NP0 = 6912, LD1 = 7168, NP1 = 7424;
constexpr int C0_ZA = 0, C0_Q = 1024, C0_ZB = 2048, C0_XBC = 3072, C0_K = 4608, C0_V = 5632;
constexpr int C1_Q = 0, C1_U = 1536, C1_K = 2048, C1_V = 3584, C1_ZC = 5120, C1_ZD = 6656;
constexpr float RMS_EPS = 1e-6f, LOG2E = 1.4426950408889634f;
constexpr size_t MiB = 1u << 20;
constexpr int KS = 8;
constexpr size_t WS_MODP = 0;
constexpr size_t WS_SSQ = 2 * MiB;
constexpr size_t WS_KBAR = 2 * MiB + 65536;
constexpr size_t WS_DT = 3 * MiB;
constexpr size_t WS_LF = 4 * MiB;
constexpr size_t WS_F2 = 6 * MiB;
constexpr size_t WS_S5P = 7 * MiB + 512 * 1024;
constexpr int S5P_STRIDE = 8704;
constexpr size_t WS_WT1 = 8 * MiB;
constexpr size_t WS_WO1 = WS_WT1 + (size_t)NP1 * 1024 * 2;
constexpr size_t WS_WG = WS_WO1 + 4 * MiB;
constexpr size_t WS_BIG = 27 * MiB;
constexpr size_t WS_WT0 = WS_BIG + (size_t)MROWS * LD0 * 2;
constexpr size_t WS_WO0 = WS_WT0 + (size_t)NP0 * 1024 * 2;
constexpr size_t WS_LFP = 251 * MiB;
constexpr size_t WS_END = WS_WO0 + 4 * MiB;
static_assert(WS_WG + 512 * 1024 <= WS_BIG && WS_END <= 256 * MiB && WS_BIG + (size_t)MROWS * LD1 * 2 <= 256 * MiB, "ws map");
constexpr int LDS_BYTES = 147456;
constexpr size_t WS_CNT = 1835008 + 3584 * 4, WS_UB = 1835008 + 32768, WS_TS = 1835008 + 32768 + 1024;
constexpr size_t WS_BAR = 1835008;
constexpr int BARST_OFF = 132608;

typedef unsigned short bf16;
typedef unsigned v4u __attribute__((ext_vector_type(4)));
typedef unsigned v2u __attribute__((ext_vector_type(2)));
typedef float f32x4 __attribute__((ext_vector_type(4)));
typedef short bf16x8 __attribute__((ext_vector_type(8)));
typedef float f32x16 __attribute__((ext_vector_type(16)));
typedef float f32x2_c __attribute__((ext_vector_type(2))); typedef __bf16 bf16x2_c __attribute__((ext_vector_type(2)));
__device__ __forceinline__ unsigned pk2(float lo, float hi) { f32x2_c v = {lo, hi}; return __builtin_bit_cast(unsigned, __builtin_convertvector(v, bf16x2_c)); }
__device__ __forceinline__ unsigned f2bf(float f) { return pk2(f, f) & 0xffffu; }
__device__ __forceinline__ float bf2f(unsigned short h) { return __uint_as_float(((unsigned)h) << 16); }
template <int CTRL> __device__ __forceinline__ float dppf(float old, float src) { return __builtin_bit_cast(float, __builtin_amdgcn_update_dpp(__builtin_bit_cast(int, old), __builtin_bit_cast(int, src), CTRL, 0xF, 0xF, false)); }
__device__ __forceinline__ float row_sum16(float v) { v += dppf<0xB1>(v, v); v += dppf<0x4E>(v, v); v += dppf<0x141>(v, v); v += dppf<0x140>(v, v); return v; }
__device__ __forceinline__ float rdlane(float v, int l) { return __builtin_bit_cast(float, __builtin_amdgcn_readlane(__builtin_bit_cast(int, v), l)); }
__device__ __forceinline__ float wave_sum(float v) { v = row_sum16(v); return (rdlane(v, 0) + rdlane(v, 16)) + (rdlane(v, 32) + rdlane(v, 48)); }
__device__ __forceinline__ float wave_scan(float x, int lane) {
    x += dppf<0x111>(0.f, x); x += dppf<0x112>(0.f, x); x += dppf<0x114>(0.f, x); x += dppf<0x118>(0.f, x);
    const float t0 = rdlane(x, 15), t1 = rdlane(x, 31), t2 = rdlane(x, 47); const int rw = lane >> 4;
    return x + (rw == 0 ? 0.f : (rw == 1 ? t0 : (rw == 2 ? t0 + t1 : (t0 + t1) + t2)));
}
__device__ __forceinline__ float silu_f(float x) { return x * __builtin_amdgcn_rcpf(1.f + __expf(-x)); }
__device__ __forceinline__ float softplus_g(float x) { return x > 20.f ? x : log1pf(__expf(x)); }

struct Args {
    const float* in[27]; float* out; unsigned char* ws;
};
enum { I_X = 0, I_C, I_ADAW, I_ADAB, I_PREG, I_POSTG, I_EINW, I_ECONVW, I_ECONVB, I_EDTB, I_EALOG, I_EDSKIP, I_ENORMG, I_EOUTW,
       I_OINW, I_OFGB, I_OLRE, I_OLIM, I_OLDT, I_OBRE, I_OBIM, I_OCRE, I_OCIM, I_ODSKIP, I_OGLUW, I_OGLUB, I_OOUTW };

__device__ __forceinline__ int src_col0(int n) {
    if (n < 1024) return n;
    if (n < 2048) return 3600 + (n - 1024);
    if (n < 3072) return 1024 + (n - 2048);
    if (n < 4608) return 2048 + (n - 3072);
    if (n < 5632) return 4624 + (n - 4608);
    if (n < 6656) return 5648 + (n - 5632);
    if (n < 6672) return 3584 + (n - 6656);
    return -1;
}
__device__ __forceinline__ int src_col1(int n) {
    if (n < 1536) return 2048 + n;
    if (n < 2048) return 6680 + (n - 1536);
    if (n < 3584) return 3584 + (n - 2048);
    if (n < 5120) return 5120 + (n - 3584);
    if (n < 6656) return n - 5120;
    if (n < 7168) return 1536 + (n - 6656);
    if (n < 7192) return 6656 + (n - 7168);
    return -1;
}
template <int MAP> __device__ __forceinline__ void transpose_item(const float* __restrict__ W, int K, int NSRC, int NDST, bf16* WT, float* scr, int item, int lane, const float* __restrict__ kscale = nullptr) {
    const int nblk = NDST / 32, kb = item / nblk, nb = item % nblk, k0 = 64 * kb, n0 = 32 * nb;
    const int nn = n0 + (lane & 31); const int sc = MAP == 0 ? src_col0(nn) : (MAP == 1 ? src_col1(nn) : nn);
    float tv[32];
#pragma unroll
    for (int i = 0; i < 32; ++i) { const int kk = 2 * i + (lane >> 5); tv[i] = sc >= 0 ? __builtin_nontemporal_load(&W[(size_t)(k0 + kk) * NSRC + sc]) : 0.f; if (kscale && k0 + kk < 1024) tv[i] *= kscale[k0 + kk]; }
#pragma unroll
    for (int i = 0; i < 32; ++i) { const int kk = 2 * i + (lane >> 5); scr[kk * 33 + (lane & 31)] = tv[i]; }
    asm volatile("s_waitcnt lgkmcnt(0)" ::: "memory");
    const int c = lane & 7;
#pragma unroll
    for (int j = 0; j < 4; ++j) { const int n = (lane >> 3) + 8 * j; const float* s = scr + (8 * c) * 33 + n;
        v4u o; o.x = pk2(s[0 * 33], s[1 * 33]); o.y = pk2(s[2 * 33], s[3 * 33]); o.z = pk2(s[4 * 33], s[5 * 33]); o.w = pk2(s[6 * 33], s[7 * 33]);
        *(v4u*)(WT + (size_t)(n0 + n) * K + k0 + 8 * c) = o; }
    asm volatile("s_waitcnt lgkmcnt(0)" ::: "memory");
}

__device__ __forceinline__ float mod_val(const float* modp, const float* adab, int l, int b, int j) {
    float s = adab[l * 3072 + j];
#pragma unroll
    for (int kc = 0; kc < KS; ++kc) s += modp[((size_t)(kc * 2 + l) * 8 + b) * 3072 + j];
    return s;
}

__device__ __forceinline__ void p0_prologue(const Args& A, char* lds, int vcu, int G) {
    const int tid = opaque_tid(), lane = tid & 63, wave = tid >> 6;
    unsigned char* ws = A.ws;
    float* scr = (float*)(lds + wave * 16384);
    const int gw = vcu * NWAVES + wave, NGW = G * NWAVES;
    constexpr int I0 = 16 * (NP0 / 32), I1 = 16 * (NP1 / 32), IO = 32 * 32, IG = 8 * 16;
    constexpr int NITEMS = I0 + I1 + 2 * IO + IG;
    for (int it = gw; it < NITEMS; it += NGW) {
        int r = it;
        if (r < I0) { transpose_item<0>(A.in[I_EINW], 1024, 6672, NP0, (bf16*)(ws + WS_WT0), scr, r, lane); continue; } r -= I0;
        if (r < I1) { transpose_item<1>(A.in[I_OINW], 1024, 7192, NP1, (bf16*)(ws + WS_WT1), scr, r, lane); continue; } r -= I1;
        if (r < IO) { transpose_item<2>(A.in[I_EOUTW], 2048, 1024, 1024, (bf16*)(ws + WS_WO0), scr, r, lane, G == 256 ? A.in[I_ENORMG] : nullptr); continue; } r -= IO;
        if (r < IO) { transpose_item<2>(A.in[I_OOUTW], 2048, 1024, 1024, (bf16*)(ws + WS_WO1), scr, r, lane); continue; } r -= IO;
        transpose_item<2>(A.in[I_OGLUW], 512, 512, 512, (bf16*)(ws + WS_WG), scr, r, lane);
    }
    __syncthreads();
    float* sc = (float*)lds;
    float* modp = (float*)(ws + WS_MODP);
    for (int item = blockIdx.x; item < 2 * KS * 6; item += G) {
        const int l = item / (KS * 6), r = item % (KS * 6), kc = r / 6, cb = r % 6;
        __syncthreads();
        for (int i = tid; i < 1024; i += NTHR) { const int b = i >> 7, k = i & 127; const float cv = A.in[I_C][b * 1024 + kc * 128 + k]; sc[i] = silu_f(cv); }
        __syncthreads();
        const int col = cb * 512 + tid; float acc[8];
#pragma unroll
        for (int b = 0; b < 8; ++b) acc[b] = 0.f;
        const float* wp = A.in[I_ADAW] + ((size_t)l * 1024 + kc * 128) * 3072 + col;
#pragma unroll 16
        for (int k = 0; k < 128; ++k) { const float w = __builtin_nontemporal_load(&wp[(size_t)k * 3072]);
#pragma unroll
            for (int b = 0; b < 8; ++b) acc[b] += sc[b * 128 + k] * w; }
#pragma unroll
        for (int b = 0; b < 8; ++b) modp[((size_t)(kc * 2 + l) * 8 + b) * 3072 + col] = acc[b];
    }
    const int gt = blockIdx.x * NTHR + tid;
    const int gs = (G >= 128 ? ((int)blockIdx.x - (G - 32)) * 64 + tid : gt);
    if (gs >= 0 && gs < 2048 && (G < 128 || tid < 64)) {
        const int g = gs >> 6, n = gs & 63;
        const float dt = __expf(A.in[I_OLDT][g]);
        const float lr = A.in[I_OLRE][g * 64 + n], li = A.in[I_OLIM][g * 64 + n];
        const float mag = expf(lr * dt); float sn, cs; sincosf(li * dt, &sn, &cs);
        const float ar = mag * cs, ai = mag * sn, den = lr * lr + li * li;
        const float qr = ((ar - 1.f) * lr + ai * li) / den, qi = (ai * lr - (ar - 1.f) * li) / den;
        unsigned char* pg = ws + WS_S5P + (size_t)g * S5P_STRIDE;
        bf16* BbT = (bf16*)pg; bf16* Cm = (bf16*)(pg + 4096); float* ari = (float*)(pg + 8192);
        ari[n] = ar; ari[64 + n] = ai;
        for (int c = 0; c < 16; ++c) { const float br = A.in[I_OBRE][(g * 64 + n) * 16 + c], bi = A.in[I_OBIM][(g * 64 + n) * 16 + c];
            BbT[(2 * n) * 16 + c] = (bf16)f2bf(qr * br - qi * bi); BbT[(2 * n + 1) * 16 + c] = (bf16)f2bf(qr * bi + qi * br);
            Cm[c * 128 + 2 * n] = (bf16)f2bf(A.in[I_OCRE][(g * 16 + c) * 64 + n]); Cm[c * 128 + 2 * n + 1] = (bf16)f2bf(-A.in[I_OCIM][(g * 16 + c) * 64 + n]); }
    }
    float* ssq = (float*)(ws + WS_SSQ);
    for (int i = gt; i < MROWS; i += G * NTHR) ssq[i] = 0.f;
}

__device__ __forceinline__ void p1a_rows(const Args& A, char* lds, int G) {
    const int tid = opaque_tid(), lane = tid & 63, wave = tid >> 6;
    const float* modp = (const float*)(A.ws + WS_MODP); float* mv = (float*)lds;
    for (int rb = blockIdx.x; rb < MROWS / 64; rb += G) {
        const int b = rb >> 5;
        __syncthreads();
#pragma unroll 1
        for (int col = tid; col < 1024; col += NTHR) { mv[col] = A.in[I_PREG][col] * (1.f + mod_val(modp, A.in[I_ADAB], 0, b, 1024 + col)); mv[1024 + col] = mod_val(modp, A.in[I_ADAB], 0, b, col); }
        __syncthreads();
        f32x4 mul[4], add[4];
#pragma unroll
        for (int j = 0; j < 4; ++j) { mul[j] = *(const f32x4*)(mv + 4 * lane + 256 * j); add[j] = *(const f32x4*)(mv + 1024 + 4 * lane + 256 * j); }
        f32x4 nx[4];
        { const f32x4* xr = (const f32x4*)(A.in[I_X] + (size_t)(rb * 64 + wave * 8) * DMOD) + lane;
#pragma unroll
          for (int j = 0; j < 4; ++j) nx[j] = __builtin_nontemporal_load(&xr[64 * j]); }
#pragma unroll 1
        for (int r = 0; r < 8; ++r) { const int m = rb * 64 + wave * 8 + r;
            f32x4 v[4]; float s = 0.f;
#pragma unroll
            for (int j = 0; j < 4; ++j) { v[j] = nx[j]; s += (v[j].x * v[j].x + v[j].y * v[j].y) + (v[j].z * v[j].z + v[j].w * v[j].w); }
            if (r < 7) { const f32x4* xr = (const f32x4*)(A.in[I_X] + (size_t)(m + 1) * DMOD) + lane;
#pragma unroll
                for (int j = 0; j < 4; ++j) nx[j] = __builtin_nontemporal_load(&xr[64 * j]); }
            const float rstd = rsqrtf(wave_sum(s) * (1.f / DMOD) + RMS_EPS);
            unsigned long long* o8 = (unsigned long long*)((unsigned char*)A.out + (size_t)m * 4096) + lane;
#pragma unroll
            for (int j = 0; j < 4; ++j) { const f32x4 h = v[j] * rstd * mul[j] + add[j]; o8[64 * j] = (unsigned long long)pk2(h.x, h.y) | ((unsigned long long)pk2(h.z, h.w) << 32); } }
    }
}
__device__ __forceinline__ void p3b_rows(const Args& A, char* lds, int G) {
    const int tid = opaque_tid(), lane = tid & 63, wave = tid >> 6;
    const float* modp = (const float*)(A.ws + WS_MODP); float* mv = (float*)lds;
    for (int rb = blockIdx.x; rb < MROWS / 64; rb += G) {
        const int b = rb >> 5;
        __syncthreads();
#pragma unroll 1
        for (int col = tid; col < 1024; col += NTHR) { mv[col] = A.in[I_POSTG][col] * mod_val(modp, A.in[I_ADAB], 0, b, 2048 + col);
            mv[1024 + col] = A.in[I_PREG][1024 + col] * (1.f + mod_val(modp, A.in[I_ADAB], 1, b, 1024 + col)); mv[2048 + col] = mod_val(modp, A.in[I_ADAB], 1, b, col); }
        __syncthreads();
        f32x4 g0[4], mul[4], add[4];
#pragma unroll
        for (int j = 0; j < 4; ++j) { g0[j] = *(const f32x4*)(mv + 4 * lane + 256 * j); mul[j] = *(const f32x4*)(mv + 1024 + 4 * lane + 256 * j); add[j] = *(const f32x4*)(mv + 2048 + 4 * lane + 256 * j); }
        f32x4 nx[4]; v2u ny[4];
        { const int m = rb * 64 + wave * 8; const f32x4* xr = (const f32x4*)(A.in[I_X] + (size_t)m * DMOD) + lane; const v2u* yr = (const v2u*)((unsigned char*)A.out + (size_t)m * 4096) + lane;
#pragma unroll
          for (int j = 0; j < 4; ++j) { nx[j] = __builtin_nontemporal_load(&xr[64 * j]); ny[j] = yr[64 * j]; } }
#pragma unroll 1
        for (int r = 0; r < 8; ++r) { const int m = rb * 64 + wave * 8 + r;
            unsigned char* slot = (unsigned char*)A.out + (size_t)m * 4096;
            f32x4 v[4], y[4]; float sy = 0.f; v2u wy[4];
#pragma unroll
            for (int j = 0; j < 4; ++j) { v[j] = nx[j]; wy[j] = ny[j]; }
            if (r < 7) { const f32x4* xr = (const f32x4*)(A.in[I_X] + (size_t)(m + 1) * DMOD) + lane; const v2u* yr = (const v2u*)(slot + 4096) + lane;
#pragma unroll
                for (int j = 0; j < 4; ++j) { nx[j] = __builtin_nontemporal_load(&xr[64 * j]); ny[j] = yr[64 * j]; } }
#pragma unroll
            for (int j = 0; j < 4; ++j) { const v2u w = wy[j]; y[j] = (f32x4){__uint_as_float(w.x << 16), __uint_as_float(w.x & 0xffff0000u), __uint_as_float(w.y << 16), __uint_as_float(w.y & 0xffff0000u)};
                sy += (y[j].x * y[j].x + y[j].y * y[j].y) + (y[j].z * y[j].z + y[j].w * y[j].w); }
            const float ry = rsqrtf(wave_sum(sy) * (1.f / DMOD) + RMS_EPS); float s = 0.f;
#pragma unroll
            for (int j = 0; j < 4; ++j) { v[j] = v[j] + g0[j] * (y[j] * ry); s += (v[j].x * v[j].x + v[j].y * v[j].y) + (v[j].z * v[j].z + v[j].w * v[j].w); }
            const float rstd = rsqrtf(wave_sum(s) * (1.f / DMOD) + RMS_EPS);
            unsigned long long* o8 = (unsigned long long*)(slot + 2048) + lane;
#pragma unroll
            for (int j = 0; j < 4; ++j) { const f32x4 h = v[j] * rstd * mul[j] + add[j]; o8[64 * j] = (unsigned long long)pk2(h.x, h.y) | ((unsigned long long)pk2(h.z, h.w) << 32); } }
    }
}
__device__ __forceinline__ void p6b_rows(const Args& A, char* lds, int G) {
    const int tid = opaque_tid(), lane = tid & 63, wave = tid >> 6;
    const float* modp = (const float*)(A.ws + WS_MODP); float* mv = (float*)lds;
    for (int rb = blockIdx.x; rb < MROWS / 64; rb += G) {
        const int b = rb >> 5;
        __syncthreads();
#pragma unroll 1
        for (int col = tid; col < 1024; col += NTHR) { mv[col] = A.in[I_POSTG][col] * mod_val(modp, A.in[I_ADAB], 0, b, 2048 + col); mv[1024 + col] = A.in[I_POSTG][1024 + col] * mod_val(modp, A.in[I_ADAB], 1, b, 2048 + col); }
        __syncthreads();
        f32x4 g0[4], g1[4];
#pragma unroll
        for (int j = 0; j < 4; ++j) { g0[j] = *(const f32x4*)(mv + 4 * lane + 256 * j); g1[j] = *(const f32x4*)(mv + 1024 + 4 * lane + 256 * j); }
        f32x4 nx[4]; v2u n0[4], n1[4];
        { const int m = rb * 64 + wave * 8; const f32x4* xr = (const f32x4*)(A.in[I_X] + (size_t)m * DMOD) + lane; const v2u* y1r = (const v2u*)((unsigned char*)A.out + (size_t)m * 4096) + lane;
#pragma unroll
          for (int j = 0; j < 4; ++j) { nx[j] = __builtin_nontemporal_load(&xr[64 * j]); n0[j] = y1r[64 * j]; n1[j] = y1r[256 + 64 * j]; } }
#pragma unroll 1
        for (int r = 0; r < 8; ++r) { const int m = rb * 64 + wave * 8 + r;
            unsigned char* slot = (unsigned char*)A.out + (size_t)m * 4096;
            f32x4 v[4], y0[4], y1[4]; float s0 = 0.f, s1 = 0.f; v2u w0[4], w1[4];
#pragma unroll
            for (int j = 0; j < 4; ++j) { v[j] = nx[j]; w0[j] = n0[j]; w1[j] = n1[j]; }
            if (r < 7) { const f32x4* xr = (const f32x4*)(A.in[I_X] + (size_t)(m + 1) * DMOD) + lane; const v2u* y1r = (const v2u*)(slot + 4096) + lane;
#pragma unroll
                for (int j = 0; j < 4; ++j) { nx[j] = __builtin_nontemporal_load(&xr[64 * j]); n0[j] = y1r[64 * j]; n1[j] = y1r[256 + 64 * j]; } }
#pragma unroll
            for (int j = 0; j < 4; ++j) { const v2u w = w0[j], u = w1[j];
                y0[j] = (f32x4){__uint_as_float(w.x << 16), __uint_as_float(w.x & 0xffff0000u), __uint_as_float(w.y << 16), __uint_as_float(w.y & 0xffff0000u)};
                y1[j] = (f32x4){__uint_as_float(u.x << 16), __uint_as_float(u.x & 0xffff0000u), __uint_as_float(u.y << 16), __uint_as_float(u.y & 0xffff0000u)};
                s0 += (y0[j].x * y0[j].x + y0[j].y * y0[j].y) + (y0[j].z * y0[j].z + y0[j].w * y0[j].w);
                s1 += (y1[j].x * y1[j].x + y1[j].y * y1[j].y) + (y1[j].z * y1[j].z + y1[j].w * y1[j].w); }
            const float r0 = rsqrtf(wave_sum(s0) * (1.f / DMOD) + RMS_EPS), r1 = rsqrtf(wave_sum(s1) * (1.f / DMOD) + RMS_EPS);
            f32x4* orow = (f32x4*)slot + lane;
#pragma unroll
            for (int j = 0; j < 4; ++j) { const f32x4 x1 = v[j] + g0[j] * (y0[j] * r0); v[j] = x1 + g1[j] * (y1[j] * r1); }
            asm volatile("" ::: "memory");
#pragma unroll
            for (int j = 0; j < 4; ++j) orow[64 * j] = v[j]; }
    }
}
#define BAR_ALL() asm volatile("s_waitcnt vmcnt(0) lgkmcnt(0)\n\ts_barrier" ::: "memory")
#define BAR_LDS() asm volatile("s_waitcnt lgkmcnt(0)\n\ts_barrier" ::: "memory")
typedef float f32x4m __attribute__((ext_vector_type(4)));
__device__ __forceinline__ void p2a_kbar(const Args& A, char* lds, int G) {
    const int tid = opaque_tid(); const bf16* P0 = (const bf16*)(A.ws + WS_BIG); float* kbar = (float*)(A.ws + WS_KBAR); float* red = (float*)lds;
    for (int item = blockIdx.x; item < NB * 16 * 8; item += G) {
        const int b = item >> 7, h = (item >> 3) & 15, n = item & 7; const int c8 = tid & 7, rg = tid >> 3;
        float acc[8];
#pragma unroll
        for (int e = 0; e < 8; ++e) acc[e] = 0.f;
#pragma unroll
        for (int i = 0; i < 4; ++i) { const bf16x8 kv = *(const bf16x8*)(P0 + (size_t)(b * SEQL + n * 256 + rg + 64 * i) * LD0 + C0_K + h * 64 + c8 * 8);
#pragma unroll
            for (int e = 0; e < 8; ++e) acc[e] += bf2f((unsigned short)kv[e]); }
        __syncthreads();
#pragma unroll
        for (int e = 0; e < 8; ++e) red[rg * 65 + c8 * 8 + e] = acc[e];
        __syncthreads();
        if (tid < 64) { float s = 0.f; for (int r = 0; r < 64; ++r) s += red[r * 65 + tid]; kbar[(size_t)item * 64 + tid] = s * (1.f / 256.f); }
    }
    __syncthreads();
}
__device__ __forceinline__ void p2a_conv(const Args& A, int G) {
    const int tid = opaque_tid(); const bf16* __restrict__ P0 = (const bf16*)(A.ws + WS_BIG); bf16* __restrict__ XC = (bf16*)A.out;
    if (tid >= 384) return;
    const int chg = tid % 192, half = tid / 192, ch = chg * 8;
    float w[4][8], bs[8];
#pragma unroll
    for (int k = 0; k < 4; ++k) { const f32x4 a = *(const f32x4*)(A.in[I_ECONVW] + k * 1536 + ch), b2 = *(const f32x4*)(A.in[I_ECONVW] + k * 1536 + ch + 4);
#pragma unroll
        for (int e = 0; e < 4; ++e) { w[k][e] = a[e]; w[k][4 + e] = b2[e]; } }
    { const f32x4 a = *(const f32x4*)(A.in[I_ECONVB] + ch), b2 = *(const f32x4*)(A.in[I_ECONVB] + ch + 4);
#pragma unroll
      for (int e = 0; e < 4; ++e) { bs[e] = a[e]; bs[4 + e] = b2[e]; } }
    for (int rb = blockIdx.x; rb < MROWS / 64; rb += G) {
        const int m0 = rb * 64 + half * 32; const int tb = m0 & (SEQL - 1);
        bf16x8 r0 = {}, r1 = {}, r2 = {};
        if (tb > 0) { r0 = *(const bf16x8*)(P0 + (size_t)(m0 - 3) * LD0 + C0_XBC + ch); r1 = *(const bf16x8*)(P0 + (size_t)(m0 - 2) * LD0 + C0_XBC + ch); r2 = *(const bf16x8*)(P0 + (size_t)(m0 - 1) * LD0 + C0_XBC + ch); }
#pragma unroll 1
        for (int i0 = 0; i0 < 32; i0 += 8) { bf16x8 rr[8];
#pragma unroll
        for (int i = 0; i < 8; ++i) rr[i] = *(const bf16x8*)(P0 + (size_t)(m0 + i0 + i) * LD0 + C0_XBC + ch);
#pragma unroll
        for (int ii = 0; ii < 8; ++ii) { const int i = i0 + ii; const bf16x8 r3 = rr[ii]; float o[8];
#pragma unroll
            for (int e = 0; e < 8; ++e) { const float a = bs[e] + w[0][e] * bf2f((unsigned short)r0[e]) + w[1][e] * bf2f((unsigned short)r1[e]) + w[2][e] * bf2f((unsigned short)r2[e]) + w[3][e] * bf2f((unsigned short)r3[e]); o[e] = silu_f(a); }
            v4u pw; pw.x = pk2(o[0], o[1]); pw.y = pk2(o[2], o[3]); pw.z = pk2(o[4], o[5]); pw.w = pk2(o[6], o[7]);
            *(v4u*)(XC + (size_t)(m0 + i) * 2048 + ch) = pw; r0 = r1; r1 = r2; r2 = r3; } }
    }
}
constexpr int S_CS = 0, S_BS = 17408, S_BST = 34816, S_XT = 53248, S_XWT = 57856, S_XS = 62464, S_GG = 67584, S_SBF = 76800, S_DTA = 85504;
constexpr int F_CS = 0, F_BS = 17408, F_BST = 34816, F_XT = 53248, F_XWT = 62464, F_XS = 71680, F_GG = 80896, F_SBF = 90112, F_DTA = 107520;
template <bool DRY> __device__ __forceinline__ void ssd_unit(const Args& A, char* lds, int b, int h) {
    const int tid = opaque_tid(), lane = tid & 63, wave = __builtin_amdgcn_readfirstlane(tid >> 6); const int fr = lane & 15, fq = lane >> 4;
    bf16* P0 = (bf16*)(A.ws + WS_BIG); const bf16* XC = (const bf16*)A.out; const float* DT = (const float*)(A.ws + WS_DT);
    const int g = h >> 3; const int xcol = h * 64, bcol = 1024 + g * 128, ccol = 1280 + g * 128;
    bf16* CS = (bf16*)(lds + F_CS); bf16* BS = (bf16*)(lds + F_BS); bf16* BST = (bf16*)(lds + F_BST); bf16* XT = (bf16*)(lds + F_XT); bf16* XWT = (bf16*)(lds + F_XWT);
    bf16* XS = (bf16*)(lds + F_XS); bf16* GG = (bf16*)(lds + F_GG); bf16* SBF = (bf16*)(lds + F_SBF); float* DTA0 = (float*)(lds + F_DTA);
    for (int i = tid; i < 64 * 136; i += NTHR) SBF[i] = 0;
    const float Ah = -__expf(A.in[I_EALOG][h]), Dh = A.in[I_EDSKIP][h];
    const int lt = wave >> 1, pt0 = 2 * (wave & 1), st0 = 2 * (wave & 1), nt0 = (wave >> 1) * 2;
    f32x4m sta[2][2];
#pragma unroll
    for (int pi = 0; pi < 2; ++pi)
#pragma unroll
        for (int ni = 0; ni < 2; ++ni) sta[pi][ni] = (f32x4m){0.f, 0.f, 0.f, 0.f};
    const size_t rb0 = (size_t)b * SEQL;
    const bf16* pB = XC + (rb0 + (tid >> 4)) * 2048 + bcol + (tid & 15) * 8; const bf16* pC = XC + (rb0 + (tid >> 4)) * 2048 + ccol + (tid & 15) * 8; const bf16* pX = XC + (rb0 + (tid >> 3)) * 2048 + xcol + (tid & 7) * 8;
    const bf16* pZ = P0 + (rb0 + lt * 16 + 4 * fq) * LD0 + C0_ZA + h * 64 + pt0 * 16 + fr;
    bf16x8 pre[5]; float dtn = 0.f;
    pre[0] = *(const bf16x8*)pB; pre[1] = *(const bf16x8*)(pB + 32 * 2048); pre[2] = *(const bf16x8*)pC; pre[3] = *(const bf16x8*)(pC + 32 * 2048); pre[4] = *(const bf16x8*)pX;
    unsigned short zn[2][4], gts[2][4]; float sqs[2][4];
#pragma unroll
    for (int pi = 0; pi < 2; ++pi)
#pragma unroll
        for (int r = 0; r < 4; ++r) { zn[pi][r] = pZ[(size_t)r * LD0 + 16 * pi]; gts[pi][r] = 0; sqs[pi][r] = 0.f; }
    if (wave == 0) { dtn = DT[(rb0 + lane) * 16 + h]; const float s = wave_scan(Ah * dtn, lane); const float tot = rdlane(s, 63);
        DTA0[lane] = dtn; DTA0[64 + lane] = s; DTA0[128 + lane] = __expf(s); DTA0[192 + lane] = __expf(tot - s); dtn = DT[(rb0 + 64 + lane) * 16 + h]; }
    BAR_LDS();
    for (int c = 0; c < SEQL / 64; ++c) {
        const size_t m0 = rb0 + c * 64; float* DTA = DTA0 + (c & 1) * 256;
        { const int t = tid >> 4, c8 = tid & 15;
          *(bf16x8*)(BS + t * 136 + c8 * 8) = pre[0]; *(bf16x8*)(BS + (t + 32) * 136 + c8 * 8) = pre[1]; *(bf16x8*)(CS + t * 136 + c8 * 8) = pre[2]; *(bf16x8*)(CS + (t + 32) * 136 + c8 * 8) = pre[3];
          const int sw0 = ((((t >> 3) ^ (c8 & 7)) << 3) + (t & 7)), sw1 = (((((t + 32) >> 3) ^ (c8 & 7)) << 3) + (t & 7));
#pragma unroll
          for (int e = 0; e < 8; ++e) { BST[(c8 * 8 + e) * 72 + sw0] = (bf16)pre[0][e]; BST[(c8 * 8 + e) * 72 + sw1] = (bf16)pre[1][e]; }
          const int tx = tid >> 3, cx = tid & 7; *(bf16x8*)(XS + tx * 72 + cx * 8) = pre[4]; const float dtv = DTA[tx], wv = DTA[192 + tx]; const int sx = ((((tx >> 3) ^ cx) << 3) + (tx & 7));
#pragma unroll
          for (int e = 0; e < 8; ++e) { const float xd = bf2f((unsigned short)pre[4][e]) * dtv; XT[(cx * 8 + e) * 72 + sx] = (bf16)f2bf(xd); XWT[(cx * 8 + e) * 72 + sx] = (bf16)f2bf(xd * wv); } }
        if (c > 0) {
#pragma unroll
            for (int pi = 0; pi < 2; ++pi)
#pragma unroll
                for (int r = 0; r < 4; ++r) { const int l = lt * 16 + 4 * fq + r;
                    if (!DRY || sqs[pi][r] == 1.2345e30f) { ((bf16*)pZ)[((size_t)(c - 1) * 64 + r) * LD0 + 16 * pi] = gts[pi][r];
                        if (fr == 0) ((float*)((unsigned char*)A.out + (m0 - 64 + l) * 4096 + 3072))[h * 4 + pt0 + pi] = sqs[pi][r]; } } }
        if (c + 1 < SEQL / 64) { const size_t o = (size_t)(c + 1) * 64 * 2048;
            pre[0] = *(const bf16x8*)(pB + o); pre[1] = *(const bf16x8*)(pB + o + 32 * 2048); pre[2] = *(const bf16x8*)(pC + o); pre[3] = *(const bf16x8*)(pC + o + 32 * 2048); pre[4] = *(const bf16x8*)(pX + o); }
        unsigned short zv[2][4];
#pragma unroll
        for (int pi = 0; pi < 2; ++pi)
#pragma unroll
            for (int r = 0; r < 4; ++r) zv[pi][r] = zn[pi][r];
        if (c + 1 < SEQL / 64) {
#pragma unroll
            for (int pi = 0; pi < 2; ++pi)
#pragma unroll
                for (int r = 0; r < 4; ++r) zn[pi][r] = pZ[((size_t)(c + 1) * 64 + r) * LD0 + 16 * pi]; }
        BAR_LDS();
        f32x4m cb[2], ya[2]; cb[0] = (f32x4m){0.f, 0.f, 0.f, 0.f}; cb[1] = cb[0]; ya[0] = cb[0]; ya[1] = cb[0];
#pragma unroll
        for (int ks = 0; ks < 4; ++ks) { const bf16x8 af = *(const bf16x8*)(CS + (lt * 16 + fr) * 136 + ks * 32 + 8 * fq);
#pragma unroll
            for (int si = 0; si < 2; ++si) { const bf16x8 bfv = *(const bf16x8*)(BS + ((st0 + si) * 16 + fr) * 136 + ks * 32 + 8 * fq); cb[si] = __builtin_amdgcn_mfma_f32_16x16x32_bf16(af, bfv, cb[si], 0, 0, 0); }
#pragma unroll
            for (int pi = 0; pi < 2; ++pi) { const bf16x8 sf = *(const bf16x8*)(SBF + ((pt0 + pi) * 16 + fr) * 136 + ks * 32 + 8 * fq); ya[pi] = __builtin_amdgcn_mfma_f32_16x16x32_bf16(af, sf, ya[pi], 0, 0, 0); } }
#pragma unroll
        for (int r = 0; r < 4; ++r) { const int l = lt * 16 + 4 * fq + r; const float al = DTA[64 + l];
#pragma unroll
            for (int si = 0; si < 2; ++si) { const int s = (st0 + si) * 16 + fr; const float v = (s <= l) ? cb[si][r] * __expf(al - DTA[64 + s]) : 0.f; GG[l * 72 + s] = (bf16)f2bf(v); }
            const float ea = DTA[128 + l]; ya[0][r] *= ea; ya[1][r] *= ea; }
        const float decay = __expf(DTA[64 + 63]);
        BAR_LDS();
#pragma unroll
        for (int ks = 0; ks < 2; ++ks) { const bf16x8 gf = *(const bf16x8*)(GG + (lt * 16 + fr) * 72 + ks * 32 + 8 * fq);
#pragma unroll
            for (int pi = 0; pi < 2; ++pi) { const int p = (pt0 + pi) * 16 + fr; const bf16x8 xf = *(const bf16x8*)(XT + p * 72 + (((ks * 4 + fq) ^ ((p >> 3) & 7)) << 3)); ya[pi] = __builtin_amdgcn_mfma_f32_16x16x32_bf16(gf, xf, ya[pi], 0, 0, 0); } }
#pragma unroll
        for (int pi = 0; pi < 2; ++pi)
#pragma unroll
            for (int ni = 0; ni < 2; ++ni) sta[pi][ni] = sta[pi][ni] * decay;
#pragma unroll
        for (int ks = 0; ks < 2; ++ks) { bf16x8 bt[2];
#pragma unroll
            for (int ni = 0; ni < 2; ++ni) { const int n = (nt0 + ni) * 16 + fr; bt[ni] = *(const bf16x8*)(BST + n * 72 + (((ks * 4 + fq) ^ ((n >> 3) & 7)) << 3)); }
#pragma unroll
            for (int pi = 0; pi < 2; ++pi) { const int p = (pt0 + pi) * 16 + fr; const bf16x8 xw = *(const bf16x8*)(XWT + p * 72 + (((ks * 4 + fq) ^ ((p >> 3) & 7)) << 3));
#pragma unroll
                for (int ni = 0; ni < 2; ++ni) sta[pi][ni] = __builtin_amdgcn_mfma_f32_16x16x32_bf16(xw, bt[ni], sta[pi][ni], 0, 0, 0); } }
#pragma unroll
        for (int pi = 0; pi < 2; ++pi)
#pragma unroll
            for (int ni = 0; ni < 2; ++ni)
#pragma unroll
                for (int r = 0; r < 4; ++r) SBF[((pt0 + pi) * 16 + 4 * fq + r) * 136 + (nt0 + ni) * 16 + fr] = (bf16)f2bf(sta[pi][ni][r]);
#pragma unroll
        for (int pi = 0; pi < 2; ++pi)
#pragma unroll
            for (int r = 0; r < 4; ++r) { const int l = lt * 16 + 4 * fq + r, p = (pt0 + pi) * 16 + fr;
                const float y = ya[pi][r] + Dh * bf2f(XS[l * 72 + p]);
                const float z = bf2f(zv[pi][r]); const float gt = y * silu_f(z);
                gts[pi][r] = (unsigned short)f2bf(gt); sqs[pi][r] = row_sum16(gt * gt); }
        if (wave == 0 && c + 1 < SEQL / 64) { float* DN = DTA0 + ((c + 1) & 1) * 256; const float s = wave_scan(Ah * dtn, lane); const float tot = rdlane(s, 63);
            DN[lane] = dtn; DN[64 + lane] = s; DN[128 + lane] = __expf(s); DN[192 + lane] = __expf(tot - s);
            if (c + 2 < SEQL / 64) dtn = DT[(m0 + 128 + lane) * 16 + h]; }
        BAR_LDS();
    }
#pragma unroll
    for (int pi = 0; pi < 2; ++pi)
#pragma unroll
        for (int r = 0; r < 4; ++r) { const int l = lt * 16 + 4 * fq + r;
            if (!DRY || sqs[pi][r] == 1.2345e30f) { ((bf16*)pZ)[((size_t)(SEQL / 64 - 1) * 64 + r) * LD0 + 16 * pi] = gts[pi][r];
                if (fr == 0) ((float*)((unsigned char*)A.out + (rb0 + SEQL - 64 + l) * 4096 + 3072))[h * 4 + pt0 + pi] = sqs[pi][r]; } }
}
__device__ __forceinline__ void p2c_fixup(const Args& A, int vcu, int G) {
    const int tid = opaque_tid(), lane = tid & 63, wave = tid >> 6; bf16* P0 = (bf16*)(A.ws + WS_BIG); const float* ssq = (const float*)(A.ws + WS_SSQ);
    f32x4 gn[4];
#pragma unroll
    for (int j = 0; j < 4; ++j) gn[j] = *((const f32x4*)A.in[I_ENORMG] + lane + 64 * j);
    for (int m = vcu * NWAVES + wave; m < MROWS; m += G * NWAVES) { const float r = rsqrtf(wave_sum(((const float*)((const unsigned char*)A.out + (size_t)m * 4096 + 3072))[lane]) * (1.f / 1024.f) + RMS_EPS);
        v2u* p = (v2u*)(P0 + (size_t)m * LD0 + C0_ZA) + lane;
#pragma unroll
        for (int j = 0; j < 4; ++j) { const v2u w = p[64 * j]; v2u o; o.x = pk2(__uint_as_float(w.x << 16) * r * gn[j].x, __uint_as_float(w.x & 0xffff0000u) * r * gn[j].y);
            o.y = pk2(__uint_as_float(w.y << 16) * r * gn[j].z, __uint_as_float(w.y & 0xffff0000u) * r * gn[j].w); p[64 * j] = o; } }
}
__device__ __forceinline__ void p5a_fcum(const Args& A, char* lds, int G) {
    const int tid = opaque_tid(), lane = tid & 63, wave = tid >> 6; const float* LF = (const float*)(A.ws + WS_LF); float* F2 = (float*)(A.ws + WS_F2); float* wtot = (float*)(lds + 120 * 1024);
    for (int item = blockIdx.x; item < NB * 24; item += G) { const int b = item / 24, h = item % 24; const float fb = A.in[I_OFGB][h];
        float v[4]; float run = 0.f;
#pragma unroll
        for (int i = 0; i < 4; ++i) { const size_t ix = ((size_t)b * SEQL + 4 * tid + i) * 24 + h; const float* L1p = (const float*)(A.ws + WS_LFP);
            const float fr_ = (LF[ix] + L1p[ix]) + (L1p[ix + (size_t)MROWS * 24] + L1p[ix + (size_t)2 * MROWS * 24]) + fb; run += -softplus_g(-fr_); v[i] = run; }
        float s = run;
#pragma unroll
        for (int o = 1; o < 64; o <<= 1) { const float x = __shfl_up(s, o); if (lane >= o) s += x; }
        __syncthreads();
        if (lane == 63) wtot[wave] = s;
        __syncthreads();
        float off = s - run; for (int w = 0; w < wave; ++w) off += wtot[w];
#pragma unroll
        for (int i = 0; i < 4; ++i) { const float f2v = (off + v[i]) * LOG2E; const int t = 4 * tid + i; F2[(size_t)item * SEQL + t] = f2v;
            if ((t & 127) == 127) wtot[64 + (t >> 7)] = f2v; if ((t & 255) == 0) wtot[96 + (t >> 8)] = f2v; }
        { const bf16* P1 = (const bf16*)(A.ws + WS_BIG); float qm = 0.f, km = 0.f;
#pragma unroll 8
          for (int i = 0; i < 32; ++i) { const size_t m = (size_t)b * SEQL + (tid >> 3) + 64 * i; const int c8 = tid & 7; float qs = 0.f, ks2 = 0.f;
              const bf16x8 qv = *(const bf16x8*)(P1 + m * LD1 + C1_Q + h * 64 + c8 * 8), kv = *(const bf16x8*)(P1 + m * LD1 + C1_K + h * 64 + c8 * 8);
#pragma unroll
              for (int e = 0; e < 8; ++e) { const float qf = bf2f((unsigned short)qv[e]), kf = bf2f((unsigned short)kv[e]); qs += qf * qf; ks2 += kf * kf; }
              qs += dppf<0xB1>(qs, qs); qs += dppf<0x4E>(qs, qs); qs += dppf<0x141>(qs, qs); ks2 += dppf<0xB1>(ks2, ks2); ks2 += dppf<0x4E>(ks2, ks2); ks2 += dppf<0x141>(ks2, ks2);
              qm = fmaxf(qm, qs); km = fmaxf(km, ks2); }
#pragma unroll
          for (int o = 1; o < 64; o <<= 1) { qm = fmaxf(qm, __shfl_xor(qm, o)); km = fmaxf(km, __shfl_xor(km, o)); }
          __syncthreads();
          if (lane == 0) { wtot[16 + wave] = qm; wtot[32 + wave] = km; }
          __syncthreads();
          if (tid < 8) { float a = 0.f, c = 0.f; for (int w = 0; w < 8; ++w) { a = fmaxf(a, wtot[16 + w]); c = fmaxf(c, wtot[32 + w]); } const float u2 = 2.f * sqrtf(a) * sqrtf(c) * 1.01f;
              const int qb = tid; const float fi0 = wtot[96 + qb]; int ts = 0; while (ts + 2 <= 4 * qb && u2 - (wtot[64 + (ts >> 1)] - fi0) <= -40.f) ts += 2;
              ((int*)(A.ws + WS_TS))[item * 8 + qb] = ts; } }
    }
    __syncthreads();
}
constexpr int S5_BU = 0  , S5_SS = 67584  , S5_US = 102400  ;
__device__ __forceinline__ float gelu_tanh(float x) { const float u = 0.7978845608028654f * (x + 0.044715f * x * x * x); const float e = __expf(2.f * u); const float t = 1.f - 2.f * __builtin_amdgcn_rcpf(e + 1.f); return 0.5f * x * (1.f + t); }
__device__ __forceinline__ void s5_unit(const Args& A, char* lds, int b, int g) {
    const int tid = opaque_tid(), lane = tid & 63, wave = __builtin_amdgcn_readfirstlane(tid >> 6); const int fr = lane & 15, fq = lane >> 4, r32 = lane & 31, hi = lane >> 5;
    const bf16* P1 = (const bf16*)(A.ws + WS_BIG); bf16* YD = (bf16*)A.out;
    const unsigned char* pg = A.ws + WS_S5P + (size_t)g * S5P_STRIDE; const bf16* BbT = (const bf16*)pg; const bf16* Cm = (const bf16*)(pg + 4096); const float* ari = (const float*)(pg + 8192);
    const int ttile = wave >> 2, ntile = wave & 3;
    const bf16x8 bfrag = *(const bf16x8*)(BbT + (ntile * 32 + r32) * 16 + 8 * hi);
    bf16x8 cfrag[4];
#pragma unroll
    for (int ks = 0; ks < 4; ++ks) cfrag[ks] = *(const bf16x8*)(Cm + fr * 128 + ks * 32 + 8 * fq);
    const float ar = ari[lane], ai = ari[64 + lane]; float sr = 0.f, si = 0.f;
    const float dskip = A.in[I_ODSKIP][g * 16 + fr];
    const size_t rb0 = (size_t)b * SEQL; const bf16* pU = P1 + (rb0 + ttile * 32 + r32) * LD1 + C1_U + g * 16 + 8 * hi;
    bf16x8 un = *(const bf16x8*)pU;
    BAR_LDS();
    for (int i = 0; i < SEQL / 64 + 2; ++i) {
        if (i < SEQL / 64) { float* BU = (float*)(lds + S5_BU) + (i & 1) * (64 * 132); f32x16 acc = {};
            acc = __builtin_amdgcn_mfma_f32_32x32x16_bf16(un, bfrag, acc, 0, 0, 0);
            if (ntile == 0) *(bf16x8*)((bf16*)(lds + S5_US) + ((i & 3) * 64 + ttile * 32 + r32) * 16 + 8 * hi) = un;
            if (i + 1 < SEQL / 64) un = *(const bf16x8*)(pU + (size_t)(i + 1) * 64 * LD1);
#pragma unroll
            for (int r = 0; r < 16; ++r) { const int t = ttile * 32 + (r & 3) + 8 * (r >> 2) + 4 * hi; BU[t * 132 + ntile * 32 + r32] = acc[r]; } }
        if (wave == 0 && i >= 1 && i <= SEQL / 64) { const float* BU = (const float*)(lds + S5_BU) + ((i - 1) & 1) * (64 * 132); bf16* SS = (bf16*)(lds + S5_SS) + ((i - 1) & 1) * (64 * 136);
#pragma unroll
            for (int hb = 0; hb < 2; ++hb) { f32x2_c bv[32];
#pragma unroll
                for (int t = 0; t < 32; ++t) bv[t] = *(const f32x2_c*)(BU + (hb * 32 + t) * 132 + 2 * lane);
                const f32x2_c a1 = {ar, ar}, a2 = {-ai, ai}; f32x2_c s2 = {sr, si};
#pragma unroll
                for (int t = 0; t < 32; ++t) { const f32x2_c sw = {s2.y, s2.x}; s2 = a1 * s2 + (a2 * sw + bv[t]);
                    *(unsigned*)(SS + (hb * 32 + t) * 136 + 2 * lane) = pk2(s2.x, s2.y); }
                sr = s2.x; si = s2.y; } }
        if (wave >= 4 && i >= 2) { const bf16* SS = (const bf16*)(lds + S5_SS) + ((i - 2) & 1) * (64 * 136); const int mt = wave - 4; const size_t m0 = rb0 + (size_t)(i - 2) * 64;
            unsigned short uv[4];
#pragma unroll
            for (int r = 0; r < 4; ++r) uv[r] = ((const bf16*)(lds + S5_US))[(((i - 2) & 3) * 64 + mt * 16 + 4 * fq + r) * 16 + fr];
            f32x4m acc = (f32x4m){0.f, 0.f, 0.f, 0.f};
#pragma unroll
            for (int ks = 0; ks < 4; ++ks) { const bf16x8 af = *(const bf16x8*)(SS + (mt * 16 + fr) * 136 + ks * 32 + 8 * fq); acc = __builtin_amdgcn_mfma_f32_16x16x32_bf16(af, cfrag[ks], acc, 0, 0, 0); }
#pragma unroll
            for (int r = 0; r < 4; ++r) { const size_t m = m0 + mt * 16 + 4 * fq + r; YD[m * 2048 + 1024 + g * 16 + fr] = (bf16)f2bf(gelu_tanh(acc[r] + dskip * bf2f(uv[r]))); } }
        BAR_LDS();
    }
}
template <bool DRY> __device__ __forceinline__ void moba_phase(const Args& A, char* lds, int vcu, int G) {
    const bf16* P0 = (const bf16*)(A.ws + WS_BIG); const float* kbar = (const float*)(A.ws + WS_KBAR);
    unsigned* cnt = (unsigned*)(A.ws + WS_CNT) + (DRY ? 192 : 128); volatile unsigned* lw = (volatile unsigned*)(lds + BARST_OFF + 16);
    const int tid = opaque_tid();
    if (tid == 0) lw[0] = atomicAdd(cnt, 1u);
    BAR_ALL();
    int u = __builtin_amdgcn_readfirstlane((int)lw[0]);
    while (u < NB * 16 * 8) {
        unsigned nxt = 0u; if (tid == 0) nxt = atomicAdd(cnt, 1u);
        const int qb = 7 - u / 128, bh = u % 128, b = bh >> 4, h = bh & 15;
        attn_body::attn_unit<8, 0, LD0, DRY>(b, h, qb, (const attn_body::bf16*)(P0 + C0_Q), (const attn_body::bf16*)(P0 + C0_K), (const attn_body::bf16*)(P0 + C0_V), (attn_body::bf16*)(P0 + C0_Q),
                                            (const attn_body::bf16*)(P0 + C0_ZB), kbar + (size_t)bh * 512, nullptr, lw, nxt, lds);
        BAR_LDS();
        u = __builtin_amdgcn_readfirstlane((int)lw[0]);
    }
}
template <bool DRY> __device__ __forceinline__ void fox_phase(const Args& A, char* lds, int vcu, int G) {
    const bf16* P1 = (const bf16*)(A.ws + WS_BIG); const float* F2 = (const float*)(A.ws + WS_F2); const int* TSv = (const int*)(A.ws + WS_TS);
    unsigned* cnt = (unsigned*)(A.ws + WS_CNT) + (DRY ? 64 : 0); volatile unsigned* lw = (volatile unsigned*)(lds + BARST_OFF + 16);
    const int tid = opaque_tid();
    if (tid == 0) lw[0] = atomicAdd(cnt, 1u);
    BAR_ALL();
    int u = __builtin_amdgcn_readfirstlane((int)lw[0]);
    while (u < NB * 24 * 8) {
        unsigned nxt = 0u; if (tid == 0) nxt = atomicAdd(cnt, 1u);
        const int qb = 7 - u / 192, bh = u % 192, b = bh / 24, h = bh % 24;
        attn_body::attn_unit<90, 1, LD1, DRY>(b, h, qb, (const attn_body::bf16*)(P1 + C1_Q), (const attn_body::bf16*)(P1 + C1_K), (const attn_body::bf16*)(P1 + C1_V), (attn_body::bf16*)(P1 + C1_Q),
                                            (const attn_body::bf16*)(P1 + C1_ZC), F2 + (size_t)bh * SEQL, TSv + bh * 8, lw, nxt, lds);
        BAR_LDS();
        u = __builtin_amdgcn_readfirstlane((int)lw[0]);
    }
}
#define LAS __attribute__((address_space(3)))
#define XB_TMO      128
#define XB_XCNT(j)  (256  + 64 * (j))
#define XB_XSUB(j)  (1280 + 64 * (j))
#define XB_XGEN(j)  (2304 + 64 * (j))
#define XB_TOP      3328
#define XB_TOPGEN   3392
#define XCD_BAR_WORDS 3456
#define XB_SPIN_CAP (1u << 18)

__device__ __forceinline__ unsigned xb_ld(unsigned* p)              { return __hip_atomic_load(p, __ATOMIC_RELAXED, __HIP_MEMORY_SCOPE_AGENT); }
__device__ __forceinline__ unsigned xb_add(unsigned* p, unsigned v) { return __hip_atomic_fetch_add(p, v, __ATOMIC_RELAXED, __HIP_MEMORY_SCOPE_AGENT); }
__device__ __forceinline__ unsigned xb_xcc_id() { return (unsigned)__builtin_amdgcn_s_getreg((3 << 11) | 20) & 0xFu; }
#define XB_SPIN(cond, bar) do { unsigned _sp = 0; while (cond) { __builtin_amdgcn_s_sleep(1); \
    if ((++_sp & 255u) == 0u) { if (xb_ld(&(bar)[XB_TMO])) break; if (_sp > XB_SPIN_CAP) { atomicAdd(&(bar)[XB_TMO], 1u); break; } } } } while (0)

struct XcdBarrier {
    unsigned* bar; unsigned x;
    volatile LAS unsigned* st;
};

__device__ __forceinline__ XcdBarrier xcd_barrier_post(unsigned* bar, volatile LAS unsigned* st) {
    XcdBarrier b; b.bar = bar; b.x = xb_xcc_id(); b.st = st;
    if (threadIdx.x == 0) (void)xb_add(&bar[XB_XCNT(b.x)], 1u);
    return b;
}
__device__ __forceinline__ void xcd_barrier_complete(unsigned* bar, unsigned x, unsigned& nloc, unsigned& nx) {
    const unsigned G = gridDim.x * gridDim.y * gridDim.z;
    unsigned sum, cnt, mine, sp = 0u;
    for (;;) {
        sum = 0u; cnt = 0u; mine = 0u;
#pragma unroll
        for (unsigned j = 0; j < 16; ++j) { const unsigned c = xb_ld(&bar[XB_XCNT(j)]); sum += c; cnt += (c > 0u) ? 1u : 0u; mine = (j == x) ? c : mine; }
        if (sum == G) break;
        __builtin_amdgcn_s_sleep(1);
        if ((++sp & 255u) == 0u) { if (xb_ld(&bar[XB_TMO])) break; if (sp > XB_SPIN_CAP) { atomicAdd(&bar[XB_TMO], 1u); break; } }
    }
    nloc = mine > 0u ? mine : 1u; nx = cnt > 0u ? cnt : 1u;
}

__device__ __forceinline__ void xcd_barrier(const XcdBarrier& b) {
    asm volatile("s_waitcnt vmcnt(0)" ::: "memory");
    __syncthreads();
    if (threadIdx.x == 0) {
        unsigned* bar = b.bar;
        __builtin_amdgcn_s_waitcnt(0);
        unsigned nloc = b.st[0], nx = b.st[1];
        if (nloc == 0u) { xcd_barrier_complete(bar, b.x, nloc, nx); b.st[0] = nloc; b.st[1] = nx; }
        const unsigned old = xb_add(&bar[XB_XSUB(b.x)], 1u);
        const unsigned gen = old / nloc;
        if (old + 1u == (gen + 1u) * nloc) {
            __builtin_amdgcn_fence(__ATOMIC_RELEASE, "agent");
            asm volatile("s_waitcnt vmcnt(0)" ::: "memory");
            const unsigned og = xb_add(&bar[XB_TOP], 1u);
            const unsigned tg = og / nx;
            if (og + 1u == (tg + 1u) * nx) xb_add(&bar[XB_TOPGEN], 1u);
            else XB_SPIN(xb_ld(&bar[XB_TOPGEN]) == tg, bar);
            __builtin_amdgcn_fence(__ATOMIC_ACQUIRE, "agent");
            xb_add(&bar[XB_XGEN(b.x)], 1u);
            asm volatile("s_waitcnt vmcnt(0)" ::: "memory");
        } else {
            XB_SPIN(xb_ld(&bar[XB_XGEN(b.x)]) == gen, bar);
            __builtin_amdgcn_fence(__ATOMIC_ACQUIRE, "agent");
            asm volatile("s_waitcnt vmcnt(0)" ::: "memory");
        }
    }
    __syncthreads();
}

constexpr int ARGS_OFF = 132096;
__device__ __forceinline__ Args get_args(const unsigned char* lds) {
    Args a; const unsigned long long* p = (const unsigned long long*)(lds + ARGS_OFF);
#pragma unroll
    for (int i = 0; i < 29; ++i) { const unsigned long long v = p[i]; const unsigned lo = __builtin_amdgcn_readfirstlane((unsigned)v), hi = __builtin_amdgcn_readfirstlane((unsigned)(v >> 32));
        const unsigned long long w = ((unsigned long long)hi << 32) | lo; if (i < 27) a.in[i] = (const float*)w; else if (i == 27) a.out = (float*)w; else a.ws = (unsigned char*)w; }
    return a;
}
#define PHASE_BEGIN { const Args args = get_args(lds); unsigned char* ws = args.ws; bf16* XN = (bf16*)args.out; bf16* PB = (bf16*)(ws + WS_BIG); (void)ws; (void)XN; (void)PB;
#ifdef DUP_SYNC
#define PHASE_END } xcd_barrier(xbar); xcd_barrier(xbar);
#else
#define PHASE_END } xcd_barrier(xbar);
#endif
#define PHASE_END_NOSYNC }
__global__ void __launch_bounds__(NTHR, 2) trunk_fwd(Args kargs_unused) {
    extern __shared__ __attribute__((aligned(16))) unsigned char lds[];
    cg::grid_group grid = cg::this_grid();
    const int G = gridDim.x, bx = blockIdx.x; const int vcu = (G % 8 == 0) ? (bx % 8) * (G / 8) + bx / 8 : bx;
    char* ldsc = (char*)lds; PG8_LAS unsigned char* ldsg = (PG8_LAS unsigned char*)lds;
    { const int t = opaque_tid(); if (t < 29) { const unsigned long long* ka = (const unsigned long long*)__builtin_amdgcn_kernarg_segment_ptr(); ((unsigned long long*)(lds + ARGS_OFF))[t] = ka[t]; }
      if (t < 2) ((unsigned*)(lds + BARST_OFF))[t] = 0u; }
    __syncthreads();
    XcdBarrier xbar;
    {
    const Args args = get_args(lds);
    unsigned* rdy = (unsigned*)(args.ws + WS_BAR) + 4160;
    if (bx == 0) { unsigned* bw = (unsigned*)(args.ws + WS_BAR); for (int i = opaque_tid(); i < 4096; i += NTHR) bw[i] = 0u;
        asm volatile("s_waitcnt vmcnt(0)" ::: "memory"); __syncthreads();
        if (opaque_tid() == 0) { __builtin_amdgcn_fence(__ATOMIC_RELEASE, "agent"); asm volatile("s_waitcnt vmcnt(0)" ::: "memory"); __hip_atomic_store(rdy, 0x600DF00Du, __ATOMIC_RELAXED, __HIP_MEMORY_SCOPE_AGENT); } }
    if (G > 0x40000000) grid.sync();
    p0_prologue(args, ldsc, vcu, G);
    if (opaque_tid() == 0) { unsigned sp = 0; while (__hip_atomic_load(rdy, __ATOMIC_RELAXED, __HIP_MEMORY_SCOPE_AGENT) != 0x600DF00Du && ++sp < (1u << 22)) __builtin_amdgcn_s_sleep(2);
        __builtin_amdgcn_fence(__ATOMIC_ACQUIRE, "agent"); asm volatile("s_waitcnt vmcnt(0)" ::: "memory"); }
    __syncthreads();
    xbar = xcd_barrier_post((unsigned*)(args.ws + WS_BAR), (volatile LAS unsigned*)(lds + BARST_OFF));
    xcd_barrier(xbar);
    if (bx == 0 && opaque_tid() == 0) __hip_atomic_store(rdy, 0u, __ATOMIC_RELAXED, __HIP_MEMORY_SCOPE_AGENT);
    }
    PHASE_BEGIN
    p1a_rows(args, ldsc, G);
#ifdef DUP_MISC
    p1a_rows(args, ldsc, G);
#endif
    PHASE_END
    PHASE_BEGIN
    { pg8::Gemm g{XN, (const bf16*)(ws + WS_WT0), MROWS, NP0, 1024, 2048, 1024, 0}; pg8::StaticOrder S; S.init(MROWS, NP0, G, bx);
      pg8::EpiX<0> E{PB, LD0, args.in[I_EDTB], (float*)(ws + WS_DT), nullptr, nullptr, attn_body::C2};
      pg8::gemm_phase<pg8::EpiX<0>, pg8::StaticOrder, true, true>(ldsg, g, S, E); }
#ifdef DUP_GEMM
    { pg8::Gemm g{XN, (const bf16*)(ws + WS_WT0), MROWS, NP0, 1024, 2048, 1024, 0}; pg8::StaticOrder S; S.init(MROWS, NP0, G, bx);
      pg8::EpiX<0> E{PB, LD0, args.in[I_EDTB], (float*)(ws + WS_DT), nullptr, nullptr, attn_body::C2};
      pg8::gemm_phase<pg8::EpiX<0>, pg8::StaticOrder, true, true>(ldsg, g, S, E); }
#endif
    PHASE_END
    PHASE_BEGIN
    p2a_kbar(args, ldsc, G);
    p2a_conv(args, G);
#ifdef DUP_MISC
    p2a_kbar(args, ldsc, G);
    p2a_conv(args, G);
#endif
    PHASE_END
    PHASE_BEGIN
    if (G == 256) { if ((bx >> 3) < 16) ssd_unit<false>(args, ldsc, bx & 7, bx >> 3); }
    else for (int v = vcu; v < 128; v += G) ssd_unit<false>(args, ldsc, v >> 4, v & 15);
    PHASE_END_NOSYNC
    PHASE_BEGIN
#ifdef DUP_MOBA
    moba_phase<true>(args, ldsc, vcu, G);
#endif
    moba_phase<false>(args, ldsc, vcu, G);
    PHASE_END
    if (G != 256) {
    PHASE_BEGIN
    p2c_fixup(args, vcu, G);
    PHASE_END
    }
    PHASE_BEGIN
    { pg8::Gemm g{PB, (const bf16*)(ws + WS_WO0), MROWS, 1024, 2048, LD0, 2048, 0}; pg8::StaticOrder S; S.init(MROWS, 1024, G, bx);
      { pg8::Unit u0; u0.pm = 0; u0.pn = 0; const bool have = S.next(0, u0); const int pm0 = u0.pm; float* rs = (float*)(lds + 131072); const int t = opaque_tid();
        if (t < 256) { float r = 1.f;
            if (G == 256 && have) { const f32x4* pp = (const f32x4*)((const unsigned char*)args.out + (size_t)(pm0 * 256 + t) * 4096 + 3072); float sm = 0.f;
#pragma unroll
                for (int i = 0; i < 16; ++i) { const f32x4 v = pp[i]; sm += (v.x + v.y) + (v.z + v.w); }
                r = rsqrtf(sm * (1.f / 1024.f) + RMS_EPS); }
            rs[t] = r; }
        __syncthreads(); }
      pg8::EpiX<5> E{XN, 2048, nullptr, nullptr, nullptr, nullptr, 1.f};
      pg8::gemm_phase<pg8::EpiX<5>, pg8::StaticOrder, true, true>(ldsg, g, S, E); }
    PHASE_END
    PHASE_BEGIN
    p3b_rows(args, ldsc, G);
#ifdef DUP_MISC
    p3b_rows(args, ldsc, G);
#endif
    PHASE_END
    PHASE_BEGIN
    { pg8::Gemm g{XN + 1024, (const bf16*)(ws + WS_WT1), MROWS, LD1, 1024, 2048, 1024, 0}; pg8::StaticOrder S; S.init(MROWS, LD1, G, bx);
      pg8::EpiX<1> E{PB, LD1, nullptr, nullptr, nullptr, nullptr, attn_body::C2};
      pg8::gemm_phase<pg8::EpiX<1>, pg8::StaticOrder, true, true>(ldsg, g, S, E); }
    { pg8::Gemm g{XN + 1024, (const bf16*)(ws + WS_WT1) + (size_t)LD1 * 1024, MROWS, 1024, 256, 2048, 1024, 1}; pg8::StaticOrder S; S.init(MROWS, 1024, G, bx);
      pg8::EpiX<4> E{nullptr, 0, nullptr, (float*)(ws + WS_LF), (const bf16*)(ws + WS_LFP), nullptr, 1.f};
      pg8::gemm_phase<pg8::EpiX<4>, pg8::StaticOrder, true, true>(ldsg, g, S, E); }
#ifdef DUP_GEMM
    { pg8::Gemm g{XN + 1024, (const bf16*)(ws + WS_WT1), MROWS, LD1, 1024, 2048, 1024, 0}; pg8::StaticOrder S; S.init(MROWS, LD1, G, bx);
      pg8::EpiX<1> E{PB, LD1, nullptr, nullptr, nullptr, nullptr, attn_body::C2};
      pg8::gemm_phase<pg8::EpiX<1>, pg8::StaticOrder, true, true>(ldsg, g, S, E); }
#endif
    PHASE_END
    PHASE_BEGIN
    p5a_fcum(args, ldsc, G);
#ifdef DUP_S5
    p5a_fcum(args, ldsc, G);
#endif
    for (int v = vcu; v < 256; v += G) s5_unit(args, ldsc, v >> 5, v & 31);
#ifdef DUP_S5
    for (int v = vcu; v < 256; v += G) s5_unit(args, ldsc, v >> 5, v & 31);
#endif
    PHASE_END
    PHASE_BEGIN
#ifdef DUP_FOX
    fox_phase<true>(args, ldsc, vcu, G);
#endif
    if (vcu < 128) { pg8::Gemm g{XN + 1024, (const bf16*)(ws + WS_WG), MROWS, 512, 512, 2048, 512, 0}; pg8::StaticOrder S; S.init(MROWS, 512, 128, vcu);
      pg8::EpiX<3> E{PB + C1_U, LD1, args.in[I_OGLUB], nullptr, XN + 1024, PB + C1_ZD, 1.f};
      pg8::gemm_phase<pg8::EpiX<3>, pg8::StaticOrder, true, true>(ldsg, g, S, E); }
    fox_phase<false>(args, ldsc, vcu, G);
    PHASE_END
    PHASE_BEGIN
    { pg8::Gemm g{PB, (const bf16*)(ws + WS_WO1), MROWS, 1024, 2048, LD1, 2048, 0}; pg8::StaticOrder S; S.init(MROWS, 1024, G, bx);
      pg8::EpiX<2> E{XN + 1024, 2048, nullptr, nullptr, nullptr, nullptr, 1.f};
      pg8::gemm_phase<pg8::EpiX<2>, pg8::StaticOrder, true, true>(ldsg, g, S, E); }
#ifdef DUP_GEMM
    { pg8::Gemm g{PB, (const bf16*)(ws + WS_WO1), MROWS, 1024, 2048, LD1, 2048, 0}; pg8::StaticOrder S; S.init(MROWS, 1024, G, bx);
      pg8::EpiX<2> E{XN + 1024, 2048, nullptr, nullptr, nullptr, nullptr, 1.f};
      pg8::gemm_phase<pg8::EpiX<2>, pg8::StaticOrder, true, true>(ldsg, g, S, E); }
#endif
    PHASE_END
    PHASE_BEGIN
    p6b_rows(args, ldsc, G);
    PHASE_END_NOSYNC
}

extern "C" void kernel_launch(void* const* d_in, const int* in_sizes, int n_in, void* d_out, int out_size, void* d_ws, size_t ws_size, hipStream_t stream) {
    static int grid = 0;
    if (grid == 0) {
        if (n_in != 27 || out_size != MROWS * DMOD || ws_size < (size_t)256 * MiB) { fprintf(stderr, "kernel_launch: unexpected shapes n_in %d out %d ws %zu\n", n_in, out_size, ws_size); grid = -1; return; }
        int dev = 0, cus = 0, per_cu = 0;
        (void)hipGetDevice(&dev); (void)hipDeviceGetAttribute(&cus, hipDeviceAttributeMultiprocessorCount, dev);
        if (hipFuncSetAttribute((const void*)trunk_fwd, hipFuncAttributeMaxDynamicSharedMemorySize, LDS_BYTES) != hipSuccess) { fprintf(stderr, "kernel_launch: hipFuncSetAttribute failed\n"); }
        if (hipOccupancyMaxActiveBlocksPerMultiprocessor(&per_cu, (const void*)trunk_fwd, NTHR, LDS_BYTES) != hipSuccess || per_cu < 1) { fprintf(stderr, "kernel_launch: occupancy query says %d\n", per_cu); per_cu = 1; }
        (void)hipGetLastError();
        grid = cus * per_cu; if (grid > 256) grid = 256; if (grid < 1) grid = 256;
    }
    if (grid < 0) return;
    Args a{};
    for (int i = 0; i < 27; ++i) a.in[i] = (const float*)d_in[i];
    a.out = (float*)d_out; a.ws = (unsigned char*)d_ws;
    void* kargs[] = {&a};
    hipError_t e = hipLaunchCooperativeKernel((const void*)trunk_fwd, dim3(grid), dim3(NTHR), kargs, LDS_BYTES, stream);
    if (e != hipSuccess) fprintf(stderr, "cooperative launch failed: %s (grid %d)\n", hipGetErrorString(e), grid);
}
```
